# Optimizing an MI355X kernel written in HIP

```python
import math
import jax, jax.numpy as jnp
from jax import lax
import numpy as np

D_MODEL = 2048
BATCH = 8
SEQ = 2048
DEPTH = 2

HEAD_DIM = 128
N_HEADS = D_MODEL // HEAD_DIM
MIX_W = N_HEADS * HEAD_DIM
A_HEADS = 3 * N_HEADS // 8
C_HEADS = N_HEADS // 4
B_HEADS = N_HEADS - A_HEADS - C_HEADS
A_W = A_HEADS * HEAD_DIM
B_W = B_HEADS * HEAD_DIM
C_W = C_HEADS * HEAD_DIM
DIL_PATTERNS = ((128, 1), (512, 4), (2048, 16))
BAND_BLK = 128
NSA_KV = 2
NSA_GROUP = B_HEADS // NSA_KV
KV_W = NSA_KV * HEAD_DIM
CMP_LEN = 32
CMP_STRIDE = 16
SLC_LEN = 64
SLC_TOPN = 8
NSA_WINDOW = 512
FORCE = 1e4
MOBA_BLK = 256
MOBA_TOPK = 3
GATHER_QBLK = 16
REL_BUCKETS = 32
REL_MAX_DIST = 1024
PEER_HEADS = 8
PEER_NKEYS = 128
PEER_EXPERTS = PEER_NKEYS * PEER_NKEYS
PEER_DQ = 256
PEER_TOPK = 16
PEER_TOKBLK = 128
PLE_DIM = 256
EPS = 1e-6
PROJ_SPLITS = (A_W, A_W, A_W, B_W, KV_W, KV_W, KV_W, KV_W, KV_W, KV_W, 3 * B_HEADS, C_W, C_W, C_W)
PROJ_COLS = sum(PROJ_SPLITS)
PROJ_BOUNDS = tuple(int(c) for c in np.cumsum(PROJ_SPLITS)[:-1])

kernel_name = 'hybrid_dilated_nsa_moba_peer'


def rmsnorm(x, g):
    x32 = x.astype(jnp.float32)
    y = x32 * lax.rsqrt(jnp.mean(x32 * x32, axis=-1, keepdims=True) + EPS)
    return (y * g.astype(jnp.float32)).astype(x.dtype)


def rel_bucket(dist):
    exact = REL_BUCKETS // 2
    d = jnp.maximum(dist, 0)
    logd = jnp.log(jnp.maximum(d, 1).astype(jnp.float32) / exact)
    large = exact + (logd / math.log(REL_MAX_DIST / exact) * (REL_BUCKETS - exact)).astype(jnp.int32)
    large = jnp.clip(large, exact, REL_BUCKETS - 1)
    return jnp.where(d < exact, d, large)


def masked_softmax(s, mask):
    s = jnp.where(mask, s.astype(jnp.float32), -jnp.inf)
    m = jnp.max(s, axis=-1, keepdims=True)
    m = jnp.where(jnp.isfinite(m), m, 0.0)
    e = jnp.exp(s - m)
    z = jnp.sum(e, axis=-1, keepdims=True)
    zs = jnp.where(z > 0, z, 1.0)
    p = e / zs
    lse = jnp.where(z > 0, m + jnp.log(zs), -jnp.inf)
    return p, lse[..., 0]


def merge_partials(outs, lses):
    w = jax.nn.softmax(jnp.stack(lses, axis=0), axis=0)
    o = jnp.sum(w[..., None] * jnp.stack(outs, axis=0).astype(jnp.float32), axis=0)
    return o.astype(outs[0].dtype)


def banded_attention(q, k, v, n_back, dist_scale, bias_tab):
    n, l, h, hd = q.shape
    blk = BAND_BLK
    nb = l // blk
    npv = -(-n_back // blk)
    w = (npv + 1) * blk
    pad = ((0, 0), (npv * blk, 0), (0, 0), (0, 0))
    kb = jnp.pad(k, pad).reshape(n, nb + npv, blk, h, hd)
    vb = jnp.pad(v, pad).reshape(n, nb + npv, blk, h, hd)
    kwin = jnp.concatenate([kb[:, j:j + nb] for j in range(npv + 1)], axis=2)
    vwin = jnp.concatenate([vb[:, j:j + nb] for j in range(npv + 1)], axis=2)
    qb = q.reshape(n, nb, blk, h, hd)
    s = jnp.einsum('nbqhd,nbkhd->nbhqk', qb, kwin).astype(jnp.float32) * (hd ** -0.5)
    dist = jnp.arange(blk)[:, None] - jnp.arange(w)[None, :] + npv * blk
    bias = bias_tab[rel_bucket(dist * dist_scale)].astype(jnp.float32)
    s = s + jnp.transpose(bias, (2, 0, 1))
    kpos = jnp.arange(nb)[:, None] * blk + jnp.arange(w)[None, :] - npv * blk
    mask = ((dist >= 0) & (dist <= n_back))[None, :, :] & (kpos >= 0)[:, None, :]
    p, lse = masked_softmax(s, mask[None, :, None])
    o = jnp.einsum('nbhqk,nbkhd->nbqhd', p.astype(v.dtype), vwin)
    return o.reshape(n, l, h, hd), jnp.transpose(lse, (0, 1, 3, 2)).reshape(n, l, h)


def dilated_attention(q, k, v, bias_tab):
    b, s, h, hd = q.shape
    outs, lses = [], []
    for window, dil in DIL_PATTERNS:
        l = s // dil
        lp = -(-l // BAND_BLK) * BAND_BLK

        def to_res(t):
            t = t.reshape(b, l, dil, h, hd).transpose(0, 2, 1, 3, 4).reshape(b * dil, l, h, hd)
            return jnp.pad(t, ((0, 0), (0, lp - l), (0, 0), (0, 0)))

        o, lse = banded_attention(to_res(q), to_res(k), to_res(v), window // dil, dil, bias_tab)
        outs.append(o[:, :l].reshape(b, dil, l, h, hd).transpose(0, 2, 1, 3, 4).reshape(b, s, h, hd))
        lses.append(lse[:, :l].reshape(b, dil, l, h).transpose(0, 2, 1, 3).reshape(b, s, h))
    return merge_partials(outs, lses)


def nsa_attention(q, kc, vc, ks, vs, kw, vw, gates, cmp_wk, cmp_wv, cmp_pos, bias_tab):
    b, s, h, hd = q.shape
    f32 = jnp.float32
    scale = hd ** -0.5
    pos = jnp.arange(s)
    qg = q.reshape(b, s, NSA_KV, NSA_GROUP, hd)
    ncmp = (s - CMP_LEN) // CMP_STRIDE + 1
    cidx = jnp.arange(ncmp)[:, None] * CMP_STRIDE + jnp.arange(CMP_LEN)[None, :]
    k_cmp = jnp.einsum('bnlgd,lde->bnge', kc[:, cidx] + cmp_pos[:, None, :], cmp_wk)
    v_cmp = jnp.einsum('bnlgd,lde->bnge', vc[:, cidx] + cmp_pos[:, None, :], cmp_wv)
    s_c = jnp.einsum('bqgrd,bngd->bgrqn', qg, k_cmp).astype(f32) * scale
    cend = jnp.arange(ncmp) * CMP_STRIDE + CMP_LEN - 1
    dist_c = pos[:, None] - cend[None, :]
    bias_c = bias_tab[rel_bucket(dist_c)].astype(f32).reshape(s, ncmp, NSA_KV, NSA_GROUP)
    s_c = s_c + bias_c.transpose(2, 3, 0, 1)
    p_c, _ = masked_softmax(s_c, dist_c >= 0)
    o_cmp = jnp.einsum('bgrqn,bngd->bqgrd', p_c.astype(vc.dtype), v_cmp).reshape(b, s, h, hd)
    nslc = s // SLC_LEN
    cstart = jnp.arange(ncmp) * CMP_STRIDE
    sstart = jnp.arange(nslc) * SLC_LEN
    cover = ((cstart[:, None] < sstart[None, :] + SLC_LEN)
             & (cstart[:, None] + CMP_LEN > sstart[None, :])).astype(f32)
    imp = jnp.einsum('bgrqn,nj->bgqj', p_c, cover)
    qblk = pos // SLC_LEN
    jb = jnp.arange(nslc)
    forced = (jb[None, :] == 0) | (jb[None, :] == qblk[:, None]) | (jb[None, :] == qblk[:, None] - 1)
    future = jb[None, :] > qblk[:, None]
    imp = jnp.where(forced, FORCE, jnp.where(future, -FORCE, imp))
    topn = min(SLC_TOPN, nslc)
    _, sel = lax.top_k(imp, topn)
    ksb = ks.transpose(0, 2, 1, 3).reshape(b, NSA_KV, nslc, SLC_LEN * hd)
    vsb = vs.transpose(0, 2, 1, 3).reshape(b, NSA_KV, nslc, SLC_LEN * hd)
    nq = s // GATHER_QBLK
    q_ch = qg.reshape(b, nq, GATHER_QBLK, NSA_KV, NSA_GROUP, hd).transpose(1, 0, 2, 3, 4, 5)
    sel_ch = sel.reshape(b, NSA_KV, nq, GATHER_QBLK, topn).transpose(2, 0, 1, 3, 4)
    tab = bias_tab.reshape(REL_BUCKETS, NSA_KV, NSA_GROUP)
    bi = jnp.arange(b)[:, None, None]
    gi = jnp.arange(NSA_KV)[None, :, None]
    kk_len = topn * SLC_LEN

    def sel_block(args):
        ci, qc, ic = args
        flat = ic.reshape(b, NSA_KV, GATHER_QBLK * topn)
        kk = ksb[bi, gi, flat].reshape(b, NSA_KV, GATHER_QBLK, kk_len, hd)
        vv = vsb[bi, gi, flat].reshape(b, NSA_KV, GATHER_QBLK, kk_len, hd)
        sc = jnp.einsum('bqgrd,bgqkd->bgrqk', qc, kk).astype(f32) * scale
        qpos = ci * GATHER_QBLK + jnp.arange(GATHER_QBLK)
        kpos = (ic[..., None] * SLC_LEN + jnp.arange(SLC_LEN)).reshape(b, NSA_KV, GATHER_QBLK, kk_len)
        dist = qpos[None, None, :, None] - kpos
        bias = tab[rel_bucket(dist), jnp.arange(NSA_KV)[None, :, None, None]].astype(f32)
        sc = sc + jnp.moveaxis(bias, -1, 2)
        p, _ = masked_softmax(sc, (dist >= 0)[:, :, None])
        return jnp.einsum('bgrqk,bgqkd->bqgrd', p.astype(vv.dtype), vv)

    o_sel = lax.map(sel_block, (jnp.arange(nq), q_ch, sel_ch))
    o_sel = o_sel.transpose(1, 0, 2, 3, 4, 5).reshape(b, s, h, hd)
    o_win, _ = banded_attention(q, jnp.repeat(kw, NSA_GROUP, axis=2), jnp.repeat(vw, NSA_GROUP, axis=2),
                                NSA_WINDOW - 1, 1, bias_tab)
    return gates[..., 0:1] * o_cmp + gates[..., 1:2] * o_sel + gates[..., 2:3] * o_win


def moba_attention(q, k, v, bias_tab):
    b, s, h, hd = q.shape
    f32 = jnp.float32
    scale = hd ** -0.5
    sp = -(-s // MOBA_BLK) * MOBA_BLK
    pad = ((0, 0), (0, sp - s), (0, 0), (0, 0))
    q, k, v = jnp.pad(q, pad), jnp.pad(k, pad), jnp.pad(v, pad)
    nblk = sp // MOBA_BLK
    qb = q.reshape(b, nblk, MOBA_BLK, h, hd)
    kb = k.reshape(b, nblk, MOBA_BLK, h, hd)
    vb = v.reshape(b, nblk, MOBA_BLK, h, hd)
    s_o = jnp.einsum('bnqhd,bnkhd->bnhqk', qb, kb).astype(f32) * scale
    dist_o = jnp.arange(MOBA_BLK)[:, None] - jnp.arange(MOBA_BLK)[None, :]
    s_o = s_o + jnp.transpose(bias_tab[rel_bucket(dist_o)].astype(f32), (2, 0, 1))
    p_o, lse_o = masked_softmax(s_o, dist_o >= 0)
    o_own = jnp.einsum('bnhqk,bnkhd->bnqhd', p_o.astype(v.dtype), vb).reshape(b, sp, h, hd)
    lse_own = jnp.transpose(lse_o, (0, 1, 3, 2)).reshape(b, sp, h)
    ntop = min(MOBA_TOPK, nblk - 1)
    if ntop == 0:
        return o_own[:, :s]
    kmean = jnp.mean(kb.astype(f32), axis=2)
    gate = jnp.einsum('bshd,bnhd->bhsn', q.astype(f32), kmean)
    qblk_all = jnp.arange(sp) // MOBA_BLK
    past = jnp.arange(nblk)[None, :] < qblk_all[:, None]
    gate = jnp.where(past, gate, -jnp.inf)
    _, sel = lax.top_k(gate, ntop)
    kbf = kb.transpose(0, 3, 1, 2, 4).reshape(b, h, nblk, MOBA_BLK * hd)
    vbf = vb.transpose(0, 3, 1, 2, 4).reshape(b, h, nblk, MOBA_BLK * hd)
    nq = sp // GATHER_QBLK
    q_ch = q.reshape(b, nq, GATHER_QBLK, h, hd).transpose(1, 0, 2, 3, 4)
    sel_ch = sel.reshape(b, h, nq, GATHER_QBLK, ntop).transpose(2, 0, 1, 3, 4)
    bi = jnp.arange(b)[:, None, None]
    hi = jnp.arange(h)[None, :, None]
    kk_len = ntop * MOBA_BLK

    def blk_fn(args):
        ci, qc, ic = args
        flat = ic.reshape(b, h, GATHER_QBLK * ntop)
        kk = kbf[bi, hi, flat].reshape(b, h, GATHER_QBLK, kk_len, hd)
        vv = vbf[bi, hi, flat].reshape(b, h, GATHER_QBLK, kk_len, hd)
        sc = jnp.einsum('bqhd,bhqkd->bhqk', qc, kk).astype(f32) * scale
        qpos = ci * GATHER_QBLK + jnp.arange(GATHER_QBLK)
        kpos = (ic[..., None] * MOBA_BLK + jnp.arange(MOBA_BLK)).reshape(b, h, GATHER_QBLK, kk_len)
        dist = qpos[None, None, :, None] - kpos
        sc = sc + bias_tab[rel_bucket(dist), jnp.arange(h)[None, :, None, None]].astype(f32)
        valid = ic < (qpos // MOBA_BLK)[None, None, :, None]
        p, lse = masked_softmax(sc, jnp.repeat(valid, MOBA_BLK, axis=-1))
        o = jnp.einsum('bhqk,bhqkd->bqhd', p.astype(vv.dtype), vv)
        return o, jnp.transpose(lse, (0, 2, 1))

    o_g, lse_g = lax.map(blk_fn, (jnp.arange(nq), q_ch, sel_ch))
    o_g = o_g.transpose(1, 0, 2, 3, 4).reshape(b, sp, h, hd)
    lse_g = lse_g.transpose(1, 0, 2, 3).reshape(b, sp, h)
    return merge_partials([o_own, o_g], [lse_own, lse_g])[:, :s]


def hybrid_mixer(a, w_in, cmp_wk, cmp_wv, cmp_pos, out_norm, w_out, rel_bias):
    b, s, _ = a.shape
    (qa, ka, va, qb, kc, vc, ks, vs, kw, vw, gt, qc, kc_c, vc_c) = jnp.split(a @ w_in, PROJ_BOUNDS, axis=-1)

    def hs(t):
        return t.reshape(b, s, -1, HEAD_DIM)

    tab_a = rel_bias[:, :A_HEADS]
    tab_b = rel_bias[:, A_HEADS:A_HEADS + B_HEADS]
    tab_c = rel_bias[:, A_HEADS + B_HEADS:]
    oa = dilated_attention(hs(qa), hs(ka), hs(va), tab_a)
    gates = jax.nn.sigmoid(gt.astype(jnp.float32)).astype(a.dtype).reshape(b, s, B_HEADS, 3)
    ob = nsa_attention(hs(qb), hs(kc), hs(vc), hs(ks), hs(vs), hs(kw), hs(vw), gates,
                       cmp_wk, cmp_wv, cmp_pos, tab_b)
    oc = moba_attention(hs(qc), hs(kc_c), hs(vc_c), tab_c)
    g_a, g_b, g_c = jnp.split(out_norm, [A_W, A_W + B_W])
    y = jnp.concatenate([rmsnorm(oa.reshape(b, s, A_W), g_a),
                         rmsnorm(ob.reshape(b, s, B_W), g_b),
                         rmsnorm(oc.reshape(b, s, C_W), g_c)], axis=-1)
    return y @ w_out


def peer_ffn(x, wq, subkeys, u, v):
    b, s, d = x.shape
    q = (x @ wq).reshape(b, s, PEER_HEADS, 2, PEER_DQ // 2)
    sc = jnp.einsum('bshcd,hckd->bshck', q, subkeys).astype(jnp.float32)
    top_s, top_i = lax.top_k(sc, PEER_TOPK)
    cand = top_s[..., 0, :, None] + top_s[..., 1, None, :]
    cand_i = top_i[..., 0, :, None] * PEER_NKEYS + top_i[..., 1, None, :]
    best_s, best_j = lax.top_k(cand.reshape(b, s, PEER_HEADS, PEER_TOPK * PEER_TOPK), PEER_TOPK)
    expert = jnp.take_along_axis(cand_i.reshape(b, s, PEER_HEADS, PEER_TOPK * PEER_TOPK), best_j, axis=-1)
    g = jax.nn.softmax(best_s, axis=-1)
    nt = (b * s) // PEER_TOKBLK
    hk = PEER_HEADS * PEER_TOPK
    xs = x.reshape(nt, PEER_TOKBLK, d)
    es = expert.reshape(nt, PEER_TOKBLK, hk)
    gs = g.reshape(nt, PEER_TOKBLK, hk).astype(x.dtype)

    def tok_fn(args):
        xc, ec, gc = args
        act = jax.nn.gelu(jnp.einsum('td,tkd->tk', xc, u[ec]), approximate=False)
        return jnp.einsum('tk,tkd->td', gc * act, v[ec])

    return lax.map(tok_fn, (xs, es, gs)).reshape(b, s, d)


def setup_inputs(seed: int = 0) -> dict:
    key = jax.random.key(seed)
    k = jax.random.split(key, 20)
    f32 = jnp.float32

    def nrm(kk, shape, scale):
        return jax.random.normal(kk, shape, f32) * scale

    return {
        'x': nrm(k[0], (BATCH, SEQ, D_MODEL), 1.0),
        'p': nrm(k[1], (DEPTH, BATCH, SEQ, PLE_DIM), 1.0),
        'ln_mix': 1.0 + nrm(k[2], (DEPTH, D_MODEL), 0.02),
        'w_in': nrm(k[3], (DEPTH, D_MODEL, PROJ_COLS), D_MODEL ** -0.5),
        'cmp_wk': nrm(k[4], (DEPTH, CMP_LEN, HEAD_DIM, HEAD_DIM), (CMP_LEN * HEAD_DIM) ** -0.5),
        'cmp_wv': nrm(k[5], (DEPTH, CMP_LEN, HEAD_DIM, HEAD_DIM), (CMP_LEN * HEAD_DIM) ** -0.5),
        'cmp_pos': nrm(k[6], (DEPTH, CMP_LEN, HEAD_DIM), 0.1),
        'out_norm': 1.0 + nrm(k[7], (DEPTH, MIX_W), 0.02),
        'w_out': nrm(k[8], (DEPTH, MIX_W, D_MODEL), MIX_W ** -0.5),
        'rel_bias': nrm(k[9], (REL_BUCKETS, N_HEADS), 0.5),
        'ln_ffn': 1.0 + nrm(k[10], (DEPTH, D_MODEL), 0.02),
        'peer_wq': nrm(k[11], (DEPTH, D_MODEL, PEER_HEADS * PEER_DQ), D_MODEL ** -0.5),
        'peer_keys': nrm(k[12], (DEPTH, PEER_HEADS, 2, PEER_NKEYS, PEER_DQ // 2), (PEER_DQ // 2) ** -0.5),
        'peer_u': nrm(k[13], (DEPTH, PEER_EXPERTS, D_MODEL), D_MODEL ** -0.5),
        'peer_v': nrm(k[14], (DEPTH, PEER_EXPERTS, D_MODEL), PEER_HEADS ** -0.5),
        'ln_ple': 1.0 + nrm(k[15], (DEPTH, D_MODEL), 0.02),
        'ple_gate': nrm(k[16], (DEPTH, D_MODEL, D_MODEL), D_MODEL ** -0.5),
        'ple_proj': nrm(k[17], (DEPTH, PLE_DIM, D_MODEL), PLE_DIM ** -0.5),
        'ln_final': 1.0 + nrm(k[18], (D_MODEL,), 0.02),
    }


def reference(x, p, ln_mix, w_in, cmp_wk, cmp_wv, cmp_pos, out_norm, w_out, rel_bias, ln_ffn,
              peer_wq, peer_keys, peer_u, peer_v, ln_ple, ple_gate, ple_proj, ln_final):
    h = x
    for i in range(DEPTH):
        h = h + hybrid_mixer(rmsnorm(h, ln_mix[i]), w_in[i], cmp_wk[i], cmp_wv[i], cmp_pos[i],
                             out_norm[i], w_out[i], rel_bias)
        h = h + peer_ffn(rmsnorm(h, ln_ffn[i]), peer_wq[i], peer_keys[i], peer_u[i], peer_v[i])
        gate = jax.nn.sigmoid((rmsnorm(h, ln_ple[i]) @ ple_gate[i]).astype(jnp.float32)).astype(h.dtype)
        h = h + gate * (p[i] @ ple_proj[i])
    return rmsnorm(h, ln_final)
```

```cpp
#include <hip/hip_runtime.h>
#include <cstdio>
#include <cstdint>

#define GAS __attribute__((address_space(1)))
#define LAS __attribute__((address_space(3)))
typedef unsigned short bf16;
typedef unsigned v4u __attribute__((ext_vector_type(4)));
typedef unsigned v2u __attribute__((ext_vector_type(2)));
typedef float f32x4 __attribute__((ext_vector_type(4)));

constexpr int NB = 8, S = 2048, T = NB * S, D = 2048, DEPTH = 2, HD = 128, PROJ = 6162;
constexpr int NTM = 34, NVT = 14;
constexpr int TM_A_Q = 0, TM_A_K = 6, TM_B_Q = 12, TM_B_KC = 18, TM_B_VC = 20, TM_B_KS = 22, TM_B_KW = 24, TM_C_Q = 26, TM_C_K = 30;
constexpr int VT_A_V = 0, VT_B_VS = 6, VT_B_VW = 8, VT_C_V = 10;
constexpr int GATE_COL0 = 4608;
constexpr int PLE = 256, NEXP = 16384;
constexpr float EPS = 1e-6f;
constexpr float QK_SCALE = 0.08838834764831845f;
#define NEG_INF (-__builtin_inff())

__host__ __device__ constexpr int tm_col0(int s) {
    return s < 6 ? 128 * s : s < 12 ? 768 + 128 * (s - 6) : s < 18 ? 2304 + 128 * (s - 12) : s < 20 ? 3072 + 128 * (s - 18) : s < 22 ? 3328 + 128 * (s - 20)
         : s < 24 ? 3584 + 128 * (s - 22) : s < 26 ? 4096 + 128 * (s - 24) : s < 30 ? 4626 + 128 * (s - 26) : 5138 + 128 * (s - 30);
}
__host__ __device__ constexpr int vt_col0(int v) {
    return v < 6 ? 1536 + 128 * v : v < 8 ? 3840 + 128 * (v - 6) : v < 10 ? 4352 + 128 * (v - 8) : 5650 + 128 * (v - 10);
}

constexpr size_t MiB = 1u << 20;
constexpr size_t align_up(size_t x) { return (x + 255) & ~(size_t)255; }
constexpr size_t WS_CTL = 0, CTL_BYTES = 1 * MiB;
constexpr size_t SZ_WINTM = (size_t)NTM * 128 * D * 2, SZ_WINVT = (size_t)NVT * 128 * D * 2, SZ_WSQ = (size_t)D * D * 2, SZ_WPROJ = (size_t)D * PLE * 2;
constexpr size_t WS_WINTM = WS_CTL + CTL_BYTES;
constexpr size_t WS_WINVT = WS_WINTM + DEPTH * SZ_WINTM;
constexpr size_t WS_WOUT = WS_WINVT + DEPTH * SZ_WINVT;
constexpr size_t WS_WQ = WS_WOUT + DEPTH * SZ_WSQ;
constexpr size_t WS_WGATE = WS_WQ + DEPTH * SZ_WSQ;
constexpr size_t WS_WPROJ = WS_WGATE + DEPTH * SZ_WSQ;
constexpr size_t WS_WG = WS_WPROJ + DEPTH * SZ_WPROJ;
constexpr size_t WS_KEYS = align_up(WS_WG + (size_t)DEPTH * 18 * D * 4);
constexpr size_t WS_CWT = WS_KEYS + (size_t)DEPTH * 16 * 128 * 128 * 2;
constexpr size_t WS_U = WS_CWT + (size_t)DEPTH * 2 * 128 * 4096 * 2;
constexpr size_t WS_V = WS_U + (size_t)DEPTH * NEXP * D * 2;
constexpr size_t WS_P = WS_V + (size_t)DEPTH * NEXP * D * 2;
constexpr size_t WS_TM = WS_P + (size_t)DEPTH * T * PLE * 2;
constexpr size_t WS_VT = WS_TM + (size_t)NB * NTM * S * 128 * 2;
constexpr size_t WS_KCMP = WS_VT + (size_t)NB * NVT * S * 128 * 2;
constexpr size_t WS_VCMPT = WS_KCMP + (size_t)NB * 2 * 128 * 128 * 2;
constexpr size_t WS_KMEAN = WS_VCMPT + (size_t)NB * 2 * 128 * 128 * 2;
constexpr size_t WS_GATES = WS_KMEAN + (size_t)NB * 8 * 4 * 128 * 4;
constexpr size_t WS_SS = align_up(WS_GATES + (size_t)T * 18 * 4);
constexpr size_t WS_OCMP = WS_SS + (size_t)T * 16 * 4;
constexpr size_t WS_SEL = WS_OCMP + (size_t)T * 768 * 4;
constexpr size_t WS_EXP = WS_SEL + (size_t)T * 16 * 4;
constexpr size_t WS_GW = WS_EXP + (size_t)T * 128 * 4;
constexpr size_t SZ_ACT = (size_t)T * D * 2;
constexpr size_t WS_ACT0 = WS_GW + (size_t)T * 128 * 4;
constexpr size_t WS_ACT1 = WS_ACT0 + SZ_ACT;
constexpr size_t WS_ACT2 = WS_ACT1 + SZ_ACT;
constexpr size_t WS_ACT3 = WS_ACT2 + SZ_ACT;
constexpr size_t WS_END = WS_ACT3 + SZ_ACT;
static_assert(WS_END <= (size_t)1024 * MiB, "workspace map exceeds 1 GiB");

__device__ __forceinline__ float bf2f(unsigned v) { return __uint_as_float(v << 16); }
__device__ __forceinline__ unsigned f2bf(float f) { unsigned u = __float_as_uint(f); return (u + 0x7fffu + ((u >> 16) & 1u)) >> 16; }
__device__ __forceinline__ unsigned pk2(float lo, float hi) { return f2bf(lo) | (f2bf(hi) << 16); }
__device__ __forceinline__ float wave_sum(float v) {
#pragma unroll
    for (int o = 1; o < 64; o <<= 1) v += __shfl_xor(v, o);
    return v;
}
__device__ __forceinline__ float wave_max(float v) {
#pragma unroll
    for (int o = 1; o < 64; o <<= 1) v = fmaxf(v, __shfl_xor(v, o));
    return v;
}
__device__ __forceinline__ int wave_min_i(int v) {
#pragma unroll
    for (int o = 1; o < 64; o <<= 1) { int t = __shfl_xor(v, o); v = t < v ? t : v; }
    return v;
}
__device__ __forceinline__ int rel_bucket(int d) {
    if (d < 16) return d < 0 ? 0 : d;
    return 16 + (d >= 21) + (d >= 27) + (d >= 35) + (d >= 46) + (d >= 59) + (d >= 77) + (d >= 99) + (d >= 128) + (d >= 166) + (d >= 216) + (d >= 280) + (d >= 363) + (d >= 470) + (d >= 609) + (d >= 790);
}
#define WAVE_LDS_SYNC() do { asm volatile("s_waitcnt lgkmcnt(0)" ::: "memory"); __builtin_amdgcn_wave_barrier(); } while (0)

struct Params {
    const float* in[19];
    float* out;
    unsigned char* ws;
};
enum { I_X = 0, I_P, I_LNMIX, I_WIN, I_CMPWK, I_CMPWV, I_CMPPOS, I_OUTNORM, I_WOUT, I_RELBIAS, I_LNFFN, I_PEERWQ, I_PEERKEYS, I_PEERU, I_PEERV, I_LNPLE, I_PLEGATE, I_PLEPROJ, I_LNFINAL };

__device__ __forceinline__ void transpose_tile(const float* src, int ldsrc, int scol0, int k0, bf16* dst, int dstride, int drow0, const float* scale, LAS float* scr, int lane) {
#pragma unroll 8
    for (int i = 0; i < 32; ++i) { const int kk = 2 * i + (lane >> 5); float v = src[(size_t)(k0 + kk) * ldsrc + scol0 + (lane & 31)]; if (scale) v *= scale[k0 + kk]; scr[kk * 33 + (lane & 31)] = v; }
    WAVE_LDS_SYNC();
    const int c = lane & 7;
#pragma unroll
    for (int j = 0; j < 4; ++j) { const int n = (lane >> 3) + 8 * j; const LAS float* s = scr + (8 * c) * 33 + n;
        v4u o; o.x = pk2(s[0 * 33], s[1 * 33]); o.y = pk2(s[2 * 33], s[3 * 33]); o.z = pk2(s[4 * 33], s[5 * 33]); o.w = pk2(s[6 * 33], s[7 * 33]);
        *(v4u*)(dst + (size_t)(drow0 + n) * dstride + k0 + 8 * c) = o; }
    WAVE_LDS_SYNC();
}
constexpr int TL_TM = 32 * NTM * 4, TL_VT = 32 * NVT * 4, TL_SQ = 32 * 64, TL_PROJ = 4 * 64, TL_CW = 64 * 4;
constexpr int TL_LAYER = TL_TM + TL_VT + 3 * TL_SQ + TL_PROJ + 2 * TL_CW;
__device__ __forceinline__ void prologue_tile(const Params& P, int item, LAS float* scr, int lane) {
    const int l = item / TL_LAYER; int r = item % TL_LAYER;
    unsigned char* ws = P.ws;
    if (r < TL_TM) { const int nb = r / 32, kb = r % 32, slot = nb / 4, sub = nb % 4;
        transpose_tile(P.in[I_WIN] + (size_t)l * D * PROJ, PROJ, tm_col0(slot) + 32 * sub, 64 * kb, (bf16*)(ws + WS_WINTM) + (size_t)l * NTM * 128 * D, D, slot * 128 + 32 * sub, nullptr, scr, lane); return; }
    r -= TL_TM;
    if (r < TL_VT) { const int nb = r / 32, kb = r % 32, slot = nb / 4, sub = nb % 4;
        transpose_tile(P.in[I_WIN] + (size_t)l * D * PROJ, PROJ, vt_col0(slot) + 32 * sub, 64 * kb, (bf16*)(ws + WS_WINVT) + (size_t)l * NVT * 128 * D, D, slot * 128 + 32 * sub, nullptr, scr, lane); return; }
    r -= TL_VT;
    if (r < TL_SQ) { const int nb = r / 32, kb = r % 32;
        transpose_tile(P.in[I_WOUT] + (size_t)l * D * D, D, 32 * nb, 64 * kb, (bf16*)(ws + WS_WOUT) + (size_t)l * D * D, D, 32 * nb, P.in[I_OUTNORM] + (size_t)l * D, scr, lane); return; }
    r -= TL_SQ;
    if (r < TL_SQ) { const int nb = r / 32, kb = r % 32;
        transpose_tile(P.in[I_PEERWQ] + (size_t)l * D * D, D, 32 * nb, 64 * kb, (bf16*)(ws + WS_WQ) + (size_t)l * D * D, D, 32 * nb, nullptr, scr, lane); return; }
    r -= TL_SQ;
    if (r < TL_SQ) { const int nb = r / 32, kb = r % 32;
        transpose_tile(P.in[I_PLEGATE] + (size_t)l * D * D, D, 32 * nb, 64 * kb, (bf16*)(ws + WS_WGATE) + (size_t)l * D * D, D, 32 * nb, nullptr, scr, lane); return; }
    r -= TL_SQ;
    if (r < TL_PROJ) { const int nb = r / 4, kb = r % 4;
        transpose_tile(P.in[I_PLEPROJ] + (size_t)l * PLE * D, D, 32 * nb, 64 * kb, (bf16*)(ws + WS_WPROJ) + (size_t)l * D * PLE, PLE, 32 * nb, nullptr, scr, lane); return; }
    r -= TL_PROJ;
    { const int which = r / TL_CW; r %= TL_CW; const int nb = r / 64, kb = r % 64;
      transpose_tile(P.in[which ? I_CMPWV : I_CMPWK] + (size_t)l * 4096 * 128, 128, 32 * nb, 64 * kb, (bf16*)(ws + WS_CWT) + ((size_t)l * 2 + which) * 128 * 4096, 4096, 32 * nb, nullptr, scr, lane); }
}
__device__ __forceinline__ void cvt_f32_bf16(const float* src, bf16* dst, size_t n, size_t i0, size_t stride) {
    for (size_t i = i0 * 8; i < n; i += stride * 8) {
        const f32x4 a = *(const f32x4*)(src + i), b = *(const f32x4*)(src + i + 4);
        v4u o; o.x = pk2(a.x, a.y); o.y = pk2(a.z, a.w); o.z = pk2(b.x, b.y); o.w = pk2(b.z, b.w);
        *(v4u*)(dst + i) = o;
    }
}
__device__ __forceinline__ void phase_prologue(const Params& P, int bid, int nb, LAS unsigned char* lds) {
    const int tid = threadIdx.x, lane = tid & 63, wave = tid >> 6, nw = blockDim.x >> 6;
    LAS float* scr = (LAS float*)lds + wave * (64 * 33);
    for (int it = bid * nw + wave; it < DEPTH * TL_LAYER; it += nb * nw) prologue_tile(P, it, scr, lane);
    const size_t gi = (size_t)bid * blockDim.x + tid, gs = (size_t)nb * blockDim.x;
    cvt_f32_bf16(P.in[I_PEERU], (bf16*)(P.ws + WS_U), (size_t)DEPTH * NEXP * D, gi, gs);
    cvt_f32_bf16(P.in[I_PEERV], (bf16*)(P.ws + WS_V), (size_t)DEPTH * NEXP * D, gi, gs);
    cvt_f32_bf16(P.in[I_P], (bf16*)(P.ws + WS_P), (size_t)DEPTH * T * PLE, gi, gs);
    cvt_f32_bf16(P.in[I_PEERKEYS], (bf16*)(P.ws + WS_KEYS), (size_t)DEPTH * 16 * 128 * 128, gi, gs);
    float* wg = (float*)(P.ws + WS_WG);
    for (size_t i = gi; i < (size_t)DEPTH * 18 * D; i += gs) { const int l = (int)(i / (18 * D)), j = (int)((i / D) % 18), k = (int)(i % D); wg[i] = P.in[I_WIN][(size_t)l * D * PROJ + (size_t)k * PROJ + GATE_COL0 + j]; }
}
__global__ void __launch_bounds__(512) k_prologue(Params P) {
    extern __shared__ __attribute__((aligned(16))) unsigned char lds[];
    phase_prologue(P, blockIdx.x, gridDim.x, (LAS unsigned char*)lds);
}

__device__ __forceinline__ float row_load_ss(const float* row, int lane, f32x4 (&v)[8]) {
    float s = 0.f;
#pragma unroll
    for (int j = 0; j < 8; ++j) { v[j] = *(const f32x4*)(row + (j * 64 + lane) * 4); s += v[j].x * v[j].x + v[j].y * v[j].y + v[j].z * v[j].z + v[j].w * v[j].w; }
    return wave_sum(s);
}
__device__ __forceinline__ void row_norm_store_bf16(f32x4 (&v)[8], float ss, const float* gain, bf16* orow, int lane) {
    const float r = 1.0f / sqrtf(ss * (1.0f / D) + EPS);
#pragma unroll
    for (int j = 0; j < 8; ++j) { const f32x4 g = *(const f32x4*)(gain + (j * 64 + lane) * 4); v[j] = v[j] * r * g;
        v2u o; o.x = pk2(v[j].x, v[j].y); o.y = pk2(v[j].z, v[j].w); *(v2u*)(orow + (j * 64 + lane) * 4) = o; }
}
__device__ __forceinline__ void phase_norm_mix(const Params& P, int l, int bid, int nb) {
    const int tid = threadIdx.x, lane = tid & 63, wave = tid >> 6, nw = blockDim.x >> 6;
    const float* hsrc = l == 0 ? P.in[I_X] : P.out;
    bf16* a = (bf16*)(P.ws + WS_ACT0); float* gates = (float*)(P.ws + WS_GATES); const float* wg = (const float*)(P.ws + WS_WG) + (size_t)l * 18 * D;
    for (int t = bid * nw + wave; t < T; t += nb * nw) {
        f32x4 v[8]; const float ss = row_load_ss(hsrc + (size_t)t * D, lane, v);
        row_norm_store_bf16(v, ss, P.in[I_LNMIX] + (size_t)l * D, a + (size_t)t * D, lane);
        for (int c = 0; c < 18; ++c) { float s = 0.f;
#pragma unroll
            for (int j = 0; j < 8; ++j) { const f32x4 w = *(const f32x4*)(wg + (size_t)c * D + (j * 64 + lane) * 4); s += v[j].x * w.x + v[j].y * w.y + v[j].z * w.z + v[j].w * w.w; }
            s = wave_sum(s);
            if (lane == 0) gates[(size_t)t * 18 + c] = 1.0f / (1.0f + __expf(-s)); }
    }
}
__device__ __forceinline__ void phase_norm(const float* src, const float* gain, bf16* dst, int bid, int nb) {
    const int tid = threadIdx.x, lane = tid & 63, wave = tid >> 6, nw = blockDim.x >> 6;
    for (int t = bid * nw + wave; t < T; t += nb * nw) { f32x4 v[8]; const float ss = row_load_ss(src + (size_t)t * D, lane, v); row_norm_store_bf16(v, ss, gain, dst + (size_t)t * D, lane); }
}
__device__ __forceinline__ void phase_final(const Params& P, int bid, int nb) {
    const int tid = threadIdx.x, lane = tid & 63, wave = tid >> 6, nw = blockDim.x >> 6;
    for (int t = bid * nw + wave; t < T; t += nb * nw) { f32x4 v[8]; float* row = P.out + (size_t)t * D; const float ss = row_load_ss(row, lane, v);
        const float r = 1.0f / sqrtf(ss * (1.0f / D) + EPS);
#pragma unroll
        for (int j = 0; j < 8; ++j) { const f32x4 g = *(const f32x4*)(P.in[I_LNFINAL] + (j * 64 + lane) * 4); *(f32x4*)(row + (j * 64 + lane) * 4) = v[j] * r * g; } }
}
__device__ __forceinline__ void phase_ynorm(const Params& P, int bid, int nb) {
    const int tid = threadIdx.x, lane = tid & 63, wave = tid >> 6, nw = blockDim.x >> 6;
    const bf16* o = (const bf16*)(P.ws + WS_ACT1); bf16* y = (bf16*)(P.ws + WS_ACT2); const float* ss = (const float*)(P.ws + WS_SS);
    for (int t = bid * nw + wave; t < T; t += nb * nw) {
        const float sv = lane < 16 ? ss[(size_t)t * 16 + lane] : 0.f;
        float sa = lane < 6 ? sv : 0.f, sb = (lane >= 6 && lane < 12) ? sv : 0.f, sc = (lane >= 12 && lane < 16) ? sv : 0.f;
        sa = wave_sum(sa); sb = wave_sum(sb); sc = wave_sum(sc);
        const float ra = 1.0f / sqrtf(sa * (1.0f / 768.f) + EPS), rb = 1.0f / sqrtf(sb * (1.0f / 768.f) + EPS), rc = 1.0f / sqrtf(sc * (1.0f / 512.f) + EPS);
#pragma unroll
        for (int j = 0; j < 4; ++j) { const int c0 = (j * 64 + lane) * 8; const float r = c0 < 768 ? ra : c0 < 1536 ? rb : rc;
            const v4u w = *(const v4u*)(o + (size_t)t * D + c0); v4u q;
            q.x = pk2(bf2f(w.x & 0xffff) * r, bf2f(w.x >> 16) * r); q.y = pk2(bf2f(w.y & 0xffff) * r, bf2f(w.y >> 16) * r);
            q.z = pk2(bf2f(w.z & 0xffff) * r, bf2f(w.z >> 16) * r); q.w = pk2(bf2f(w.w & 0xffff) * r, bf2f(w.w >> 16) * r);
            *(v4u*)(y + (size_t)t * D + c0) = q; }
    }
}
__global__ void __launch_bounds__(512) k_norm_mix(Params P, int l) { phase_norm_mix(P, l, blockIdx.x, gridDim.x); }
__global__ void __launch_bounds__(512) k_norm_ffn(Params P, int l) { phase_norm(P.out, P.in[I_LNFFN] + (size_t)l * D, (bf16*)(P.ws + WS_ACT0), blockIdx.x, gridDim.x); }
__global__ void __launch_bounds__(512) k_final(Params P) { phase_final(P, blockIdx.x, gridDim.x); }
__global__ void __launch_bounds__(512) k_ynorm(Params P) { phase_ynorm(P, blockIdx.x, gridDim.x); }

struct EpiProjTM {
    bf16* tm;
    __device__ __forceinline__ void elem(int R, int C, float v) const { const int b = R >> 11, s = R & 2047, slot = C >> 7, d = C & 127; tm[(((size_t)b * NTM + slot) * S + s) * 128 + d] = (bf16)f2bf(v); }
};
struct EpiProjVT {
    bf16* vt;
    __device__ __forceinline__ void elem(int R, int C, float v) const { const int b = C >> 11, s = C & 2047, slot = R >> 7, d = R & 127; vt[(((size_t)b * NVT + slot) * 128 + d) * S + s] = (bf16)f2bf(v); }
};
struct EpiResid {
    const float* base; float* out;
    __device__ __forceinline__ void elem(int R, int C, float v) const { out[(size_t)R * D + C] = base[(size_t)R * D + C] + v; }
};
struct EpiStoreBf16 {
    bf16* o;
    __device__ __forceinline__ void elem(int R, int C, float v) const { o[(size_t)R * D + C] = (bf16)f2bf(v); }
};
struct EpiPleGate {
    float* out; const bf16* pp;
    __device__ __forceinline__ void elem(int R, int C, float v) const { const size_t i = (size_t)R * D + C; out[i] = out[i] + (1.0f / (1.0f + __expf(-v))) * bf2f(pp[i]); }
};

template <class Epi>
__global__ void __launch_bounds__(256) k_gemm_naive(const bf16* Aside, const bf16* Bside, int K, int nR, int nC, Epi E) {
    __shared__ float As[32][68], Bs[32][68];
    const int tid = threadIdx.x, tx = tid & 15, ty = tid >> 4;
    const int r0 = blockIdx.y * 64, c0 = blockIdx.x * 64;
    float acc[4][4];
#pragma unroll
    for (int i = 0; i < 4; ++i)
#pragma unroll
        for (int j = 0; j < 4; ++j) acc[i][j] = 0.f;
    const int lr = tid >> 2, lk = (tid & 3) * 8;
    for (int k0 = 0; k0 < K; k0 += 32) {
        const v4u av = *(const v4u*)(Aside + (size_t)(r0 + lr) * K + k0 + lk), bv = *(const v4u*)(Bside + (size_t)(c0 + lr) * K + k0 + lk);
        __syncthreads();
        As[lk + 0][lr] = bf2f(av.x & 0xffff); As[lk + 1][lr] = bf2f(av.x >> 16); As[lk + 2][lr] = bf2f(av.y & 0xffff); As[lk + 3][lr] = bf2f(av.y >> 16);
        As[lk + 4][lr] = bf2f(av.z & 0xffff); As[lk + 5][lr] = bf2f(av.z >> 16); As[lk + 6][lr] = bf2f(av.w & 0xffff); As[lk + 7][lr] = bf2f(av.w >> 16);
        Bs[lk + 0][lr] = bf2f(bv.x & 0xffff); Bs[lk + 1][lr] = bf2f(bv.x >> 16); Bs[lk + 2][lr] = bf2f(bv.y & 0xffff); Bs[lk + 3][lr] = bf2f(bv.y >> 16);
        Bs[lk + 4][lr] = bf2f(bv.z & 0xffff); Bs[lk + 5][lr] = bf2f(bv.z >> 16); Bs[lk + 6][lr] = bf2f(bv.w & 0xffff); Bs[lk + 7][lr] = bf2f(bv.w >> 16);
        __syncthreads();
#pragma unroll
        for (int kk = 0; kk < 32; ++kk) {
            const f32x4 a = *(const f32x4*)&As[kk][ty * 4], b = *(const f32x4*)&Bs[kk][tx * 4];
            const float aa[4] = {a.x, a.y, a.z, a.w}, bb[4] = {b.x, b.y, b.z, b.w};
#pragma unroll
            for (int i = 0; i < 4; ++i)
#pragma unroll
                for (int j = 0; j < 4; ++j) acc[i][j] += aa[i] * bb[j];
        }
    }
#pragma unroll
    for (int i = 0; i < 4; ++i)
#pragma unroll
        for (int j = 0; j < 4; ++j) E.elem(r0 + ty * 4 + i, c0 + tx * 4 + j, acc[i][j]);
}

__global__ void __launch_bounds__(256) k_prep_cmp(Params P, int l) {
    const int bgn = blockIdx.x, n = bgn & 127, g = (bgn >> 7) & 1, b = bgn >> 8;
    const int tid = threadIdx.x, which = tid >> 7, e = tid & 127;
    const bf16* tm = (const bf16*)(P.ws + WS_TM);
    const bf16* src = tm + (((size_t)b * NTM + (which ? TM_B_VC : TM_B_KC) + g) * S) * 128;
    const float* w = P.in[which ? I_CMPWV : I_CMPWK] + (size_t)l * 32 * 128 * 128; const float* pos = P.in[I_CMPPOS] + (size_t)l * 32 * 128;
    float acc = 0.f;
    if (n < 127) for (int ll = 0; ll < 32; ++ll) for (int d = 0; d < 128; ++d) acc += (bf2f(src[(size_t)(16 * n + ll) * 128 + d]) + pos[ll * 128 + d]) * w[((size_t)ll * 128 + d) * 128 + e];
    if (which == 0) ((bf16*)(P.ws + WS_KCMP))[(((size_t)b * 2 + g) * 128 + n) * 128 + e] = (bf16)f2bf(acc);
    else ((bf16*)(P.ws + WS_VCMPT))[(((size_t)b * 2 + g) * 128 + e) * 128 + n] = (bf16)f2bf(acc);
}
__global__ void __launch_bounds__(128) k_prep_kmean(Params P) {
    const int id = blockIdx.x, h = id & 3, blk = (id >> 2) & 7, b = id >> 5, d = threadIdx.x;
    const bf16* k = (const bf16*)(P.ws + WS_TM) + (((size_t)b * NTM + TM_C_K + h) * S + blk * 256) * 128;
    float s = 0.f; for (int j = 0; j < 256; ++j) s += bf2f(k[(size_t)j * 128 + d]);
    ((float*)(P.ws + WS_KMEAN))[(((size_t)b * 8 + blk) * 4 + h) * 128 + d] = s * (1.0f / 256.f);
}

struct KeyRef { const bf16* krow; int vkey; int dist; bool valid; };
template <class F>
__device__ __forceinline__ void naive_attend(const LAS float* qs, LAS float* sc, int n, F f, const float* biascol, const bf16* Vt, int vstride, int lane, float& o0, float& o1, float& lse, float& zinv) {
    float mx = NEG_INF;
    for (int idx = lane; idx < n; idx += 64) {
        const KeyRef kr = f(idx); float s = NEG_INF;
        if (kr.valid) { float dot = 0.f;
#pragma unroll 4
            for (int c = 0; c < 16; ++c) { const v4u w = *(const v4u*)(kr.krow + c * 8); const f32x4 qa = *(const LAS f32x4*)(qs + c * 8), qb = *(const LAS f32x4*)(qs + c * 8 + 4);
                dot += bf2f(w.x & 0xffff) * qa.x + bf2f(w.x >> 16) * qa.y + bf2f(w.y & 0xffff) * qa.z + bf2f(w.y >> 16) * qa.w + bf2f(w.z & 0xffff) * qb.x + bf2f(w.z >> 16) * qb.y + bf2f(w.w & 0xffff) * qb.z + bf2f(w.w >> 16) * qb.w; }
            s = dot * QK_SCALE + biascol[rel_bucket(kr.dist) * 16]; }
        sc[idx] = s; mx = fmaxf(mx, s);
    }
    mx = wave_max(mx); const float m = (mx > NEG_INF) ? mx : 0.f;
    WAVE_LDS_SYNC();
    float z = 0.f;
    for (int idx = lane; idx < n; idx += 64) { const float e = __expf(sc[idx] - m); sc[idx] = e; z += e; }
    z = wave_sum(z); const float zs = z > 0.f ? z : 1.f;
    WAVE_LDS_SYNC();
    float a0 = 0.f, a1 = 0.f;
    for (int idx = 0; idx < n; ++idx) { const float p = sc[idx]; if (p != 0.f) { const KeyRef kr = f(idx); a0 += p * bf2f(Vt[(size_t)(2 * lane) * vstride + kr.vkey]); a1 += p * bf2f(Vt[(size_t)(2 * lane + 1) * vstride + kr.vkey]); } }
    zinv = 1.0f / zs; o0 = a0 * zinv; o1 = a1 * zinv; lse = z > 0.f ? m + __logf(zs) : NEG_INF;
}
__device__ __forceinline__ void load_q_lds(const bf16* qrow, LAS float* qs, int lane) { qs[2 * lane] = bf2f(qrow[2 * lane]); qs[2 * lane + 1] = bf2f(qrow[2 * lane + 1]); WAVE_LDS_SYNC(); }

__global__ void __launch_bounds__(256) k_attn_A(Params P) {
    __shared__ float qsm[4][128]; __shared__ float scm[4][2048];
    const int wave = threadIdx.x >> 6, lane = threadIdx.x & 63; const int id = blockIdx.x * 4 + wave;
    const int i = id & 2047, h = (id >> 11) % 6, b = id / (6 * S);
    const bf16* tm = (const bf16*)(P.ws + WS_TM); const bf16* vt = (const bf16*)(P.ws + WS_VT);
    const bf16* Q = tm + (((size_t)b * NTM + TM_A_Q + h) * S) * 128; const bf16* K = tm + (((size_t)b * NTM + TM_A_K + h) * S) * 128; const bf16* V = vt + (((size_t)b * NVT + VT_A_V + h) * 128) * S;
    LAS float* qs = (LAS float*)qsm[wave]; LAS float* sc = (LAS float*)scm[wave];
    load_q_lds(Q + (size_t)i * 128, qs, lane);
    const float* biascol = P.in[I_RELBIAS] + h;
    float o0[3], o1[3], lse[3], zi;
    const int dils[3] = {1, 4, 16};
#pragma unroll
    for (int p = 0; p < 3; ++p) { const int dil = dils[p]; const int nk = min(128, i / dil) + 1;
        naive_attend(qs, sc, nk, [&](int idx) { KeyRef r; const int j = i - idx * dil; r.krow = K + (size_t)j * 128; r.vkey = j; r.dist = idx * dil; r.valid = true; return r; }, biascol, V, S, lane, o0[p], o1[p], lse[p], zi);
        WAVE_LDS_SYNC(); }
    const float m = fmaxf(lse[0], fmaxf(lse[1], lse[2])); const float w0 = __expf(lse[0] - m), w1 = __expf(lse[1] - m), w2 = __expf(lse[2] - m), wi = 1.0f / (w0 + w1 + w2);
    const float r0 = (w0 * o0[0] + w1 * o0[1] + w2 * o0[2]) * wi, r1 = (w0 * o1[0] + w1 * o1[1] + w2 * o1[2]) * wi;
    const size_t t = (size_t)b * S + i; bf16* o = (bf16*)(P.ws + WS_ACT1);
    *(unsigned*)(o + t * D + h * 128 + 2 * lane) = pk2(r0, r1);
    const float ssq = wave_sum(r0 * r0 + r1 * r1); if (lane == 0) ((float*)(P.ws + WS_SS))[t * 16 + h] = ssq;
}
__global__ void __launch_bounds__(256) k_attn_B1(Params P) {
    __shared__ float qsm[4][128]; __shared__ float scm[4][128]; __shared__ float impm[4][32];
    const int wave = threadIdx.x >> 6, lane = threadIdx.x & 63; const int id = blockIdx.x * 4 + wave;
    const int i = id & 2047, g = (id >> 11) & 1, b = id >> 12;
    const bf16* tm = (const bf16*)(P.ws + WS_TM);
    const bf16* Kc = (const bf16*)(P.ws + WS_KCMP) + ((size_t)b * 2 + g) * 128 * 128; const bf16* Vc = (const bf16*)(P.ws + WS_VCMPT) + ((size_t)b * 2 + g) * 128 * 128;
    LAS float* qs = (LAS float*)qsm[wave]; LAS float* sc = (LAS float*)scm[wave]; LAS float* imp = (LAS float*)impm[wave];
    const size_t t = (size_t)b * S + i; const float* gates = (const float*)(P.ws + WS_GATES) + t * 18; float* ocmp = (float*)(P.ws + WS_OCMP) + t * 768;
    const int ncv = i >= 31 ? (i - 31) / 16 + 1 : 0;
    if (lane < 32) imp[lane] = 0.f;
    WAVE_LDS_SYNC();
    for (int r = 0; r < 3; ++r) { const int h = g * 3 + r;
        load_q_lds(tm + (((size_t)b * NTM + TM_B_Q + h) * S + i) * 128, qs, lane);
        float o0, o1, lse, zi;
        naive_attend(qs, sc, ncv, [&](int n) { KeyRef kr; kr.krow = Kc + (size_t)n * 128; kr.vkey = n; kr.dist = i - (16 * n + 31); kr.valid = true; return kr; }, P.in[I_RELBIAS] + 6 + h, Vc, 128, lane, o0, o1, lse, zi);
        const float g0 = gates[h * 3 + 0];
        ocmp[h * 128 + 2 * lane] = g0 * o0; ocmp[h * 128 + 2 * lane + 1] = g0 * o1;
        WAVE_LDS_SYNC();
        if (lane < 32) { float a = 0.f; for (int n = 4 * lane - 1; n <= 4 * lane + 3; ++n) if (n >= 0 && n < ncv) a += sc[n] * zi; imp[lane] += a; }
        WAVE_LDS_SYNC(); }
    const int qblk = i >> 6; float val = NEG_INF;
    if (lane < 32) { val = imp[lane]; if (lane == 0 || lane == qblk || lane == qblk - 1) val = 1e4f; else if (lane > qblk) val = -1e4f; }
    int* sel = (int*)(P.ws + WS_SEL) + (t * 2 + g) * 8;
    for (int k = 0; k < 8; ++k) { const float m = wave_max(val); const int mi = wave_min_i(val == m ? lane : 1 << 30); if (lane == mi) val = NEG_INF; if (lane == 0) sel[k] = mi; }
}
__global__ void __launch_bounds__(256) k_attn_B2(Params P) {
    __shared__ float qsm[4][128]; __shared__ float scm[4][512];
    const int wave = threadIdx.x >> 6, lane = threadIdx.x & 63; const int id = blockIdx.x * 4 + wave;
    const int i = id & 2047, h = (id >> 11) % 6, b = id / (6 * S), g = h / 3;
    const bf16* tm = (const bf16*)(P.ws + WS_TM); const bf16* vt = (const bf16*)(P.ws + WS_VT);
    const bf16* Ks = tm + (((size_t)b * NTM + TM_B_KS + g) * S) * 128; const bf16* Kw = tm + (((size_t)b * NTM + TM_B_KW + g) * S) * 128;
    const bf16* Vs = vt + (((size_t)b * NVT + VT_B_VS + g) * 128) * S; const bf16* Vw = vt + (((size_t)b * NVT + VT_B_VW + g) * 128) * S;
    LAS float* qs = (LAS float*)qsm[wave]; LAS float* sc = (LAS float*)scm[wave];
    const size_t t = (size_t)b * S + i; const float* gates = (const float*)(P.ws + WS_GATES) + t * 18; const float* ocmp = (const float*)(P.ws + WS_OCMP) + t * 768;
    const int* sel = (const int*)(P.ws + WS_SEL) + (t * 2 + g) * 8;
    load_q_lds(tm + (((size_t)b * NTM + TM_B_Q + h) * S + i) * 128, qs, lane);
    const float* biascol = P.in[I_RELBIAS] + 6 + h;
    float s0, s1, w0, w1, lse, zi;
    naive_attend(qs, sc, 512, [&](int idx) { KeyRef kr; const int key = sel[idx >> 6] * 64 + (idx & 63); kr.krow = Ks + (size_t)key * 128; kr.vkey = key; kr.dist = i - key; kr.valid = key <= i; return kr; }, biascol, Vs, S, lane, s0, s1, lse, zi);
    WAVE_LDS_SYNC();
    naive_attend(qs, sc, min(511, i) + 1, [&](int idx) { KeyRef kr; const int j = i - idx; kr.krow = Kw + (size_t)j * 128; kr.vkey = j; kr.dist = idx; kr.valid = true; return kr; }, biascol, Vw, S, lane, w0, w1, lse, zi);
    const float g1 = gates[h * 3 + 1], g2 = gates[h * 3 + 2];
    const float r0 = ocmp[h * 128 + 2 * lane] + g1 * s0 + g2 * w0, r1 = ocmp[h * 128 + 2 * lane + 1] + g1 * s1 + g2 * w1;
    bf16* o = (bf16*)(P.ws + WS_ACT1);
    *(unsigned*)(o + t * D + (6 + h) * 128 + 2 * lane) = pk2(r0, r1);
    const float ssq = wave_sum(r0 * r0 + r1 * r1); if (lane == 0) ((float*)(P.ws + WS_SS))[t * 16 + 6 + h] = ssq;
}
__global__ void __launch_bounds__(256) k_attn_C(Params P) {
    __shared__ float qsm[4][128]; __shared__ float scm[4][768];
    const int wave = threadIdx.x >> 6, lane = threadIdx.x & 63; const int id = blockIdx.x * 4 + wave;
    const int i = id & 2047, h = (id >> 11) & 3, b = id >> 13;
    const bf16* tm = (const bf16*)(P.ws + WS_TM); const bf16* vt = (const bf16*)(P.ws + WS_VT);
    const bf16* K = tm + (((size_t)b * NTM + TM_C_K + h) * S) * 128; const bf16* V = vt + (((size_t)b * NVT + VT_C_V + h) * 128) * S;
    LAS float* qs = (LAS float*)qsm[wave]; LAS float* sc = (LAS float*)scm[wave];
    load_q_lds(tm + (((size_t)b * NTM + TM_C_Q + h) * S + i) * 128, qs, lane);
    const float* biascol = P.in[I_RELBIAS] + 12 + h;
    const int qblk = i >> 8, blk0 = qblk << 8;
    float a0, a1, lseo, zi;
    naive_attend(qs, sc, i - blk0 + 1, [&](int idx) { KeyRef kr; const int j = blk0 + idx; kr.krow = K + (size_t)j * 128; kr.vkey = j; kr.dist = i - j; kr.valid = true; return kr; }, biascol, V, S, lane, a0, a1, lseo, zi);
    WAVE_LDS_SYNC();
    const float* km = (const float*)(P.ws + WS_KMEAN) + (size_t)b * 8 * 4 * 128;
    float gv = NEG_INF;
    { float part[8];
#pragma unroll
      for (int n = 0; n < 8; ++n) part[n] = wave_sum(qs[2 * lane] * km[((size_t)n * 4 + h) * 128 + 2 * lane] + qs[2 * lane + 1] * km[((size_t)n * 4 + h) * 128 + 2 * lane + 1]);
#pragma unroll
      for (int n = 0; n < 8; ++n) if (lane == n && n < qblk) gv = part[n]; }
    int selb[3];
#pragma unroll
    for (int k = 0; k < 3; ++k) { const float m = wave_max(gv); const int mi = wave_min_i((gv == m && lane < 8) ? lane : 1 << 30); if (lane == mi) gv = __builtin_nanf(""); selb[k] = mi; }
    float b0, b1, lseg;
    naive_attend(qs, sc, 768, [&](int idx) { KeyRef kr; const int sb = idx < 256 ? selb[0] : idx < 512 ? selb[1] : selb[2]; const int key = sb * 256 + (idx & 255); kr.krow = K + (size_t)key * 128; kr.vkey = key; kr.dist = i - key; kr.valid = sb < qblk; return kr; }, biascol, V, S, lane, b0, b1, lseg, zi);
    float r0, r1;
    if (lseg == NEG_INF) { r0 = a0; r1 = a1; }
    else { const float m = fmaxf(lseo, lseg), wo = __expf(lseo - m), wg = __expf(lseg - m), wi = 1.0f / (wo + wg); r0 = (wo * a0 + wg * b0) * wi; r1 = (wo * a1 + wg * b1) * wi; }
    const size_t t = (size_t)b * S + i; bf16* o = (bf16*)(P.ws + WS_ACT1);
    *(unsigned*)(o + t * D + (12 + h) * 128 + 2 * lane) = pk2(r0, r1);
    const float ssq = wave_sum(r0 * r0 + r1 * r1); if (lane == 0) ((float*)(P.ws + WS_SS))[t * 16 + 12 + h] = ssq;
}

template <int NV>
__device__ __forceinline__ void wave_top16(float (&v)[NV], int idx0, int istep, int lane, float& outv, int& outi) {
    outv = 0.f; outi = 0;
    for (int k = 0; k < 16; ++k) {
        float bv = v[0]; int bi = idx0;
#pragma unroll
        for (int e = 1; e < NV; ++e) if (v[e] > bv) { bv = v[e]; bi = idx0 + e * istep; }
        const float m = wave_max(bv); const int mi = wave_min_i(bv == m ? bi : 1 << 30);
#pragma unroll
        for (int e = 0; e < NV; ++e) if (idx0 + e * istep == mi) v[e] = NEG_INF;
        if (lane == k) { outv = m; outi = mi; }
    }
}
__global__ void __launch_bounds__(256) k_peer_select_naive(Params P, int l) {
    __shared__ float qsm[4][256];
    const int wave = threadIdx.x >> 6, lane = threadIdx.x & 63; const int id = blockIdx.x * 4 + wave; const int h = id & 7; const size_t t = id >> 3;
    const bf16* q = (const bf16*)(P.ws + WS_ACT1) + t * D + h * 256; LAS float* qs = (LAS float*)qsm[wave];
#pragma unroll
    for (int j = 0; j < 4; ++j) qs[lane * 4 + j] = bf2f(q[lane * 4 + j]);
    WAVE_LDS_SYNC();
    float tv[2]; int ti[2];
#pragma unroll
    for (int c = 0; c < 2; ++c) {
        const float* keys = P.in[I_PEERKEYS] + ((((size_t)l * 8 + h) * 2 + c) * 128) * 128;
        float sc[2] = {0.f, 0.f};
        for (int d = 0; d < 128; d += 4) { const f32x4 qq = *(const LAS f32x4*)(qs + c * 128 + d); const f32x4 k0 = *(const f32x4*)(keys + (size_t)lane * 128 + d), k1 = *(const f32x4*)(keys + (size_t)(lane + 64) * 128 + d);
            sc[0] += qq.x * k0.x + qq.y * k0.y + qq.z * k0.z + qq.w * k0.w; sc[1] += qq.x * k1.x + qq.y * k1.y + qq.z * k1.z + qq.w * k1.w; }
        wave_top16<2>(sc, lane, 64, lane, tv[c], ti[c]);
    }
    float cv[4];
    const float s0 = __shfl(tv[0], lane >> 2);
#pragma unroll
    for (int e = 0; e < 4; ++e) cv[e] = s0 + __shfl(tv[1], (lane & 3) * 4 + e);
    float bs; int bj; wave_top16<4>(cv, lane * 4, 1, lane, bs, bj);
    const int ei = __shfl(ti[0], bj >> 4) * 128 + __shfl(ti[1], bj & 15);
    const float m = __shfl(bs, 0); float e = lane < 16 ? __expf(bs - m) : 0.f; const float z = wave_sum(e);
    if (lane < 16) { ((int*)(P.ws + WS_EXP))[t * 128 + h * 16 + lane] = ei; ((float*)(P.ws + WS_GW))[t * 128 + h * 16 + lane] = e / z; }
}
__device__ __forceinline__ void unpack8(const v4u w, float (&f)[8]) { f[0] = bf2f(w.x & 0xffff); f[1] = bf2f(w.x >> 16); f[2] = bf2f(w.y & 0xffff); f[3] = bf2f(w.y >> 16); f[4] = bf2f(w.z & 0xffff); f[5] = bf2f(w.z >> 16); f[6] = bf2f(w.w & 0xffff); f[7] = bf2f(w.w >> 16); }
__device__ __forceinline__ void phase_peer_apply(const Params& P, int l, int bid, int nb) {
    const int tid = threadIdx.x, lane = tid & 63, wave = tid >> 6, nw = blockDim.x >> 6;
    const bf16* xf = (const bf16*)(P.ws + WS_ACT0); const bf16* U = (const bf16*)(P.ws + WS_U) + (size_t)l * NEXP * D; const bf16* V = (const bf16*)(P.ws + WS_V) + (size_t)l * NEXP * D;
    const int* ex = (const int*)(P.ws + WS_EXP); const float* gw = (const float*)(P.ws + WS_GW); bf16* hn = (bf16*)(P.ws + WS_ACT2);
    for (int t = bid * nw + wave; t < T; t += nb * nw) {
        float x[32], acc[32];
#pragma unroll
        for (int j = 0; j < 4; ++j) { float f[8]; unpack8(*(const v4u*)(xf + (size_t)t * D + (j * 64 + lane) * 8), f);
#pragma unroll
            for (int e = 0; e < 8; ++e) { x[j * 8 + e] = f[e]; acc[j * 8 + e] = 0.f; } }
        for (int k = 0; k < 128; ++k) {
            const int e = ex[(size_t)t * 128 + k]; const float g = gw[(size_t)t * 128 + k];
            const bf16* ur = U + (size_t)e * D; const bf16* vr = V + (size_t)e * D;
            float dot = 0.f;
#pragma unroll
            for (int j = 0; j < 4; ++j) { float f[8]; unpack8(*(const v4u*)(ur + (j * 64 + lane) * 8), f);
#pragma unroll
                for (int q = 0; q < 8; ++q) dot += f[q] * x[j * 8 + q]; }
            dot = wave_sum(dot);
            const float w = g * 0.5f * dot * (1.0f + erff(dot * 0.70710678118654752f));
#pragma unroll
            for (int j = 0; j < 4; ++j) { float f[8]; unpack8(*(const v4u*)(vr + (j * 64 + lane) * 8), f);
#pragma unroll
                for (int q = 0; q < 8; ++q) acc[j * 8 + q] += w * f[q]; }
        }
        float* hrow = P.out + (size_t)t * D; float ss = 0.f;
#pragma unroll
        for (int j = 0; j < 4; ++j)
#pragma unroll
            for (int q = 0; q < 2; ++q) { f32x4 hv = *(const f32x4*)(hrow + (j * 64 + lane) * 8 + q * 4);
                hv.x += acc[j * 8 + q * 4 + 0]; hv.y += acc[j * 8 + q * 4 + 1]; hv.z += acc[j * 8 + q * 4 + 2]; hv.w += acc[j * 8 + q * 4 + 3];
                *(f32x4*)(hrow + (j * 64 + lane) * 8 + q * 4) = hv; acc[j * 8 + q * 4 + 0] = hv.x; acc[j * 8 + q * 4 + 1] = hv.y; acc[j * 8 + q * 4 + 2] = hv.z; acc[j * 8 + q * 4 + 3] = hv.w;
                ss += hv.x * hv.x + hv.y * hv.y + hv.z * hv.z + hv.w * hv.w; }
        ss = wave_sum(ss); const float r = 1.0f / sqrtf(ss * (1.0f / D) + EPS); const float* gain = P.in[I_LNPLE] + (size_t)l * D;
#pragma unroll
        for (int j = 0; j < 4; ++j) { const f32x4 g0 = *(const f32x4*)(gain + (j * 64 + lane) * 8), g1 = *(const f32x4*)(gain + (j * 64 + lane) * 8 + 4);
            v4u o; o.x = pk2(acc[j * 8 + 0] * r * g0.x, acc[j * 8 + 1] * r * g0.y); o.y = pk2(acc[j * 8 + 2] * r * g0.z, acc[j * 8 + 3] * r * g0.w);
            o.z = pk2(acc[j * 8 + 4] * r * g1.x, acc[j * 8 + 5] * r * g1.y); o.w = pk2(acc[j * 8 + 6] * r * g1.z, acc[j * 8 + 7] * r * g1.w);
            *(v4u*)(hn + (size_t)t * D + (j * 64 + lane) * 8) = o; }
    }
}
__global__ void __launch_bounds__(512) k_peer_apply(Params P, int l) { phase_peer_apply(P, l, blockIdx.x, gridDim.x); }

extern "C" void kernel_launch(void* const* d_in, const int* in_sizes, int n_in, void* d_out, int out_size, void* d_ws, size_t ws_size, hipStream_t stream) {
    static int ok = 0;
    if (ok == 0) {
        ok = 1;
        if (n_in != 19 || out_size != T * D || ws_size < WS_END) { fprintf(stderr, "kernel_launch: unexpected shapes (n_in %d out %d ws %zu need %zu)\n", n_in, out_size, ws_size, (size_t)WS_END); ok = -1; }
        if (hipFuncSetAttribute((const void*)k_prologue, hipFuncAttributeMaxDynamicSharedMemorySize, 8 * 64 * 33 * 4) != hipSuccess) { fprintf(stderr, "kernel_launch: hipFuncSetAttribute failed\n"); }
    }
    if (ok < 0) return;
    Params P{};
    for (int i = 0; i < 19; ++i) P.in[i] = (const float*)d_in[i];
    P.out = (float*)d_out; P.ws = (unsigned char*)d_ws;
    unsigned char* ws = P.ws;
    const int G = 1024;
    k_prologue<<<G, 512, 8 * 64 * 33 * 4, stream>>>(P);
    for (int l = 0; l < DEPTH; ++l) {
        k_norm_mix<<<G, 512, 0, stream>>>(P, l);
        {
            const bf16* a = (const bf16*)(ws + WS_ACT0);
            const bf16* wtm = (const bf16*)(ws + WS_WINTM) + (size_t)l * NTM * 128 * D; const bf16* wvt = (const bf16*)(ws + WS_WINVT) + (size_t)l * NVT * 128 * D;
            EpiProjTM e1{(bf16*)(ws + WS_TM)}; k_gemm_naive<EpiProjTM><<<dim3(NTM * 128 / 64, T / 64), 256, 0, stream>>>(a, wtm, D, T, NTM * 128, e1);
            EpiProjVT e2{(bf16*)(ws + WS_VT)}; k_gemm_naive<EpiProjVT><<<dim3(T / 64, NVT * 128 / 64), 256, 0, stream>>>(wvt, a, D, NVT * 128, T, e2);
        }
        k_prep_cmp<<<NB * 2 * 128, 256, 0, stream>>>(P, l);
        k_prep_kmean<<<NB * 8 * 4, 128, 0, stream>>>(P);
        k_attn_A<<<NB * 6 * S / 4, 256, 0, stream>>>(P);
        k_attn_B1<<<NB * 2 * S / 4, 256, 0, stream>>>(P);
        k_attn_B2<<<NB * 6 * S / 4, 256, 0, stream>>>(P);
        k_attn_C<<<NB * 4 * S / 4, 256, 0, stream>>>(P);
        k_ynorm<<<G, 512, 0, stream>>>(P);
        {   EpiResid e{l == 0 ? P.in[I_X] : P.out, P.out};
            k_gemm_naive<EpiResid><<<dim3(D / 64, T / 64), 256, 0, stream>>>((const bf16*)(ws + WS_ACT2), (const bf16*)(ws + WS_WOUT) + (size_t)l * D * D, D, T, D, e); }
        k_norm_ffn<<<G, 512, 0, stream>>>(P, l);
        {   EpiStoreBf16 e{(bf16*)(ws + WS_ACT1)};
            k_gemm_naive<EpiStoreBf16><<<dim3(D / 64, T / 64), 256, 0, stream>>>((const bf16*)(ws + WS_ACT0), (const bf16*)(ws + WS_WQ) + (size_t)l * D * D, D, T, D, e);
            EpiStoreBf16 e2{(bf16*)(ws + WS_ACT3)};
            k_gemm_naive<EpiStoreBf16><<<dim3(D / 64, T / 64), 256, 0, stream>>>((const bf16*)(ws + WS_P) + (size_t)l * T * PLE, (const bf16*)(ws + WS_WPROJ) + (size_t)l * D * PLE, PLE, T, D, e2); }
        k_peer_select_naive<<<T * 8 / 4, 256, 0, stream>>>(P, l);
        k_peer_apply<<<G, 512, 0, stream>>>(P, l);
        {   EpiPleGate e{P.out, (const bf16*)(ws + WS_ACT3)};
            k_gemm_naive<EpiPleGate><<<dim3(D / 64, T / 64), 256, 0, stream>>>((const bf16*)(ws + WS_ACT2), (const bf16*)(ws + WS_WGATE) + (size_t)l * D * D, D, T, D, e); }
    }
    k_final<<<G, 512, 0, stream>>>(P);
}
```

```cpp
#include <hip/hip_runtime.h>
#ifndef WQ_I8
#define WQ_I8 1
#endif
#ifndef WOUT_I8
#define WOUT_I8 1
#endif
#ifndef PROJ_I8
#define PROJ_I8 1
#endif
#ifndef GATE_I8
#define GATE_I8 1
#endif
#ifndef FA_STAGGER
#define FA_STAGGER 0
#endif
#ifndef PEER_SLICED
#define PEER_SLICED 1
#ifndef TBL_IN_ATTN
#define TBL_IN_ATTN 1
#endif
#ifndef H16
#define H16 1
#endif
#ifndef PEER_A_I8
#define PEER_A_I8 1
#endif
#endif
#ifndef DUP_PHASE
#define DUP_PHASE 0
#endif
#include <cstdio>
#include <cstdint>

#define GAS __attribute__((address_space(1)))
#define LAS __attribute__((address_space(3)))
typedef unsigned short bf16;
typedef unsigned v4u __attribute__((ext_vector_type(4)));
typedef unsigned v2u __attribute__((ext_vector_type(2)));
typedef float f32x4 __attribute__((ext_vector_type(4)));

constexpr int NB = 8, S = 2048, T = NB * S, D = 2048, DEPTH = 2, HD = 128, PROJ = 6162;
constexpr int NTM = 34, NVT = 14;
constexpr int TM_A_Q = 0, TM_A_K = 6, TM_B_Q = 12, TM_B_KC = 18, TM_B_VC = 20, TM_B_KS = 22, TM_B_KW = 24, TM_C_Q = 26, TM_C_K = 30;
constexpr int VT_A_V = 0, VT_B_VS = 6, VT_B_VW = 8, VT_C_V = 10;
constexpr int GATE_COL0 = 4608;
constexpr int PLE = 256, NEXP = 16384;
constexpr float EPS = 1e-6f;
constexpr float QK_SCALE = 0.08838834764831845f;
#define NEG_INF (-__builtin_inff())

__host__ __device__ constexpr int tm_col0(int s) {
    return s < 6 ? 128 * s : s < 12 ? 768 + 128 * (s - 6) : s < 18 ? 2304 + 128 * (s - 12) : s < 20 ? 3072 + 128 * (s - 18) : s < 22 ? 3328 + 128 * (s - 20)
         : s < 24 ? 3584 + 128 * (s - 22) : s < 26 ? 4096 + 128 * (s - 24) : s < 30 ? 4626 + 128 * (s - 26) : 5138 + 128 * (s - 30);
}
__host__ __device__ constexpr int vt_col0(int v) {
    return v < 6 ? 1536 + 128 * v : v < 8 ? 3840 + 128 * (v - 6) : v < 10 ? 4352 + 128 * (v - 8) : 5650 + 128 * (v - 10);
}

constexpr size_t MiB = 1u << 20;
constexpr size_t align_up(size_t x) { return (x + 255) & ~(size_t)255; }
constexpr size_t WS_CTL = 0, CTL_BYTES = 1 * MiB, CTL_USED_BYTES = 128 * 1024;
constexpr size_t SZ_WINTM = (size_t)NTM * 128 * D * 2, SZ_WINVT = (size_t)NVT * 128 * D * 2, SZ_WSQ = (size_t)D * D * 2, SZ_WPROJ = (size_t)D * PLE * 2;
constexpr size_t WS_WINTM = WS_CTL + CTL_BYTES;
constexpr size_t WS_WINVT = WS_WINTM + DEPTH * SZ_WINTM;
constexpr size_t WS_WOUT = WS_WINVT + DEPTH * SZ_WINVT;
constexpr size_t WS_WQ = WS_WOUT + DEPTH * SZ_WSQ;
constexpr size_t WS_WGATE = WS_WQ + DEPTH * SZ_WSQ;
constexpr size_t WS_WPROJ = WS_WGATE + DEPTH * SZ_WSQ;
constexpr size_t WS_WG = WS_WPROJ + DEPTH * SZ_WPROJ;
constexpr size_t WS_KEYS = align_up(WS_WG + (size_t)DEPTH * 18 * D * 4);
constexpr size_t WS_CWT = WS_KEYS + (size_t)DEPTH * 16 * 128 * 128 * 2;
constexpr size_t WS_U = WS_CWT + (size_t)DEPTH * 2 * 128 * 4096 * 2;
constexpr size_t WS_V = WS_U + (size_t)DEPTH * NEXP * D;
constexpr size_t WS_SU = WS_V + (size_t)DEPTH * NEXP * D;
constexpr size_t WS_SV = WS_SU + (size_t)DEPTH * NEXP * 4;
constexpr size_t WS_P = WS_SV + (size_t)DEPTH * NEXP * 4;
constexpr size_t WS_TM = WS_P + (size_t)DEPTH * T * PLE * 2;
constexpr size_t WS_VT = WS_TM + (size_t)NB * NTM * S * 128 * 2;
constexpr size_t WS_KCMP = WS_VT + (size_t)NB * NVT * S * 128 * 2;
constexpr size_t WS_VCMPT = WS_KCMP + (size_t)NB * 2 * 128 * 128 * 2;
constexpr size_t WS_KMEAN = WS_VCMPT + (size_t)NB * 2 * 128 * 128 * 2;
constexpr size_t WS_GATES = WS_KMEAN + (size_t)NB * 8 * 4 * 128 * 4;
constexpr size_t WS_SS = align_up(WS_GATES + (size_t)T * 18 * 4);
constexpr size_t WS_OCMP = WS_SS + (size_t)T * 16 * 4;
constexpr size_t WS_SEL = WS_OCMP + (size_t)T * 768 * 4;
constexpr size_t WS_EXP = WS_SEL + (size_t)T * 16 * 4;
constexpr size_t WS_GW = WS_EXP + (size_t)T * 128 * 4;
constexpr size_t SZ_ACT = (size_t)T * D * 2;
constexpr size_t WS_ACT0 = WS_GW + (size_t)T * 128 * 4;
constexpr size_t WS_ACT1 = WS_ACT0 + SZ_ACT;
constexpr size_t WS_ACT2 = WS_ACT1 + SZ_ACT;
constexpr size_t WS_ACT3 = WS_ACT2 + SZ_ACT;
constexpr size_t WS_TBL = WS_ACT3 + SZ_ACT;
constexpr size_t WS_PD = WS_TBL + (size_t)16 * 3 * 2304 * 4;
constexpr size_t WS_H16 = WS_PD + (size_t)16 * T * 128 * 2;
constexpr size_t WS_WV = WS_PD + (size_t)16 * T * 128 * 4;
constexpr size_t WS_WG8 = WS_WV + (size_t)T * 128 * 4;
constexpr size_t WS_SWG = WS_WG8 + (size_t)DEPTH * D * D;
constexpr size_t WS_SHN = WS_SWG + (size_t)DEPTH * D * 4;
constexpr size_t WS_WIN8TM = WS_SHN + (size_t)T * 4;
constexpr size_t WS_WIN8VT = WS_WIN8TM + (size_t)DEPTH * NTM * 128 * D;
constexpr size_t WS_SWTM = WS_WIN8VT + (size_t)DEPTH * NVT * 128 * D;
constexpr size_t WS_SWVT = WS_SWTM + (size_t)DEPTH * NTM * 128 * 4;
constexpr size_t WS_SA = WS_SWVT + (size_t)DEPTH * NVT * 128 * 4;
constexpr size_t WS_XF8 = WS_SA + (size_t)T * 4;
constexpr size_t WS_SXF = WS_XF8 + (size_t)T * D;
constexpr size_t WS_WQ8 = WS_SXF + (size_t)T * 4;
constexpr size_t WS_SWQ = WS_WQ8 + (size_t)DEPTH * D * D;
constexpr size_t WS_WO8 = WS_SWQ + (size_t)DEPTH * D * 4;
constexpr size_t WS_SWO = WS_WO8 + (size_t)DEPTH * D * D;
constexpr size_t WS_SY = WS_SWO + (size_t)DEPTH * D * 4;
constexpr size_t WS_POSW = WS_SY + (size_t)T * 4;
constexpr size_t WS_END = WS_POSW + (size_t)DEPTH * 2 * 32 * 128 * 4;
static_assert(!H16 || (WQ_I8 && WOUT_I8 && PROJ_I8 && GATE_I8 && PEER_A_I8 && PEER_SLICED), "the fp16 residual stream is wired into the int8 paths only");
static_assert(WS_END <= (size_t)1024 * MiB, "workspace map exceeds 1 GiB");

__device__ __forceinline__ float bf2f(unsigned v) { return __uint_as_float(v << 16); }
__device__ __forceinline__ unsigned f2bf(float f) { unsigned u = __float_as_uint(f); return (u + 0x7fffu + ((u >> 16) & 1u)) >> 16; }
__device__ __forceinline__ unsigned pk2(float lo, float hi) { return f2bf(lo) | (f2bf(hi) << 16); }
__device__ __forceinline__ unsigned pack_i8x4(float a, float b, float c, float d, float S) {
    const int ia = (int)rintf(a * S), ib = (int)rintf(b * S), ic = (int)rintf(c * S), id = (int)rintf(d * S);
    return (unsigned)(ia & 255) | ((unsigned)(ib & 255) << 8) | ((unsigned)(ic & 255) << 16) | ((unsigned)id << 24);
}
typedef _Float16 h4_t __attribute__((ext_vector_type(4)));
typedef _Float16 h2_t __attribute__((ext_vector_type(2)));
__device__ __forceinline__ f32x4 ldh4(const GAS _Float16* p) { const h4_t v = *(const GAS h4_t*)p; return (f32x4){(float)v.x, (float)v.y, (float)v.z, (float)v.w}; }
__device__ __forceinline__ void sth4(GAS _Float16* p, f32x4 v) { *(GAS h4_t*)p = (h4_t){(_Float16)v.x, (_Float16)v.y, (_Float16)v.z, (_Float16)v.w}; }
template <bool SRC16> __device__ __forceinline__ f32x4 ldrow4(const void* base, size_t idx) { if (SRC16) return ldh4((const GAS _Float16*)base + idx); return *(const GAS f32x4*)((const GAS float*)base + idx); }
template <int M> __device__ __forceinline__ int swz_xor_i(int v) { return __builtin_amdgcn_ds_swizzle(v, (M << 10) | 0x1F); }
template <int M> __device__ __forceinline__ float swz_xor(float v) { return __builtin_bit_cast(float, swz_xor_i<M>(__builtin_bit_cast(int, v))); }
__device__ __forceinline__ void halves_i(int v, int& lo, int& hi) { const auto pr = __builtin_amdgcn_permlane32_swap((unsigned)v, (unsigned)v, false, false); lo = (int)pr[0]; hi = (int)pr[1]; }
__device__ __forceinline__ void halves(float v, float& lo, float& hi) { int a, b; halves_i(__builtin_bit_cast(int, v), a, b); lo = __builtin_bit_cast(float, a); hi = __builtin_bit_cast(float, b); }
__device__ __forceinline__ float wave_sum(float v) {
    v += swz_xor<1>(v); v += swz_xor<2>(v); v += swz_xor<4>(v); v += swz_xor<8>(v); v += swz_xor<16>(v);
    float lo, hi; halves(v, lo, hi); return lo + hi;
}
__device__ __forceinline__ float wave_max(float v) {
    v = fmaxf(v, swz_xor<1>(v)); v = fmaxf(v, swz_xor<2>(v)); v = fmaxf(v, swz_xor<4>(v)); v = fmaxf(v, swz_xor<8>(v)); v = fmaxf(v, swz_xor<16>(v));
    float lo, hi; halves(v, lo, hi); return fmaxf(lo, hi);
}
__device__ __forceinline__ int wave_min_i(int v) {
    int t;
    t = swz_xor_i<1>(v); v = t < v ? t : v; t = swz_xor_i<2>(v); v = t < v ? t : v; t = swz_xor_i<4>(v); v = t < v ? t : v; t = swz_xor_i<8>(v); v = t < v ? t : v; t = swz_xor_i<16>(v); v = t < v ? t : v;
    int lo, hi; halves_i(v, lo, hi); return lo < hi ? lo : hi;
}
__device__ __forceinline__ unsigned wave_or(unsigned v) {
    int x = (int)v; x |= swz_xor_i<1>(x); x |= swz_xor_i<2>(x); x |= swz_xor_i<4>(x); x |= swz_xor_i<8>(x); x |= swz_xor_i<16>(x);
    int lo, hi; halves_i(x, lo, hi); return (unsigned)(lo | hi);
}
__device__ __forceinline__ float lane_get(float v, int src) { return __builtin_bit_cast(float, __builtin_amdgcn_ds_bpermute(src << 2, __builtin_bit_cast(int, v))); }
__device__ __forceinline__ int lane_get_i(int v, int src) { return __builtin_amdgcn_ds_bpermute(src << 2, v); }
__device__ __forceinline__ int rel_bucket(int d) {
    if (d < 16) return d < 0 ? 0 : d;
    return 16 + (d >= 21) + (d >= 27) + (d >= 35) + (d >= 46) + (d >= 59) + (d >= 77) + (d >= 99) + (d >= 128) + (d >= 166) + (d >= 216) + (d >= 280) + (d >= 363) + (d >= 470) + (d >= 609) + (d >= 790);
}
#define WAVE_LDS_SYNC() do { asm volatile("s_waitcnt lgkmcnt(0)" ::: "memory"); __builtin_amdgcn_wave_barrier(); } while (0)

struct Params {
    const float* in[19];
    float* out;
    unsigned char* ws;
};
__device__ __forceinline__ int launder_i(int v) { asm volatile("" : "+v"(v)); return v; }
__device__ __forceinline__ int launder_s(int v) { asm volatile("" : "+s"(v)); return v; }
template <class Tp> __device__ __forceinline__ Tp* launder_p(Tp* p) { asm volatile("" : "+s"(p)); return p; }
__device__ __forceinline__ Params fresh(const Params& P) { Params Q;
#pragma unroll
    for (int i = 0; i < 19; ++i) Q.in[i] = launder_p(P.in[i]);
    Q.out = launder_p(P.out); Q.ws = launder_p(P.ws); return Q; }
#define TID() launder_i((int)threadIdx.x)
enum { I_X = 0, I_P, I_LNMIX, I_WIN, I_CMPWK, I_CMPWV, I_CMPPOS, I_OUTNORM, I_WOUT, I_RELBIAS, I_LNFFN, I_PEERWQ, I_PEERKEYS, I_PEERU, I_PEERV, I_LNPLE, I_PLEGATE, I_PLEPROJ, I_LNFINAL };

__device__ __forceinline__ void transpose_tile(const float* src, int ldsrc, int scol0, int k0, bf16* dst, int dstride, int drow0, const float* scale, LAS float* scr, int lane) {
    const bool al16 = ((scol0 & 3) == 0) && ((ldsrc & 3) == 0);
    if (al16) {
#pragma unroll
        for (int i = 0; i < 8; ++i) { const int kk = 8 * i + (lane >> 3), c4 = (lane & 7) * 4; f32x4 v = *(const GAS f32x4*)((const GAS float*)src + (size_t)(k0 + kk) * ldsrc + scol0 + c4);
            if (scale) { const float sc_ = scale[k0 + kk]; v = v * sc_; }
            scr[kk * 33 + c4] = v.x; scr[kk * 33 + c4 + 1] = v.y; scr[kk * 33 + c4 + 2] = v.z; scr[kk * 33 + c4 + 3] = v.w; }
    } else if (((scol0 | ldsrc) & 1) == 0) {
        typedef float f32x2 __attribute__((ext_vector_type(2)));
#pragma unroll
        for (int i = 0; i < 16; ++i) { const int kk = 4 * i + (lane >> 4), c2 = (lane & 15) * 2; f32x2 v = *(const GAS f32x2*)((const GAS float*)src + (size_t)(k0 + kk) * ldsrc + scol0 + c2);
            if (scale) { const float sc_ = scale[k0 + kk]; v = v * sc_; }
            scr[kk * 33 + c2] = v.x; scr[kk * 33 + c2 + 1] = v.y; }
    } else {
#pragma unroll 8
        for (int i = 0; i < 32; ++i) { const int kk = 2 * i + (lane >> 5); float v = src[(size_t)(k0 + kk) * ldsrc + scol0 + (lane & 31)]; if (scale) v *= scale[k0 + kk]; scr[kk * 33 + (lane & 31)] = v; }
    }
    WAVE_LDS_SYNC();
    const int c = lane & 7;
#pragma unroll
    for (int j = 0; j < 4; ++j) { const int n = (lane >> 3) + 8 * j; const LAS float* s = scr + (8 * c) * 33 + n;
        v4u o; o.x = pk2(s[0 * 33], s[1 * 33]); o.y = pk2(s[2 * 33], s[3 * 33]); o.z = pk2(s[4 * 33], s[5 * 33]); o.w = pk2(s[6 * 33], s[7 * 33]);
        *(v4u*)(dst + (size_t)(drow0 + n) * dstride + k0 + 8 * c) = o; }
    WAVE_LDS_SYNC();
}
constexpr int TL_TM = 32 * NTM * 4, TL_VT = 32 * NVT * 4, TL_SQ = 32 * 64, TL_PROJ = 4 * 64, TL_CW = 64 * 4;
constexpr int TL_LAYER = TL_TM + TL_VT + 3 * TL_SQ + TL_PROJ + 2 * TL_CW;
__device__ __forceinline__ void prologue_tile(const Params& P, int item, LAS float* scr, int lane) {
    const int l = item / TL_LAYER; int r = item % TL_LAYER;
    unsigned char* ws = P.ws;
    if (r < TL_TM) { const int nb = r / 32, kb = r % 32, slot = nb / 4, sub = nb % 4;
        transpose_tile(P.in[I_WIN] + (size_t)l * D * PROJ, PROJ, tm_col0(slot) + 32 * sub, 64 * kb, (bf16*)(ws + WS_WINTM) + (size_t)l * NTM * 128 * D, D, slot * 128 + 32 * sub, nullptr, scr, lane); return; }
    r -= TL_TM;
    if (r < TL_VT) { const int nb = r / 32, kb = r % 32, slot = nb / 4, sub = nb % 4;
        transpose_tile(P.in[I_WIN] + (size_t)l * D * PROJ, PROJ, vt_col0(slot) + 32 * sub, 64 * kb, (bf16*)(ws + WS_WINVT) + (size_t)l * NVT * 128 * D, D, slot * 128 + 32 * sub, nullptr, scr, lane); return; }
    r -= TL_VT;
    if (r < TL_SQ) { const int nb = r / 32, kb = r % 32;
        transpose_tile(P.in[I_WOUT] + (size_t)l * D * D, D, 32 * nb, 64 * kb, (bf16*)(ws + WS_WOUT) + (size_t)l * D * D, D, 32 * nb, P.in[I_OUTNORM] + (size_t)l * D, scr, lane); return; }
    r -= TL_SQ;
    if (r < TL_SQ) { const int nb = r / 32, kb = r % 32;
        transpose_tile(P.in[I_PEERWQ] + (size_t)l * D * D, D, 32 * nb, 64 * kb, (bf16*)(ws + WS_WQ) + (size_t)l * D * D, D, 32 * nb, nullptr, scr, lane); return; }
    r -= TL_SQ;
    if (r < TL_SQ) { const int nb = r / 32, kb = r % 32;
        transpose_tile(P.in[I_PLEGATE] + (size_t)l * D * D, D, 32 * nb, 64 * kb, (bf16*)(ws + WS_WGATE) + (size_t)l * D * D, D, 32 * nb, nullptr, scr, lane); return; }
    r -= TL_SQ;
    if (r < TL_PROJ) { const int nb = r / 4, kb = r % 4;
        transpose_tile(P.in[I_PLEPROJ] + (size_t)l * PLE * D, D, 32 * nb, 64 * kb, (bf16*)(ws + WS_WPROJ) + (size_t)l * D * PLE, PLE, 32 * nb, nullptr, scr, lane); return; }
    r -= TL_PROJ;
    { const int which = r / TL_CW; r %= TL_CW; const int nb = r / 64, kb = r % 64;
      transpose_tile((which ? P.in[I_CMPWV] : P.in[I_CMPWK]) + (size_t)l * 4096 * 128, 128, 32 * nb, 64 * kb, (bf16*)(ws + WS_CWT) + ((size_t)l * 2 + which) * 128 * 4096, 4096, 32 * nb, nullptr, scr, lane); }
}
__device__ __forceinline__ void cvt_f32_bf16(const float* src, bf16* dst, size_t n, size_t i0, size_t stride) {
    for (size_t i = i0 * 8; i < n; i += stride * 8) {
        const f32x4 a = *(const f32x4*)(src + i), b = *(const f32x4*)(src + i + 4);
        v4u o; o.x = pk2(a.x, a.y); o.y = pk2(a.z, a.w); o.z = pk2(b.x, b.y); o.w = pk2(b.z, b.w);
        *(v4u*)(dst + i) = o;
    }
}
__device__ __forceinline__ void convert_table_rows(const Params& P, int row_lo, int row_hi, int wslot, int nwslots, int lane) {
    for (int row0 = row_lo + wslot * 2; row0 < row_hi; row0 += nwslots * 2) {
        f32x4 v[2][2][4]; float am[2] = {0.f, 0.f};
#pragma unroll
        for (int u = 0; u < 2; ++u) { const int row = row0 + u; const int isv = row >= DEPTH * NEXP, rr = isv ? row - DEPTH * NEXP : row;
            const GAS float* src = (const GAS float*)(isv ? P.in[I_PEERV] : P.in[I_PEERU]) + (size_t)rr * D + lane * 16;
#pragma unroll
            for (int j = 0; j < 2; ++j)
#pragma unroll
                for (int q = 0; q < 4; ++q) v[u][j][q] = *(const GAS f32x4*)(src + j * 1024 + q * 4); }
#pragma unroll
        for (int u = 0; u < 2; ++u) { const int row = row0 + u; const int isv = row >= DEPTH * NEXP, rr = isv ? row - DEPTH * NEXP : row;
#pragma unroll
            for (int j = 0; j < 2; ++j)
#pragma unroll
                for (int q = 0; q < 4; ++q) am[u] = fmaxf(am[u], fmaxf(fmaxf(fabsf(v[u][j][q].x), fabsf(v[u][j][q].y)), fmaxf(fabsf(v[u][j][q].z), fabsf(v[u][j][q].w))));
            am[u] = wave_max(am[u]); const bool i8row = PEER_A_I8 && !isv; const float sc = am[u] > 0.f ? am[u] * (i8row ? 1.0f / 127.0f : 1.0f / 240.0f) : 1.0f, inv = 1.0f / sc;
            const int lyr = rr >= NEXP, ee = rr & (NEXP - 1);
            GAS unsigned char* dstb = (GAS unsigned char*)(P.ws + (isv ? WS_V : WS_U)) + (size_t)lyr * NEXP * D + (size_t)ee * 128;
#pragma unroll
            for (int j = 0; j < 2; ++j) { v4u o; int w;
                if (i8row) { o.x = pack_i8x4(v[u][j][0].x, v[u][j][0].y, v[u][j][0].z, v[u][j][0].w, inv); o.y = pack_i8x4(v[u][j][1].x, v[u][j][1].y, v[u][j][1].z, v[u][j][1].w, inv);
                             o.z = pack_i8x4(v[u][j][2].x, v[u][j][2].y, v[u][j][2].z, v[u][j][2].w, inv); o.w = pack_i8x4(v[u][j][3].x, v[u][j][3].y, v[u][j][3].z, v[u][j][3].w, inv); } else {
                w = __builtin_amdgcn_cvt_pk_fp8_f32(v[u][j][0].x * inv, v[u][j][0].y * inv, 0, false); w = __builtin_amdgcn_cvt_pk_fp8_f32(v[u][j][0].z * inv, v[u][j][0].w * inv, w, true); o.x = (unsigned)w;
                w = __builtin_amdgcn_cvt_pk_fp8_f32(v[u][j][1].x * inv, v[u][j][1].y * inv, 0, false); w = __builtin_amdgcn_cvt_pk_fp8_f32(v[u][j][1].z * inv, v[u][j][1].w * inv, w, true); o.y = (unsigned)w;
                w = __builtin_amdgcn_cvt_pk_fp8_f32(v[u][j][2].x * inv, v[u][j][2].y * inv, 0, false); w = __builtin_amdgcn_cvt_pk_fp8_f32(v[u][j][2].z * inv, v[u][j][2].w * inv, w, true); o.z = (unsigned)w;
                w = __builtin_amdgcn_cvt_pk_fp8_f32(v[u][j][3].x * inv, v[u][j][3].y * inv, 0, false); w = __builtin_amdgcn_cvt_pk_fp8_f32(v[u][j][3].z * inv, v[u][j][3].w * inv, w, true); o.w = (unsigned)w; }
#if PEER_SLICED
                { const int qc = lane + 64 * j; *(GAS v4u*)(dstb + (size_t)(qc >> 3) * NEXP * 128 + (qc & 7) * 16) = o; }
#else
                *(GAS v4u*)((GAS unsigned char*)(P.ws + (isv ? WS_V : WS_U)) + (size_t)rr * D + lane * 16 + j * 1024) = o;
#endif
            }
            if (lane == 0) ((GAS float*)(P.ws + (isv ? WS_SV : WS_SU)))[rr] = sc; }
    }
}
__device__ __forceinline__ void phase_prologue(const Params& P, int bid, int nb, LAS unsigned char* lds) {
    const int tid = TID(), lane = tid & 63, wave = tid >> 6, nw = 8;
    LAS float* scr = (LAS float*)lds + wave * (64 * 33);
    for (int it = bid * nw + wave; it < DEPTH * TL_LAYER; it += nb * nw) prologue_tile(P, it, scr, lane);
    const size_t gi = (size_t)bid * 512 + tid, gs = (size_t)nb * 512;
#if !TBL_IN_ATTN
    convert_table_rows(P, 0, 2 * DEPTH * NEXP, bid * nw + wave, nb * nw, lane);
#endif
    cvt_f32_bf16(P.in[I_P], (bf16*)(P.ws + WS_P), (size_t)DEPTH * T * PLE, gi, gs);
    cvt_f32_bf16(P.in[I_PEERKEYS], (bf16*)(P.ws + WS_KEYS), (size_t)DEPTH * 16 * 128 * 128, gi, gs);
    bf16* wg = (bf16*)(P.ws + WS_WG);
    for (size_t i = gi; i < (size_t)DEPTH * 18 * D; i += gs) { const int l = (int)(i / (18 * D)), j = (int)((i / D) % 18), k = (int)(i % D); wg[i] = (bf16)f2bf(P.in[I_WIN][(size_t)l * D * PROJ + (size_t)k * PROJ + GATE_COL0 + j]); }
    float* tbl = (float*)(P.ws + WS_TBL);
    for (size_t i = gi; i < (size_t)16 * 3 * 2304; i += gs) { const int idx = (int)(i % 2304), kind = (int)((i / 2304) % 3), gh = (int)(i / (3 * 2304)); const int d = idx - 256; float v = -2e30f;
        if (d >= 0) { const float bias = P.in[I_RELBIAS][rel_bucket(d) * 16 + gh] * 1.4426950408889634f;
            if (kind == 0) v = bias;
            else if (kind == 1) { if (d <= 511) v = bias; }
            else { const int mult = (d <= 128 ? 1 : 0) + ((d & 3) == 0 && d <= 512 ? 1 : 0) + ((d & 15) == 0 ? 1 : 0); if (mult > 0) v = bias + (mult == 1 ? 0.f : mult == 2 ? 1.0f : 1.5849625007211562f); } }
        tbl[i] = v; }
    __syncthreads();
    { LAS float* red = (LAS float*)lds;
      for (int item = bid; item < DEPTH * 2 * 32; item += nb) { const int l = item >> 6, which = (item >> 5) & 1, kc = item & 31, e = tid & 127, kq = tid >> 7;
          const GAS float* w = (const GAS float*)(which ? P.in[I_CMPWV] : P.in[I_CMPWK]) + ((size_t)l * 4096 + kc * 128 + kq * 32) * 128 + e; const GAS float* pos = (const GAS float*)P.in[I_CMPPOS] + (size_t)l * 4096 + kc * 128 + kq * 32;
          float a = 0.f;
#pragma unroll 8
          for (int j = 0; j < 32; ++j) a = __builtin_fmaf(pos[j], w[(size_t)j * 128], a);
          red[tid] = a; __syncthreads();
          if (tid < 128) ((GAS float*)(P.ws + WS_POSW))[(size_t)item * 128 + tid] = (red[tid] + red[128 + tid]) + (red[256 + tid] + red[384 + tid]);
          __syncthreads(); } }
}

__device__ __forceinline__ float row_load_ss(const float* row, int lane, f32x4 (&v)[8]) {
    float s = 0.f;
#pragma unroll
    for (int j = 0; j < 8; ++j) { v[j] = *(const f32x4*)(row + (j * 64 + lane) * 4); s += v[j].x * v[j].x + v[j].y * v[j].y + v[j].z * v[j].z + v[j].w * v[j].w; }
    return wave_sum(s);
}
__device__ __forceinline__ void row_norm_store_bf16(f32x4 (&v)[8], float ss, const float* gain, bf16* orow, int lane, unsigned char* o8 = nullptr, float* sc8 = nullptr) {
    const float r = 1.0f / sqrtf(ss * (1.0f / D) + EPS); float am = 0.f;
#pragma unroll
    for (int j = 0; j < 8; ++j) { const f32x4 g = *(const f32x4*)(gain + (j * 64 + lane) * 4); v[j] = v[j] * r * g; am = fmaxf(am, fmaxf(fmaxf(fabsf(v[j].x), fabsf(v[j].y)), fmaxf(fabsf(v[j].z), fabsf(v[j].w))));
        if (orow) { v2u o; o.x = pk2(v[j].x, v[j].y); o.y = pk2(v[j].z, v[j].w); *(v2u*)(orow + (j * 64 + lane) * 4) = o; } }
    if (o8) { am = wave_max(am); const float S8 = am > 0.f ? 127.0f / am : 0.f;
#pragma unroll
        for (int j = 0; j < 8; ++j) *(GAS unsigned*)((GAS unsigned char*)o8 + (j * 64 + lane) * 4) = pack_i8x4(v[j].x, v[j].y, v[j].z, v[j].w, S8);
        if (lane == 0) *sc8 = am * (1.0f / 127.0f); }
}
typedef __bf16 bf2g_t __attribute__((ext_vector_type(2)));
__device__ __forceinline__ float dot2g(unsigned a, unsigned b, float c) { return __builtin_amdgcn_fdot2_f32_bf16(__builtin_bit_cast(bf2g_t, a), __builtin_bit_cast(bf2g_t, b), c, false); }
__device__ __forceinline__ void quant_all_rows(const Params& P, int l, int bid, int nb);
#if H16
__device__ __forceinline__ void phase_norm_mix(const Params& P, int l, int bid, int nb, LAS unsigned char* lds) {
    const int tid = TID(), lane = tid & 63, wave = tid >> 6, nw = 8;
    const GAS float* xsrc = (const GAS float*)P.in[I_X]; const GAS _Float16* hsrc = (const GAS _Float16*)(P.ws + WS_H16);
    GAS unsigned char* a8 = (GAS unsigned char*)(P.ws + WS_ACT0); GAS float* gates = (GAS float*)(P.ws + WS_GATES); GAS float* sa = (GAS float*)(P.ws + WS_SA);
    const GAS float* gain = (const GAS float*)P.in[I_LNMIX] + (size_t)l * D;
    { const GAS v4u* wsrc = (const GAS v4u*)((const GAS bf16*)(P.ws + WS_WG) + (size_t)l * 18 * D); LAS v4u* wl = (LAS v4u*)lds;
      v4u stg[9];
#pragma unroll
      for (int i = 0; i < 9; ++i) stg[i] = wsrc[tid + 512 * i];
      quant_all_rows(P, l, bid, nb);
#pragma unroll
      for (int i = 0; i < 9; ++i) wl[tid + 512 * i] = stg[i]; }
    __syncthreads();
    const LAS v2u* wl2 = (const LAS v2u*)lds;
    const int step = nb * nw;
    for (int t0 = bid * nw + wave; t0 < T; t0 += 4 * step) {
        v2u ab[4][8];
#pragma unroll
        for (int pr = 0; pr < 2; ++pr) {
            f32x4 v[2][8]; float ss[2] = {0.f, 0.f};
#pragma unroll
            for (int u = 0; u < 2; ++u) { const int t = t0 + (2 * pr + u) * step; const size_t tt = t < T ? t : t0;
                if (l == 0) {
#pragma unroll
                    for (int j = 0; j < 8; ++j) v[u][j] = *(const GAS f32x4*)(xsrc + tt * D + (j * 64 + lane) * 4);
                } else {
#pragma unroll
                    for (int j = 0; j < 8; ++j) v[u][j] = ldh4(hsrc + tt * D + (j * 64 + lane) * 4);
                } }
#pragma unroll
            for (int u = 0; u < 2; ++u) {
#pragma unroll
                for (int j = 0; j < 8; ++j) ss[u] += v[u][j].x * v[u][j].x + v[u][j].y * v[u][j].y + v[u][j].z * v[u][j].z + v[u][j].w * v[u][j].w;
                ss[u] = wave_sum(ss[u]); }
#pragma unroll
            for (int u = 0; u < 2; ++u) { const int t = t0 + (2 * pr + u) * step; const float r = 1.0f / sqrtf(ss[u] * (1.0f / D) + EPS); float am = 0.f;
#pragma unroll
                for (int j = 0; j < 8; ++j) { const f32x4 g = *(const GAS f32x4*)(gain + (j * 64 + lane) * 4); v[u][j] = v[u][j] * r * g;
                    ab[2 * pr + u][j].x = pk2(v[u][j].x, v[u][j].y); ab[2 * pr + u][j].y = pk2(v[u][j].z, v[u][j].w);
                    am = fmaxf(am, fmaxf(fmaxf(fabsf(v[u][j].x), fabsf(v[u][j].y)), fmaxf(fabsf(v[u][j].z), fabsf(v[u][j].w)))); }
                am = wave_max(am); const float S8 = am > 0.f ? 127.0f / am : 0.f;
                if (t < T) {
#pragma unroll
                    for (int j = 0; j < 8; ++j) *(GAS unsigned*)(a8 + (size_t)t * D + (j * 64 + lane) * 4) = pack_i8x4(v[u][j].x, v[u][j].y, v[u][j].z, v[u][j].w, S8);
                    if (lane == 0) sa[t] = am * (1.0f / 127.0f); } }
        }
        const int trow = t0 + (lane >> 4) * step;
#pragma unroll 2
        for (int c = 0; c < 18; ++c) { float s0 = 0.f, s1 = 0.f, s2 = 0.f, s3 = 0.f;
#pragma unroll
            for (int j = 0; j < 8; ++j) { const v2u w = wl2[c * (D / 4) + j * 64 + lane];
                s0 = dot2g(ab[0][j].x, w.x, s0); s0 = dot2g(ab[0][j].y, w.y, s0); s1 = dot2g(ab[1][j].x, w.x, s1); s1 = dot2g(ab[1][j].y, w.y, s1);
                s2 = dot2g(ab[2][j].x, w.x, s2); s2 = dot2g(ab[2][j].y, w.y, s2); s3 = dot2g(ab[3][j].x, w.x, s3); s3 = dot2g(ab[3][j].y, w.y, s3); }
            const auto p02 = __builtin_amdgcn_permlane32_swap(__builtin_bit_cast(unsigned, s0), __builtin_bit_cast(unsigned, s2), false, false);
            const auto p13 = __builtin_amdgcn_permlane32_swap(__builtin_bit_cast(unsigned, s1), __builtin_bit_cast(unsigned, s3), false, false);
            const float x0 = __builtin_bit_cast(float, (unsigned)p02[0]) + __builtin_bit_cast(float, (unsigned)p02[1]), x1 = __builtin_bit_cast(float, (unsigned)p13[0]) + __builtin_bit_cast(float, (unsigned)p13[1]);
            const auto q = __builtin_amdgcn_permlane16_swap(__builtin_bit_cast(unsigned, x0), __builtin_bit_cast(unsigned, x1), false, false);
            float y = __builtin_bit_cast(float, (unsigned)q[0]) + __builtin_bit_cast(float, (unsigned)q[1]);
            y += swz_xor<8>(y); y += swz_xor<4>(y); y += swz_xor<2>(y); y += swz_xor<1>(y);
            if ((lane & 15) == 0 && trow < T) gates[(size_t)trow * 18 + c] = 1.0f / (1.0f + __expf(-y)); }
    }
    __syncthreads();
}
#else
__device__ __forceinline__ void phase_norm_mix(const Params& P, int l, int bid, int nb, LAS unsigned char* lds) {
    const int tid = TID(), lane = tid & 63, wave = tid >> 6, nw = 8;
    const float* hsrc = l == 0 ? P.in[I_X] : P.out;
    bf16* a = (bf16*)(P.ws + WS_ACT0); float* gates = (float*)(P.ws + WS_GATES);
    { const GAS v4u* wsrc = (const GAS v4u*)((const GAS bf16*)(P.ws + WS_WG) + (size_t)l * 18 * D); LAS v4u* wl = (LAS v4u*)lds;
      for (int i = tid; i < 18 * D / 8; i += 512) wl[i] = wsrc[i]; }
    __syncthreads();
    const LAS v2u* wl2 = (const LAS v2u*)lds;
    for (int t = bid * nw + wave; t < T; t += nb * nw) {
        f32x4 v[8]; float ss;
#if H16
        if (l == 0) ss = row_load_ss(hsrc + (size_t)t * D, lane, v);
        else { float s_ = 0.f;
#pragma unroll
            for (int j = 0; j < 8; ++j) { v[j] = ldh4((const GAS _Float16*)(P.ws + WS_H16) + (size_t)t * D + (j * 64 + lane) * 4); s_ += v[j].x * v[j].x + v[j].y * v[j].y + v[j].z * v[j].z + v[j].w * v[j].w; }
            ss = wave_sum(s_); }
#else
        ss = row_load_ss(hsrc + (size_t)t * D, lane, v);
#endif
        const float r = 1.0f / sqrtf(ss * (1.0f / D) + EPS); v2u ab[8];
#pragma unroll
        for (int j = 0; j < 8; ++j) { const f32x4 g = *(const f32x4*)(P.in[I_LNMIX] + (size_t)l * D + (j * 64 + lane) * 4); v[j] = v[j] * r * g;
            ab[j].x = pk2(v[j].x, v[j].y); ab[j].y = pk2(v[j].z, v[j].w);
#if !PROJ_I8
            *(v2u*)(a + (size_t)t * D + (j * 64 + lane) * 4) = ab[j];
#endif
        }
#if PROJ_I8
        { float am = 0.f;
#pragma unroll
          for (int j = 0; j < 8; ++j) am = fmaxf(am, fmaxf(fmaxf(fabsf(v[j].x), fabsf(v[j].y)), fmaxf(fabsf(v[j].z), fabsf(v[j].w))));
          am = wave_max(am); const float S8 = am > 0.f ? 127.0f / am : 0.f;
#pragma unroll
          for (int j = 0; j < 8; ++j) *(GAS unsigned*)((GAS unsigned char*)a + (size_t)t * D + (j * 64 + lane) * 4) = pack_i8x4(v[j].x, v[j].y, v[j].z, v[j].w, S8);
          if (lane == 0) ((GAS float*)(P.ws + WS_SA))[t] = am * (1.0f / 127.0f); }
#endif
#pragma unroll 2
        for (int c = 0; c < 18; ++c) { float sacc = 0.f;
#pragma unroll
            for (int j = 0; j < 8; ++j) { const v2u w = wl2[c * (D / 4) + j * 64 + lane]; sacc = dot2g(ab[j].x, w.x, sacc); sacc = dot2g(ab[j].y, w.y, sacc); }
            const float sv_ = wave_sum(sacc); if (lane == 0) gates[(size_t)t * 18 + c] = 1.0f / (1.0f + __expf(-sv_)); }
    }
    __syncthreads();
}
#endif
template <bool SRC16 = false>
__device__ __forceinline__ void phase_norm(const void* src, const float* gain, bf16* dst, int bid, int nb, unsigned char* d8 = nullptr, float* s8 = nullptr) {
    const int tid = TID(), lane = tid & 63, wave = tid >> 6, nw = 8;
    const int step = nb * nw;
    int t = bid * nw + wave;
    for (; t + step < T; t += 2 * step) { f32x4 v0[8], v1[8];
#pragma unroll
        for (int j = 0; j < 8; ++j) { v0[j] = ldrow4<SRC16>(src, (size_t)t * D + (j * 64 + lane) * 4); v1[j] = ldrow4<SRC16>(src, (size_t)(t + step) * D + (j * 64 + lane) * 4); }
        float s0 = 0.f, s1 = 0.f;
#pragma unroll
        for (int j = 0; j < 8; ++j) { s0 += v0[j].x * v0[j].x + v0[j].y * v0[j].y + v0[j].z * v0[j].z + v0[j].w * v0[j].w; s1 += v1[j].x * v1[j].x + v1[j].y * v1[j].y + v1[j].z * v1[j].z + v1[j].w * v1[j].w; }
        s0 = wave_sum(s0); s1 = wave_sum(s1);
        row_norm_store_bf16(v0, s0, gain, dst ? dst + (size_t)t * D : nullptr, lane, d8 ? d8 + (size_t)t * D : nullptr, s8 + t); row_norm_store_bf16(v1, s1, gain, dst ? dst + (size_t)(t + step) * D : nullptr, lane, d8 ? d8 + (size_t)(t + step) * D : nullptr, s8 + t + step); }
    for (; t < T; t += step) { f32x4 v[8]; float s_ = 0.f;
#pragma unroll
        for (int j = 0; j < 8; ++j) { v[j] = ldrow4<SRC16>(src, (size_t)t * D + (j * 64 + lane) * 4); s_ += v[j].x * v[j].x + v[j].y * v[j].y + v[j].z * v[j].z + v[j].w * v[j].w; }
        row_norm_store_bf16(v, wave_sum(s_), gain, dst ? dst + (size_t)t * D : nullptr, lane, d8 ? d8 + (size_t)t * D : nullptr, s8 + t); }
}
__device__ __forceinline__ void phase_final(const Params& P, int bid, int nb) {
    const int tid = TID(), lane = tid & 63, wave = tid >> 6, nw = 8;
    const int step = nb * nw; int t = bid * nw + wave;
    for (; t + step < T; t += 2 * step) { f32x4 v0[8], v1[8]; GAS float* r0p = (GAS float*)P.out + (size_t)t * D; GAS float* r1p = (GAS float*)P.out + (size_t)(t + step) * D;
#pragma unroll
        for (int j = 0; j < 8; ++j) {
#if H16
            v0[j] = ldh4((const GAS _Float16*)(P.ws + WS_H16) + (size_t)t * D + (j * 64 + lane) * 4); v1[j] = ldh4((const GAS _Float16*)(P.ws + WS_H16) + (size_t)(t + step) * D + (j * 64 + lane) * 4);
#else
            v0[j] = *(const GAS f32x4*)(r0p + (j * 64 + lane) * 4); v1[j] = *(const GAS f32x4*)(r1p + (j * 64 + lane) * 4);
#endif
        }
        float s0 = 0.f, s1 = 0.f;
#pragma unroll
        for (int j = 0; j < 8; ++j) { s0 += v0[j].x * v0[j].x + v0[j].y * v0[j].y + v0[j].z * v0[j].z + v0[j].w * v0[j].w; s1 += v1[j].x * v1[j].x + v1[j].y * v1[j].y + v1[j].z * v1[j].z + v1[j].w * v1[j].w; }
        s0 = wave_sum(s0); s1 = wave_sum(s1);
        const float q0 = 1.0f / sqrtf(s0 * (1.0f / D) + EPS), q1 = 1.0f / sqrtf(s1 * (1.0f / D) + EPS);
#pragma unroll
        for (int j = 0; j < 8; ++j) { const f32x4 g = *(const f32x4*)(P.in[I_LNFINAL] + (j * 64 + lane) * 4); *(GAS f32x4*)(r0p + (j * 64 + lane) * 4) = v0[j] * q0 * g; *(GAS f32x4*)(r1p + (j * 64 + lane) * 4) = v1[j] * q1 * g; } }
    for (; t < T; t += step) { f32x4 v[8]; float* row = P.out + (size_t)t * D;
#if H16
        float s_ = 0.f;
#pragma unroll
        for (int j = 0; j < 8; ++j) { v[j] = ldh4((const GAS _Float16*)(P.ws + WS_H16) + (size_t)t * D + (j * 64 + lane) * 4); s_ += v[j].x * v[j].x + v[j].y * v[j].y + v[j].z * v[j].z + v[j].w * v[j].w; }
        const float ss = wave_sum(s_);
#else
        const float ss = row_load_ss(row, lane, v);
#endif
        const float r = 1.0f / sqrtf(ss * (1.0f / D) + EPS);
#pragma unroll
        for (int j = 0; j < 8; ++j) { const f32x4 g = *(const f32x4*)(P.in[I_LNFINAL] + (j * 64 + lane) * 4); *(f32x4*)(row + (j * 64 + lane) * 4) = v[j] * r * g; } }
}
__device__ __forceinline__ void phase_ynorm(const Params& P, int bid, int nb) {
    const int tid = TID(), lane = tid & 63, wave = tid >> 6, nw = 8;
    const GAS bf16* o = (const GAS bf16*)(P.ws + WS_ACT1); GAS bf16* y = (GAS bf16*)(P.ws + WS_ACT2); const GAS float* ss = (const GAS float*)(P.ws + WS_SS);
    const int step = nb * nw;
    for (int t0 = bid * nw + wave; t0 < T; t0 += 2 * step) {
        v4u w[2][4]; float sv[2];
#pragma unroll
        for (int u = 0; u < 2; ++u) { const int t = t0 + u * step; const bool ok = t < T; const size_t tt = ok ? t : t0;
            sv[u] = lane < 16 ? ss[tt * 16 + lane] : 0.f;
#pragma unroll
            for (int j = 0; j < 4; ++j) w[u][j] = *(const GAS v4u*)(o + tt * D + (j * 64 + lane) * 8); }
#pragma unroll
        for (int u = 0; u < 2; ++u) { const int t = t0 + u * step; if (t >= T) break;
            float sa = lane < 6 ? sv[u] : 0.f, sb = (lane >= 6 && lane < 12) ? sv[u] : 0.f, sc = (lane >= 12 && lane < 16) ? sv[u] : 0.f;
            sa = wave_sum(sa); sb = wave_sum(sb); sc = wave_sum(sc);
            const float ra = 1.0f / sqrtf(sa * (1.0f / 768.f) + EPS), rb = 1.0f / sqrtf(sb * (1.0f / 768.f) + EPS), rc = 1.0f / sqrtf(sc * (1.0f / 512.f) + EPS);
#if WOUT_I8
            float yv[4][8]; float am = 0.f;
#pragma unroll
            for (int j = 0; j < 4; ++j) { const int c0 = (j * 64 + lane) * 8; const float r = c0 < 768 ? ra : c0 < 1536 ? rb : rc; const v4u ww = w[u][j];
                yv[j][0] = bf2f(ww.x & 0xffff) * r; yv[j][1] = bf2f(ww.x >> 16) * r; yv[j][2] = bf2f(ww.y & 0xffff) * r; yv[j][3] = bf2f(ww.y >> 16) * r;
                yv[j][4] = bf2f(ww.z & 0xffff) * r; yv[j][5] = bf2f(ww.z >> 16) * r; yv[j][6] = bf2f(ww.w & 0xffff) * r; yv[j][7] = bf2f(ww.w >> 16) * r;
#pragma unroll
                for (int e = 0; e < 8; ++e) am = fmaxf(am, fabsf(yv[j][e])); }
            am = wave_max(am); const float S8 = am > 0.f ? 127.0f / am : 0.f;
#pragma unroll
            for (int j = 0; j < 4; ++j) *(GAS v2u*)((GAS unsigned char*)y + (size_t)t * D + (j * 64 + lane) * 8) = (v2u){pack_i8x4(yv[j][0], yv[j][1], yv[j][2], yv[j][3], S8), pack_i8x4(yv[j][4], yv[j][5], yv[j][6], yv[j][7], S8)};
            if (lane == 0) ((GAS float*)(P.ws + WS_SY))[t] = am * (1.0f / 127.0f); }
#else
#pragma unroll
            for (int j = 0; j < 4; ++j) { const int c0 = (j * 64 + lane) * 8; const float r = c0 < 768 ? ra : c0 < 1536 ? rb : rc; const v4u ww = w[u][j]; v4u q;
                q.x = pk2(bf2f(ww.x & 0xffff) * r, bf2f(ww.x >> 16) * r); q.y = pk2(bf2f(ww.y & 0xffff) * r, bf2f(ww.y >> 16) * r);
                q.z = pk2(bf2f(ww.z & 0xffff) * r, bf2f(ww.z >> 16) * r); q.w = pk2(bf2f(ww.w & 0xffff) * r, bf2f(ww.w >> 16) * r);
                *(GAS v4u*)(y + (size_t)t * D + c0) = q; } }
#endif
    }
}

struct EpiProjTM {
    bf16* tm;
    __device__ __forceinline__ void elem(int R, int C, float v) const { const int b = R >> 11, s = R & 2047, slot = C >> 7, d = C & 127; tm[(((size_t)b * NTM + slot) * S + s) * 128 + d] = (bf16)f2bf(v); }
};
struct EpiProjVT {
    bf16* vt;
    __device__ __forceinline__ void elem(int R, int C, float v) const { const int b = C >> 11, s = C & 2047, slot = R >> 7, d = R & 127; vt[(((size_t)b * NVT + slot) * 128 + d) * S + s] = (bf16)f2bf(v); }
};
struct EpiResid {
    const float* base; float* out;
    __device__ __forceinline__ void elem(int R, int C, float v) const { out[(size_t)R * D + C] = base[(size_t)R * D + C] + v; }
};
struct EpiStoreBf16 {
    bf16* o;
    __device__ __forceinline__ void elem(int R, int C, float v) const { o[(size_t)R * D + C] = (bf16)f2bf(v); }
};
struct EpiPleGate {
    float* out; const bf16* pp;
    __device__ __forceinline__ void elem(int R, int C, float v) const { const size_t i = (size_t)R * D + C; out[i] = out[i] + (1.0f / (1.0f + __expf(-v))) * bf2f(pp[i]); }
};

template <class Epi>
__device__ __forceinline__ void gemm_naive_tile(const bf16* Aside, const bf16* Bside, int K, int r0, int c0, const Epi& E, int tid, LAS float* sm) {
    typedef LAS float (*T68)[68];
    T68 As = (T68)sm, Bs = (T68)(sm + 32 * 68);
    const int tx = tid & 15, ty = tid >> 4;
    float acc[4][4];
#pragma unroll
    for (int i = 0; i < 4; ++i)
#pragma unroll
        for (int j = 0; j < 4; ++j) acc[i][j] = 0.f;
    const int lr = tid >> 2, lk = (tid & 3) * 8;
    for (int k0 = 0; k0 < K; k0 += 32) {
        const v4u av = *(const v4u*)(Aside + (size_t)(r0 + lr) * K + k0 + lk), bv = *(const v4u*)(Bside + (size_t)(c0 + lr) * K + k0 + lk);
        __syncthreads();
        As[lk + 0][lr] = bf2f(av.x & 0xffff); As[lk + 1][lr] = bf2f(av.x >> 16); As[lk + 2][lr] = bf2f(av.y & 0xffff); As[lk + 3][lr] = bf2f(av.y >> 16);
        As[lk + 4][lr] = bf2f(av.z & 0xffff); As[lk + 5][lr] = bf2f(av.z >> 16); As[lk + 6][lr] = bf2f(av.w & 0xffff); As[lk + 7][lr] = bf2f(av.w >> 16);
        Bs[lk + 0][lr] = bf2f(bv.x & 0xffff); Bs[lk + 1][lr] = bf2f(bv.x >> 16); Bs[lk + 2][lr] = bf2f(bv.y & 0xffff); Bs[lk + 3][lr] = bf2f(bv.y >> 16);
        Bs[lk + 4][lr] = bf2f(bv.z & 0xffff); Bs[lk + 5][lr] = bf2f(bv.z >> 16); Bs[lk + 6][lr] = bf2f(bv.w & 0xffff); Bs[lk + 7][lr] = bf2f(bv.w >> 16);
        __syncthreads();
#pragma unroll
        for (int kk = 0; kk < 32; ++kk) {
            const f32x4 a = *(const LAS f32x4*)&As[kk][ty * 4], b = *(const LAS f32x4*)&Bs[kk][tx * 4];
            const float aa[4] = {a.x, a.y, a.z, a.w}, bb[4] = {b.x, b.y, b.z, b.w};
#pragma unroll
            for (int i = 0; i < 4; ++i)
#pragma unroll
                for (int j = 0; j < 4; ++j) acc[i][j] += aa[i] * bb[j];
        }
    }
#pragma unroll
    for (int i = 0; i < 4; ++i)
#pragma unroll
        for (int j = 0; j < 4; ++j) E.elem(r0 + ty * 4 + i, c0 + tx * 4 + j, acc[i][j]);
}
template <class Epi>
__device__ __forceinline__ void phase_gemm_naive(const bf16* Aside, const bf16* Bside, int K, int nR, int nC, const Epi& E, int bid, int nb, LAS unsigned char* lds) {
    const int tid_ = TID(); const int half = tid_ >> 8, vtid = tid_ & 255; LAS float* sm = (LAS float*)lds + half * (2 * 32 * 68);
    const int tc = nC / 64, nt = (nR / 64) * tc;
    for (int base = bid * 2; base < nt; base += nb * 2) { const int tile = base + half; gemm_naive_tile(Aside, Bside, K, (tile / tc) * 64, (tile % tc) * 64, E, vtid, sm); }
    __syncthreads();
}


namespace pg8 {
#define PG8_LAS __attribute__((address_space(3)))
typedef unsigned short bf16_t;
typedef short bf16x8 __attribute__((ext_vector_type(8)));
typedef float f32x4 __attribute__((ext_vector_type(4)));
typedef unsigned u32x4 __attribute__((ext_vector_type(4)));
constexpr int BM = 256, BK = 64, HALF = 128, HTB = HALF * BK * 2, STAGE_BYTES = 8 * HTB, NXCD = 8, WGM = 8;
__host__ __device__ __forceinline__ int lds_byte(int r, int c) { const int st = (r >> 4) * 2 + (c >> 5), rr = r & 15, cc = c & 31, ob = rr * 64 + cc * 2; return st * 1024 + (ob ^ (((ob >> 9) & 1) << 5)); }
__host__ __device__ __forceinline__ void stage_rc(int b, int& R, int& C) { const int st = b / 1024, sb = b % 1024, swz = sb ^ (((sb >> 9) & 1) << 5); R = (st >> 1) * 16 + swz / 64; C = (st & 1) * 32 + (swz % 64) / 2; }
__host__ __device__ __forceinline__ int perm32(int rho) { const int n = rho >> 4, i = rho & 15; return 8 * (i >> 2) + 4 * n + (i & 3); }
struct Unit { int pm, pn; };
struct Gemm { const bf16_t* A; const bf16_t* Bt; int K; const bf16_t* A2; const bf16_t* Bt2; int splitM, splitN;
    __device__ __forceinline__ const char* a_ptr(int pm, size_t tstep) const { return pm < splitM ? (const char*)A + (size_t)pm * tstep : (const char*)A2 + (size_t)(pm - splitM) * tstep; }
    __device__ __forceinline__ const char* b_ptr(int pn, size_t tstep) const { return pn < splitN ? (const char*)Bt + (size_t)pn * tstep : (const char*)Bt2 + (size_t)(pn - splitN) * tstep; } };
__device__ __forceinline__ void order_map(int wgid, int nM, int nN, Unit& u) {
    const int nwg = nM * nN; { const int q = nwg / NXCD, r = nwg % NXCD, xcd = wgid % NXCD, off = wgid / NXCD; wgid = (xcd < r ? xcd * (q + 1) : r * (q + 1) + (xcd - r) * q) + off; }
    const int nig = WGM * nN, gid = wgid / nig, fm = gid * WGM, gsz = (nM - fm) < WGM ? (nM - fm) : WGM;
    u.pm = fm + ((wgid % nig) % gsz); u.pn = (wgid % nig) / gsz;
}
struct StaticOrder {
    int nM, nN, nwg, G, c;
    __device__ void init(int M, int N, int G_, int c_) { nM = M / BM; nN = N / BM; nwg = nM * nN; G = G_; c = c_; }
    __device__ bool next(int i, Unit& u) const { const long L = (long)i * G + c; if (L >= nwg) return false; order_map((int)L, nM, nN, u); return true; }
    __device__ __forceinline__ void a_ready(const Unit&) const {}
    __device__ __forceinline__ void done(const Unit&) const {}
};
struct DualOrder {
    int nM1, nN1, nM2, nN2, G, c;
    __device__ bool next(int i, Unit& u) const { long L = (long)i * G + c; const int n1 = nM1 * nN1;
        if (L < n1) { order_map((int)L, nM1, nN1, u); return true; }
        L -= n1; if (L >= nM2 * nN2) return false; order_map((int)L, nM2, nN2, u); u.pm += nM1; u.pn += nN1; return true; }
    __device__ __forceinline__ void a_ready(const Unit&) const {}
    __device__ __forceinline__ void done(const Unit&) const {}
};
__device__ __forceinline__ unsigned cvt_pk_bf16(float lo, float hi) { unsigned r; asm volatile("v_cvt_pk_bf16_f32 %0, %1, %2" : "=v"(r) : "v"(lo), "v"(hi)); return r; }
struct EpiProj {
    static constexpr bool PERM = true, AFTER_DRAIN = false, I8 = false;
    bf16_t* tm; bf16_t* vt;
    __device__ __forceinline__ void operator()(const f32x4 (&acc)[2][2][4][2], const Unit& u, int wr, int wc, int fr, int fq) const {
        if (u.pm < 64) {
#pragma unroll
            for (int ai = 0; ai < 2; ++ai)
#pragma unroll
                for (int m = 0; m < 4; ++m) { const int r = u.pm * BM + ai * HALF + wr * 64 + m * 16 + fr, b = r >> 11, s = r & 2047;
#pragma unroll
                    for (int bj = 0; bj < 2; ++bj) { const int slot = 2 * u.pn + bj, d0 = wc * 32 + 8 * fq;
                        const f32x4 v0 = acc[ai][bj][m][0], v1 = acc[ai][bj][m][1];
                        u32x4 w; w.x = cvt_pk_bf16(v0[0], v0[1]); w.y = cvt_pk_bf16(v0[2], v0[3]); w.z = cvt_pk_bf16(v1[0], v1[1]); w.w = cvt_pk_bf16(v1[2], v1[3]);
                        *(GAS u32x4*)((GAS bf16_t*)tm + (((size_t)b * NTM + slot) * S + s) * 128 + d0) = w; } }
        } else {
            const int pmv = u.pm - 64, pnv = u.pn - 17;
#pragma unroll
            for (int ai = 0; ai < 2; ++ai)
#pragma unroll
                for (int m = 0; m < 4; ++m) { const int vslot = 2 * pmv + ai, d = wr * 64 + m * 16 + fr;
#pragma unroll
                    for (int bj = 0; bj < 2; ++bj) { const int c0 = pnv * BM + bj * HALF + wc * 32 + 8 * fq, b = c0 >> 11, s = c0 & 2047;
                        const f32x4 v0 = acc[ai][bj][m][0], v1 = acc[ai][bj][m][1];
                        u32x4 w; w.x = cvt_pk_bf16(v0[0], v0[1]); w.y = cvt_pk_bf16(v0[2], v0[3]); w.z = cvt_pk_bf16(v1[0], v1[1]); w.w = cvt_pk_bf16(v1[2], v1[3]);
                        *(GAS u32x4*)((GAS bf16_t*)vt + (((size_t)b * NVT + vslot) * 128 + d) * S + s) = w; } }
        }
    }
};
struct EpiResidT {
    static constexpr bool PERM = false, AFTER_DRAIN = false, I8 = false;
    const float* base; float* out;
    __device__ __forceinline__ void operator()(const f32x4 (&acc)[2][2][4][2], const Unit& u, int wr, int wc, int fr, int fq) const {
        const int row0 = u.pm * BM + wr * 64 + fr, col0 = u.pn * BM + wc * 32 + 4 * fq;
        const GAS float* bp = (const GAS float*)base; GAS float* op = (GAS float*)out;
#pragma unroll
        for (int ai = 0; ai < 2; ++ai)
#pragma unroll
            for (int mp = 0; mp < 2; ++mp) { f32x4 t[2][2][2];
#pragma unroll
                for (int mm = 0; mm < 2; ++mm) { const size_t off = (size_t)(row0 + ai * HALF + (2 * mp + mm) * 16) * D + col0;
#pragma unroll
                    for (int bj = 0; bj < 2; ++bj)
#pragma unroll
                        for (int n = 0; n < 2; ++n) t[mm][bj][n] = *(const GAS f32x4*)(bp + off + bj * HALF + n * 16); }
#pragma unroll
                for (int mm = 0; mm < 2; ++mm) { const size_t off = (size_t)(row0 + ai * HALF + (2 * mp + mm) * 16) * D + col0;
#pragma unroll
                    for (int bj = 0; bj < 2; ++bj)
#pragma unroll
                        for (int n = 0; n < 2; ++n) *(GAS f32x4*)(op + off + bj * HALF + n * 16) = t[mm][bj][n] + acc[ai][bj][2 * mp + mm][n]; } }
    }
};
struct EpiStoreT {
    static constexpr bool PERM = true, AFTER_DRAIN = false, I8 = false;
    bf16_t* o;
    __device__ __forceinline__ void operator()(const f32x4 (&acc)[2][2][4][2], const Unit& u, int wr, int wc, int fr, int fq) const {
        const int row0 = u.pm * BM + wr * 64 + fr, col0 = u.pn * BM + wc * 32 + 8 * fq;
#pragma unroll
        for (int ai = 0; ai < 2; ++ai)
#pragma unroll
            for (int m = 0; m < 4; ++m) { bf16_t* rowp = o + (size_t)(row0 + ai * HALF + m * 16) * D + col0;
#pragma unroll
                for (int bj = 0; bj < 2; ++bj) { const f32x4 v0 = acc[ai][bj][m][0], v1 = acc[ai][bj][m][1];
                    u32x4 w; w.x = cvt_pk_bf16(v0[0], v0[1]); w.y = cvt_pk_bf16(v0[2], v0[3]); w.z = cvt_pk_bf16(v1[0], v1[1]); w.w = cvt_pk_bf16(v1[2], v1[3]);
                    *(GAS u32x4*)((GAS bf16_t*)rowp + bj * HALF) = w; } }
    }
};
struct EpiPleGateT {
    static constexpr bool PERM = false, AFTER_DRAIN = false, I8 = false;
    float* out; const bf16_t* pp;
    __device__ __forceinline__ void operator()(const f32x4 (&acc)[2][2][4][2], const Unit& u, int wr, int wc, int fr, int fq) const {
        const int row0 = u.pm * BM + wr * 64 + fr, col0 = u.pn * BM + wc * 32 + 4 * fq;
        GAS float* op = (GAS float*)out; const GAS bf16_t* ppp = (const GAS bf16_t*)pp;
#pragma unroll
        for (int ai = 0; ai < 2; ++ai)
#pragma unroll
            for (int mp = 0; mp < 2; ++mp) { f32x4 t[2][2][2]; v2u pw[2][2][2];
#pragma unroll
                for (int mm = 0; mm < 2; ++mm) { const size_t off = (size_t)(row0 + ai * HALF + (2 * mp + mm) * 16) * D + col0;
#pragma unroll
                    for (int bj = 0; bj < 2; ++bj)
#pragma unroll
                        for (int n = 0; n < 2; ++n) { t[mm][bj][n] = *(const GAS f32x4*)(op + off + bj * HALF + n * 16); pw[mm][bj][n] = *(const GAS v2u*)(ppp + off + bj * HALF + n * 16); } }
#pragma unroll
                for (int mm = 0; mm < 2; ++mm) { const size_t off = (size_t)(row0 + ai * HALF + (2 * mp + mm) * 16) * D + col0;
#pragma unroll
                    for (int bj = 0; bj < 2; ++bj)
#pragma unroll
                        for (int n = 0; n < 2; ++n) { const f32x4 hv = t[mm][bj][n], a = acc[ai][bj][2 * mp + mm][n]; const v2u p2 = pw[mm][bj][n];
                            f32x4 r; r[0] = hv[0] + bf2f(p2.x & 0xffff) / (1.0f + __expf(-a[0])); r[1] = hv[1] + bf2f(p2.x >> 16) / (1.0f + __expf(-a[1]));
                            r[2] = hv[2] + bf2f(p2.y & 0xffff) / (1.0f + __expf(-a[2])); r[3] = hv[3] + bf2f(p2.y >> 16) / (1.0f + __expf(-a[3]));
                            *(GAS f32x4*)(op + off + bj * HALF + n * 16) = r; } } }
    }
};

typedef int i32x4 __attribute__((ext_vector_type(4)));
template <bool I8> struct AccSel { typedef f32x4 type; };
template <> struct AccSel<true> { typedef i32x4 type; };
__device__ __forceinline__ void mma16(f32x4& acc, const bf16x8 b, const bf16x8 a) { acc = __builtin_amdgcn_mfma_f32_16x16x32_bf16(b, a, acc, 0, 0, 0); }
__device__ __forceinline__ void mma16(i32x4& acc, const bf16x8 b, const bf16x8 a) { acc = __builtin_amdgcn_mfma_i32_16x16x64_i8(__builtin_bit_cast(i32x4, b), __builtin_bit_cast(i32x4, a), acc, 0, 0, 0); }
struct EpiPleGateI8 {
    static constexpr bool PERM = false, AFTER_DRAIN = false, I8 = true;
    float* out; const bf16_t* pp; const float* sa; const float* sw;
    __device__ __forceinline__ void operator()(const i32x4 (&acc)[2][2][4][2], const Unit& u, int wr, int wc, int fr, int fq) const {
        const int row0 = u.pm * BM + wr * 64 + fr, col0 = u.pn * BM + wc * 32 + 4 * fq;
        GAS float* op = (GAS float*)out; const GAS bf16_t* ppp = (const GAS bf16_t*)pp;
        f32x4 swv[2][2];
#pragma unroll
        for (int bj = 0; bj < 2; ++bj)
#pragma unroll
            for (int n = 0; n < 2; ++n) swv[bj][n] = *(const GAS f32x4*)((const GAS float*)sw + col0 + bj * HALF + n * 16);
#pragma unroll
        for (int ai = 0; ai < 2; ++ai)
#pragma unroll
            for (int mp = 0; mp < 2; ++mp) { f32x4 t[2][2][2]; v2u pw[2][2][2]; float rs[2];
#pragma unroll
                for (int mm = 0; mm < 2; ++mm) { const int row = row0 + ai * HALF + (2 * mp + mm) * 16; const size_t off = (size_t)row * D + col0; rs[mm] = ((const GAS float*)sa)[row];
#pragma unroll
                    for (int bj = 0; bj < 2; ++bj)
#pragma unroll
                        for (int n = 0; n < 2; ++n) {
#if H16
                            t[mm][bj][n] = ldh4((const GAS _Float16*)out + off + bj * HALF + n * 16);
#else
                            t[mm][bj][n] = *(const GAS f32x4*)(op + off + bj * HALF + n * 16);
#endif
                            pw[mm][bj][n] = *(const GAS v2u*)(ppp + off + bj * HALF + n * 16); } }
#pragma unroll
                for (int mm = 0; mm < 2; ++mm) { const size_t off = (size_t)(row0 + ai * HALF + (2 * mp + mm) * 16) * D + col0;
#pragma unroll
                    for (int bj = 0; bj < 2; ++bj)
#pragma unroll
                        for (int n = 0; n < 2; ++n) { const f32x4 hv = t[mm][bj][n]; const i32x4 ai4 = acc[ai][bj][2 * mp + mm][n]; const v2u p2 = pw[mm][bj][n]; const f32x4 sc = swv[bj][n] * rs[mm];
                            const float a0 = (float)ai4[0] * sc[0], a1 = (float)ai4[1] * sc[1], a2 = (float)ai4[2] * sc[2], a3 = (float)ai4[3] * sc[3];
                            f32x4 r; r[0] = hv[0] + bf2f(p2.x & 0xffff) / (1.0f + __expf(-a0)); r[1] = hv[1] + bf2f(p2.x >> 16) / (1.0f + __expf(-a1));
                            r[2] = hv[2] + bf2f(p2.y & 0xffff) / (1.0f + __expf(-a2)); r[3] = hv[3] + bf2f(p2.y >> 16) / (1.0f + __expf(-a3));
#if H16
                            sth4((GAS _Float16*)out + off + bj * HALF + n * 16, r);
#else
                            *(GAS f32x4*)(op + off + bj * HALF + n * 16) = r;
#endif
                        } } }
    }
};
struct EpiStoreI8 {
    static constexpr bool PERM = true, AFTER_DRAIN = false, I8 = true;
    bf16_t* o; const float* sa; const float* sw;
    __device__ __forceinline__ void operator()(const i32x4 (&acc)[2][2][4][2], const Unit& u, int wr, int wc, int fr, int fq) const {
        const int row0 = u.pm * BM + wr * 64 + fr, col0 = u.pn * BM + wc * 32 + 8 * fq;
        f32x4 cs[2][2];
#pragma unroll
        for (int bj = 0; bj < 2; ++bj) { const GAS float* p = (const GAS float*)sw + col0 + bj * HALF; cs[bj][0] = *(const GAS f32x4*)p; cs[bj][1] = *(const GAS f32x4*)(p + 4); }
#pragma unroll
        for (int ai = 0; ai < 2; ++ai)
#pragma unroll
            for (int m = 0; m < 4; ++m) { const int row = row0 + ai * HALF + m * 16; bf16_t* rowp = o + (size_t)row * D + col0; const float rs = ((const GAS float*)sa)[row];
#pragma unroll
                for (int bj = 0; bj < 2; ++bj) { const i32x4 a0 = acc[ai][bj][m][0], a1 = acc[ai][bj][m][1]; const f32x4 s0 = cs[bj][0] * rs, s1 = cs[bj][1] * rs;
                    u32x4 w; w.x = cvt_pk_bf16((float)a0[0] * s0[0], (float)a0[1] * s0[1]); w.y = cvt_pk_bf16((float)a0[2] * s0[2], (float)a0[3] * s0[3]);
                    w.z = cvt_pk_bf16((float)a1[0] * s1[0], (float)a1[1] * s1[1]); w.w = cvt_pk_bf16((float)a1[2] * s1[2], (float)a1[3] * s1[3]);
                    *(GAS u32x4*)((GAS bf16_t*)rowp + bj * HALF) = w; } }
    }
};
struct EpiResidI8 {
    static constexpr bool PERM = false, AFTER_DRAIN = false, I8 = true;
    const float* base; float* out; const float* sa; const float* sw;
    __device__ __forceinline__ void operator()(const i32x4 (&acc)[2][2][4][2], const Unit& u, int wr, int wc, int fr, int fq) const {
        const int row0 = u.pm * BM + wr * 64 + fr, col0 = u.pn * BM + wc * 32 + 4 * fq;
        const GAS float* bp = (const GAS float*)base; GAS float* op = (GAS float*)out;
#if H16
        GAS _Float16* oh = (GAS _Float16*)out;
#endif
        f32x4 cs[2][2];
#pragma unroll
        for (int bj = 0; bj < 2; ++bj)
#pragma unroll
            for (int n = 0; n < 2; ++n) cs[bj][n] = *(const GAS f32x4*)((const GAS float*)sw + col0 + bj * HALF + n * 16);
#pragma unroll
        for (int ai = 0; ai < 2; ++ai)
#pragma unroll
            for (int mp = 0; mp < 2; ++mp) { f32x4 t[2][2][2]; float rs[2];
#pragma unroll
                for (int mm = 0; mm < 2; ++mm) { const int row = row0 + ai * HALF + (2 * mp + mm) * 16; const size_t off = (size_t)row * D + col0; rs[mm] = ((const GAS float*)sa)[row];
#pragma unroll
                    for (int bj = 0; bj < 2; ++bj)
#pragma unroll
                        for (int n = 0; n < 2; ++n) {
#if H16
                            if (bp) t[mm][bj][n] = *(const GAS f32x4*)(bp + off + bj * HALF + n * 16); else t[mm][bj][n] = ldh4(oh + off + bj * HALF + n * 16);
#else
                            t[mm][bj][n] = *(const GAS f32x4*)(bp + off + bj * HALF + n * 16);
#endif
                        } }
#pragma unroll
                for (int mm = 0; mm < 2; ++mm) { const size_t off = (size_t)(row0 + ai * HALF + (2 * mp + mm) * 16) * D + col0;
#pragma unroll
                    for (int bj = 0; bj < 2; ++bj)
#pragma unroll
                        for (int n = 0; n < 2; ++n) { const i32x4 a = acc[ai][bj][2 * mp + mm][n]; const f32x4 sc = cs[bj][n] * rs[mm];
                            const f32x4 rv = t[mm][bj][n] + (f32x4){(float)a[0] * sc[0], (float)a[1] * sc[1], (float)a[2] * sc[2], (float)a[3] * sc[3]};
#if H16
                            sth4(oh + off + bj * HALF + n * 16, rv);
#else
                            *(GAS f32x4*)(op + off + bj * HALF + n * 16) = rv;
#endif
                        } } }
    }
};
struct EpiProjI8 {
    static constexpr bool PERM = true, AFTER_DRAIN = false, I8 = true;
    bf16_t* tm; bf16_t* vt; const float* sa; const float* swtm; const float* swvt;
    __device__ __forceinline__ void operator()(const i32x4 (&acc)[2][2][4][2], const Unit& u, int wr, int wc, int fr, int fq) const {
        if (u.pm < 64) {
            f32x4 cs[2][2];
#pragma unroll
            for (int bj = 0; bj < 2; ++bj) { const GAS float* p = (const GAS float*)swtm + (2 * u.pn + bj) * 128 + wc * 32 + 8 * fq; cs[bj][0] = *(const GAS f32x4*)p; cs[bj][1] = *(const GAS f32x4*)(p + 4); }
#pragma unroll
            for (int ai = 0; ai < 2; ++ai)
#pragma unroll
                for (int m = 0; m < 4; ++m) { const int r = u.pm * BM + ai * HALF + wr * 64 + m * 16 + fr, b = r >> 11, s = r & 2047; const float rs = ((const GAS float*)sa)[r];
#pragma unroll
                    for (int bj = 0; bj < 2; ++bj) { const int slot = 2 * u.pn + bj, d0 = wc * 32 + 8 * fq;
                        const i32x4 a0 = acc[ai][bj][m][0], a1 = acc[ai][bj][m][1]; const f32x4 s0 = cs[bj][0] * rs, s1 = cs[bj][1] * rs;
                        u32x4 w; w.x = cvt_pk_bf16((float)a0[0] * s0[0], (float)a0[1] * s0[1]); w.y = cvt_pk_bf16((float)a0[2] * s0[2], (float)a0[3] * s0[3]);
                        w.z = cvt_pk_bf16((float)a1[0] * s1[0], (float)a1[1] * s1[1]); w.w = cvt_pk_bf16((float)a1[2] * s1[2], (float)a1[3] * s1[3]);
                        *(GAS u32x4*)((GAS bf16_t*)tm + (((size_t)b * NTM + slot) * S + s) * 128 + d0) = w; } }
        } else {
            const int pmv = u.pm - 64, pnv = u.pn - 17;
            f32x4 cs[2][2];
#pragma unroll
            for (int bj = 0; bj < 2; ++bj) { const GAS float* p = (const GAS float*)sa + pnv * BM + bj * HALF + wc * 32 + 8 * fq; cs[bj][0] = *(const GAS f32x4*)p; cs[bj][1] = *(const GAS f32x4*)(p + 4); }
#pragma unroll
            for (int ai = 0; ai < 2; ++ai)
#pragma unroll
                for (int m = 0; m < 4; ++m) { const int vslot = 2 * pmv + ai, d = wr * 64 + m * 16 + fr; const float rs = ((const GAS float*)swvt)[vslot * 128 + d];
#pragma unroll
                    for (int bj = 0; bj < 2; ++bj) { const int c0 = pnv * BM + bj * HALF + wc * 32 + 8 * fq, b = c0 >> 11, s = c0 & 2047;
                        const i32x4 a0 = acc[ai][bj][m][0], a1 = acc[ai][bj][m][1]; const f32x4 s0 = cs[bj][0] * rs, s1 = cs[bj][1] * rs;
                        u32x4 w; w.x = cvt_pk_bf16((float)a0[0] * s0[0], (float)a0[1] * s0[1]); w.y = cvt_pk_bf16((float)a0[2] * s0[2], (float)a0[3] * s0[3]);
                        w.z = cvt_pk_bf16((float)a1[0] * s1[0], (float)a1[1] * s1[1]); w.w = cvt_pk_bf16((float)a1[2] * s1[2], (float)a1[3] * s1[3]);
                        *(GAS u32x4*)((GAS bf16_t*)vt + (((size_t)b * NVT + vslot) * 128 + d) * S + s) = w; } }
        }
    }
};
template <class Epi, class Sched>
__device__ __forceinline__ void gemm_phase(PG8_LAS unsigned char* lds, const Gemm g, const Sched& S, const Epi& E) {
    const int tid = TID(), wid = __builtin_amdgcn_readfirstlane(tid >> 6), lane = tid & 63, wr = wid >> 2, wc = wid & 3, fr = lane & 15, fq = lane >> 4;
    const int K = g.K, nt = K / BK;
    unsigned voffA[2], voffB[2];
#pragma unroll
    for (int i = 0; i < 2; ++i) { int R, C; stage_rc(tid * 16 + i * 8192, R, C); const int Rb = Epi::PERM ? ((R & ~31) + perm32(R & 31)) : R;
        voffA[i] = (unsigned)(R * K + C) * 2u; voffB[i] = (unsigned)(Rb * K + C) * 2u; }
    const size_t kstep = (size_t)(BK * 2);
    const size_t hstep = (size_t)HALF * K * 2;
    const size_t tstep = 2 * hstep;
    const unsigned ldsw = (unsigned)wid * 1024u;
    const int aoff = lds_byte(wr * 64 + fr, fq * 8), boff = lds_byte(wc * 32 + fr, fq * 8);
#define PG8_SA(b, h) (((b) * 2 + (h)) * HTB)
#define PG8_SB(b, h) ((4 + (b) * 2 + (h)) * HTB)
#define PG8_STAGE(bufoff, gbase, voff) do { _Pragma("unroll") for (int _i = 0; _i < 2; ++_i) \
        __builtin_amdgcn_global_load_lds((const unsigned*)((const char*)(gbase) + (voff)[_i]), (PG8_LAS unsigned*)(lds + (bufoff) + ldsw + _i * 8192), 16, 0, 0); } while (0)
#define PG8_LDA(dst, b, h) do { _Pragma("unroll") for (int m = 0; m < 4; ++m) _Pragma("unroll") for (int k = 0; k < 2; ++k) dst[m][k] = *(const PG8_LAS bf16x8*)(lds + PG8_SA(b, h) + aoff + m * 2048 + k * 1024); } while (0)
#define PG8_LDB(dst, b, h) do { _Pragma("unroll") for (int n = 0; n < 2; ++n) _Pragma("unroll") for (int k = 0; k < 2; ++k) dst[n][k] = *(const PG8_LAS bf16x8*)(lds + PG8_SB(b, h) + boff + n * 2048 + k * 1024); } while (0)
#define PG8_MMA(ai, bj, At, Bt) do { __builtin_amdgcn_s_setprio(1); _Pragma("unroll") for (int m = 0; m < 4; ++m) _Pragma("unroll") for (int n = 0; n < 2; ++n) _Pragma("unroll") for (int k = 0; k < 2; ++k) \
        mma16(acc[ai][bj][m][n], Bt[n][k], At[m][k]); __builtin_amdgcn_s_setprio(0); } while (0)
#define PG8_WAIT_V(n) asm volatile("s_waitcnt vmcnt(" #n ")" ::: "memory")
#define PG8_WAIT_L(n) asm volatile("s_waitcnt lgkmcnt(" #n ")" ::: "memory")
#define PG8_BAR __builtin_amdgcn_s_barrier()
#define PG8_SCHED __builtin_amdgcn_sched_barrier(0)
    Unit cur, nxt; int ui = 0;
    if (!S.next(0, cur)) return;
    typedef typename AccSel<Epi::I8>::type acc_t;
    acc_t acc[2][2][4][2];
#pragma unroll
    for (int a = 0; a < 2; ++a)
#pragma unroll
        for (int b = 0; b < 2; ++b)
#pragma unroll
            for (int m = 0; m < 4; ++m)
#pragma unroll
                for (int n = 0; n < 2; ++n) acc[a][b][m][n] = acc_t{};
    bf16x8 At[4][2], B0[2][2], B1[2][2];
    const char* cA = g.a_ptr(cur.pm, tstep); const char* cB = g.b_ptr(cur.pn, tstep);
    S.a_ready(cur);
    PG8_STAGE(PG8_SB(0, 0), cB, voffB); PG8_STAGE(PG8_SA(0, 0), cA, voffA); PG8_STAGE(PG8_SB(0, 1), cB + hstep, voffB); PG8_STAGE(PG8_SA(0, 1), cA + hstep, voffA);
    if (wr == 1) PG8_BAR;
    PG8_WAIT_V(4); PG8_BAR;
    PG8_STAGE(PG8_SB(1, 0), cB + kstep, voffB); PG8_STAGE(PG8_SA(1, 0), cA + kstep, voffA); PG8_STAGE(PG8_SB(1, 1), cB + hstep + kstep, voffB);
    PG8_WAIT_V(6); PG8_BAR;
    for (;;) {
        const bool has_next = S.next(ui + 1, nxt);
        const char* nA = has_next ? g.a_ptr(nxt.pm, tstep) : cA; const char* nB = has_next ? g.b_ptr(nxt.pn, tstep) : cB;
        for (int t = 0; t < nt; t += 2) {
            const bool last = (t == nt - 2);
            const char* a1 = cA + (size_t)(t + 1) * kstep;
            const char* a2 = last ? nA : cA + (size_t)(t + 2) * kstep; const char* b2 = last ? nB : cB + (size_t)(t + 2) * kstep;
            const char* a3 = a2 + kstep; const char* b3 = b2 + kstep;
            if (last && has_next) S.a_ready(nxt);
            PG8_LDB(B0, 0, 0); PG8_SCHED; PG8_LDA(At, 0, 0); PG8_STAGE(PG8_SA(1, 1), a1 + hstep, voffA);
            PG8_WAIT_L(8); PG8_BAR; PG8_WAIT_L(0); PG8_MMA(0, 0, At, B0); PG8_BAR; PG8_SCHED;
            PG8_LDB(B1, 0, 1); PG8_STAGE(PG8_SB(0, 0), b2, voffB);
            PG8_BAR; PG8_WAIT_L(0); PG8_MMA(0, 1, At, B1); PG8_BAR;
            PG8_LDA(At, 0, 1); PG8_STAGE(PG8_SA(0, 0), a2, voffA);
            PG8_BAR; PG8_WAIT_L(0); PG8_MMA(1, 0, At, B0); PG8_BAR; PG8_SCHED;
            PG8_STAGE(PG8_SB(0, 1), b2 + hstep, voffB);
            PG8_WAIT_V(6); PG8_BAR; PG8_MMA(1, 1, At, B1); PG8_BAR;
            PG8_LDB(B0, 1, 0); PG8_SCHED; PG8_LDA(At, 1, 0); PG8_STAGE(PG8_SA(0, 1), a2 + hstep, voffA);
            PG8_WAIT_L(8); PG8_BAR; PG8_WAIT_L(0); PG8_MMA(0, 0, At, B0); PG8_BAR; PG8_SCHED;
            PG8_LDB(B1, 1, 1); PG8_STAGE(PG8_SB(1, 0), b3, voffB);
            PG8_BAR; PG8_WAIT_L(0); PG8_MMA(0, 1, At, B1); PG8_BAR;
            PG8_LDA(At, 1, 1); PG8_STAGE(PG8_SA(1, 0), a3, voffA);
            PG8_BAR; PG8_WAIT_L(0); PG8_MMA(1, 0, At, B0); PG8_BAR; PG8_SCHED;
            PG8_STAGE(PG8_SB(1, 1), b3 + hstep, voffB);
            PG8_WAIT_V(6); PG8_BAR; PG8_MMA(1, 1, At, B1); PG8_BAR;
        }
        if constexpr (!Epi::AFTER_DRAIN) { E(acc, cur, wr, wc, fr, fq); S.done(cur); }
        if (!has_next) break;
#pragma unroll
        for (int a = 0; a < 2; ++a)
#pragma unroll
            for (int b = 0; b < 2; ++b)
#pragma unroll
                for (int m = 0; m < 4; ++m)
#pragma unroll
                    for (int n = 0; n < 2; ++n) acc[a][b][m][n] = acc_t{};
        cur = nxt; cA = nA; cB = nB; ++ui;
    }
    PG8_WAIT_V(0);
    if (wr == 0) PG8_BAR;
    PG8_BAR;
    if constexpr (Epi::AFTER_DRAIN) { E.fused(acc, cur, wr, wc, fr, fq, lds, wid, lane); S.done(cur); }
#undef PG8_SA
#undef PG8_SB
#undef PG8_STAGE
#undef PG8_LDA
#undef PG8_LDB
#undef PG8_MMA
#undef PG8_WAIT_V
#undef PG8_WAIT_L
#undef PG8_BAR
#undef PG8_SCHED
}
}

__device__ __forceinline__ void phase_prep_naive(const Params& P, int l, int bid, int nb) {
    const int tid_ = TID(); const int half = tid_ >> 8, tid = tid_ & 255;
    for (int vb = bid * 2 + half; vb < NB * 2 * 128; vb += nb * 2) {
        const int n = vb & 127, g = (vb >> 7) & 1, b = vb >> 8;
        const int which = tid >> 7, e = tid & 127;
        const bf16* tm = (const bf16*)(P.ws + WS_TM);
        const bf16* src = tm + (((size_t)b * NTM + (which ? TM_B_VC : TM_B_KC) + g) * S) * 128;
        const float* w = (which ? P.in[I_CMPWV] : P.in[I_CMPWK]) + (size_t)l * 32 * 128 * 128; const float* pos = P.in[I_CMPPOS] + (size_t)l * 32 * 128;
        float acc = 0.f;
        if (n < 127) for (int ll = 0; ll < 32; ++ll) for (int d = 0; d < 128; ++d) acc += (bf2f(src[(size_t)(16 * n + ll) * 128 + d]) + pos[ll * 128 + d]) * w[((size_t)ll * 128 + d) * 128 + e];
        if (which == 0) ((bf16*)(P.ws + WS_KCMP))[(((size_t)b * 2 + g) * 128 + n) * 128 + e] = (bf16)f2bf(acc);
        else ((bf16*)(P.ws + WS_VCMPT))[(((size_t)b * 2 + g) * 128 + e) * 128 + n] = (bf16)f2bf(acc);
    }
    for (int w = bid * 512 + tid_; w < NB * 8 * 4 * 128; w += nb * 512) {
        const int d = w & 127, id = w >> 7, h = id & 3, blk = (id >> 2) & 7, b = id >> 5;
        const bf16* k = (const bf16*)(P.ws + WS_TM) + (((size_t)b * NTM + TM_C_K + h) * S + blk * 256) * 128;
        float s = 0.f; for (int j = 0; j < 256; ++j) s += bf2f(k[(size_t)j * 128 + d]);
        ((float*)(P.ws + WS_KMEAN))[(((size_t)b * 8 + blk) * 4 + h) * 128 + d] = s * (1.0f / 256.f);
    }
}

struct KeyRef { const bf16* krow; int vkey; int dist; bool valid; };
template <class F>
__device__ __forceinline__ void naive_attend(const LAS float* qs, LAS float* sc, int n, F f, const float* biascol, const bf16* Vt, int vstride, int lane, float& o0, float& o1, float& lse, float& zinv) {
    float mx = NEG_INF;
    for (int idx = lane; idx < n; idx += 64) {
        const KeyRef kr = f(idx); float s = NEG_INF;
        if (kr.valid) { float dot = 0.f;
#pragma unroll 4
            for (int c = 0; c < 16; ++c) { const v4u w = *(const v4u*)(kr.krow + c * 8); const f32x4 qa = *(const LAS f32x4*)(qs + c * 8), qb = *(const LAS f32x4*)(qs + c * 8 + 4);
                dot += bf2f(w.x & 0xffff) * qa.x + bf2f(w.x >> 16) * qa.y + bf2f(w.y & 0xffff) * qa.z + bf2f(w.y >> 16) * qa.w + bf2f(w.z & 0xffff) * qb.x + bf2f(w.z >> 16) * qb.y + bf2f(w.w & 0xffff) * qb.z + bf2f(w.w >> 16) * qb.w; }
            s = dot * QK_SCALE + biascol[rel_bucket(kr.dist) * 16]; }
        sc[idx] = s; mx = fmaxf(mx, s);
    }
    mx = wave_max(mx); const float m = (mx > NEG_INF) ? mx : 0.f;
    WAVE_LDS_SYNC();
    float z = 0.f;
    for (int idx = lane; idx < n; idx += 64) { const float e = __expf(sc[idx] - m); sc[idx] = e; z += e; }
    z = wave_sum(z); const float zs = z > 0.f ? z : 1.f;
    WAVE_LDS_SYNC();
    float a0 = 0.f, a1 = 0.f;
    for (int idx = 0; idx < n; ++idx) { const float p = sc[idx]; if (p != 0.f) { const KeyRef kr = f(idx); a0 += p * bf2f(Vt[(size_t)(2 * lane) * vstride + kr.vkey]); a1 += p * bf2f(Vt[(size_t)(2 * lane + 1) * vstride + kr.vkey]); } }
    zinv = 1.0f / zs; o0 = a0 * zinv; o1 = a1 * zinv; lse = z > 0.f ? m + __logf(zs) : NEG_INF;
}
__device__ __forceinline__ void load_q_lds(const bf16* qrow, LAS float* qs, int lane) { qs[2 * lane] = bf2f(qrow[2 * lane]); qs[2 * lane + 1] = bf2f(qrow[2 * lane + 1]); WAVE_LDS_SYNC(); }

__device__ __forceinline__ void attnA_item(const Params& P, int id, int lane, LAS float* qs, LAS float* sc) {
    const int i = id & 2047, h = (id >> 11) % 6, b = id / (6 * S);
    const bf16* tm = (const bf16*)(P.ws + WS_TM); const bf16* vt = (const bf16*)(P.ws + WS_VT);
    const bf16* Q = tm + (((size_t)b * NTM + TM_A_Q + h) * S) * 128; const bf16* K = tm + (((size_t)b * NTM + TM_A_K + h) * S) * 128; const bf16* V = vt + (((size_t)b * NVT + VT_A_V + h) * 128) * S;
    load_q_lds(Q + (size_t)i * 128, qs, lane);
    const float* biascol = P.in[I_RELBIAS] + h;
    float o0[3], o1[3], lse[3], zi;
#pragma unroll
    for (int p = 0; p < 3; ++p) { const int dil = p == 0 ? 1 : p == 1 ? 4 : 16; const int nk = min(128, i / dil) + 1;
        naive_attend(qs, sc, nk, [&](int idx) { KeyRef r; const int j = i - idx * dil; r.krow = K + (size_t)j * 128; r.vkey = j; r.dist = idx * dil; r.valid = true; return r; }, biascol, V, S, lane, o0[p], o1[p], lse[p], zi);
        WAVE_LDS_SYNC(); }
    const float m = fmaxf(lse[0], fmaxf(lse[1], lse[2])); const float w0 = __expf(lse[0] - m), w1 = __expf(lse[1] - m), w2 = __expf(lse[2] - m), wi = 1.0f / (w0 + w1 + w2);
    const float r0 = (w0 * o0[0] + w1 * o0[1] + w2 * o0[2]) * wi, r1 = (w0 * o1[0] + w1 * o1[1] + w2 * o1[2]) * wi;
    const size_t t = (size_t)b * S + i; bf16* o = (bf16*)(P.ws + WS_ACT1);
    *(unsigned*)(o + t * D + h * 128 + 2 * lane) = pk2(r0, r1);
    const float ssq = wave_sum(r0 * r0 + r1 * r1); if (lane == 0) ((float*)(P.ws + WS_SS))[t * 16 + h] = ssq;
}
__device__ __forceinline__ void attnB1_item(const Params& P, int id, int lane, LAS float* qs, LAS float* sc, LAS float* imp) {
    const int i = id & 2047, g = (id >> 11) & 1, b = id >> 12;
    const bf16* tm = (const bf16*)(P.ws + WS_TM);
    const bf16* Kc = (const bf16*)(P.ws + WS_KCMP) + ((size_t)b * 2 + g) * 128 * 128; const bf16* Vc = (const bf16*)(P.ws + WS_VCMPT) + ((size_t)b * 2 + g) * 128 * 128;
    const size_t t = (size_t)b * S + i; const float* gates = (const float*)(P.ws + WS_GATES) + t * 18; float* ocmp = (float*)(P.ws + WS_OCMP) + t * 768;
    const int ncv = i >= 31 ? (i - 31) / 16 + 1 : 0;
    if (lane < 32) imp[lane] = 0.f;
    WAVE_LDS_SYNC();
    for (int r = 0; r < 3; ++r) { const int h = g * 3 + r;
        load_q_lds(tm + (((size_t)b * NTM + TM_B_Q + h) * S + i) * 128, qs, lane);
        float o0, o1, lse, zi;
        naive_attend(qs, sc, ncv, [&](int n) { KeyRef kr; kr.krow = Kc + (size_t)n * 128; kr.vkey = n; kr.dist = i - (16 * n + 31); kr.valid = true; return kr; }, P.in[I_RELBIAS] + 6 + h, Vc, 128, lane, o0, o1, lse, zi);
        const float g0 = gates[h * 3 + 0];
        ocmp[h * 128 + 2 * lane] = g0 * o0; ocmp[h * 128 + 2 * lane + 1] = g0 * o1;
        WAVE_LDS_SYNC();
        if (lane < 32) { float a = 0.f; for (int n = 4 * lane - 1; n <= 4 * lane + 3; ++n) if (n >= 0 && n < ncv) a += sc[n] * zi; imp[lane] += a; }
        WAVE_LDS_SYNC(); }
    const int qblk = i >> 6; float val = NEG_INF;
    if (lane < 32) { val = imp[lane]; if (lane == 0 || lane == qblk || lane == qblk - 1) val = 1e4f; else if (lane > qblk) val = -1e4f; }
    int* sel = (int*)(P.ws + WS_SEL) + (t * 2 + g) * 8;
    for (int k = 0; k < 8; ++k) { const float m = wave_max(val); const int mi = wave_min_i(val == m ? lane : 1 << 30); if (lane == mi) val = NEG_INF; if (lane == 0) sel[k] = mi; }
    WAVE_LDS_SYNC();
}
__device__ __forceinline__ void attnB2_item(const Params& P, int id, int lane, LAS float* qs, LAS float* sc) {
    const int i = id & 2047, h = (id >> 11) % 6, b = id / (6 * S), g = h / 3;
    const bf16* tm = (const bf16*)(P.ws + WS_TM); const bf16* vt = (const bf16*)(P.ws + WS_VT);
    const bf16* Ks = tm + (((size_t)b * NTM + TM_B_KS + g) * S) * 128; const bf16* Kw = tm + (((size_t)b * NTM + TM_B_KW + g) * S) * 128;
    const bf16* Vs = vt + (((size_t)b * NVT + VT_B_VS + g) * 128) * S; const bf16* Vw = vt + (((size_t)b * NVT + VT_B_VW + g) * 128) * S;
    const size_t t = (size_t)b * S + i; const float* gates = (const float*)(P.ws + WS_GATES) + t * 18; const float* ocmp = (const float*)(P.ws + WS_OCMP) + t * 768;
    const int* sel = (const int*)(P.ws + WS_SEL) + (t * 2 + g) * 8;
    load_q_lds(tm + (((size_t)b * NTM + TM_B_Q + h) * S + i) * 128, qs, lane);
    const float* biascol = P.in[I_RELBIAS] + 6 + h;
    float s0, s1, w0, w1, lse, zi;
    naive_attend(qs, sc, 512, [&](int idx) { KeyRef kr; const int key = sel[idx >> 6] * 64 + (idx & 63); kr.krow = Ks + (size_t)key * 128; kr.vkey = key; kr.dist = i - key; kr.valid = key <= i; return kr; }, biascol, Vs, S, lane, s0, s1, lse, zi);
    WAVE_LDS_SYNC();
    naive_attend(qs, sc, min(511, i) + 1, [&](int idx) { KeyRef kr; const int j = i - idx; kr.krow = Kw + (size_t)j * 128; kr.vkey = j; kr.dist = idx; kr.valid = true; return kr; }, biascol, Vw, S, lane, w0, w1, lse, zi);
    WAVE_LDS_SYNC();
    const float g1 = gates[h * 3 + 1], g2 = gates[h * 3 + 2];
    const float r0 = ocmp[h * 128 + 2 * lane] + g1 * s0 + g2 * w0, r1 = ocmp[h * 128 + 2 * lane + 1] + g1 * s1 + g2 * w1;
    bf16* o = (bf16*)(P.ws + WS_ACT1);
    *(unsigned*)(o + t * D + (6 + h) * 128 + 2 * lane) = pk2(r0, r1);
    const float ssq = wave_sum(r0 * r0 + r1 * r1); if (lane == 0) ((float*)(P.ws + WS_SS))[t * 16 + 6 + h] = ssq;
}
__device__ __forceinline__ void attnC_item(const Params& P, int id, int lane, LAS float* qs, LAS float* sc) {
    const int i = id & 2047, h = (id >> 11) & 3, b = id >> 13;
    const bf16* tm = (const bf16*)(P.ws + WS_TM); const bf16* vt = (const bf16*)(P.ws + WS_VT);
    const bf16* K = tm + (((size_t)b * NTM + TM_C_K + h) * S) * 128; const bf16* V = vt + (((size_t)b * NVT + VT_C_V + h) * 128) * S;
    load_q_lds(tm + (((size_t)b * NTM + TM_C_Q + h) * S + i) * 128, qs, lane);
    const float* biascol = P.in[I_RELBIAS] + 12 + h;
    const int qblk = i >> 8, blk0 = qblk << 8;
    float a0, a1, lseo, zi;
    naive_attend(qs, sc, i - blk0 + 1, [&](int idx) { KeyRef kr; const int j = blk0 + idx; kr.krow = K + (size_t)j * 128; kr.vkey = j; kr.dist = i - j; kr.valid = true; return kr; }, biascol, V, S, lane, a0, a1, lseo, zi);
    WAVE_LDS_SYNC();
    const float* km = (const float*)(P.ws + WS_KMEAN) + (size_t)b * 8 * 4 * 128;
    float gv = NEG_INF;
    { float part[8];
#pragma unroll
      for (int n = 0; n < 8; ++n) part[n] = wave_sum(qs[2 * lane] * km[((size_t)n * 4 + h) * 128 + 2 * lane] + qs[2 * lane + 1] * km[((size_t)n * 4 + h) * 128 + 2 * lane + 1]);
#pragma unroll
      for (int n = 0; n < 8; ++n) if (lane == n && n < qblk) gv = part[n]; }
    int sb0, sb1, sb2;
    { float m = wave_max(gv); sb0 = wave_min_i((gv == m && lane < 8) ? lane : 1 << 30); if (lane == sb0) gv = __builtin_nanf("");
      m = wave_max(gv); sb1 = wave_min_i((gv == m && lane < 8) ? lane : 1 << 30); if (lane == sb1) gv = __builtin_nanf("");
      m = wave_max(gv); sb2 = wave_min_i((gv == m && lane < 8) ? lane : 1 << 30); }
    float b0, b1, lseg;
    naive_attend(qs, sc, 768, [&](int idx) { KeyRef kr; const int sb = idx < 256 ? sb0 : idx < 512 ? sb1 : sb2; const int key = sb * 256 + (idx & 255); kr.krow = K + (size_t)key * 128; kr.vkey = key; kr.dist = i - key; kr.valid = sb < qblk; return kr; }, biascol, V, S, lane, b0, b1, lseg, zi);
    WAVE_LDS_SYNC();
    float r0, r1;
    if (lseg == NEG_INF) { r0 = a0; r1 = a1; }
    else { const float m = fmaxf(lseo, lseg), wo = __expf(lseo - m), wg = __expf(lseg - m), wi = 1.0f / (wo + wg); r0 = (wo * a0 + wg * b0) * wi; r1 = (wo * a1 + wg * b1) * wi; }
    const size_t t = (size_t)b * S + i; bf16* o = (bf16*)(P.ws + WS_ACT1);
    *(unsigned*)(o + t * D + (12 + h) * 128 + 2 * lane) = pk2(r0, r1);
    const float ssq = wave_sum(r0 * r0 + r1 * r1); if (lane == 0) ((float*)(P.ws + WS_SS))[t * 16 + 12 + h] = ssq;
}
constexpr int NA_WAVE_F = 128 + 2048 + 32;
__device__ __forceinline__ void phase_attn_naive1(const Params& P, int bid, int nb, LAS unsigned char* lds) {
    const int tid_ = TID(); const int lane = tid_ & 63, wave = tid_ >> 6, gw = bid * 8 + wave, ngw = nb * 8;
    LAS float* qs = (LAS float*)lds + wave * NA_WAVE_F; LAS float* sc = qs + 128; LAS float* imp = sc + 2048;
    for (int id = gw; id < NB * 6 * S; id += ngw) attnA_item(P, id, lane, qs, sc);
    for (int id = gw; id < NB * 2 * S; id += ngw) attnB1_item(P, id, lane, qs, sc, imp);
    for (int id = gw; id < NB * 4 * S; id += ngw) attnC_item(P, id, lane, qs, sc);
}
__device__ __forceinline__ void phase_attn_naive2(const Params& P, int bid, int nb, LAS unsigned char* lds) {
    const int tid_ = TID(); const int lane = tid_ & 63, wave = tid_ >> 6, gw = bid * 8 + wave, ngw = nb * 8;
    LAS float* qs = (LAS float*)lds + wave * NA_WAVE_F; LAS float* sc = qs + 128;
    for (int id = gw; id < NB * 6 * S; id += ngw) attnB2_item(P, id, lane, qs, sc);
}

template <int NV>
__device__ __forceinline__ void wave_top16(float (&v)[NV], int idx0, int istep, int lane, float& outv, int& outi) {
    outv = 0.f; outi = 0;
    for (int k = 0; k < 16; ++k) {
        float bv = v[0]; int bi = idx0;
#pragma unroll
        for (int e = 1; e < NV; ++e) if (v[e] > bv) { bv = v[e]; bi = idx0 + e * istep; }
        const float m = wave_max(bv); const int mi = wave_min_i(bv == m ? bi : 1 << 30);
#pragma unroll
        for (int e = 0; e < NV; ++e) if (idx0 + e * istep == mi) v[e] = NEG_INF;
        if (lane == k) { outv = m; outi = mi; }
    }
}
__device__ __forceinline__ void peer_select_item(const Params& P, int l, int id, int lane, LAS float* qs) {
    const int h = id & 7; const size_t t = id >> 3;
    const bf16* q = (const bf16*)(P.ws + WS_ACT1) + t * D + h * 256;
#pragma unroll
    for (int j = 0; j < 4; ++j) qs[lane * 4 + j] = bf2f(q[lane * 4 + j]);
    WAVE_LDS_SYNC();
    float tv[2]; int ti[2];
#pragma unroll
    for (int c = 0; c < 2; ++c) {
        const float* keys = P.in[I_PEERKEYS] + ((((size_t)l * 8 + h) * 2 + c) * 128) * 128;
        float sc[2] = {0.f, 0.f};
        const float* k0p = keys + (size_t)lane * 128; const float* k1p = k0p + 64 * 128;
#pragma unroll 4
        for (int d = 0; d < 128; d += 4) { const f32x4 qq = *(const LAS f32x4*)(qs + c * 128 + d); const f32x4 k0 = *(const f32x4*)(k0p + d), k1 = *(const f32x4*)(k1p + d);
            sc[0] += qq.x * k0.x + qq.y * k0.y + qq.z * k0.z + qq.w * k0.w; sc[1] += qq.x * k1.x + qq.y * k1.y + qq.z * k1.z + qq.w * k1.w; }
        wave_top16<2>(sc, lane, 64, lane, tv[c], ti[c]);
    }
    float cv[4];
    const float s0 = lane_get(tv[0], lane >> 2);
#pragma unroll
    for (int e = 0; e < 4; ++e) cv[e] = s0 + lane_get(tv[1], (lane & 3) * 4 + e);
    float bs; int bj; wave_top16<4>(cv, lane * 4, 1, lane, bs, bj);
    const int ei = lane_get_i(ti[0], bj >> 4) * 128 + lane_get_i(ti[1], bj & 15);
    const float m = lane_get(bs, 0); float e = lane < 16 ? __expf(bs - m) : 0.f; const float z = wave_sum(e);
    if (lane < 16) { ((int*)(P.ws + WS_EXP))[t * 128 + h * 16 + lane] = ei; ((float*)(P.ws + WS_GW))[t * 128 + h * 16 + lane] = e / z; }
    WAVE_LDS_SYNC();
}
__device__ __forceinline__ void phase_peer_select_naive(const Params& P, int l, int bid, int nb, LAS unsigned char* lds) {
    const int tid_ = TID(); const int lane = tid_ & 63, wave = tid_ >> 6, gw = bid * 8 + wave, ngw = nb * 8;
    LAS float* qs = (LAS float*)lds + wave * 256;
    for (int id = gw; id < T * 8; id += ngw) peer_select_item(P, l, id, lane, qs);
}
__device__ __forceinline__ void unpack8(const v4u w, float (&f)[8]) { f[0] = bf2f(w.x & 0xffff); f[1] = bf2f(w.x >> 16); f[2] = bf2f(w.y & 0xffff); f[3] = bf2f(w.y >> 16); f[4] = bf2f(w.z & 0xffff); f[5] = bf2f(w.z >> 16); f[6] = bf2f(w.w & 0xffff); f[7] = bf2f(w.w >> 16); }

namespace fa {
typedef short bf16x8 __attribute__((ext_vector_type(8)));
typedef float f32x16 __attribute__((ext_vector_type(16)));
typedef __bf16 bf2_t __attribute__((ext_vector_type(2)));
typedef float f2_t __attribute__((ext_vector_type(2)));
#define FA_MFMA(a, b, c) __builtin_amdgcn_mfma_f32_32x32x16_bf16((a), (b), (c), 0, 0, 0)
constexpr float C1 = 0.08838834764831845f * 1.4426950408889634f;
constexpr float LOG2E = 1.4426950408889634f;
constexpr float DEAD = -2e30f, MINIT = -1e30f;
constexpr int KP = 272, VP = 136;
constexpr int STG = 64 * KP + 128 * VP;
constexpr int L_STG0 = 0, L_STG1 = STG, L_T1 = 2 * STG, TBL = 2304 * 4, L_T2 = L_T1 + TBL, L_X = L_T2 + TBL;
constexpr int L_KC = 0, KCP = 272, L_VC = 128 * KCP, VCP = 264;
static_assert(L_VC + 128 * VCP <= L_T1 && L_X + 3 * TBL <= 131072 - 256, "attention LDS map");
constexpr int L_CTL = 131072 - 256;
__device__ __forceinline__ unsigned cvt2(float lo, float hi) { f2_t v = {lo, hi}; return __builtin_bit_cast(unsigned, __builtin_convertvector(v, bf2_t)); }
__device__ __forceinline__ float xhalf(float v, int h) { float lo, hi; halves(v, lo, hi); return h ? lo : hi; }
__device__ __forceinline__ int xhalf_i(int v, int h) { int lo, hi; halves_i(v, lo, hi); return h ? lo : hi; }

__device__ __forceinline__ void copy_table(LAS float* T, const Params& P, int kind, int gh, int tid) {
    const GAS f32x4* src = (const GAS f32x4*)((const GAS float*)(P.ws + WS_TBL) + (size_t)(gh * 3 + kind) * 2304);
    for (int i = tid; i < 576; i += 512) *(LAS f32x4*)(T + 4 * i) = src[i];
}
struct Stream { const bf16* K; const bf16* Vt; const LAS float* T; int jlo, jhi; unsigned ormask; int shift; unsigned rowmask; int maxd; };
struct State { f32x16 o[4]; float m, l; };
__device__ __forceinline__ void state_init(State& s) {
#pragma unroll
    for (int mt = 0; mt < 4; ++mt)
#pragma unroll
        for (int i = 0; i < 16; ++i) s.o[mt][i] = 0.f;
    s.m = MINIT; s.l = 0.f;
}
__device__ __forceinline__ int next_active(int j, int jhi, unsigned ormask, int shift) { while (j <= jhi && !((ormask >> (j >> shift)) & 1u)) ++j; return j <= jhi ? j : -1; }
__device__ __forceinline__ void run_stream(const Stream& st, const bf16x8 (&bq)[8], State& S, int qpos, LAS unsigned char* lds, int tid) {
    const int lane = tid & 63, r = lane & 31, h = lane >> 5;
    int j = next_active(st.jlo, st.jhi, st.ormask, st.shift);
    if (j < 0) return;
    const GAS unsigned char* Kg = (const GAS unsigned char*)st.K; const GAS unsigned char* Vg = (const GAS unsigned char*)st.Vt;
    const int kc0 = tid, kc1 = tid + 512;
    const unsigned k_lds0 = (kc0 >> 4) * KP + (kc0 & 15) * 16, k_lds1 = (kc1 >> 4) * KP + (kc1 & 15) * 16;
    const unsigned v_lds0 = 64 * KP + (kc0 >> 3) * VP + (kc0 & 7) * 16, v_lds1 = 64 * KP + (kc1 >> 3) * VP + (kc1 & 7) * 16;
    const size_t v_g0 = (size_t)(kc0 >> 3) * (::S * 2) + (kc0 & 7) * 16, v_g1 = (size_t)(kc1 >> 3) * (::S * 2) + (kc1 & 7) * 16;
    v4u ka0, ka1, va0, va1, kb0, kb1, vb0, vb1;
#define FA_PREFETCH(kr0, kr1, vr0, vr1, jj) do { const size_t kb_ = (size_t)(jj) * (64 * 256); kr0 = *(const GAS v4u*)(Kg + kb_ + (size_t)kc0 * 16); kr1 = *(const GAS v4u*)(Kg + kb_ + (size_t)kc1 * 16); \
        const size_t vb_ = (size_t)(jj) * 128; vr0 = *(const GAS v4u*)(Vg + vb_ + v_g0); vr1 = *(const GAS v4u*)(Vg + vb_ + v_g1); } while (0)
#define FA_WRITE(kr0, kr1, vr0, vr1, stg) do { LAS unsigned char* sw = lds + (stg); *(LAS v4u*)(sw + k_lds0) = kr0; *(LAS v4u*)(sw + k_lds1) = kr1; \
        *(LAS v2u*)(sw + v_lds0) = (v2u){vr0.x, vr0.y}; *(LAS v2u*)(sw + v_lds0 + 8) = (v2u){vr0.z, vr0.w}; *(LAS v2u*)(sw + v_lds1) = (v2u){vr1.x, vr1.y}; *(LAS v2u*)(sw + v_lds1 + 8) = (v2u){vr1.z, vr1.w}; } while (0)
    auto compute = [&](const int j, const LAS unsigned char* sb, const bool force_dead) __attribute__((always_inline)) {
#if FA_STAGGER
        if (tid >= 256) __builtin_amdgcn_s_sleep(FA_STAGGER);
#endif
        const bool bit = ((st.rowmask >> (j >> st.shift)) & 1u) && !force_dead;
        const int bidx = bit ? (qpos - 64 * j + 256 - 4 * h - 59) : (4 - 4 * h);
        const LAS float* tp = st.T + bidx;
        const int wq_hi = qpos - r + 31, wq_lo = qpos - r;
#pragma unroll
        for (int kt = 0; kt < 2; ++kt) {
            if (64 * j + 32 * kt > wq_hi || 64 * j + 32 * kt + 31 < wq_lo - st.maxd) continue;
            f32x16 sc;
#pragma unroll
            for (int i = 0; i < 16; ++i) sc[i] = 0.f;
            { bf16x8 af[8];
#pragma unroll
              for (int ks = 0; ks < 8; ++ks) af[ks] = *(const LAS bf16x8*)(sb + (32 * kt + r) * KP + (16 * ks + 8 * h) * 2);
              __builtin_amdgcn_s_setprio(1);
#pragma unroll
              for (int ks = 0; ks < 8; ++ks) sc = FA_MFMA(af[ks], bq[ks], sc);
              __builtin_amdgcn_s_setprio(0); }
            float mloc = S.m;
#pragma unroll
            for (int i = 0; i < 16; ++i) { const float s = __builtin_fmaf(sc[i], C1, tp[59 - 32 * kt - 8 * (i >> 2) - (i & 3)]); sc[i] = s; mloc = fmaxf(mloc, s); }
            float mlo_, mhi_; halves(mloc, mlo_, mhi_); const float mnew = fmaxf(mlo_, mhi_);
            const float alpha = __builtin_amdgcn_exp2f(S.m - mnew);
            float lsum = 0.f;
#pragma unroll
            for (int i = 0; i < 16; ++i) { const float p = __builtin_amdgcn_exp2f(sc[i] - mnew); sc[i] = p; lsum += p; }
            S.l = S.l * alpha + lsum; S.m = mnew;
            if (__builtin_amdgcn_ballot_w64(alpha != 1.0f) != 0ull) {
#pragma unroll
                for (int mt = 0; mt < 4; ++mt)
#pragma unroll
                    for (int i = 0; i < 16; ++i) S.o[mt][i] *= alpha;
            }
#pragma unroll
            for (int s2 = 0; s2 < 2; ++s2) { const int sp = 2 * kt + s2, s8 = s2 * 8;
                v4u pw; pw.x = cvt2(sc[s8 + 0], sc[s8 + 1]); pw.y = cvt2(sc[s8 + 2], sc[s8 + 3]); pw.z = cvt2(sc[s8 + 4], sc[s8 + 5]); pw.w = cvt2(sc[s8 + 6], sc[s8 + 7]);
                const bf16x8 pb = __builtin_bit_cast(bf16x8, pw);
                bf16x8 vf[4];
#pragma unroll
                for (int mt = 0; mt < 4; ++mt) { const LAS unsigned char* vp = sb + 64 * KP + (32 * mt + r) * VP + (16 * sp + 4 * h) * 2;
                    const v2u lo = *(const LAS v2u*)vp, hi = *(const LAS v2u*)(vp + 16);
                    vf[mt] = __builtin_bit_cast(bf16x8, (v4u){lo.x, lo.y, hi.x, hi.y}); }
                __builtin_amdgcn_s_setprio(1);
#pragma unroll
                for (int mt = 0; mt < 4; ++mt) S.o[mt] = FA_MFMA(vf[mt], pb, S.o[mt]);
                __builtin_amdgcn_s_setprio(0); }
        }
    };
    int jc = j, jn = next_active(jc + 1, st.jhi, st.ormask, st.shift);
    FA_PREFETCH(ka0, ka1, va0, va1, jc); FA_WRITE(ka0, ka1, va0, va1, L_STG0);
    FA_PREFETCH(ka0, ka1, va0, va1, jn >= 0 ? jn : jc);
    __syncthreads();
    for (;;) {
        const int j2 = jn >= 0 ? next_active(jn + 1, st.jhi, st.ormask, st.shift) : -1;
        FA_PREFETCH(kb0, kb1, vb0, vb1, j2 >= 0 ? j2 : jc);
        compute(jc, lds + L_STG0, false);
        asm volatile("s_waitcnt vmcnt(4)" ::: "memory");
        FA_WRITE(ka0, ka1, va0, va1, L_STG1);
        asm volatile("s_waitcnt lgkmcnt(0)\n\ts_barrier" ::: "memory");
        if (jn < 0) break;
        const int j3 = j2 >= 0 ? next_active(j2 + 1, st.jhi, st.ormask, st.shift) : -1;
        FA_PREFETCH(ka0, ka1, va0, va1, j3 >= 0 ? j3 : jn);
        compute(jn, lds + L_STG1, false);
        asm volatile("s_waitcnt vmcnt(4)" ::: "memory");
        FA_WRITE(kb0, kb1, vb0, vb1, L_STG0);
        asm volatile("s_waitcnt lgkmcnt(0)\n\ts_barrier" ::: "memory");
        if (j2 < 0) break;
        jc = j2; jn = j3;
    }
    asm volatile("s_waitcnt vmcnt(0)" ::: "memory");
    __syncthreads();
#undef FA_PREFETCH
#undef FA_WRITE
}
__device__ __forceinline__ void load_q(const bf16* Qrow, bf16x8 (&bq)[8], int h) {
#pragma unroll
    for (int ks = 0; ks < 8; ++ks) bq[ks] = __builtin_bit_cast(bf16x8, *(const GAS v4u*)((const GAS bf16*)Qrow + 16 * ks + 8 * h));
}
__device__ __forceinline__ float finish(State& S, float wgt) { float llo_, lhi_; halves(S.l, llo_, lhi_); const float lt = llo_ + lhi_; const float inv = wgt / lt;
#pragma unroll
    for (int mt = 0; mt < 4; ++mt)
#pragma unroll
        for (int i = 0; i < 16; ++i) S.o[mt][i] *= inv;
    return inv; }
__device__ __forceinline__ void store_out(const State& S, bf16* o, float* ss, size_t t, int gh, int h) {
    float q = 0.f; GAS bf16* op = (GAS bf16*)o + t * D + gh * 128 + 4 * h;
#pragma unroll
    for (int mt = 0; mt < 4; ++mt)
#pragma unroll
        for (int g = 0; g < 4; ++g) { const float a = S.o[mt][4 * g], b = S.o[mt][4 * g + 1], c = S.o[mt][4 * g + 2], d = S.o[mt][4 * g + 3];
            q += a * a + b * b + c * c + d * d; *(GAS v2u*)(op + 32 * mt + 8 * g) = (v2u){cvt2(a, b), cvt2(c, d)}; }
    { float qlo_, qhi_; halves(q, qlo_, qhi_); q = qlo_ + qhi_; } if (h == 0) ss[t * 16 + gh] = q;
}
__device__ __forceinline__ void decode_unit(int u, int& b, int& gh, int& qt) {
    int isb, w;
    if (u < 240) { isb = 1; qt = 7 - u / 48; w = u % 48; }
    else if (u < 320) { isb = 0; qt = 7; w = u - 240; }
    else if (u < 368) { isb = 1; qt = 2; w = u - 320; }
    else if (u < 528) { isb = 0; qt = 6 - (u - 368) / 80; w = (u - 368) % 80; }
    else if (u < 576) { isb = 1; qt = 1; w = u - 528; }
    else if (u < 736) { isb = 0; qt = 4 - (u - 576) / 80; w = (u - 576) % 80; }
    else if (u < 784) { isb = 1; qt = 0; w = u - 736; }
    else { isb = 0; qt = 2 - (u - 784) / 80; w = (u - 784) % 80; }
    b = w & 7; const int hh = w >> 3;
    if (isb) gh = 6 + hh; else gh = hh < 6 ? hh : 12 + (hh - 6);
}

__device__ __forceinline__ void attn_unit(const Params& P, int u, LAS unsigned char* lds) {
    const int tid = TID();
    const int lane = tid & 63, wave = tid >> 6, r = lane & 31, h = lane >> 5;
    int b, gh, qt; decode_unit(u, b, gh, qt);
    const int q0 = qt * 256, qpos = q0 + 32 * wave + r; const size_t t = (size_t)b * S + qpos;
    const bf16* tm = (const bf16*)(P.ws + WS_TM); const bf16* vt = (const bf16*)(P.ws + WS_VT);
    bf16* o = (bf16*)(P.ws + WS_ACT1); float* ss = (float*)(P.ws + WS_SS);
    volatile LAS unsigned* ctl = (volatile LAS unsigned*)(lds + L_CTL);
    LAS float* T1 = (LAS float*)(lds + L_T1); LAS float* T2 = (LAS float*)(lds + L_T2);
    bf16x8 bq[8]; State St;
    if (gh < 6) {
        copy_table(T1, P, 2, gh, tid);
        load_q(tm + (((size_t)b * NTM + TM_A_Q + gh) * S + qpos) * 128, bq, h);
        __syncthreads();
        state_init(St);
        Stream s{tm + ((size_t)b * NTM + TM_A_K + gh) * S * 128, vt + ((size_t)b * NVT + VT_A_V + gh) * 128 * S, T1, 0, 4 * qt + 3, 0xffffffffu, 0, 0xffffffffu, 4096};
        run_stream(s, bq, St, qpos, lds, tid);
        finish(St, 1.0f); store_out(St, o, ss, t, gh, h);
    } else if (gh >= 12) {
        const int hc = gh - 12;
        copy_table(T1, P, 0, gh, tid);
        LAS float* km = (LAS float*)(lds + L_X);
        { const float* kmg = (const float*)(P.ws + WS_KMEAN) + (size_t)b * 8 * 4 * 128;
          for (int i = tid; i < qt * 128; i += 512) km[i] = kmg[((size_t)(i >> 7) * 4 + hc) * 128 + (i & 127)]; }
        load_q(tm + (((size_t)b * NTM + TM_C_Q + hc) * S + qpos) * 128, bq, h);
        if (tid == 0) ctl[1] = 0u;
        __syncthreads();
        float gate[8];
#pragma unroll
        for (int n = 0; n < 8; ++n) gate[n] = 0.f;
#pragma unroll
        for (int ks = 0; ks < 8; ++ks) { const v4u w = __builtin_bit_cast(v4u, bq[ks]); float f[8]; unpack8(w, f);
#pragma unroll
            for (int n = 0; n < 8; ++n) if (n < qt) { const f32x4 k0 = *(const LAS f32x4*)(km + n * 128 + 16 * ks + 8 * h), k1 = *(const LAS f32x4*)(km + n * 128 + 16 * ks + 8 * h + 4);
                gate[n] += f[0] * k0.x + f[1] * k0.y + f[2] * k0.z + f[3] * k0.w + f[4] * k1.x + f[5] * k1.y + f[6] * k1.z + f[7] * k1.w; } }
        unsigned rowmask = 1u << qt;
#pragma unroll
        for (int n = 0; n < 8; ++n) { float glo_, ghi_; halves(gate[n], glo_, ghi_); gate[n] = glo_ + ghi_; if (n >= qt) gate[n] = NEG_INF; }
#pragma unroll
        for (int k = 0; k < 3; ++k) { float bv = NEG_INF; int bi = -1;
#pragma unroll
            for (int n = 0; n < 8; ++n) if (gate[n] > bv) { bv = gate[n]; bi = n; }
#pragma unroll
            for (int n = 0; n < 8; ++n) if (n == bi) { gate[n] = NEG_INF; rowmask |= 1u << n; } }
        { const unsigned om = wave_or(rowmask); if (lane == 0) atomicOr((unsigned*)(ctl + 1), om); }
        __syncthreads();
        const unsigned ormask = ctl[1];
        state_init(St);
        Stream s{tm + ((size_t)b * NTM + TM_C_K + hc) * S * 128, vt + ((size_t)b * NVT + VT_C_V + hc) * 128 * S, T1, 0, 4 * qt + 3, ormask, 2, rowmask, 4096};
        run_stream(s, bq, St, qpos, lds, tid);
        finish(St, 1.0f); store_out(St, o, ss, t, gh, h);
    } else {
        const int hb = gh - 6, g = hb / 3;
        const float* gates = (const float*)(P.ws + WS_GATES) + t * 18 + hb * 3; const float g0 = gates[0], g1 = gates[1], g2 = gates[2];
        GAS float* oacc = (GAS float*)(P.ws + WS_OCMP) + t * 768 + hb * 128 + 4 * h;
        { const GAS unsigned char* kcg = (const GAS unsigned char*)((const bf16*)(P.ws + WS_KCMP) + ((size_t)b * 2 + g) * 128 * 128); const GAS unsigned char* vcg = (const GAS unsigned char*)((const bf16*)(P.ws + WS_VCMPT) + ((size_t)b * 2 + g) * 128 * 128);
#pragma unroll
          for (int c = tid; c < 2048; c += 512) { const v4u kv = *(const GAS v4u*)(kcg + (size_t)c * 16); *(LAS v4u*)(lds + L_KC + (c >> 4) * KCP + (c & 15) * 16) = kv;
              const v4u vv = *(const GAS v4u*)(vcg + (size_t)c * 16); LAS unsigned char* vd = lds + L_VC + (c >> 4) * VCP + (c & 15) * 16; *(LAS v2u*)vd = (v2u){vv.x, vv.y}; *(LAS v2u*)(vd + 8) = (v2u){vv.z, vv.w}; } }
#pragma unroll
        for (int rr = 0; rr < 3; ++rr) copy_table((LAS float*)(lds + L_X + rr * TBL), P, 0, 6 + g * 3 + rr, tid);
        copy_table(T1, P, 0, gh, tid); copy_table(T2, P, 1, gh, tid);
        if (tid == 0) ctl[1] = 0u;
        __syncthreads();
        float imp[16];
#pragma unroll
        for (int a = 0; a < 16; ++a) imp[a] = 0.f;
        f32x16 sc[4];
#pragma unroll 1
        for (int rq = 0; rq < 3; ++rq) { int rr = hb - g * 3 + 1 + rq; rr = rr >= 3 ? rr - 3 : rr; const int hh = g * 3 + rr;
            asm volatile("" ::: "memory");
            load_q(tm + (((size_t)b * NTM + TM_B_Q + hh) * S + qpos) * 128, bq, h);
            const LAS float* Tc = (const LAS float*)(lds + L_X + rr * TBL);
#pragma unroll
            for (int kt = 0; kt < 4; ++kt) {
#pragma unroll
                for (int i = 0; i < 16; ++i) sc[kt][i] = 0.f;
#pragma unroll
                for (int ks = 0; ks < 8; ++ks) { const bf16x8 a = *(const LAS bf16x8*)(lds + L_KC + (32 * kt + r) * KCP + (16 * ks + 8 * h) * 2); sc[kt] = FA_MFMA(a, bq[ks], sc[kt]); } }
            float mloc = MINIT;
#pragma unroll
            for (int kt = 0; kt < 4; ++kt)
#pragma unroll
                for (int i = 0; i < 16; ++i) { const int n = 32 * kt + 8 * (i >> 2) + 4 * h + (i & 3); int idx = qpos - 16 * n - 31 + 256; idx = idx < 0 ? 0 : idx;
                    const float s = __builtin_fmaf(sc[kt][i], C1, Tc[idx]); sc[kt][i] = s; mloc = fmaxf(mloc, s); }
            float mlo_, mhi_; halves(mloc, mlo_, mhi_); const float mrow = fmaxf(mlo_, mhi_); float lsum = 0.f;
#pragma unroll
            for (int kt = 0; kt < 4; ++kt)
#pragma unroll
                for (int i = 0; i < 16; ++i) { const float p = __builtin_amdgcn_exp2f(sc[kt][i] - mrow); sc[kt][i] = p; lsum += p; }
            { float slo_, shi_; halves(lsum, slo_, shi_); lsum = slo_ + shi_; } const float inv = lsum > 0.f ? 1.0f / lsum : 0.f;
#pragma unroll
            for (int a = 0; a < 16; ++a) { const int kt = a >> 2, i0 = (a & 3) * 4;
                const float p0 = sc[kt][i0] * inv, p1 = sc[kt][i0 + 1] * inv, p2 = sc[kt][i0 + 2] * inv, p3 = sc[kt][i0 + 3] * inv;
                sc[kt][i0] = p0; sc[kt][i0 + 1] = p1; sc[kt][i0 + 2] = p2; sc[kt][i0 + 3] = p3;
                imp[a] += (p0 + p1) + (p2 + p3); }
            { float prev = 0.f;
#pragma unroll
              for (int a = 0; a < 16; ++a) { const float lv = xhalf(sc[a >> 2][(a & 3) * 4 + 3], h); imp[a] += h ? lv : prev; prev = lv; } }
        }
        state_init(St);
#pragma unroll
        for (int sp = 0; sp < 8; ++sp) { const int kt = sp >> 1, s8 = (sp & 1) * 8;
            v4u pw; pw.x = cvt2(sc[kt][s8 + 0], sc[kt][s8 + 1]); pw.y = cvt2(sc[kt][s8 + 2], sc[kt][s8 + 3]); pw.z = cvt2(sc[kt][s8 + 4], sc[kt][s8 + 5]); pw.w = cvt2(sc[kt][s8 + 6], sc[kt][s8 + 7]);
            const bf16x8 pb = __builtin_bit_cast(bf16x8, pw);
#pragma unroll
            for (int mt = 0; mt < 4; ++mt) { const LAS unsigned char* vp = lds + L_VC + (32 * mt + r) * VCP + (16 * sp + 4 * h) * 2;
                const v2u lo = *(const LAS v2u*)vp, hi = *(const LAS v2u*)(vp + 16);
                St.o[mt] = FA_MFMA(__builtin_bit_cast(bf16x8, (v4u){lo.x, lo.y, hi.x, hi.y}), pb, St.o[mt]); } }
#pragma unroll
        for (int mt = 0; mt < 4; ++mt)
#pragma unroll
            for (int gq = 0; gq < 4; ++gq) *(GAS f32x4*)(oacc + 32 * mt + 8 * gq) = (f32x4){St.o[mt][4 * gq] * g0, St.o[mt][4 * gq + 1] * g0, St.o[mt][4 * gq + 2] * g0, St.o[mt][4 * gq + 3] * g0};
        const int qblk = qpos >> 6;
        unsigned selmask;
        if (qblk <= 7) selmask = (2u << qblk) - 1u;
        else { selmask = 1u | (3u << (qblk - 1));
#pragma unroll
            for (int a = 0; a < 16; ++a) { const int jb = 2 * a + h; if (jb == 0 || jb >= qblk - 1) imp[a] = NEG_INF; }
#pragma unroll 1
            for (int k = 0; k < 5; ++k) { float bv = NEG_INF; int bj = 1 << 20;
#pragma unroll
                for (int a = 0; a < 16; ++a) if (imp[a] > bv) { bv = imp[a]; bj = 2 * a + h; }
                const float ov = xhalf(bv, h); const int oj = xhalf_i(bj, h);
                const bool mine = (bv > ov) || (bv == ov && bj < oj);
                const int wj = mine ? bj : oj;
                if (wj < 32) { selmask |= 1u << wj;
#pragma unroll
                    for (int a = 0; a < 16; ++a) if (2 * a + h == wj) imp[a] = NEG_INF; } } }
        { const unsigned om = wave_or(selmask); if (lane == 0) atomicOr((unsigned*)(ctl + 1), om); }
        load_q(tm + (((size_t)b * NTM + TM_B_Q + hb) * S + qpos) * 128, bq, h);
        __syncthreads();
        const unsigned ormask = ctl[1];
        state_init(St);
        { Stream s{tm + ((size_t)b * NTM + TM_B_KS + g) * S * 128, vt + ((size_t)b * NVT + VT_B_VS + g) * 128 * S, T1, 0, 4 * qt + 3, ormask, 0, selmask, 4096};
          run_stream(s, bq, St, qpos, lds, tid); }
        finish(St, g1);
#pragma unroll
        for (int mt = 0; mt < 4; ++mt)
#pragma unroll
            for (int gq = 0; gq < 4; ++gq) { const f32x4 pv = *(const GAS f32x4*)(oacc + 32 * mt + 8 * gq);
                *(GAS f32x4*)(oacc + 32 * mt + 8 * gq) = (f32x4){pv.x + St.o[mt][4 * gq], pv.y + St.o[mt][4 * gq + 1], pv.z + St.o[mt][4 * gq + 2], pv.w + St.o[mt][4 * gq + 3]}; }
        state_init(St);
        { const int jlo = q0 >= 512 ? (q0 - 512) / 64 : 0;
          Stream s{tm + ((size_t)b * NTM + TM_B_KW + g) * S * 128, vt + ((size_t)b * NVT + VT_B_VW + g) * 128 * S, T2, jlo, 4 * qt + 3, 0xffffffffu, 0, 0xffffffffu, 511};
          run_stream(s, bq, St, qpos, lds, tid); }
        finish(St, g2);
#pragma unroll
        for (int mt = 0; mt < 4; ++mt)
#pragma unroll
            for (int gq = 0; gq < 4; ++gq) { const f32x4 pv = *(const GAS f32x4*)(oacc + 32 * mt + 8 * gq);
                St.o[mt][4 * gq] += pv.x; St.o[mt][4 * gq + 1] += pv.y; St.o[mt][4 * gq + 2] += pv.z; St.o[mt][4 * gq + 3] += pv.w; }
        store_out(St, o, ss, t, gh, h);
    }
}
__device__ __forceinline__ void phase_attn(const Params& P, int l, LAS unsigned char* lds) {
    const int tid = TID();
    volatile LAS unsigned* ctl = (volatile LAS unsigned*)(lds + L_CTL);
    unsigned* qctr = (unsigned*)(P.ws + WS_CTL) + 8192 + 64 * l;
    for (;;) {
        __syncthreads();
        if (tid == 0) ctl[0] = __hip_atomic_fetch_add(qctr, 1u, __ATOMIC_RELAXED, __HIP_MEMORY_SCOPE_AGENT);
        __syncthreads();
        const unsigned u = ctl[0];
#if TBL_IN_ATTN
        if (l == 0) {
            if (u >= 1280u) break;
            if (u < 1024u && (u & 3u) == 3u) { const int cu = (int)(u >> 2); convert_table_rows(P, cu * 256, cu * 256 + 256, tid >> 6, 8, tid & 63); continue; }
            attn_unit(P, (int)(u < 1024u ? u - (u >> 2) : u - 256u), lds); continue;
        }
#endif
        if (u >= 1024u) break;
        attn_unit(P, (int)u, lds);
    }
}
#undef FA_MFMA
}

namespace pf {
typedef short bf16x8 __attribute__((ext_vector_type(8)));
typedef float f32x16 __attribute__((ext_vector_type(16)));
__device__ __forceinline__ void cmp_unit(const Params& P, int l, int u, LAS unsigned char* lds) {
    const int tid = TID(), lane = tid & 63, wave = tid >> 6, r = lane & 31, h = lane >> 5;
    const int which = u >> 7, bg = (u >> 3) & 15, b = bg >> 1, g = bg & 1, n0 = ((u >> 1) & 3) * 32, e0 = (u & 1) * 64;
    const GAS bf16* A = (const GAS bf16*)(P.ws + WS_TM) + (((size_t)b * NTM + (which ? TM_B_VC : TM_B_KC) + g) * S + 16 * (n0 + r)) * 128 + 512 * wave + 8 * h;
    const GAS bf16* Bt = (const GAS bf16*)(P.ws + WS_CWT) + (((size_t)l * 2 + which) * 128 + e0 + r) * 4096 + 512 * wave + 8 * h;
    float pw = 0.f;
    if (tid < 64) { const GAS float* pp = (const GAS float*)(P.ws + WS_POSW) + ((size_t)l * 2 + which) * 32 * 128 + e0 + tid;
#pragma unroll
        for (int kc = 0; kc < 32; ++kc) pw += pp[kc * 128]; }
    f32x16 acc[2];
#pragma unroll
    for (int ct = 0; ct < 2; ++ct)
#pragma unroll
        for (int i = 0; i < 16; ++i) acc[ct][i] = 0.f;
#pragma unroll 8
    for (int ks = 0; ks < 32; ++ks) {
        const bf16x8 a = __builtin_bit_cast(bf16x8, *(const GAS v4u*)(A + 16 * ks));
#pragma unroll
        for (int ct = 0; ct < 2; ++ct) { const bf16x8 bb = __builtin_bit_cast(bf16x8, *(const GAS v4u*)(Bt + (size_t)ct * 32 * 4096 + 16 * ks)); acc[ct] = __builtin_amdgcn_mfma_f32_32x32x16_bf16(a, bb, acc[ct], 0, 0, 0); }
    }
    LAS float* red = (LAS float*)lds; LAS float* pwl = red + 8 * 2048;
#pragma unroll
    for (int ct = 0; ct < 2; ++ct)
#pragma unroll
        for (int i = 0; i < 16; ++i) red[((wave * 2 + ct) * 16 + i) * 64 + lane] = acc[ct][i];
    if (tid < 64) pwl[tid] = pw;
    __syncthreads();
#pragma unroll
    for (int j = 0; j < 4; ++j) { const int o = tid + 512 * j; float v = 0.f;
#pragma unroll
        for (int w = 0; w < 8; ++w) v += red[w * 2048 + o];
        const int ln = o & 63, i = (o >> 6) & 15, ct = o >> 10; const int n = n0 + (i & 3) + 8 * (i >> 2) + 4 * (ln >> 5), e = e0 + 32 * ct + (ln & 31);
        v += pwl[32 * ct + (ln & 31)];
        if (n == 127) v = 0.f;
        if (which == 0) ((GAS bf16*)(P.ws + WS_KCMP))[(((size_t)b * 2 + g) * 128 + n) * 128 + e] = (bf16)f2bf(v);
        else ((GAS bf16*)(P.ws + WS_VCMPT))[(((size_t)b * 2 + g) * 128 + e) * 128 + n] = (bf16)f2bf(v); }
    __syncthreads();
}
__device__ __forceinline__ void kmean_unit(const Params& P, int u, LAS unsigned char* lds) {
    const int tid = TID(), dp = tid & 63, part = tid >> 6; const int hc = u & 3, blk = (u >> 2) & 7, b = u >> 5;
    const GAS bf16* k = (const GAS bf16*)(P.ws + WS_TM) + (((size_t)b * NTM + TM_C_K + hc) * S + blk * 256 + part * 32) * 128 + 2 * dp;
    float s0 = 0.f, s1 = 0.f;
#pragma unroll 8
    for (int j = 0; j < 32; ++j) { const unsigned w = *(const GAS unsigned*)(k + (size_t)j * 128); s0 += bf2f(w & 0xffff); s1 += bf2f(w >> 16); }
    LAS float* red = (LAS float*)lds; red[part * 128 + 2 * dp] = s0; red[part * 128 + 2 * dp + 1] = s1;
    __syncthreads();
    if (tid < 128) { float v = 0.f;
#pragma unroll
        for (int p = 0; p < 8; ++p) v += red[p * 128 + tid];
        ((GAS float*)(P.ws + WS_KMEAN))[(((size_t)b * 8 + blk) * 4 + hc) * 128 + tid] = v * (1.0f / 256.f); }
    __syncthreads();
}
__device__ __forceinline__ void phase_prep(const Params& P, int l, int bid, int nb, LAS unsigned char* lds) {
    for (int u = bid; u < 512; u += nb) { if (u < 256) cmp_unit(P, l, u, lds); else kmean_unit(P, u - 256, lds); }
}
}

typedef __bf16 bf2_t __attribute__((ext_vector_type(2)));
__device__ __forceinline__ float dot2bf(unsigned a, unsigned b, float c) { return __builtin_amdgcn_fdot2_f32_bf16(__builtin_bit_cast(bf2_t, a), __builtin_bit_cast(bf2_t, b), c, false); }

namespace ps {
typedef short bf16x8 __attribute__((ext_vector_type(8)));
typedef float f32x16 __attribute__((ext_vector_type(16)));
#define PS_CE(a, b) do { const float hi_ = fmaxf((a), (b)), lo_ = fminf((a), (b)); (a) = hi_; (b) = lo_; } while (0)
__device__ __forceinline__ void sort16(float (&v)[16]) {
#pragma unroll
    for (int k = 2; k <= 16; k <<= 1)
#pragma unroll
        for (int j = k >> 1; j > 0; j >>= 1)
#pragma unroll
            for (int i = 0; i < 16; ++i) { const int p = i ^ j; if (p > i) { if ((i & k) == 0) PS_CE(v[i], v[p]); else PS_CE(v[p], v[i]); } }
}
__device__ __forceinline__ void merge16(float (&a)[16], const float (&b)[16]) {
#pragma unroll
    for (int i = 0; i < 16; ++i) a[i] = fmaxf(a[i], b[15 - i]);
#pragma unroll
    for (int j = 8; j > 0; j >>= 1)
#pragma unroll
        for (int i = 0; i < 16; ++i) { const int p = i ^ j; if (p > i) PS_CE(a[i], a[p]); }
}
__device__ __forceinline__ float pack_low(float v, unsigned mask, unsigned tag) { return __uint_as_float((__float_as_uint(v) & ~mask) | tag); }
__device__ __forceinline__ void top16_half(const GAS bf16* keys, const GAS bf16* qrow, int r, int h2, float (&top)[16]) {
    bf16x8 bq[8];
#pragma unroll
    for (int ks = 0; ks < 8; ++ks) bq[ks] = __builtin_bit_cast(bf16x8, *(const GAS v4u*)(qrow + 16 * ks + 8 * h2));
    float grp[4][16];
#pragma unroll
    for (int kt = 0; kt < 4; ++kt) { f32x16 sc;
#pragma unroll
        for (int i = 0; i < 16; ++i) sc[i] = 0.f;
#pragma unroll
        for (int ks = 0; ks < 8; ++ks) { const bf16x8 a = __builtin_bit_cast(bf16x8, *(const GAS v4u*)(keys + (size_t)(32 * kt + r) * 128 + 16 * ks + 8 * h2)); sc = __builtin_amdgcn_mfma_f32_32x32x16_bf16(a, bq[ks], sc, 0, 0, 0); }
#pragma unroll
        for (int i = 0; i < 16; ++i) { const int key = 32 * kt + (i & 3) + 8 * (i >> 2); grp[kt][i] = pack_low(sc[i], 0x7Fu, (unsigned)(127 - key) - 4u * (unsigned)h2); } }
    sort16(grp[0]); sort16(grp[1]); sort16(grp[2]); sort16(grp[3]);
    merge16(grp[0], grp[1]); merge16(grp[2], grp[3]); merge16(grp[0], grp[2]);
    float oth[16];
#pragma unroll
    for (int i = 0; i < 16; ++i) oth[i] = fa::xhalf(grp[0][i], h2);
    merge16(grp[0], oth);
#pragma unroll
    for (int i = 0; i < 16; ++i) top[i] = grp[0][i];
}
__device__ __forceinline__ void select_unit(const Params& P, int l, int u, LAS unsigned char* lds) {
    const int tid = TID(), lane = tid & 63, wave = tid >> 6, r = lane & 31, h2 = lane >> 5;
    const size_t t = (size_t)u * 32 + r;
    const GAS bf16* q = (const GAS bf16*)(P.ws + WS_ACT1) + t * D + wave * 256;
    const GAS bf16* keys = (const GAS bf16*)(P.ws + WS_KEYS) + (((size_t)l * 8 + wave) * 2) * 128 * 128;
    float ts0[16], ts1[16];
    top16_half(keys, q, r, h2, ts0);
    top16_half(keys + 128 * 128, q + 128, r, h2, ts1);
    LAS int* til = (LAS int*)lds + (wave * 32 + r) * 32;
#pragma unroll
    for (int k = 0; k < 16; ++k) { float va = ts0[k], vb = ts1[k]; asm volatile("" : "+v"(va), "+v"(vb)); const float v = h2 ? vb : va; til[h2 * 16 + k] = 127 - (int)(__float_as_uint(v) & 0x7Fu); }
    float cg[4][16];
    cg[0][0] = pack_low(ts0[0] + ts1[0], 0xFFu, 255u);
    cg[0][1] = pack_low(ts0[0] + ts1[1], 0xFFu, 254u);
    cg[0][2] = pack_low(ts0[0] + ts1[2], 0xFFu, 253u);
    cg[0][3] = pack_low(ts0[0] + ts1[3], 0xFFu, 252u);
    cg[0][4] = pack_low(ts0[0] + ts1[4], 0xFFu, 251u);
    cg[0][5] = pack_low(ts0[0] + ts1[5], 0xFFu, 250u);
    cg[0][6] = pack_low(ts0[0] + ts1[6], 0xFFu, 249u);
    cg[0][7] = pack_low(ts0[0] + ts1[7], 0xFFu, 248u);
    cg[0][8] = pack_low(ts0[0] + ts1[8], 0xFFu, 247u);
    cg[0][9] = pack_low(ts0[0] + ts1[9], 0xFFu, 246u);
    cg[0][10] = pack_low(ts0[0] + ts1[10], 0xFFu, 245u);
    cg[0][11] = pack_low(ts0[0] + ts1[11], 0xFFu, 244u);
    cg[0][12] = pack_low(ts0[0] + ts1[12], 0xFFu, 243u);
    cg[0][13] = pack_low(ts0[0] + ts1[13], 0xFFu, 242u);
    cg[0][14] = pack_low(ts0[0] + ts1[14], 0xFFu, 241u);
    cg[0][15] = pack_low(ts0[0] + ts1[15], 0xFFu, 240u);
    cg[1][0] = pack_low(ts0[1] + ts1[0], 0xFFu, 239u);
    cg[1][1] = pack_low(ts0[1] + ts1[1], 0xFFu, 238u);
    cg[1][2] = pack_low(ts0[1] + ts1[2], 0xFFu, 237u);
    cg[1][3] = pack_low(ts0[1] + ts1[3], 0xFFu, 236u);
    cg[1][4] = pack_low(ts0[1] + ts1[4], 0xFFu, 235u);
    cg[1][5] = pack_low(ts0[1] + ts1[5], 0xFFu, 234u);
    cg[1][6] = pack_low(ts0[1] + ts1[6], 0xFFu, 233u);
    cg[1][7] = pack_low(ts0[1] + ts1[7], 0xFFu, 232u);
    cg[1][8] = pack_low(ts0[2] + ts1[0], 0xFFu, 223u);
    cg[1][9] = pack_low(ts0[2] + ts1[1], 0xFFu, 222u);
    cg[1][10] = pack_low(ts0[2] + ts1[2], 0xFFu, 221u);
    cg[1][11] = pack_low(ts0[2] + ts1[3], 0xFFu, 220u);
    cg[1][12] = pack_low(ts0[2] + ts1[4], 0xFFu, 219u);
    cg[1][13] = pack_low(ts0[3] + ts1[0], 0xFFu, 207u);
    cg[1][14] = pack_low(ts0[3] + ts1[1], 0xFFu, 206u);
    cg[1][15] = pack_low(ts0[3] + ts1[2], 0xFFu, 205u);
    cg[2][0] = pack_low(ts0[3] + ts1[3], 0xFFu, 204u);
    cg[2][1] = pack_low(ts0[4] + ts1[0], 0xFFu, 191u);
    cg[2][2] = pack_low(ts0[4] + ts1[1], 0xFFu, 190u);
    cg[2][3] = pack_low(ts0[4] + ts1[2], 0xFFu, 189u);
    cg[2][4] = pack_low(ts0[5] + ts1[0], 0xFFu, 175u);
    cg[2][5] = pack_low(ts0[5] + ts1[1], 0xFFu, 174u);
    cg[2][6] = pack_low(ts0[6] + ts1[0], 0xFFu, 159u);
    cg[2][7] = pack_low(ts0[6] + ts1[1], 0xFFu, 158u);
    cg[2][8] = pack_low(ts0[7] + ts1[0], 0xFFu, 143u);
    cg[2][9] = pack_low(ts0[7] + ts1[1], 0xFFu, 142u);
    cg[2][10] = pack_low(ts0[8] + ts1[0], 0xFFu, 127u);
    cg[2][11] = pack_low(ts0[9] + ts1[0], 0xFFu, 111u);
    cg[2][12] = pack_low(ts0[10] + ts1[0], 0xFFu, 95u);
    cg[2][13] = pack_low(ts0[11] + ts1[0], 0xFFu, 79u);
    cg[2][14] = pack_low(ts0[12] + ts1[0], 0xFFu, 63u);
    cg[2][15] = pack_low(ts0[13] + ts1[0], 0xFFu, 47u);
    cg[3][0] = pack_low(ts0[14] + ts1[0], 0xFFu, 31u);
    cg[3][1] = pack_low(ts0[15] + ts1[0], 0xFFu, 15u);
    cg[3][2] = NEG_INF;
    cg[3][3] = NEG_INF;
    cg[3][4] = NEG_INF;
    cg[3][5] = NEG_INF;
    cg[3][6] = NEG_INF;
    cg[3][7] = NEG_INF;
    cg[3][8] = NEG_INF;
    cg[3][9] = NEG_INF;
    cg[3][10] = NEG_INF;
    cg[3][11] = NEG_INF;
    cg[3][12] = NEG_INF;
    cg[3][13] = NEG_INF;
    cg[3][14] = NEG_INF;
    cg[3][15] = NEG_INF;
    sort16(cg[0]); sort16(cg[1]); sort16(cg[2]); sort16(cg[3]);
    merge16(cg[0], cg[1]); merge16(cg[2], cg[3]); merge16(cg[0], cg[2]);
    WAVE_LDS_SYNC();
    const float m = cg[0][0]; float z = 0.f; float ev[16];
#pragma unroll
    for (int k = 0; k < 16; ++k) { ev[k] = __expf(cg[0][k] - m); z += ev[k]; }
    const float zi = 1.0f / z;
    int eo[8]; float go[8];
#pragma unroll
    for (int k = 0; k < 8; ++k) { float wa = cg[0][k], wb = cg[0][8 + k], ea = ev[k], eb = ev[8 + k]; asm volatile("" : "+v"(wa), "+v"(wb), "+v"(ea), "+v"(eb));
        const float w = h2 ? wb : wa; const int flat = 255 - (int)(__float_as_uint(w) & 0xFFu);
        eo[k] = til[flat >> 4] * 128 + til[16 + (flat & 15)]; go[k] = (h2 ? eb : ea) * zi; }
    GAS int* ex = (GAS int*)(P.ws + WS_EXP) + t * 128 + wave * 16 + 8 * h2; GAS float* gw = (GAS float*)(P.ws + WS_GW) + t * 128 + wave * 16 + 8 * h2;
    typedef int i32x4 __attribute__((ext_vector_type(4)));
    *(GAS i32x4*)ex = (i32x4){eo[0], eo[1], eo[2], eo[3]}; *(GAS i32x4*)(ex + 4) = (i32x4){eo[4], eo[5], eo[6], eo[7]};
    *(GAS f32x4*)gw = (f32x4){go[0], go[1], go[2], go[3]}; *(GAS f32x4*)(gw + 4) = (f32x4){go[4], go[5], go[6], go[7]};
    WAVE_LDS_SYNC();
}
__device__ __forceinline__ void phase_select(const Params& P, int l, int bid, int nb, LAS unsigned char* lds) {
    for (int u = bid; u < T / 32; u += nb) select_unit(P, l, u, lds);
}
#undef PS_CE
}


typedef float f2v_t __attribute__((ext_vector_type(2)));
__device__ __forceinline__ void fp8x4_to_f32(unsigned w, float& a, float& b, float& c, float& d) { const f2v_t lo = __builtin_amdgcn_cvt_pk_f32_fp8((int)w, false), hi = __builtin_amdgcn_cvt_pk_f32_fp8((int)w, true); a = lo.x; b = lo.y; c = hi.x; d = hi.y; }
constexpr int PA_CH = 4;
__device__ __forceinline__ void phase_peer_apply3(const Params& P, int l, int bid, int nb) {
    const int tid = TID(), lane = tid & 63, wave = __builtin_amdgcn_readfirstlane(tid >> 6);
    const GAS bf16* xf = (const GAS bf16*)(P.ws + WS_ACT0);
    const GAS unsigned char* U = (const GAS unsigned char*)(P.ws + WS_U) + (size_t)l * NEXP * D + lane * 16; const GAS unsigned char* V = (const GAS unsigned char*)(P.ws + WS_V) + (size_t)l * NEXP * D + lane * 16;
    const float* su = (const float*)(P.ws + WS_SU) + (size_t)l * NEXP; const float* sv = (const float*)(P.ws + WS_SV) + (size_t)l * NEXP;
    const int* ex = (const int*)(P.ws + WS_EXP); const float* gw = (const float*)(P.ws + WS_GW); GAS bf16* hn = (GAS bf16*)(P.ws + WS_ACT2);
    for (int t = bid * 8 + wave; t < T; t += nb * 8) {
        float x[32], acc[32];
#pragma unroll
        for (int j = 0; j < 2; ++j)
#pragma unroll
            for (int q = 0; q < 2; ++q) { float f[8]; unpack8(*(const GAS v4u*)(xf + (size_t)t * D + j * 1024 + lane * 16 + q * 8), f);
#pragma unroll
                for (int e = 0; e < 8; ++e) { x[j * 16 + q * 8 + e] = f[e]; acc[j * 16 + q * 8 + e] = 0.f; } }
        const int* exr = ex + (size_t)t * 128; const float* gwr = gw + (size_t)t * 128;
        int en[PA_CH];
#pragma unroll
        for (int i = 0; i < PA_CH; ++i) en[i] = __builtin_amdgcn_readfirstlane(exr[i]);
        v4u Ur[PA_CH][2], Vr[2][2];
#pragma unroll
        for (int i = 0; i < PA_CH; ++i)
#pragma unroll
            for (int j = 0; j < 2; ++j) Ur[i][j] = *(const GAS v4u*)(U + (size_t)en[i] * D + j * 1024);
#if DUP_PHASE == 10
        for (int rep = 0; rep < 2; ++rep) { if (rep == 1) { float zz = 0.f; asm volatile("" : "+v"(zz));
#pragma unroll
            for (int i = 0; i < 32; ++i) acc[i] *= zz; }
#endif
#pragma unroll 1
        for (int kc = 0; kc < 128 / PA_CH; ++kc) {
            int ec[PA_CH]; float d[PA_CH];
#pragma unroll
            for (int i = 0; i < PA_CH; ++i) ec[i] = en[i];
            const int kn = kc < 128 / PA_CH - 1 ? kc + 1 : kc;
#pragma unroll
            for (int i = 0; i < PA_CH; ++i) en[i] = __builtin_amdgcn_readfirstlane(exr[PA_CH * kn + i]);
#pragma unroll
            for (int i = 0; i < PA_CH; ++i) { float s = 0.f;
#pragma unroll
                for (int j = 0; j < 2; ++j) { float a, b, c, dd;
                    fp8x4_to_f32(Ur[i][j].x, a, b, c, dd); s += a * x[j * 16 + 0] + b * x[j * 16 + 1] + c * x[j * 16 + 2] + dd * x[j * 16 + 3];
                    fp8x4_to_f32(Ur[i][j].y, a, b, c, dd); s += a * x[j * 16 + 4] + b * x[j * 16 + 5] + c * x[j * 16 + 6] + dd * x[j * 16 + 7];
                    fp8x4_to_f32(Ur[i][j].z, a, b, c, dd); s += a * x[j * 16 + 8] + b * x[j * 16 + 9] + c * x[j * 16 + 10] + dd * x[j * 16 + 11];
                    fp8x4_to_f32(Ur[i][j].w, a, b, c, dd); s += a * x[j * 16 + 12] + b * x[j * 16 + 13] + c * x[j * 16 + 14] + dd * x[j * 16 + 15]; }
                d[i] = s; }
#define PA_VLOAD(slot, i) do { _Pragma("unroll") for (int j = 0; j < 2; ++j) Vr[slot][j] = *(const GAS v4u*)(V + (size_t)ec[i] * D + j * 1024); } while (0)
#define PA_VACC1(wd, base) do { float a, b, c, dd; fp8x4_to_f32((wd), a, b, c, dd); acc[(base)] += wgt * a; acc[(base) + 1] += wgt * b; acc[(base) + 2] += wgt * c; acc[(base) + 3] += wgt * dd; } while (0)
#define PA_VACC(slot, i) do { const float wgt = d[i]; _Pragma("unroll") for (int j = 0; j < 2; ++j) { PA_VACC1(Vr[slot][j].x, j * 16); PA_VACC1(Vr[slot][j].y, j * 16 + 4); PA_VACC1(Vr[slot][j].z, j * 16 + 8); PA_VACC1(Vr[slot][j].w, j * 16 + 12); } } while (0)
            PA_VLOAD(0, 0); PA_VLOAD(1, 1);
#pragma unroll
            for (int i = 0; i < PA_CH; ++i)
#pragma unroll
                for (int j = 0; j < 2; ++j) Ur[i][j] = *(const GAS v4u*)(U + (size_t)en[i] * D + j * 1024);
#pragma unroll
            for (int i = 0; i < PA_CH; ++i) { const float dt = wave_sum(d[i]) * __builtin_bit_cast(float, __builtin_amdgcn_readfirstlane(__builtin_bit_cast(int, su[ec[i]])));
                const float g = __builtin_bit_cast(float, __builtin_amdgcn_readfirstlane(__builtin_bit_cast(int, gwr[PA_CH * kc + i]))) * __builtin_bit_cast(float, __builtin_amdgcn_readfirstlane(__builtin_bit_cast(int, sv[ec[i]])));
                d[i] = g * 0.5f * dt * (1.0f + erff(dt * 0.70710678118654752f)); }
#pragma unroll
            for (int i = 0; i < PA_CH; ++i) { if (i & 1) { PA_VACC(1, i); if (i + 2 < PA_CH) PA_VLOAD(1, i + 2); } else { PA_VACC(0, i); if (i + 2 < PA_CH) PA_VLOAD(0, i + 2); } }
#undef PA_VLOAD
#undef PA_VACC
#undef PA_VACC1
        }
#if DUP_PHASE == 10
        }
#endif
        GAS float* hrow = (GAS float*)P.out + (size_t)t * D + lane * 16; float ss = 0.f;
#pragma unroll
        for (int j = 0; j < 2; ++j)
#pragma unroll
            for (int q = 0; q < 4; ++q) { f32x4 hv = *(const GAS f32x4*)(hrow + j * 1024 + q * 4);
                hv.x += acc[j * 16 + q * 4 + 0]; hv.y += acc[j * 16 + q * 4 + 1]; hv.z += acc[j * 16 + q * 4 + 2]; hv.w += acc[j * 16 + q * 4 + 3];
                *(GAS f32x4*)(hrow + j * 1024 + q * 4) = hv; acc[j * 16 + q * 4 + 0] = hv.x; acc[j * 16 + q * 4 + 1] = hv.y; acc[j * 16 + q * 4 + 2] = hv.z; acc[j * 16 + q * 4 + 3] = hv.w;
                ss += hv.x * hv.x + hv.y * hv.y + hv.z * hv.z + hv.w * hv.w; }
        ss = wave_sum(ss); const float rr = 1.0f / sqrtf(ss * (1.0f / D) + EPS); const GAS float* gain = (const GAS float*)P.in[I_LNPLE] + (size_t)l * D + lane * 16;
#pragma unroll
        for (int j = 0; j < 2; ++j)
#pragma unroll
            for (int q = 0; q < 2; ++q) { const f32x4 g0 = *(const GAS f32x4*)(gain + j * 1024 + q * 8), g1 = *(const GAS f32x4*)(gain + j * 1024 + q * 8 + 4); const int b0 = j * 16 + q * 8;
                v4u o; o.x = pk2(acc[b0 + 0] * rr * g0.x, acc[b0 + 1] * rr * g0.y); o.y = pk2(acc[b0 + 2] * rr * g0.z, acc[b0 + 3] * rr * g0.w);
                o.z = pk2(acc[b0 + 4] * rr * g1.x, acc[b0 + 5] * rr * g1.y); o.w = pk2(acc[b0 + 6] * rr * g1.z, acc[b0 + 7] * rr * g1.w);
                *(GAS v4u*)(hn + (size_t)t * D + j * 1024 + lane * 16 + q * 8) = o; }
    }
}


__device__ __forceinline__ void norm_row_i8(f32x4 (&v)[8], float ss, const float* gain, GAS unsigned char* orow, GAS float* sc, int lane) {
    const float r = 1.0f / sqrtf(ss * (1.0f / D) + EPS); float am = 0.f;
#pragma unroll
    for (int j = 0; j < 8; ++j) { const f32x4 g = *(const f32x4*)(gain + (j * 64 + lane) * 4); v[j] = v[j] * r * g; am = fmaxf(am, fmaxf(fmaxf(fabsf(v[j].x), fabsf(v[j].y)), fmaxf(fabsf(v[j].z), fabsf(v[j].w)))); }
    am = wave_max(am); const float S = am > 0.f ? 127.0f / am : 0.f;
#pragma unroll
    for (int j = 0; j < 8; ++j) *(GAS unsigned*)(orow + (j * 64 + lane) * 4) = pack_i8x4(v[j].x, v[j].y, v[j].z, v[j].w, S);
    if (lane == 0) *sc = am * (1.0f / 127.0f);
}
template <bool SRC16 = false>
__device__ __forceinline__ void phase_norm_i8(const void* src, const float* gain, unsigned char* dst8, float* scales, int bid, int nb) {
    const int tid = TID(), lane = tid & 63, wave = tid >> 6, nw = 8;
    const int step = nb * nw; int t = bid * nw + wave;
    for (; t + step < T; t += 2 * step) { f32x4 v0[8], v1[8];
#pragma unroll
        for (int j = 0; j < 8; ++j) { v0[j] = ldrow4<SRC16>(src, (size_t)t * D + (j * 64 + lane) * 4); v1[j] = ldrow4<SRC16>(src, (size_t)(t + step) * D + (j * 64 + lane) * 4); }
        float s0 = 0.f, s1 = 0.f;
#pragma unroll
        for (int j = 0; j < 8; ++j) { s0 += v0[j].x * v0[j].x + v0[j].y * v0[j].y + v0[j].z * v0[j].z + v0[j].w * v0[j].w; s1 += v1[j].x * v1[j].x + v1[j].y * v1[j].y + v1[j].z * v1[j].z + v1[j].w * v1[j].w; }
        s0 = wave_sum(s0); s1 = wave_sum(s1);
        norm_row_i8(v0, s0, gain, (GAS unsigned char*)dst8 + (size_t)t * D, (GAS float*)scales + t, lane); norm_row_i8(v1, s1, gain, (GAS unsigned char*)dst8 + (size_t)(t + step) * D, (GAS float*)scales + t + step, lane); }
    for (; t < T; t += step) { f32x4 v[8]; float s_ = 0.f;
#pragma unroll
        for (int j = 0; j < 8; ++j) { v[j] = ldrow4<SRC16>(src, (size_t)t * D + (j * 64 + lane) * 4); s_ += v[j].x * v[j].x + v[j].y * v[j].y + v[j].z * v[j].z + v[j].w * v[j].w; }
        const float ss = wave_sum(s_); norm_row_i8(v, ss, gain, (GAS unsigned char*)dst8 + (size_t)t * D, (GAS float*)scales + t, lane); }
}
__device__ __forceinline__ void quant_rows_i8(const bf16* srcm, unsigned char* dstm, float* scm, int nrows, int bid, int nb) {
    const int tid = TID(), lane = tid & 63, wave = tid >> 6;
    for (int n = bid * 8 + wave; n < nrows; n += nb * 8) {
        const GAS bf16* src = (const GAS bf16*)srcm + (size_t)n * D; float f[4][8]; float am = 0.f;
#pragma unroll
        for (int j = 0; j < 4; ++j) { unpack8(*(const GAS v4u*)(src + (j * 64 + lane) * 8), f[j]);
#pragma unroll
            for (int e = 0; e < 8; ++e) am = fmaxf(am, fabsf(f[j][e])); }
        am = wave_max(am); const float S = am > 0.f ? 127.0f / am : 0.f;
        GAS unsigned char* dst = (GAS unsigned char*)dstm + (size_t)n * D;
#pragma unroll
        for (int j = 0; j < 4; ++j) *(GAS v2u*)(dst + (j * 64 + lane) * 8) = (v2u){pack_i8x4(f[j][0], f[j][1], f[j][2], f[j][3], S), pack_i8x4(f[j][4], f[j][5], f[j][6], f[j][7], S)};
        if (lane == 0) ((GAS float*)scm)[n] = am * (1.0f / 127.0f);
    }
}
constexpr int QR_TM = NTM * 128, QR_VT = QR_TM + NVT * 128, QR_WO = QR_VT + D, QR_WQ = QR_WO + D, QR_ALL = QR_WQ + D;
__device__ __forceinline__ void quant_row_ptrs(unsigned char* ws, int l, int g, const GAS bf16*& src, GAS unsigned char*& dst, GAS float*& sc) {
    size_t so, d8, ss; int r;
    if (g < QR_TM) { r = l * NTM * 128 + g; so = WS_WINTM; d8 = WS_WIN8TM; ss = WS_SWTM; }
    else if (g < QR_VT) { r = l * NVT * 128 + (g - QR_TM); so = WS_WINVT; d8 = WS_WIN8VT; ss = WS_SWVT; }
    else if (g < QR_WO) { r = l * D + (g - QR_VT); so = WS_WOUT; d8 = WS_WO8; ss = WS_SWO; }
    else if (g < QR_WQ) { r = l * D + (g - QR_WO); so = WS_WQ; d8 = WS_WQ8; ss = WS_SWQ; }
    else { r = l * D + (g - QR_WQ); so = WS_WGATE; d8 = WS_WG8; ss = WS_SWG; }
    src = (const GAS bf16*)(ws + so) + (size_t)r * D; dst = (GAS unsigned char*)(ws + d8) + (size_t)r * D; sc = (GAS float*)(ws + ss) + r;
}
__device__ __forceinline__ void quant_all_rows(const Params& P, int l, int bid, int nb) {
    const int tid = TID(), lane = tid & 63, wave = tid >> 6; const int step = nb * 8;
    for (int g0 = bid * 8 + wave; g0 < QR_ALL; g0 += 3 * step) {
        v4u w[3][4]; GAS unsigned char* dst[3]; GAS float* sc[3];
#pragma unroll
        for (int u = 0; u < 3; ++u) { const int g = g0 + u * step; const GAS bf16* src; quant_row_ptrs(P.ws, l, g < QR_ALL ? g : g0, src, dst[u], sc[u]);
#pragma unroll
            for (int j = 0; j < 4; ++j) w[u][j] = *(const GAS v4u*)(src + (j * 64 + lane) * 8); }
#pragma unroll
        for (int u = 0; u < 3; ++u) { if (g0 + u * step >= QR_ALL) break;
            float f[4][8]; float am = 0.f;
#pragma unroll
            for (int j = 0; j < 4; ++j) { unpack8(w[u][j], f[j]);
#pragma unroll
                for (int e = 0; e < 8; ++e) am = fmaxf(am, fabsf(f[j][e])); }
            am = wave_max(am); const float S = am > 0.f ? 127.0f / am : 0.f;
#pragma unroll
            for (int j = 0; j < 4; ++j) *(GAS v2u*)(dst[u] + (j * 64 + lane) * 8) = (v2u){pack_i8x4(f[j][0], f[j][1], f[j][2], f[j][3], S), pack_i8x4(f[j][4], f[j][5], f[j][6], f[j][7], S)};
            if (lane == 0) *sc[u] = am * (1.0f / 127.0f); }
    }
}
__device__ __forceinline__ void quant_wgate(const Params& P, int l, int bid, int nb) {
    const int tid = TID(), lane = tid & 63, wave = tid >> 6;
    for (int n = bid * 8 + wave; n < D; n += nb * 8) {
        const GAS bf16* src = (const GAS bf16*)(P.ws + WS_WGATE) + ((size_t)l * D + n) * D; float f[4][8]; float am = 0.f;
#pragma unroll
        for (int j = 0; j < 4; ++j) { unpack8(*(const GAS v4u*)(src + (j * 64 + lane) * 8), f[j]);
#pragma unroll
            for (int e = 0; e < 8; ++e) am = fmaxf(am, fabsf(f[j][e])); }
        am = wave_max(am); const float S = am > 0.f ? 127.0f / am : 0.f;
        GAS unsigned char* dst = (GAS unsigned char*)(P.ws + WS_WG8) + ((size_t)l * D + n) * D;
#pragma unroll
        for (int j = 0; j < 4; ++j) *(GAS v2u*)(dst + (j * 64 + lane) * 8) = (v2u){pack_i8x4(f[j][0], f[j][1], f[j][2], f[j][3], S), pack_i8x4(f[j][4], f[j][5], f[j][6], f[j][7], S)};
        if (lane == 0) ((GAS float*)(P.ws + WS_SWG))[(size_t)l * D + n] = am * (1.0f / 127.0f);
    }
}
#define XB_TMO      128
#define XB_XCNT(j)  (256  + 64 * (j))
#define XB_XSUB(j)  (1280 + 64 * (j))
#define XB_XGEN(j)  (2304 + 64 * (j))
#define XB_TOP      3328
#define XB_TOPGEN   3392
#define XCD_BAR_WORDS 3456
#define XB_SPIN_CAP (1u << 22)
__device__ __forceinline__ unsigned xb_ld(unsigned* p)              { return __hip_atomic_load(p, __ATOMIC_RELAXED, __HIP_MEMORY_SCOPE_AGENT); }
__device__ __forceinline__ unsigned xb_add(unsigned* p, unsigned v) { return __hip_atomic_fetch_add(p, v, __ATOMIC_RELAXED, __HIP_MEMORY_SCOPE_AGENT); }
__device__ __forceinline__ unsigned xb_xcc_id() { return (unsigned)__builtin_amdgcn_s_getreg((3 << 11) | 20) & 0xFu; }
#define XB_SPIN(cond, bar) do { unsigned _sp = 0; while (cond) { __builtin_amdgcn_s_sleep(1); \
    if ((++_sp & 255u) == 0u) { if (xb_ld(&(bar)[XB_TMO])) break; if (_sp > XB_SPIN_CAP) { atomicAdd(&(bar)[XB_TMO], 1u); break; } } } } while (0)
struct XcdBarrier { unsigned* bar; unsigned x; volatile LAS unsigned* st; };
__device__ __forceinline__ XcdBarrier xcd_barrier_post(unsigned* bar, volatile LAS unsigned* st) {
    XcdBarrier b; b.bar = bar; b.x = xb_xcc_id(); b.st = st;
    if (threadIdx.x == 0) (void)xb_add(&bar[XB_XCNT(b.x)], 1u);
    return b;
}
__device__ __forceinline__ void xcd_barrier_complete(unsigned* bar, unsigned x, unsigned& nloc, unsigned& nx) {
    const unsigned G = gridDim.x * gridDim.y * gridDim.z;
    unsigned sum, cnt, mine, sp = 0u;
    for (;;) {
        sum = 0u; cnt = 0u; mine = 0u;
#pragma unroll
        for (unsigned j = 0; j < 16; ++j) { const unsigned c = xb_ld(&bar[XB_XCNT(j)]); sum += c; cnt += (c > 0u) ? 1u : 0u; mine = (j == x) ? c : mine; }
        if (sum == G) break;
        __builtin_amdgcn_s_sleep(1);
        if ((++sp & 255u) == 0u) { if (xb_ld(&bar[XB_TMO])) break; if (sp > XB_SPIN_CAP) { atomicAdd(&bar[XB_TMO], 1u); break; } }
    }
    nloc = mine > 0u ? mine : 1u; nx = cnt > 0u ? cnt : 1u;
}
__device__ __forceinline__ void xcd_barrier(const XcdBarrier& b) {
    asm volatile("s_waitcnt vmcnt(0)" ::: "memory");
    __syncthreads();
    if (threadIdx.x == 0) {
        unsigned* bar = b.bar;
        __builtin_amdgcn_s_waitcnt(0);
        unsigned nloc = b.st[0], nx = b.st[1];
        if (nloc == 0u) { xcd_barrier_complete(bar, b.x, nloc, nx); b.st[0] = nloc; b.st[1] = nx; }
        const unsigned old = xb_add(&bar[XB_XSUB(b.x)], 1u);
        const unsigned gen = old / nloc;
        if (old + 1u == (gen + 1u) * nloc) {
            __builtin_amdgcn_fence(__ATOMIC_RELEASE, "agent");
            asm volatile("s_waitcnt vmcnt(0)" ::: "memory");
            const unsigned og = xb_add(&bar[XB_TOP], 1u);
            const unsigned tg = og / nx;
            if (og + 1u == (tg + 1u) * nx) xb_add(&bar[XB_TOPGEN], 1u);
            else XB_SPIN(xb_ld(&bar[XB_TOPGEN]) == tg, bar);
            __builtin_amdgcn_fence(__ATOMIC_ACQUIRE, "agent");
            xb_add(&bar[XB_XGEN(b.x)], 1u);
            asm volatile("s_waitcnt vmcnt(0)" ::: "memory");
        } else {
            XB_SPIN(xb_ld(&bar[XB_XGEN(b.x)]) == gen, bar);
            __builtin_amdgcn_fence(__ATOMIC_ACQUIRE, "agent");
            asm volatile("s_waitcnt vmcnt(0)" ::: "memory");
        }
    }
    __syncthreads();
}


namespace pz {
constexpr int NSL = 16, NTG = T / 8, QITEMS = (NSL / 8) * NTG;
__device__ __forceinline__ void load_rows(const GAS unsigned char* tab, unsigned poff, const int (&id)[16], v4u (&rows)[16]) {
#pragma unroll
    for (int i = 0; i < 16; ++i) rows[i] = *(const GAS v4u*)(tab + (((unsigned)id[i] << 7) | poff));
}
__device__ __forceinline__ void load_ids(const int* ex, size_t t, int e8, int (&id)[16]) {
    typedef int i32x4 __attribute__((ext_vector_type(4)));
#pragma unroll
    for (int q = 0; q < 4; ++q) { const i32x4 v = *(const GAS i32x4*)((const GAS int*)ex + t * 128 + 16 * e8 + 4 * q); id[4 * q] = v.x; id[4 * q + 1] = v.y; id[4 * q + 2] = v.z; id[4 * q + 3] = v.w; }
}
typedef float f2p __attribute__((ext_vector_type(2)));
__device__ __forceinline__ unsigned item_A(const Params& P, int l, int xq, int c, int tg, int lane, int (&id)[2][16], v4u (&rows)[2][16], unsigned itn_raw) {
    const int e8 = lane >> 3, part = lane & 7;
    const GAS unsigned char* tab0 = (const GAS unsigned char*)(P.ws + WS_U) + (size_t)l * NSL * NEXP * 128; const unsigned poff = part * 16;
    const GAS unsigned char* tab = tab0 + (size_t)c * NEXP * 128; unsigned itn = 0xffffffffu; size_t tn0 = 0; const GAS unsigned char* tabn = tab;
    const GAS bf16* xf = (const GAS bf16*)(P.ws + WS_ACT0) + 128 * c + 16 * part; const int* ex = (const int*)(P.ws + WS_EXP);
    GAS bf16* pdh = (GAS bf16*)(P.ws + WS_PD) + (size_t)c * T * 128 + 16 * e8;
    const size_t t0 = (size_t)tg * 8;
#pragma unroll
    for (int n = 0; n < 8; ++n) { const size_t t = t0 + n; const int bf = n & 1;
        if (n < 7) load_rows(tab, poff, id[bf ^ 1], rows[bf ^ 1]);
        if (n < 6) load_ids(ex, t + 2, e8, id[bf]);
        if (n == 6) { itn = (unsigned)__builtin_amdgcn_readfirstlane((int)itn_raw);
            if (itn < (unsigned)QITEMS) { tn0 = (size_t)(itn % NTG) * 8; tabn = tab0 + (size_t)(xq + 8 * (int)(itn / NTG)) * NEXP * 128; load_ids(ex, tn0, e8, id[0]); } }
        if (n == 7 && itn < (unsigned)QITEMS) { load_rows(tabn, poff, id[0], rows[0]); load_ids(ex, tn0 + 1, e8, id[1]); }
#if PEER_A_I8
        const v4u xw = *(const GAS v4u*)((const GAS unsigned char*)(P.ws + WS_XF8) + t * D + 128 * c + 16 * part);
        int sacc[16];
#pragma unroll
        for (int i = 0; i < 16; ++i) { const v4u rw = rows[bf][i]; int a; asm("v_dot4_i32_i8 %0, %1, %2, 0" : "=v"(a) : "v"(rw.x), "v"(xw.x)); a = __builtin_amdgcn_sdot4((int)rw.y, (int)xw.y, a, false);
            a = __builtin_amdgcn_sdot4((int)rw.z, (int)xw.z, a, false); sacc[i] = __builtin_amdgcn_sdot4((int)rw.w, (int)xw.w, a, false); }
        { const bool b2 = part & 4, b1 = part & 2, b0 = part & 1; int r8[8], r4[4], r2[2];
#pragma unroll
          for (int i = 0; i < 8; ++i) { const int snd = b2 ? sacc[i] : sacc[8 + i], kp = b2 ? sacc[8 + i] : sacc[i]; r8[i] = kp + swz_xor_i<4>(snd); }
#pragma unroll
          for (int i = 0; i < 4; ++i) { const int snd = b1 ? r8[i] : r8[4 + i], kp = b1 ? r8[4 + i] : r8[i]; r4[i] = kp + swz_xor_i<2>(snd); }
#pragma unroll
          for (int i = 0; i < 2; ++i) { const int snd = b0 ? r4[i] : r4[2 + i], kp = b0 ? r4[2 + i] : r4[i]; r2[i] = kp + swz_xor_i<1>(snd); }
          *(GAS unsigned*)((GAS bf16*)pdh + t * 128 + 2 * part) = pk2((float)r2[0] * (1.0f / 16384.0f), (float)r2[1] * (1.0f / 16384.0f)); }
#else
        f2p x2[8];
        { const v4u w0 = *(const GAS v4u*)(xf + t * D), w1 = *(const GAS v4u*)(xf + t * D + 8);
          x2[0] = (f2p){bf2f(w0.x & 0xffff), bf2f(w0.x >> 16)}; x2[1] = (f2p){bf2f(w0.y & 0xffff), bf2f(w0.y >> 16)}; x2[2] = (f2p){bf2f(w0.z & 0xffff), bf2f(w0.z >> 16)}; x2[3] = (f2p){bf2f(w0.w & 0xffff), bf2f(w0.w >> 16)};
          x2[4] = (f2p){bf2f(w1.x & 0xffff), bf2f(w1.x >> 16)}; x2[5] = (f2p){bf2f(w1.y & 0xffff), bf2f(w1.y >> 16)}; x2[6] = (f2p){bf2f(w1.z & 0xffff), bf2f(w1.z >> 16)}; x2[7] = (f2p){bf2f(w1.w & 0xffff), bf2f(w1.w >> 16)}; }
        float sacc[16];
#pragma unroll
        for (int i = 0; i < 16; ++i) { const v4u rw = rows[bf][i]; f2p s2 = {0.f, 0.f};
            s2 = __builtin_elementwise_fma(__builtin_amdgcn_cvt_pk_f32_fp8((int)rw.x, false), x2[0], s2); s2 = __builtin_elementwise_fma(__builtin_amdgcn_cvt_pk_f32_fp8((int)rw.x, true), x2[1], s2);
            s2 = __builtin_elementwise_fma(__builtin_amdgcn_cvt_pk_f32_fp8((int)rw.y, false), x2[2], s2); s2 = __builtin_elementwise_fma(__builtin_amdgcn_cvt_pk_f32_fp8((int)rw.y, true), x2[3], s2);
            s2 = __builtin_elementwise_fma(__builtin_amdgcn_cvt_pk_f32_fp8((int)rw.z, false), x2[4], s2); s2 = __builtin_elementwise_fma(__builtin_amdgcn_cvt_pk_f32_fp8((int)rw.z, true), x2[5], s2);
            s2 = __builtin_elementwise_fma(__builtin_amdgcn_cvt_pk_f32_fp8((int)rw.w, false), x2[6], s2); s2 = __builtin_elementwise_fma(__builtin_amdgcn_cvt_pk_f32_fp8((int)rw.w, true), x2[7], s2);
            sacc[i] = s2.x + s2.y; }
        { const bool b2 = part & 4, b1 = part & 2, b0 = part & 1; float r8[8], r4[4], r2[2];
#pragma unroll
          for (int i = 0; i < 8; ++i) { const float snd = b2 ? sacc[i] : sacc[8 + i], kp = b2 ? sacc[8 + i] : sacc[i]; r8[i] = kp + swz_xor<4>(snd); }
#pragma unroll
          for (int i = 0; i < 4; ++i) { const float snd = b1 ? r8[i] : r8[4 + i], kp = b1 ? r8[4 + i] : r8[i]; r4[i] = kp + swz_xor<2>(snd); }
#pragma unroll
          for (int i = 0; i < 2; ++i) { const float snd = b0 ? r4[i] : r4[2 + i], kp = b0 ? r4[2 + i] : r4[i]; r2[i] = kp + swz_xor<1>(snd); }
          *(GAS unsigned*)((GAS bf16*)pdh + t * 128 + 2 * part) = pk2(r2[0], r2[1]); }
#endif
    }
    return itn;
}
__device__ __forceinline__ unsigned item_B(const Params& P, int l, int xq, int c, int tg, int lane, int (&id)[2][16], v4u (&rows)[2][16], unsigned itn_raw) {
    const int e8 = lane >> 3, part = lane & 7;
    const GAS unsigned char* tab0 = (const GAS unsigned char*)(P.ws + WS_V) + (size_t)l * NSL * NEXP * 128; const unsigned poff = part * 16;
    const GAS unsigned char* tab = tab0 + (size_t)c * NEXP * 128; unsigned itn = 0xffffffffu; size_t tn0 = 0; const GAS unsigned char* tabn = tab;
    const int* ex = (const int*)(P.ws + WS_EXP); const GAS float* wv = (const GAS float*)(P.ws + WS_WV) + 16 * e8;
    GAS float* hcol = (GAS float*)P.out + 128 * c + 16 * part;
    const size_t t0 = (size_t)tg * 8;
#pragma unroll
    for (int n = 0; n < 8; ++n) { const size_t t = t0 + n; const int bf = n & 1;
        if (n < 7) load_rows(tab, poff, id[bf ^ 1], rows[bf ^ 1]);
        if (n < 6) load_ids(ex, t + 2, e8, id[bf]);
        if (n == 6) { itn = (unsigned)__builtin_amdgcn_readfirstlane((int)itn_raw);
            if (itn < (unsigned)QITEMS) { tn0 = (size_t)(itn % NTG) * 8; tabn = tab0 + (size_t)(xq + 8 * (int)(itn / NTG)) * NEXP * 128; load_ids(ex, tn0, e8, id[0]); } }
        if (n == 7 && itn < (unsigned)QITEMS) { load_rows(tabn, poff, id[0], rows[0]); load_ids(ex, tn0 + 1, e8, id[1]); }
        float w[16];
#pragma unroll
        for (int q = 0; q < 4; ++q) { const f32x4 v = *(const GAS f32x4*)(wv + t * 128 + 4 * q); w[4 * q] = v.x; w[4 * q + 1] = v.y; w[4 * q + 2] = v.z; w[4 * q + 3] = v.w; }
        f2p acc2[8];
#pragma unroll
        for (int q = 0; q < 8; ++q) acc2[q] = (f2p){0.f, 0.f};
#pragma unroll
        for (int i = 0; i < 16; ++i) { const v4u rw = rows[bf][i]; const f2p w2 = {w[i], w[i]};
            acc2[0] = __builtin_elementwise_fma(__builtin_amdgcn_cvt_pk_f32_fp8((int)rw.x, false), w2, acc2[0]); acc2[1] = __builtin_elementwise_fma(__builtin_amdgcn_cvt_pk_f32_fp8((int)rw.x, true), w2, acc2[1]);
            acc2[2] = __builtin_elementwise_fma(__builtin_amdgcn_cvt_pk_f32_fp8((int)rw.y, false), w2, acc2[2]); acc2[3] = __builtin_elementwise_fma(__builtin_amdgcn_cvt_pk_f32_fp8((int)rw.y, true), w2, acc2[3]);
            acc2[4] = __builtin_elementwise_fma(__builtin_amdgcn_cvt_pk_f32_fp8((int)rw.z, false), w2, acc2[4]); acc2[5] = __builtin_elementwise_fma(__builtin_amdgcn_cvt_pk_f32_fp8((int)rw.z, true), w2, acc2[5]);
            acc2[6] = __builtin_elementwise_fma(__builtin_amdgcn_cvt_pk_f32_fp8((int)rw.w, false), w2, acc2[6]); acc2[7] = __builtin_elementwise_fma(__builtin_amdgcn_cvt_pk_f32_fp8((int)rw.w, true), w2, acc2[7]); }
        float acc[16];
#pragma unroll
        for (int q = 0; q < 8; ++q) { acc[2 * q] = acc2[q].x; acc[2 * q + 1] = acc2[q].y; }
        { const bool b3 = e8 & 1; float r8[8], r4[4], r2[2];
#pragma unroll
          for (int i = 0; i < 8; ++i) { const auto pr = __builtin_amdgcn_permlane32_swap(__builtin_bit_cast(unsigned, acc[i]), __builtin_bit_cast(unsigned, acc[8 + i]), false, false);
              r8[i] = __builtin_bit_cast(float, (unsigned)pr[0]) + __builtin_bit_cast(float, (unsigned)pr[1]); }
#pragma unroll
          for (int i = 0; i < 4; ++i) { const auto pr = __builtin_amdgcn_permlane16_swap(__builtin_bit_cast(unsigned, r8[i]), __builtin_bit_cast(unsigned, r8[4 + i]), false, false);
              r4[i] = __builtin_bit_cast(float, (unsigned)pr[0]) + __builtin_bit_cast(float, (unsigned)pr[1]); }
#pragma unroll
          for (int i = 0; i < 2; ++i) { const float snd = b3 ? r4[i] : r4[2 + i], kp = b3 ? r4[2 + i] : r4[i]; r2[i] = kp + swz_xor<8>(snd); }
#if H16
          GAS h2_t* hp = (GAS h2_t*)((GAS _Float16*)(P.ws + WS_H16) + 128 * c + 16 * part + t * D + 2 * e8); const h2_t hv = *hp; *hp = (h2_t){(_Float16)((float)hv.x + r2[0]), (_Float16)((float)hv.y + r2[1])}; }
#else
          GAS f2p* hp = (GAS f2p*)(hcol + t * D + 2 * e8); f2p hv = *hp; hv.x += r2[0]; hv.y += r2[1]; *hp = hv; }
#endif
    }
    return itn;
}
template <int WHICH>
__device__ __forceinline__ void phase_sliced(const Params& P, int l) {
    unsigned* qbase = (unsigned*)(P.ws + WS_CTL) + 16384 + 64 * ((l * 2 + WHICH) * 8);
    const unsigned x0 = xb_xcc_id() & 7u;
    const int lane = TID() & 63, e8 = lane >> 3, part = lane & 7;
    const int* ex = (const int*)(P.ws + WS_EXP);
    const GAS unsigned char* tab0 = (const GAS unsigned char*)(P.ws + (WHICH == 0 ? WS_U : WS_V)) + (size_t)l * NSL * NEXP * 128; const unsigned poff = part * 16;
    for (unsigned s_ = 0; s_ < 8; ++s_) { const unsigned xq = (x0 + s_) & 7u;
        unsigned it = 0u;
        if (lane == 0) it = __hip_atomic_fetch_add(qbase + 64 * xq, 1u, __ATOMIC_RELAXED, __HIP_MEMORY_SCOPE_AGENT);
        it = (unsigned)__builtin_amdgcn_readfirstlane((int)it);
        if (it >= (unsigned)QITEMS) continue;
        int id[2][16]; v4u rows[2][16];
        { const size_t t0 = (size_t)(it % NTG) * 8; const GAS unsigned char* tab = tab0 + (size_t)((int)xq + 8 * (int)(it / NTG)) * NEXP * 128;
          load_ids(ex, t0, e8, id[0]); load_rows(tab, poff, id[0], rows[0]); load_ids(ex, t0 + 1, e8, id[1]); }
        for (;;) {
            unsigned itn_raw = 0xffffffffu;
            if (lane == 0) itn_raw = __hip_atomic_fetch_add(qbase + 64 * xq, 1u, __ATOMIC_RELAXED, __HIP_MEMORY_SCOPE_AGENT);
            const int c = (int)xq + 8 * (int)(it / NTG), tg = (int)(it % NTG);
            const unsigned itn = WHICH == 0 ? item_A(P, l, (int)xq, c, tg, lane, id, rows, itn_raw) : item_B(P, l, (int)xq, c, tg, lane, id, rows, itn_raw);
            if (itn >= (unsigned)QITEMS) break;
            it = itn;
        }
    }
}
__device__ __forceinline__ void phase_weights(const Params& P, int l, int bid, int nb) {
    const int tid = TID();
    const GAS bf16* pd = (const GAS bf16*)(P.ws + WS_PD); const GAS int* ex = (const GAS int*)(P.ws + WS_EXP); const GAS float* gw = (const GAS float*)(P.ws + WS_GW);
    const GAS float* su = (const GAS float*)(P.ws + WS_SU) + (size_t)l * NEXP; const GAS float* sv = (const GAS float*)(P.ws + WS_SV) + (size_t)l * NEXP; GAS float* wv = (GAS float*)(P.ws + WS_WV);
    typedef int i32x4 __attribute__((ext_vector_type(4)));
    for (size_t i8 = (size_t)bid * 512 + tid; i8 < (size_t)T * 128 / 8; i8 += (size_t)nb * 512) {
        const size_t i = i8 * 8; float s8[8];
#pragma unroll
        for (int q = 0; q < 8; ++q) s8[q] = 0.f;
#pragma unroll
        for (int c = 0; c < NSL; ++c) { float f[8]; unpack8(*(const GAS v4u*)(pd + (size_t)c * T * 128 + i), f);
#pragma unroll
            for (int q = 0; q < 8; ++q) s8[q] += f[q]; }
        const i32x4 e0 = *(const GAS i32x4*)(ex + i), e1 = *(const GAS i32x4*)(ex + i + 4); const f32x4 g0 = *(const GAS f32x4*)(gw + i), g1 = *(const GAS f32x4*)(gw + i + 4);
        const int ee[8] = {e0.x, e0.y, e0.z, e0.w, e1.x, e1.y, e1.z, e1.w}; const float gg[8] = {g0.x, g0.y, g0.z, g0.w, g1.x, g1.y, g1.z, g1.w}; float o[8];
        const float xs = PEER_A_I8 ? 16384.0f * ((const GAS float*)(P.ws + WS_SXF))[i >> 7] : 1.0f;
#pragma unroll
        for (int q = 0; q < 8; ++q) { const float dt = s8[q] * xs * su[ee[q]]; o[q] = gg[q] * sv[ee[q]] * 0.5f * dt * (1.0f + erff(dt * 0.70710678118654752f)); }
        *(GAS f32x4*)(wv + i) = (f32x4){o[0], o[1], o[2], o[3]}; *(GAS f32x4*)(wv + i + 4) = (f32x4){o[4], o[5], o[6], o[7]};
    }
}
}

#ifndef FAST_GEMM
#define FAST_GEMM 1
#endif
#ifndef FAST_ATTN
#define FAST_ATTN 1
#endif
#ifndef FAST_SELECT
#define FAST_SELECT 1
#endif
#ifndef FAST_PREP
#define FAST_PREP 1
#endif
constexpr int LDS_BYTES = 147456;
constexpr int LDS_MISC = 131072;
constexpr int NPH_L = 12, NPHASES = 1 + DEPTH * NPH_L + 1;
struct Args { Params P; int ph_lo, ph_hi; };
__global__ void __launch_bounds__(512, 2) mk_fwd(Args a) {
    extern __shared__ __attribute__((aligned(16))) unsigned char lds_raw[];
    LAS unsigned char* lds = (LAS unsigned char*)lds_raw;
    const Params& P0 = a.P;
    const int bid0 = blockIdx.x, nb = gridDim.x;
    volatile LAS unsigned* misc = (volatile LAS unsigned*)(lds + LDS_MISC);
    if (threadIdx.x < 64) misc[threadIdx.x] = 0u;
    __syncthreads();
    XcdBarrier bar = xcd_barrier_post((unsigned*)(P0.ws + WS_CTL) + 1024, misc + 8);
    const int lo = a.ph_lo, hi = a.ph_hi;
#define IN(k) (lo <= (k) && (k) < hi)
#define BAR(k) do { if (IN(k) && IN((k) + 1)) xcd_barrier(bar); } while (0)
#define PH const Params P = fresh(P0); const int bid = launder_s(bid0); unsigned char* ws = P.ws; (void)ws; (void)bid
    if (IN(0)) { PH; phase_prologue(P, bid, nb, lds); }
#if DUP_PHASE == 100
    BAR(0);
    if (IN(0)) { PH; phase_prologue(P, bid, nb, lds); }
#endif
    BAR(0);
    for (int l = 0; l < DEPTH; ++l) {
        const int pb = 1 + l * NPH_L;
        if (IN(pb + 0)) { PH; phase_norm_mix(P, l, bid, nb, lds);
#if GATE_I8 && WQ_I8 && WOUT_I8 && PROJ_I8 && H16
#elif GATE_I8 && WQ_I8 && WOUT_I8 && PROJ_I8
            quant_all_rows(P, l, bid, nb);
#else
#if GATE_I8
            quant_wgate(P, l, bid, nb);
#endif
#if WQ_I8
            quant_rows_i8((const bf16*)(ws + WS_WQ) + (size_t)l * D * D, (unsigned char*)(ws + WS_WQ8) + (size_t)l * D * D, (float*)(ws + WS_SWQ) + (size_t)l * D, D, bid, nb);
#endif
#if WOUT_I8
            quant_rows_i8((const bf16*)(ws + WS_WOUT) + (size_t)l * D * D, (unsigned char*)(ws + WS_WO8) + (size_t)l * D * D, (float*)(ws + WS_SWO) + (size_t)l * D, D, bid, nb);
#endif
#if PROJ_I8
            quant_rows_i8((const bf16*)(ws + WS_WINTM) + (size_t)l * NTM * 128 * D, (unsigned char*)(ws + WS_WIN8TM) + (size_t)l * NTM * 128 * D, (float*)(ws + WS_SWTM) + (size_t)l * NTM * 128, NTM * 128, bid, nb);
            quant_rows_i8((const bf16*)(ws + WS_WINVT) + (size_t)l * NVT * 128 * D, (unsigned char*)(ws + WS_WIN8VT) + (size_t)l * NVT * 128 * D, (float*)(ws + WS_SWVT) + (size_t)l * NVT * 128, NVT * 128, bid, nb);
#endif
#endif
        }
#if DUP_PHASE == 300
        if (IN(pb + 0)) { PH; phase_norm_mix(P, l, bid, nb, lds); }
#endif
        BAR(pb + 0);
        if (IN(pb + 1)) { PH;
            const bf16* act = (const bf16*)(ws + WS_ACT0);
            const bf16* wtm = (const bf16*)(ws + WS_WINTM) + (size_t)l * NTM * 128 * D; const bf16* wvt = (const bf16*)(ws + WS_WINVT) + (size_t)l * NVT * 128 * D;
#if FAST_GEMM
#if PROJ_I8
            pg8::Gemm g{act, (const bf16*)(ws + WS_WIN8TM + (size_t)l * NTM * 128 * D), D / 2, (const bf16*)(ws + WS_WIN8VT + (size_t)l * NVT * 128 * D), act, 64, 17}; pg8::DualOrder so{64, 17, 7, 64, nb, bid};
            pg8::EpiProjI8 e{(bf16*)(ws + WS_TM), (bf16*)(ws + WS_VT), (const float*)(ws + WS_SA), (const float*)(ws + WS_SWTM) + (size_t)l * NTM * 128, (const float*)(ws + WS_SWVT) + (size_t)l * NVT * 128};
            pg8::gemm_phase(lds, g, so, e);
#else
            pg8::Gemm g{act, wtm, D, wvt, act, 64, 17}; pg8::DualOrder so{64, 17, 7, 64, nb, bid}; pg8::EpiProj e{(bf16*)(ws + WS_TM), (bf16*)(ws + WS_VT)};
            pg8::gemm_phase(lds, g, so, e);
#endif
#if DUP_PHASE == 200
            __syncthreads(); pg8::gemm_phase(lds, g, so, e);
#endif
#else
            EpiProjTM e1{(bf16*)(ws + WS_TM)}; phase_gemm_naive(act, wtm, D, T, NTM * 128, e1, bid, nb, lds);
            EpiProjVT e2{(bf16*)(ws + WS_VT)}; phase_gemm_naive(wvt, act, D, NVT * 128, T, e2, bid, nb, lds);
#endif
        }
        BAR(pb + 1);
#if FAST_PREP
        if (IN(pb + 2)) { PH; pf::phase_prep(P, l, bid, nb, lds); }
#if DUP_PHASE == 300
        if (IN(pb + 2)) { PH; pf::phase_prep(P, l, bid, nb, lds); }
#endif
#else
        if (IN(pb + 2)) { PH; phase_prep_naive(P, l, bid, nb); }
#endif
        BAR(pb + 2);
#if FAST_ATTN
        if (IN(pb + 3)) { PH; fa::phase_attn(P, l, lds); }
#if DUP_PHASE == 3
        BAR(pb + 3);
        if (IN(pb + 3)) { PH; if (bid == 0 && TID() == 0) ((unsigned*)(P.ws + WS_CTL))[8192 + 64 * l] = 0u; }
        BAR(pb + 3);
        if (IN(pb + 3)) { PH; fa::phase_attn(P, l, lds); }
#endif
        BAR(pb + 3);
#else
        if (IN(pb + 3)) { PH; phase_attn_naive1(P, bid, nb, lds); }
        BAR(pb + 3);
        if (IN(pb + 4)) { PH; phase_attn_naive2(P, bid, nb, lds); }
#endif
#if !FAST_ATTN
        BAR(pb + 4);
#endif
        if (IN(pb + 5)) { PH; phase_ynorm(P, bid, nb); }
#if DUP_PHASE == 300
        if (IN(pb + 5)) { PH; phase_ynorm(P, bid, nb); }
#endif
        BAR(pb + 5);
        if (IN(pb + 6)) { PH;
#if FAST_GEMM
#if WOUT_I8
            pg8::Gemm g{(const bf16*)(ws + WS_ACT2), (const bf16*)(ws + WS_WO8 + (size_t)l * D * D), D / 2, nullptr, nullptr, 1 << 30, 1 << 30}; pg8::StaticOrder so; so.init(T, D, nb, bid);
#if H16
            pg8::EpiResidI8 e{l == 0 ? P.in[I_X] : nullptr, (float*)(ws + WS_H16), (const float*)(ws + WS_SY), (const float*)(ws + WS_SWO) + (size_t)l * D}; pg8::gemm_phase(lds, g, so, e); }
#else
            pg8::EpiResidI8 e{l == 0 ? P.in[I_X] : P.out, P.out, (const float*)(ws + WS_SY), (const float*)(ws + WS_SWO) + (size_t)l * D}; pg8::gemm_phase(lds, g, so, e); }
#endif
#else
            pg8::Gemm g{(const bf16*)(ws + WS_ACT2), (const bf16*)(ws + WS_WOUT) + (size_t)l * D * D, D, nullptr, nullptr, 1 << 30, 1 << 30}; pg8::StaticOrder so; so.init(T, D, nb, bid);
            pg8::EpiResidT e{l == 0 ? P.in[I_X] : P.out, P.out}; pg8::gemm_phase(lds, g, so, e); }
#endif
#else
            EpiResid e{l == 0 ? P.in[I_X] : P.out, P.out};
            phase_gemm_naive((const bf16*)(ws + WS_ACT2), (const bf16*)(ws + WS_WOUT) + (size_t)l * D * D, D, T, D, e, bid, nb, lds); }
#endif
        BAR(pb + 6);
#if H16
        if (IN(pb + 7)) { PH; phase_norm<true>(ws + WS_H16, P.in[I_LNFFN] + (size_t)l * D, nullptr, bid, nb, (unsigned char*)(ws + WS_XF8), (float*)(ws + WS_SXF)); }
#else
        if (IN(pb + 7)) { PH; phase_norm(P.out, P.in[I_LNFFN] + (size_t)l * D, (bf16*)(ws + WS_ACT0), bid, nb, WQ_I8 ? (unsigned char*)(ws + WS_XF8) : nullptr, (float*)(ws + WS_SXF)); }
#endif
#if DUP_PHASE == 300
        if (IN(pb + 7)) { PH; phase_norm(P.out, P.in[I_LNFFN] + (size_t)l * D, (bf16*)(ws + WS_ACT0), bid, nb); }
#endif
        BAR(pb + 7);
        if (IN(pb + 8)) { PH;
#if FAST_GEMM
#if WQ_I8
            { pg8::Gemm g{(const bf16*)(ws + WS_XF8), (const bf16*)(ws + WS_WQ8 + (size_t)l * D * D), D / 2, nullptr, nullptr, 1 << 30, 1 << 30}; pg8::StaticOrder so; so.init(T, D, nb, bid);
              pg8::EpiStoreI8 e{(bf16*)(ws + WS_ACT1), (const float*)(ws + WS_SXF), (const float*)(ws + WS_SWQ) + (size_t)l * D}; pg8::gemm_phase(lds, g, so, e);
#else
            { pg8::Gemm g{(const bf16*)(ws + WS_ACT0), (const bf16*)(ws + WS_WQ) + (size_t)l * D * D, D, nullptr, nullptr, 1 << 30, 1 << 30}; pg8::StaticOrder so; so.init(T, D, nb, bid);
              pg8::EpiStoreT e{(bf16*)(ws + WS_ACT1)}; pg8::gemm_phase(lds, g, so, e);
#endif
#if DUP_PHASE == 200
              __syncthreads(); pg8::gemm_phase(lds, g, so, e);
#endif
            }
            { pg8::Gemm g{(const bf16*)(ws + WS_P) + (size_t)l * T * PLE, (const bf16*)(ws + WS_WPROJ) + (size_t)l * D * PLE, PLE, nullptr, nullptr, 1 << 30, 1 << 30}; pg8::StaticOrder so; so.init(T, D, nb, bid);
              pg8::EpiStoreT e{(bf16*)(ws + WS_ACT3)}; pg8::gemm_phase(lds, g, so, e); }
#else
            EpiStoreBf16 e{(bf16*)(ws + WS_ACT1)}; phase_gemm_naive((const bf16*)(ws + WS_ACT0), (const bf16*)(ws + WS_WQ) + (size_t)l * D * D, D, T, D, e, bid, nb, lds);
            EpiStoreBf16 e2{(bf16*)(ws + WS_ACT3)}; phase_gemm_naive((const bf16*)(ws + WS_P) + (size_t)l * T * PLE, (const bf16*)(ws + WS_WPROJ) + (size_t)l * D * PLE, PLE, T, D, e2, bid, nb, lds);
#endif
        }
        BAR(pb + 8);
#if FAST_SELECT
        if (IN(pb + 9)) { PH; ps::phase_select(P, l, bid, nb, lds); }
#if DUP_PHASE == 300
        if (IN(pb + 9)) { PH; ps::phase_select(P, l, bid, nb, lds); }
#endif
#else
        if (IN(pb + 9)) { PH; phase_peer_select_naive(P, l, bid, nb, lds); }
#endif
#if DUP_PHASE == 9
        BAR(pb + 9);
        if (IN(pb + 9)) { PH; phase_peer_select_naive(P, l, bid, nb, lds); }
#endif
        BAR(pb + 9);
#if PEER_SLICED
        if (IN(pb + 10)) { PH; pz::phase_sliced<0>(P, l); }
        BAR(pb + 10);
        if (IN(pb + 10)) { PH; pz::phase_weights(P, l, bid, nb); }
        BAR(pb + 10);
        if (IN(pb + 10)) { PH; pz::phase_sliced<1>(P, l); }
        BAR(pb + 10);
#if GATE_I8
        if (IN(pb + 10)) { PH; phase_norm_i8<H16 != 0>(H16 ? (const void*)(ws + WS_H16) : (const void*)P.out, P.in[I_LNPLE] + (size_t)l * D, (unsigned char*)(ws + WS_ACT2), (float*)(ws + WS_SHN), bid, nb); }
#else
        if (IN(pb + 10)) { PH; phase_norm(P.out, P.in[I_LNPLE] + (size_t)l * D, (bf16*)(ws + WS_ACT2), bid, nb); }
#endif
        BAR(pb + 10);
#else
        if (IN(pb + 10)) { PH; phase_peer_apply3(P, l, bid, nb); }
        BAR(pb + 10);
#endif
        if (IN(pb + 11)) { PH;
#if FAST_GEMM
#if GATE_I8
            pg8::Gemm g{(const bf16*)(ws + WS_ACT2), (const bf16*)(ws + WS_WG8 + (size_t)l * D * D), D / 2, nullptr, nullptr, 1 << 30, 1 << 30}; pg8::StaticOrder so; so.init(T, D, nb, bid);
            pg8::EpiPleGateI8 e{H16 ? (float*)(ws + WS_H16) : P.out, (const bf16*)(ws + WS_ACT3), (const float*)(ws + WS_SHN), (const float*)(ws + WS_SWG) + (size_t)l * D}; pg8::gemm_phase(lds, g, so, e); }
#else
            pg8::Gemm g{(const bf16*)(ws + WS_ACT2), (const bf16*)(ws + WS_WGATE) + (size_t)l * D * D, D, nullptr, nullptr, 1 << 30, 1 << 30}; pg8::StaticOrder so; so.init(T, D, nb, bid);
            pg8::EpiPleGateT e{P.out, (const bf16*)(ws + WS_ACT3)}; pg8::gemm_phase(lds, g, so, e); }
#endif
#else
            EpiPleGate e{P.out, (const bf16*)(ws + WS_ACT3)};
            phase_gemm_naive((const bf16*)(ws + WS_ACT2), (const bf16*)(ws + WS_WGATE) + (size_t)l * D * D, D, T, D, e, bid, nb, lds); }
#endif
        BAR(pb + 11);
    }
#if DUP_PHASE == 400
    for (int zz = 0; zz < 20; ++zz) xcd_barrier(bar);
#endif
    if (IN(NPHASES - 1)) { PH; phase_final(P, bid, nb); }
#undef IN
#undef BAR
#undef PH
}

#ifndef MK_LAUNCHES
#define MK_LAUNCHES 1
#endif
extern "C" void kernel_launch(void* const* d_in, const int* in_sizes, int n_in, void* d_out, int out_size, void* d_ws, size_t ws_size, hipStream_t stream) {
    static int grid = 0;
    if (grid == 0) {
        if (n_in != 19 || out_size != T * D || ws_size < WS_END) { fprintf(stderr, "kernel_launch: unexpected shapes (n_in %d out %d ws %zu need %zu)\n", n_in, out_size, ws_size, (size_t)WS_END); grid = -1; return; }
        int dev = 0, cus = 0, per_cu = 0;
        if (hipGetDevice(&dev) != hipSuccess || hipDeviceGetAttribute(&cus, hipDeviceAttributeMultiprocessorCount, dev) != hipSuccess) { grid = -1; return; }
        if (hipFuncSetAttribute((const void*)mk_fwd, hipFuncAttributeMaxDynamicSharedMemorySize, LDS_BYTES) != hipSuccess) { fprintf(stderr, "kernel_launch: hipFuncSetAttribute failed\n"); grid = -1; return; }
        if (hipOccupancyMaxActiveBlocksPerMultiprocessor(&per_cu, (const void*)mk_fwd, 512, LDS_BYTES) != hipSuccess || per_cu < 1) { fprintf(stderr, "kernel_launch: occupancy query reports %d blocks per CU\n", per_cu); }
        (void)hipGetLastError();
        grid = cus;
    }
    if (grid < 0) return;
    (void)hipMemsetAsync((char*)d_ws + WS_CTL, 0, CTL_USED_BYTES, stream);
    Args a{};
    for (int i = 0; i < 19; ++i) a.P.in[i] = (const float*)d_in[i];
    a.P.out = (float*)d_out; a.P.ws = (unsigned char*)d_ws;
#if MK_LAUNCHES == 1
    a.ph_lo = 0; a.ph_hi = NPHASES;
    hipLaunchKernelGGL(mk_fwd, dim3(grid), dim3(512), LDS_BYTES, stream, a);
#else
    for (int p = 0; p < NPHASES; ++p) { a.ph_lo = p; a.ph_hi = p + 1; hipLaunchKernelGGL(mk_fwd, dim3(grid), dim3(512), LDS_BYTES, stream, a); }
#endif
}
```

```cpp
#include <hip/hip_runtime.h>
#ifndef WQ_I8
#define WQ_I8 1
#endif
#ifndef WOUT_I8
#define WOUT_I8 1
#endif
#ifndef PROJ_I8
#define PROJ_I8 1
#endif
#ifndef GATE_I8
#define GATE_I8 1
#endif
#ifndef FA_STAGGER
#define FA_STAGGER 0
#endif
#ifndef PEER_SLICED
#define PEER_SLICED 1
#ifndef H16
#define H16 1
#endif
#ifndef PEER_A_I8
#define PEER_A_I8 1
#endif
#endif
#ifndef DUP_PHASE
#define DUP_PHASE 0
#endif
#include <cstdio>
#include <cstdint>

#define GAS __attribute__((address_space(1)))
#define LAS __attribute__((address_space(3)))
typedef unsigned short bf16;
typedef unsigned v4u __attribute__((ext_vector_type(4)));
typedef unsigned v2u __attribute__((ext_vector_type(2)));
typedef float f32x4 __attribute__((ext_vector_type(4)));

constexpr int NB = 8, S = 2048, T = NB * S, D = 2048, DEPTH = 2, HD = 128, PROJ = 6162;
constexpr int NTM = 34, NVT = 14;
constexpr int TM_A_Q = 0, TM_A_K = 6, TM_B_Q = 12, TM_B_KC = 18, TM_B_VC = 20, TM_B_KS = 22, TM_B_KW = 24, TM_C_Q = 26, TM_C_K = 30;
constexpr int VT_A_V = 0, VT_B_VS = 6, VT_B_VW = 8, VT_C_V = 10;
constexpr int GATE_COL0 = 4608;
constexpr int PLE = 256, NEXP = 16384;
constexpr float EPS = 1e-6f;
constexpr float QK_SCALE = 0.08838834764831845f;
#define NEG_INF (-__builtin_inff())

__host__ __device__ constexpr int tm_col0(int s) {
    return s < 6 ? 128 * s : s < 12 ? 768 + 128 * (s - 6) : s < 18 ? 2304 + 128 * (s - 12) : s < 20 ? 3072 + 128 * (s - 18) : s < 22 ? 3328 + 128 * (s - 20)
         : s < 24 ? 3584 + 128 * (s - 22) : s < 26 ? 4096 + 128 * (s - 24) : s < 30 ? 4626 + 128 * (s - 26) : 5138 + 128 * (s - 30);
}
__host__ __device__ constexpr int vt_col0(int v) {
    return v < 6 ? 1536 + 128 * v : v < 8 ? 3840 + 128 * (v - 6) : v < 10 ? 4352 + 128 * (v - 8) : 5650 + 128 * (v - 10);
}

constexpr size_t MiB = 1u << 20;
constexpr size_t align_up(size_t x) { return (x + 255) & ~(size_t)255; }
constexpr size_t WS_CTL = 0, CTL_BYTES = 1 * MiB, CTL_USED_BYTES = 128 * 1024;
constexpr size_t SZ_WINTM = (size_t)NTM * 128 * D * 2, SZ_WINVT = (size_t)NVT * 128 * D * 2, SZ_WSQ = (size_t)D * D * 2, SZ_WPROJ = (size_t)D * PLE * 2;
constexpr size_t WS_WINTM = WS_CTL + CTL_BYTES;
constexpr size_t WS_WINVT = WS_WINTM + DEPTH * SZ_WINTM;
constexpr size_t WS_WOUT = WS_WINVT + DEPTH * SZ_WINVT;
constexpr size_t WS_WQ = WS_WOUT + DEPTH * SZ_WSQ;
constexpr size_t WS_WGATE = WS_WQ + DEPTH * SZ_WSQ;
constexpr size_t WS_WPROJ = WS_WGATE + DEPTH * SZ_WSQ;
constexpr size_t WS_WG = WS_WPROJ + DEPTH * SZ_WPROJ;
constexpr size_t WS_KEYS = align_up(WS_WG + (size_t)DEPTH * 18 * D * 4);
constexpr size_t WS_CWT = WS_KEYS + (size_t)DEPTH * 16 * 128 * 128 * 2;
constexpr size_t WS_U = WS_CWT + (size_t)DEPTH * 2 * 128 * 4096 * 2;
constexpr size_t WS_V = WS_U + (size_t)DEPTH * NEXP * D;
constexpr size_t WS_SU = WS_V + (size_t)DEPTH * NEXP * D;
constexpr size_t WS_SV = WS_SU + (size_t)DEPTH * NEXP * 4;
constexpr size_t WS_P = WS_SV + (size_t)DEPTH * NEXP * 4;
constexpr size_t WS_TM = WS_P + (size_t)DEPTH * T * PLE * 2;
constexpr size_t WS_VT = WS_TM + (size_t)NB * NTM * S * 128 * 2;
constexpr size_t WS_KCMP = WS_VT + (size_t)NB * NVT * S * 128 * 2;
constexpr size_t WS_VCMPT = WS_KCMP + (size_t)NB * 2 * 128 * 128 * 2;
constexpr size_t WS_KMEAN = WS_VCMPT + (size_t)NB * 2 * 128 * 128 * 2;
constexpr size_t WS_GATES = WS_KMEAN + (size_t)NB * 8 * 4 * 128 * 4;
constexpr size_t WS_SS = align_up(WS_GATES + (size_t)T * 18 * 4);
constexpr size_t WS_OCMP = WS_SS + (size_t)T * 16 * 4;
constexpr size_t WS_SEL = WS_OCMP + (size_t)T * 768 * 4;
constexpr size_t WS_EXP = WS_SEL + (size_t)T * 16 * 4;
constexpr size_t WS_GW = WS_EXP + (size_t)T * 128 * 4;
constexpr size_t SZ_ACT = (size_t)T * D * 2;
constexpr size_t WS_ACT0 = WS_GW + (size_t)T * 128 * 4;
constexpr size_t WS_ACT1 = WS_ACT0 + SZ_ACT;
constexpr size_t WS_ACT2 = WS_ACT1 + SZ_ACT;
constexpr size_t WS_ACT3 = WS_ACT2 + SZ_ACT;
constexpr size_t WS_TBL = WS_ACT3 + SZ_ACT;
constexpr size_t WS_PD = WS_TBL + (size_t)16 * 3 * 2304 * 4;
constexpr size_t WS_H16 = WS_PD + (size_t)16 * T * 128 * 2;
constexpr size_t WS_WV = WS_PD + (size_t)16 * T * 128 * 4;
constexpr size_t WS_WG8 = WS_WV + (size_t)T * 128 * 4;
constexpr size_t WS_SWG = WS_WG8 + (size_t)DEPTH * D * D;
constexpr size_t WS_SHN = WS_SWG + (size_t)DEPTH * D * 4;
constexpr size_t WS_WIN8TM = WS_SHN + (size_t)T * 4;
constexpr size_t WS_WIN8VT = WS_WIN8TM + (size_t)DEPTH * NTM * 128 * D;
constexpr size_t WS_SWTM = WS_WIN8VT + (size_t)DEPTH * NVT * 128 * D;
constexpr size_t WS_SWVT = WS_SWTM + (size_t)DEPTH * NTM * 128 * 4;
constexpr size_t WS_SA = WS_SWVT + (size_t)DEPTH * NVT * 128 * 4;
constexpr size_t WS_XF8 = WS_SA + (size_t)T * 4;
constexpr size_t WS_SXF = WS_XF8 + (size_t)T * D;
constexpr size_t WS_WQ8 = WS_SXF + (size_t)T * 4;
constexpr size_t WS_SWQ = WS_WQ8 + (size_t)DEPTH * D * D;
constexpr size_t WS_WO8 = WS_SWQ + (size_t)DEPTH * D * 4;
constexpr size_t WS_SWO = WS_WO8 + (size_t)DEPTH * D * D;
constexpr size_t WS_SY = WS_SWO + (size_t)DEPTH * D * 4;
constexpr size_t WS_POSW = WS_SY + (size_t)T * 4;
constexpr size_t WS_END = WS_POSW + (size_t)DEPTH * 2 * 32 * 128 * 4;
static_assert(!H16 || (WQ_I8 && WOUT_I8 && PROJ_I8 && GATE_I8 && PEER_A_I8 && PEER_SLICED), "the fp16 residual stream is wired into the int8 paths only");
static_assert(WS_END <= (size_t)1024 * MiB, "workspace map exceeds 1 GiB");

__device__ __forceinline__ float bf2f(unsigned v) { return __uint_as_float(v << 16); }
__device__ __forceinline__ unsigned f2bf(float f) { unsigned u = __float_as_uint(f); return (u + 0x7fffu + ((u >> 16) & 1u)) >> 16; }
__device__ __forceinline__ unsigned pk2(float lo, float hi) { return f2bf(lo) | (f2bf(hi) << 16); }
__device__ __forceinline__ unsigned pack_i8x4(float a, float b, float c, float d, float S) {
    const int ia = (int)rintf(a * S), ib = (int)rintf(b * S), ic = (int)rintf(c * S), id = (int)rintf(d * S);
    return (unsigned)(ia & 255) | ((unsigned)(ib & 255) << 8) | ((unsigned)(ic & 255) << 16) | ((unsigned)id << 24);
}
typedef _Float16 h4_t __attribute__((ext_vector_type(4)));
typedef _Float16 h2_t __attribute__((ext_vector_type(2)));
__device__ __forceinline__ f32x4 ldh4(const GAS _Float16* p) { const h4_t v = *(const GAS h4_t*)p; return (f32x4){(float)v.x, (float)v.y, (float)v.z, (float)v.w}; }
__device__ __forceinline__ void sth4(GAS _Float16* p, f32x4 v) { *(GAS h4_t*)p = (h4_t){(_Float16)v.x, (_Float16)v.y, (_Float16)v.z, (_Float16)v.w}; }
template <bool SRC16> __device__ __forceinline__ f32x4 ldrow4(const void* base, size_t idx) { if (SRC16) return ldh4((const GAS _Float16*)base + idx); return *(const GAS f32x4*)((const GAS float*)base + idx); }
template <int M> __device__ __forceinline__ int swz_xor_i(int v) { return __builtin_amdgcn_ds_swizzle(v, (M << 10) | 0x1F); }
template <int M> __device__ __forceinline__ float swz_xor(float v) { return __builtin_bit_cast(float, swz_xor_i<M>(__builtin_bit_cast(int, v))); }
__device__ __forceinline__ void halves_i(int v, int& lo, int& hi) { const auto pr = __builtin_amdgcn_permlane32_swap((unsigned)v, (unsigned)v, false, false); lo = (int)pr[0]; hi = (int)pr[1]; }
__device__ __forceinline__ void halves(float v, float& lo, float& hi) { int a, b; halves_i(__builtin_bit_cast(int, v), a, b); lo = __builtin_bit_cast(float, a); hi = __builtin_bit_cast(float, b); }
__device__ __forceinline__ float wave_sum(float v) {
    v += swz_xor<1>(v); v += swz_xor<2>(v); v += swz_xor<4>(v); v += swz_xor<8>(v); v += swz_xor<16>(v);
    float lo, hi; halves(v, lo, hi); return lo + hi;
}
__device__ __forceinline__ float wave_max(float v) {
    v = fmaxf(v, swz_xor<1>(v)); v = fmaxf(v, swz_xor<2>(v)); v = fmaxf(v, swz_xor<4>(v)); v = fmaxf(v, swz_xor<8>(v)); v = fmaxf(v, swz_xor<16>(v));
    float lo, hi; halves(v, lo, hi); return fmaxf(lo, hi);
}
__device__ __forceinline__ int wave_min_i(int v) {
    int t;
    t = swz_xor_i<1>(v); v = t < v ? t : v; t = swz_xor_i<2>(v); v = t < v ? t : v; t = swz_xor_i<4>(v); v = t < v ? t : v; t = swz_xor_i<8>(v); v = t < v ? t : v; t = swz_xor_i<16>(v); v = t < v ? t : v;
    int lo, hi; halves_i(v, lo, hi); return lo < hi ? lo : hi;
}
__device__ __forceinline__ unsigned wave_or(unsigned v) {
    int x = (int)v; x |= swz_xor_i<1>(x); x |= swz_xor_i<2>(x); x |= swz_xor_i<4>(x); x |= swz_xor_i<8>(x); x |= swz_xor_i<16>(x);
    int lo, hi; halves_i(x, lo, hi); return (unsigned)(lo | hi);
}
__device__ __forceinline__ float lane_get(float v, int src) { return __builtin_bit_cast(float, __builtin_amdgcn_ds_bpermute(src << 2, __builtin_bit_cast(int, v))); }
__device__ __forceinline__ int lane_get_i(int v, int src) { return __builtin_amdgcn_ds_bpermute(src << 2, v); }
__device__ __forceinline__ int rel_bucket(int d) {
    if (d < 16) return d < 0 ? 0 : d;
    return 16 + (d >= 21) + (d >= 27) + (d >= 35) + (d >= 46) + (d >= 59) + (d >= 77) + (d >= 99) + (d >= 128) + (d >= 166) + (d >= 216) + (d >= 280) + (d >= 363) + (d >= 470) + (d >= 609) + (d >= 790);
}
#define WAVE_LDS_SYNC() do { asm volatile("s_waitcnt lgkmcnt(0)" ::: "memory"); __builtin_amdgcn_wave_barrier(); } while (0)

struct Params {
    const float* in[19];
    float* out;
    unsigned char* ws;
};
__device__ __forceinline__ int launder_i(int v) { asm volatile("" : "+v"(v)); return v; }
__device__ __forceinline__ int launder_s(int v) { asm volatile("" : "+s"(v)); return v; }
template <class Tp> __device__ __forceinline__ Tp* launder_p(Tp* p) { asm volatile("" : "+s"(p)); return p; }
__device__ __forceinline__ Params fresh(const Params& P) { Params Q;
#pragma unroll
    for (int i = 0; i < 19; ++i) Q.in[i] = launder_p(P.in[i]);
    Q.out = launder_p(P.out); Q.ws = launder_p(P.ws); return Q; }
#define TID() launder_i((int)threadIdx.x)
enum { I_X = 0, I_P, I_LNMIX, I_WIN, I_CMPWK, I_CMPWV, I_CMPPOS, I_OUTNORM, I_WOUT, I_RELBIAS, I_LNFFN, I_PEERWQ, I_PEERKEYS, I_PEERU, I_PEERV, I_LNPLE, I_PLEGATE, I_PLEPROJ, I_LNFINAL };

__device__ __forceinline__ void transpose_tile(const float* src, int ldsrc, int scol0, int k0, bf16* dst, int dstride, int drow0, const float* scale, LAS float* scr, int lane) {
    const bool al16 = ((scol0 & 3) == 0) && ((ldsrc & 3) == 0);
    if (al16) {
#pragma unroll
        for (int i = 0; i < 8; ++i) { const int kk = 8 * i + (lane >> 3), c4 = (lane & 7) * 4; f32x4 v = *(const GAS f32x4*)((const GAS float*)src + (size_t)(k0 + kk) * ldsrc + scol0 + c4);
            if (scale) { const float sc_ = scale[k0 + kk]; v = v * sc_; }
            scr[kk * 33 + c4] = v.x; scr[kk * 33 + c4 + 1] = v.y; scr[kk * 33 + c4 + 2] = v.z; scr[kk * 33 + c4 + 3] = v.w; }
    } else if (((scol0 | ldsrc) & 1) == 0) {
        typedef float f32x2 __attribute__((ext_vector_type(2)));
#pragma unroll
        for (int i = 0; i < 16; ++i) { const int kk = 4 * i + (lane >> 4), c2 = (lane & 15) * 2; f32x2 v = *(const GAS f32x2*)((const GAS float*)src + (size_t)(k0 + kk) * ldsrc + scol0 + c2);
            if (scale) { const float sc_ = scale[k0 + kk]; v = v * sc_; }
            scr[kk * 33 + c2] = v.x; scr[kk * 33 + c2 + 1] = v.y; }
    } else {
#pragma unroll 8
        for (int i = 0; i < 32; ++i) { const int kk = 2 * i + (lane >> 5); float v = src[(size_t)(k0 + kk) * ldsrc + scol0 + (lane & 31)]; if (scale) v *= scale[k0 + kk]; scr[kk * 33 + (lane & 31)] = v; }
    }
    WAVE_LDS_SYNC();
    const int c = lane & 7;
#pragma unroll
    for (int j = 0; j < 4; ++j) { const int n = (lane >> 3) + 8 * j; const LAS float* s = scr + (8 * c) * 33 + n;
        v4u o; o.x = pk2(s[0 * 33], s[1 * 33]); o.y = pk2(s[2 * 33], s[3 * 33]); o.z = pk2(s[4 * 33], s[5 * 33]); o.w = pk2(s[6 * 33], s[7 * 33]);
        *(v4u*)(dst + (size_t)(drow0 + n) * dstride + k0 + 8 * c) = o; }
    WAVE_LDS_SYNC();
}
constexpr int TL_TM = 32 * NTM * 4, TL_VT = 32 * NVT * 4, TL_SQ = 32 * 64, TL_PROJ = 4 * 64, TL_CW = 64 * 4;
constexpr int TL_LAYER = TL_TM + TL_VT + 3 * TL_SQ + TL_PROJ + 2 * TL_CW;
__device__ __forceinline__ void prologue_tile(const Params& P, int item, LAS float* scr, int lane) {
    const int l = item / TL_LAYER; int r = item % TL_LAYER;
    unsigned char* ws = P.ws;
    if (r < TL_TM) { const int nb = r / 32, kb = r % 32, slot = nb / 4, sub = nb % 4;
        transpose_tile(P.in[I_WIN] + (size_t)l * D * PROJ, PROJ, tm_col0(slot) + 32 * sub, 64 * kb, (bf16*)(ws + WS_WINTM) + (size_t)l * NTM * 128 * D, D, slot * 128 + 32 * sub, nullptr, scr, lane); return; }
    r -= TL_TM;
    if (r < TL_VT) { const int nb = r / 32, kb = r % 32, slot = nb / 4, sub = nb % 4;
        transpose_tile(P.in[I_WIN] + (size_t)l * D * PROJ, PROJ, vt_col0(slot) + 32 * sub, 64 * kb, (bf16*)(ws + WS_WINVT) + (size_t)l * NVT * 128 * D, D, slot * 128 + 32 * sub, nullptr, scr, lane); return; }
    r -= TL_VT;
    if (r < TL_SQ) { const int nb = r / 32, kb = r % 32;
        transpose_tile(P.in[I_WOUT] + (size_t)l * D * D, D, 32 * nb, 64 * kb, (bf16*)(ws + WS_WOUT) + (size_t)l * D * D, D, 32 * nb, P.in[I_OUTNORM] + (size_t)l * D, scr, lane); return; }
    r -= TL_SQ;
    if (r < TL_SQ) { const int nb = r / 32, kb = r % 32;
        transpose_tile(P.in[I_PEERWQ] + (size_t)l * D * D, D, 32 * nb, 64 * kb, (bf16*)(ws + WS_WQ) + (size_t)l * D * D, D, 32 * nb, nullptr, scr, lane); return; }
    r -= TL_SQ;
    if (r < TL_SQ) { const int nb = r / 32, kb = r % 32;
        transpose_tile(P.in[I_PLEGATE] + (size_t)l * D * D, D, 32 * nb, 64 * kb, (bf16*)(ws + WS_WGATE) + (size_t)l * D * D, D, 32 * nb, nullptr, scr, lane); return; }
    r -= TL_SQ;
    if (r < TL_PROJ) { const int nb = r / 4, kb = r % 4;
        transpose_tile(P.in[I_PLEPROJ] + (size_t)l * PLE * D, D, 32 * nb, 64 * kb, (bf16*)(ws + WS_WPROJ) + (size_t)l * D * PLE, PLE, 32 * nb, nullptr, scr, lane); return; }
    r -= TL_PROJ;
    { const int which = r / TL_CW; r %= TL_CW; const int nb = r / 64, kb = r % 64;
      transpose_tile((which ? P.in[I_CMPWV] : P.in[I_CMPWK]) + (size_t)l * 4096 * 128, 128, 32 * nb, 64 * kb, (bf16*)(ws + WS_CWT) + ((size_t)l * 2 + which) * 128 * 4096, 4096, 32 * nb, nullptr, scr, lane); }
}
__device__ __forceinline__ void cvt_f32_bf16(const float* src, bf16* dst, size_t n, size_t i0, size_t stride) {
    for (size_t i = i0 * 8; i < n; i += stride * 8) {
        const f32x4 a = *(const f32x4*)(src + i), b = *(const f32x4*)(src + i + 4);
        v4u o; o.x = pk2(a.x, a.y); o.y = pk2(a.z, a.w); o.z = pk2(b.x, b.y); o.w = pk2(b.z, b.w);
        *(v4u*)(dst + i) = o;
    }
}
__device__ __forceinline__ void phase_prologue(const Params& P, int bid, int nb, LAS unsigned char* lds) {
    const int tid = TID(), lane = tid & 63, wave = tid >> 6, nw = 8;
    LAS float* scr = (LAS float*)lds + wave * (64 * 33);
    for (int it = bid * nw + wave; it < DEPTH * TL_LAYER; it += nb * nw) prologue_tile(P, it, scr, lane);
    const size_t gi = (size_t)bid * 512 + tid, gs = (size_t)nb * 512;
    for (int row0 = (bid * nw + wave) * 2; row0 < 2 * DEPTH * NEXP; row0 += nb * nw * 2) {
        f32x4 v[2][2][4]; float am[2] = {0.f, 0.f};
#pragma unroll
        for (int u = 0; u < 2; ++u) { const int row = row0 + u; const int isv = row >= DEPTH * NEXP, rr = isv ? row - DEPTH * NEXP : row;
            const GAS float* src = (const GAS float*)(isv ? P.in[I_PEERV] : P.in[I_PEERU]) + (size_t)rr * D + lane * 16;
#pragma unroll
            for (int j = 0; j < 2; ++j)
#pragma unroll
                for (int q = 0; q < 4; ++q) v[u][j][q] = *(const GAS f32x4*)(src + j * 1024 + q * 4); }
#pragma unroll
        for (int u = 0; u < 2; ++u) { const int row = row0 + u; const int isv = row >= DEPTH * NEXP, rr = isv ? row - DEPTH * NEXP : row;
#pragma unroll
            for (int j = 0; j < 2; ++j)
#pragma unroll
                for (int q = 0; q < 4; ++q) am[u] = fmaxf(am[u], fmaxf(fmaxf(fabsf(v[u][j][q].x), fabsf(v[u][j][q].y)), fmaxf(fabsf(v[u][j][q].z), fabsf(v[u][j][q].w))));
            am[u] = wave_max(am[u]); const bool i8row = PEER_A_I8 && !isv; const float sc = am[u] > 0.f ? am[u] * (i8row ? 1.0f / 127.0f : 1.0f / 240.0f) : 1.0f, inv = 1.0f / sc;
            const int lyr = rr >= NEXP, ee = rr & (NEXP - 1);
            GAS unsigned char* dstb = (GAS unsigned char*)(P.ws + (isv ? WS_V : WS_U)) + (size_t)lyr * NEXP * D + (size_t)ee * 128;
#pragma unroll
            for (int j = 0; j < 2; ++j) { v4u o; int w;
                if (i8row) { o.x = pack_i8x4(v[u][j][0].x, v[u][j][0].y, v[u][j][0].z, v[u][j][0].w, inv); o.y = pack_i8x4(v[u][j][1].x, v[u][j][1].y, v[u][j][1].z, v[u][j][1].w, inv);
                             o.z = pack_i8x4(v[u][j][2].x, v[u][j][2].y, v[u][j][2].z, v[u][j][2].w, inv); o.w = pack_i8x4(v[u][j][3].x, v[u][j][3].y, v[u][j][3].z, v[u][j][3].w, inv); } else {
                w = __builtin_amdgcn_cvt_pk_fp8_f32(v[u][j][0].x * inv, v[u][j][0].y * inv, 0, false); w = __builtin_amdgcn_cvt_pk_fp8_f32(v[u][j][0].z * inv, v[u][j][0].w * inv, w, true); o.x = (unsigned)w;
                w = __builtin_amdgcn_cvt_pk_fp8_f32(v[u][j][1].x * inv, v[u][j][1].y * inv, 0, false); w = __builtin_amdgcn_cvt_pk_fp8_f32(v[u][j][1].z * inv, v[u][j][1].w * inv, w, true); o.y = (unsigned)w;
                w = __builtin_amdgcn_cvt_pk_fp8_f32(v[u][j][2].x * inv, v[u][j][2].y * inv, 0, false); w = __builtin_amdgcn_cvt_pk_fp8_f32(v[u][j][2].z * inv, v[u][j][2].w * inv, w, true); o.z = (unsigned)w;
                w = __builtin_amdgcn_cvt_pk_fp8_f32(v[u][j][3].x * inv, v[u][j][3].y * inv, 0, false); w = __builtin_amdgcn_cvt_pk_fp8_f32(v[u][j][3].z * inv, v[u][j][3].w * inv, w, true); o.w = (unsigned)w; }
#if PEER_SLICED
                { const int qc = lane + 64 * j; *(GAS v4u*)(dstb + (size_t)(qc >> 3) * NEXP * 128 + (qc & 7) * 16) = o; }
#else
                *(GAS v4u*)((GAS unsigned char*)(P.ws + (isv ? WS_V : WS_U)) + (size_t)rr * D + lane * 16 + j * 1024) = o;
#endif
            }
            if (lane == 0) ((GAS float*)(P.ws + (isv ? WS_SV : WS_SU)))[rr] = sc; }
    }
    cvt_f32_bf16(P.in[I_P], (bf16*)(P.ws + WS_P), (size_t)DEPTH * T * PLE, gi, gs);
    cvt_f32_bf16(P.in[I_PEERKEYS], (bf16*)(P.ws + WS_KEYS), (size_t)DEPTH * 16 * 128 * 128, gi, gs);
    bf16* wg = (bf16*)(P.ws + WS_WG);
    for (size_t i = gi; i < (size_t)DEPTH * 18 * D; i += gs) { const int l = (int)(i / (18 * D)), j = (int)((i / D) % 18), k = (int)(i % D); wg[i] = (bf16)f2bf(P.in[I_WIN][(size_t)l * D * PROJ + (size_t)k * PROJ + GATE_COL0 + j]); }
    float* tbl = (float*)(P.ws + WS_TBL);
    for (size_t i = gi; i < (size_t)16 * 3 * 2304; i += gs) { const int idx = (int)(i % 2304), kind = (int)((i / 2304) % 3), gh = (int)(i / (3 * 2304)); const int d = idx - 256; float v = -2e30f;
        if (d >= 0) { const float bias = P.in[I_RELBIAS][rel_bucket(d) * 16 + gh] * 1.4426950408889634f;
            if (kind == 0) v = bias;
            else if (kind == 1) { if (d <= 511) v = bias; }
            else { const int mult = (d <= 128 ? 1 : 0) + ((d & 3) == 0 && d <= 512 ? 1 : 0) + ((d & 15) == 0 ? 1 : 0); if (mult > 0) v = bias + (mult == 1 ? 0.f : mult == 2 ? 1.0f : 1.5849625007211562f); } }
        tbl[i] = v; }
    __syncthreads();
    { LAS float* red = (LAS float*)lds;
      for (int item = bid; item < DEPTH * 2 * 32; item += nb) { const int l = item >> 6, which = (item >> 5) & 1, kc = item & 31, e = tid & 127, kq = tid >> 7;
          const GAS float* w = (const GAS float*)(which ? P.in[I_CMPWV] : P.in[I_CMPWK]) + ((size_t)l * 4096 + kc * 128 + kq * 32) * 128 + e; const GAS float* pos = (const GAS float*)P.in[I_CMPPOS] + (size_t)l * 4096 + kc * 128 + kq * 32;
          float a = 0.f;
#pragma unroll 8
          for (int j = 0; j < 32; ++j) a = __builtin_fmaf(pos[j], w[(size_t)j * 128], a);
          red[tid] = a; __syncthreads();
          if (tid < 128) ((GAS float*)(P.ws + WS_POSW))[(size_t)item * 128 + tid] = (red[tid] + red[128 + tid]) + (red[256 + tid] + red[384 + tid]);
          __syncthreads(); } }
}

__device__ __forceinline__ float row_load_ss(const float* row, int lane, f32x4 (&v)[8]) {
    float s = 0.f;
#pragma unroll
    for (int j = 0; j < 8; ++j) { v[j] = *(const f32x4*)(row + (j * 64 + lane) * 4); s += v[j].x * v[j].x + v[j].y * v[j].y + v[j].z * v[j].z + v[j].w * v[j].w; }
    return wave_sum(s);
}
__device__ __forceinline__ void row_norm_store_bf16(f32x4 (&v)[8], float ss, const float* gain, bf16* orow, int lane, unsigned char* o8 = nullptr, float* sc8 = nullptr) {
    const float r = 1.0f / sqrtf(ss * (1.0f / D) + EPS); float am = 0.f;
#pragma unroll
    for (int j = 0; j < 8; ++j) { const f32x4 g = *(const f32x4*)(gain + (j * 64 + lane) * 4); v[j] = v[j] * r * g; am = fmaxf(am, fmaxf(fmaxf(fabsf(v[j].x), fabsf(v[j].y)), fmaxf(fabsf(v[j].z), fabsf(v[j].w))));
        if (orow) { v2u o; o.x = pk2(v[j].x, v[j].y); o.y = pk2(v[j].z, v[j].w); *(v2u*)(orow + (j * 64 + lane) * 4) = o; } }
    if (o8) { am = wave_max(am); const float S8 = am > 0.f ? 127.0f / am : 0.f;
#pragma unroll
        for (int j = 0; j < 8; ++j) *(GAS unsigned*)((GAS unsigned char*)o8 + (j * 64 + lane) * 4) = pack_i8x4(v[j].x, v[j].y, v[j].z, v[j].w, S8);
        if (lane == 0) *sc8 = am * (1.0f / 127.0f); }
}
typedef __bf16 bf2g_t __attribute__((ext_vector_type(2)));
__device__ __forceinline__ float dot2g(unsigned a, unsigned b, float c) { return __builtin_amdgcn_fdot2_f32_bf16(__builtin_bit_cast(bf2g_t, a), __builtin_bit_cast(bf2g_t, b), c, false); }
__device__ __forceinline__ void quant_all_rows(const Params& P, int l, int bid, int nb);
#if H16
__device__ __forceinline__ void phase_norm_mix(const Params& P, int l, int bid, int nb, LAS unsigned char* lds) {
    const int tid = TID(), lane = tid & 63, wave = tid >> 6, nw = 8;
    const GAS float* xsrc = (const GAS float*)P.in[I_X]; const GAS _Float16* hsrc = (const GAS _Float16*)(P.ws + WS_H16);
    GAS unsigned char* a8 = (GAS unsigned char*)(P.ws + WS_ACT0); GAS float* gates = (GAS float*)(P.ws + WS_GATES); GAS float* sa = (GAS float*)(P.ws + WS_SA);
    const GAS float* gain = (const GAS float*)P.in[I_LNMIX] + (size_t)l * D;
    { const GAS v4u* wsrc = (const GAS v4u*)((const GAS bf16*)(P.ws + WS_WG) + (size_t)l * 18 * D); LAS v4u* wl = (LAS v4u*)lds;
      v4u stg[9];
#pragma unroll
      for (int i = 0; i < 9; ++i) stg[i] = wsrc[tid + 512 * i];
      quant_all_rows(P, l, bid, nb);
#pragma unroll
      for (int i = 0; i < 9; ++i) wl[tid + 512 * i] = stg[i]; }
    __syncthreads();
    const LAS v2u* wl2 = (const LAS v2u*)lds;
    const int step = nb * nw;
    for (int t0 = bid * nw + wave; t0 < T; t0 += 4 * step) {
        v2u ab[4][8];
#pragma unroll
        for (int pr = 0; pr < 2; ++pr) {
            f32x4 v[2][8]; float ss[2] = {0.f, 0.f};
#pragma unroll
            for (int u = 0; u < 2; ++u) { const int t = t0 + (2 * pr + u) * step; const size_t tt = t < T ? t : t0;
                if (l == 0) {
#pragma unroll
                    for (int j = 0; j < 8; ++j) v[u][j] = *(const GAS f32x4*)(xsrc + tt * D + (j * 64 + lane) * 4);
                } else {
#pragma unroll
                    for (int j = 0; j < 8; ++j) v[u][j] = ldh4(hsrc + tt * D + (j * 64 + lane) * 4);
                } }
#pragma unroll
            for (int u = 0; u < 2; ++u) {
#pragma unroll
                for (int j = 0; j < 8; ++j) ss[u] += v[u][j].x * v[u][j].x + v[u][j].y * v[u][j].y + v[u][j].z * v[u][j].z + v[u][j].w * v[u][j].w;
                ss[u] = wave_sum(ss[u]); }
#pragma unroll
            for (int u = 0; u < 2; ++u) { const int t = t0 + (2 * pr + u) * step; const float r = 1.0f / sqrtf(ss[u] * (1.0f / D) + EPS); float am = 0.f;
#pragma unroll
                for (int j = 0; j < 8; ++j) { const f32x4 g = *(const GAS f32x4*)(gain + (j * 64 + lane) * 4); v[u][j] = v[u][j] * r * g;
                    ab[2 * pr + u][j].x = pk2(v[u][j].x, v[u][j].y); ab[2 * pr + u][j].y = pk2(v[u][j].z, v[u][j].w);
                    am = fmaxf(am, fmaxf(fmaxf(fabsf(v[u][j].x), fabsf(v[u][j].y)), fmaxf(fabsf(v[u][j].z), fabsf(v[u][j].w)))); }
                am = wave_max(am); const float S8 = am > 0.f ? 127.0f / am : 0.f;
                if (t < T) {
#pragma unroll
                    for (int j = 0; j < 8; ++j) *(GAS unsigned*)(a8 + (size_t)t * D + (j * 64 + lane) * 4) = pack_i8x4(v[u][j].x, v[u][j].y, v[u][j].z, v[u][j].w, S8);
                    if (lane == 0) sa[t] = am * (1.0f / 127.0f); } }
        }
        const int trow = t0 + (lane >> 4) * step;
#pragma unroll 2
        for (int c = 0; c < 18; ++c) { float s0 = 0.f, s1 = 0.f, s2 = 0.f, s3 = 0.f;
#pragma unroll
            for (int j = 0; j < 8; ++j) { const v2u w = wl2[c * (D / 4) + j * 64 + lane];
                s0 = dot2g(ab[0][j].x, w.x, s0); s0 = dot2g(ab[0][j].y, w.y, s0); s1 = dot2g(ab[1][j].x, w.x, s1); s1 = dot2g(ab[1][j].y, w.y, s1);
                s2 = dot2g(ab[2][j].x, w.x, s2); s2 = dot2g(ab[2][j].y, w.y, s2); s3 = dot2g(ab[3][j].x, w.x, s3); s3 = dot2g(ab[3][j].y, w.y, s3); }
            const auto p02 = __builtin_amdgcn_permlane32_swap(__builtin_bit_cast(unsigned, s0), __builtin_bit_cast(unsigned, s2), false, false);
            const auto p13 = __builtin_amdgcn_permlane32_swap(__builtin_bit_cast(unsigned, s1), __builtin_bit_cast(unsigned, s3), false, false);
            const float x0 = __builtin_bit_cast(float, (unsigned)p02[0]) + __builtin_bit_cast(float, (unsigned)p02[1]), x1 = __builtin_bit_cast(float, (unsigned)p13[0]) + __builtin_bit_cast(float, (unsigned)p13[1]);
            const auto q = __builtin_amdgcn_permlane16_swap(__builtin_bit_cast(unsigned, x0), __builtin_bit_cast(unsigned, x1), false, false);
            float y = __builtin_bit_cast(float, (unsigned)q[0]) + __builtin_bit_cast(float, (unsigned)q[1]);
            y += swz_xor<8>(y); y += swz_xor<4>(y); y += swz_xor<2>(y); y += swz_xor<1>(y);
            if ((lane & 15) == 0 && trow < T) gates[(size_t)trow * 18 + c] = 1.0f / (1.0f + __expf(-y)); }
    }
    __syncthreads();
}
#else
__device__ __forceinline__ void phase_norm_mix(const Params& P, int l, int bid, int nb, LAS unsigned char* lds) {
    const int tid = TID(), lane = tid & 63, wave = tid >> 6, nw = 8;
    const float* hsrc = l == 0 ? P.in[I_X] : P.out;
    bf16* a = (bf16*)(P.ws + WS_ACT0); float* gates = (float*)(P.ws + WS_GATES);
    { const GAS v4u* wsrc = (const GAS v4u*)((const GAS bf16*)(P.ws + WS_WG) + (size_t)l * 18 * D); LAS v4u* wl = (LAS v4u*)lds;
      for (int i = tid; i < 18 * D / 8; i += 512) wl[i] = wsrc[i]; }
    __syncthreads();
    const LAS v2u* wl2 = (const LAS v2u*)lds;
    for (int t = bid * nw + wave; t < T; t += nb * nw) {
        f32x4 v[8]; float ss;
#if H16
        if (l == 0) ss = row_load_ss(hsrc + (size_t)t * D, lane, v);
        else { float s_ = 0.f;
#pragma unroll
            for (int j = 0; j < 8; ++j) { v[j] = ldh4((const GAS _Float16*)(P.ws + WS_H16) + (size_t)t * D + (j * 64 + lane) * 4); s_ += v[j].x * v[j].x + v[j].y * v[j].y + v[j].z * v[j].z + v[j].w * v[j].w; }
            ss = wave_sum(s_); }
#else
        ss = row_load_ss(hsrc + (size_t)t * D, lane, v);
#endif
        const float r = 1.0f / sqrtf(ss * (1.0f / D) + EPS); v2u ab[8];
#pragma unroll
        for (int j = 0; j < 8; ++j) { const f32x4 g = *(const f32x4*)(P.in[I_LNMIX] + (size_t)l * D + (j * 64 + lane) * 4); v[j] = v[j] * r * g;
            ab[j].x = pk2(v[j].x, v[j].y); ab[j].y = pk2(v[j].z, v[j].w);
#if !PROJ_I8
            *(v2u*)(a + (size_t)t * D + (j * 64 + lane) * 4) = ab[j];
#endif
        }
#if PROJ_I8
        { float am = 0.f;
#pragma unroll
          for (int j = 0; j < 8; ++j) am = fmaxf(am, fmaxf(fmaxf(fabsf(v[j].x), fabsf(v[j].y)), fmaxf(fabsf(v[j].z), fabsf(v[j].w))));
          am = wave_max(am); const float S8 = am > 0.f ? 127.0f / am : 0.f;
#pragma unroll
          for (int j = 0; j < 8; ++j) *(GAS unsigned*)((GAS unsigned char*)a + (size_t)t * D + (j * 64 + lane) * 4) = pack_i8x4(v[j].x, v[j].y, v[j].z, v[j].w, S8);
          if (lane == 0) ((GAS float*)(P.ws + WS_SA))[t] = am * (1.0f / 127.0f); }
#endif
#pragma unroll 2
        for (int c = 0; c < 18; ++c) { float sacc = 0.f;
#pragma unroll
            for (int j = 0; j < 8; ++j) { const v2u w = wl2[c * (D / 4) + j * 64 + lane]; sacc = dot2g(ab[j].x, w.x, sacc); sacc = dot2g(ab[j].y, w.y, sacc); }
            const float sv_ = wave_sum(sacc); if (lane == 0) gates[(size_t)t * 18 + c] = 1.0f / (1.0f + __expf(-sv_)); }
    }
    __syncthreads();
}
#endif
template <bool SRC16 = false>
__device__ __forceinline__ void phase_norm(const void* src, const float* gain, bf16* dst, int bid, int nb, unsigned char* d8 = nullptr, float* s8 = nullptr) {
    const int tid = TID(), lane = tid & 63, wave = tid >> 6, nw = 8;
    const int step = nb * nw;
    int t = bid * nw + wave;
    for (; t + step < T; t += 2 * step) { f32x4 v0[8], v1[8];
#pragma unroll
        for (int j = 0; j < 8; ++j) { v0[j] = ldrow4<SRC16>(src, (size_t)t * D + (j * 64 + lane) * 4); v1[j] = ldrow4<SRC16>(src, (size_t)(t + step) * D + (j * 64 + lane) * 4); }
        float s0 = 0.f, s1 = 0.f;
#pragma unroll
        for (int j = 0; j < 8; ++j) { s0 += v0[j].x * v0[j].x + v0[j].y * v0[j].y + v0[j].z * v0[j].z + v0[j].w * v0[j].w; s1 += v1[j].x * v1[j].x + v1[j].y * v1[j].y + v1[j].z * v1[j].z + v1[j].w * v1[j].w; }
        s0 = wave_sum(s0); s1 = wave_sum(s1);
        row_norm_store_bf16(v0, s0, gain, dst ? dst + (size_t)t * D : nullptr, lane, d8 ? d8 + (size_t)t * D : nullptr, s8 + t); row_norm_store_bf16(v1, s1, gain, dst ? dst + (size_t)(t + step) * D : nullptr, lane, d8 ? d8 + (size_t)(t + step) * D : nullptr, s8 + t + step); }
    for (; t < T; t += step) { f32x4 v[8]; float s_ = 0.f;
#pragma unroll
        for (int j = 0; j < 8; ++j) { v[j] = ldrow4<SRC16>(src, (size_t)t * D + (j * 64 + lane) * 4); s_ += v[j].x * v[j].x + v[j].y * v[j].y + v[j].z * v[j].z + v[j].w * v[j].w; }
        row_norm_store_bf16(v, wave_sum(s_), gain, dst ? dst + (size_t)t * D : nullptr, lane, d8 ? d8 + (size_t)t * D : nullptr, s8 + t); }
}
__device__ __forceinline__ void phase_final(const Params& P, int bid, int nb) {
    const int tid = TID(), lane = tid & 63, wave = tid >> 6, nw = 8;
    const int step = nb * nw; int t = bid * nw + wave;
    for (; t + step < T; t += 2 * step) { f32x4 v0[8], v1[8]; GAS float* r0p = (GAS float*)P.out + (size_t)t * D; GAS float* r1p = (GAS float*)P.out + (size_t)(t + step) * D;
#pragma unroll
        for (int j = 0; j < 8; ++j) {
#if H16
            v0[j] = ldh4((const GAS _Float16*)(P.ws + WS_H16) + (size_t)t * D + (j * 64 + lane) * 4); v1[j] = ldh4((const GAS _Float16*)(P.ws + WS_H16) + (size_t)(t + step) * D + (j * 64 + lane) * 4);
#else
            v0[j] = *(const GAS f32x4*)(r0p + (j * 64 + lane) * 4); v1[j] = *(const GAS f32x4*)(r1p + (j * 64 + lane) * 4);
#endif
        }
        float s0 = 0.f, s1 = 0.f;
#pragma unroll
        for (int j = 0; j < 8; ++j) { s0 += v0[j].x * v0[j].x + v0[j].y * v0[j].y + v0[j].z * v0[j].z + v0[j].w * v0[j].w; s1 += v1[j].x * v1[j].x + v1[j].y * v1[j].y + v1[j].z * v1[j].z + v1[j].w * v1[j].w; }
        s0 = wave_sum(s0); s1 = wave_sum(s1);
        const float q0 = 1.0f / sqrtf(s0 * (1.0f / D) + EPS), q1 = 1.0f / sqrtf(s1 * (1.0f / D) + EPS);
#pragma unroll
        for (int j = 0; j < 8; ++j) { const f32x4 g = *(const f32x4*)(P.in[I_LNFINAL] + (j * 64 + lane) * 4); *(GAS f32x4*)(r0p + (j * 64 + lane) * 4) = v0[j] * q0 * g; *(GAS f32x4*)(r1p + (j * 64 + lane) * 4) = v1[j] * q1 * g; } }
    for (; t < T; t += step) { f32x4 v[8]; float* row = P.out + (size_t)t * D;
#if H16
        float s_ = 0.f;
#pragma unroll
        for (int j = 0; j < 8; ++j) { v[j] = ldh4((const GAS _Float16*)(P.ws + WS_H16) + (size_t)t * D + (j * 64 + lane) * 4); s_ += v[j].x * v[j].x + v[j].y * v[j].y + v[j].z * v[j].z + v[j].w * v[j].w; }
        const float ss = wave_sum(s_);
#else
        const float ss = row_load_ss(row, lane, v);
#endif
        const float r = 1.0f / sqrtf(ss * (1.0f / D) + EPS);
#pragma unroll
        for (int j = 0; j < 8; ++j) { const f32x4 g = *(const f32x4*)(P.in[I_LNFINAL] + (j * 64 + lane) * 4); *(f32x4*)(row + (j * 64 + lane) * 4) = v[j] * r * g; } }
}
__device__ __forceinline__ void phase_ynorm(const Params& P, int bid, int nb) {
    const int tid = TID(), lane = tid & 63, wave = tid >> 6, nw = 8;
    const GAS bf16* o = (const GAS bf16*)(P.ws + WS_ACT1); GAS bf16* y = (GAS bf16*)(P.ws + WS_ACT2); const GAS float* ss = (const GAS float*)(P.ws + WS_SS);
    const int step = nb * nw;
    for (int t0 = bid * nw + wave; t0 < T; t0 += 2 * step) {
        v4u w[2][4]; float sv[2];
#pragma unroll
        for (int u = 0; u < 2; ++u) { const int t = t0 + u * step; const bool ok = t < T; const size_t tt = ok ? t : t0;
            sv[u] = lane < 16 ? ss[tt * 16 + lane] : 0.f;
#pragma unroll
            for (int j = 0; j < 4; ++j) w[u][j] = *(const GAS v4u*)(o + tt * D + (j * 64 + lane) * 8); }
#pragma unroll
        for (int u = 0; u < 2; ++u) { const int t = t0 + u * step; if (t >= T) break;
            float sa = lane < 6 ? sv[u] : 0.f, sb = (lane >= 6 && lane < 12) ? sv[u] : 0.f, sc = (lane >= 12 && lane < 16) ? sv[u] : 0.f;
            sa = wave_sum(sa); sb = wave_sum(sb); sc = wave_sum(sc);
            const float ra = 1.0f / sqrtf(sa * (1.0f / 768.f) + EPS), rb = 1.0f / sqrtf(sb * (1.0f / 768.f) + EPS), rc = 1.0f / sqrtf(sc * (1.0f / 512.f) + EPS);
#if WOUT_I8
            float yv[4][8]; float am = 0.f;
#pragma unroll
            for (int j = 0; j < 4; ++j) { const int c0 = (j * 64 + lane) * 8; const float r = c0 < 768 ? ra : c0 < 1536 ? rb : rc; const v4u ww = w[u][j];
                yv[j][0] = bf2f(ww.x & 0xffff) * r; yv[j][1] = bf2f(ww.x >> 16) * r; yv[j][2] = bf2f(ww.y & 0xffff) * r; yv[j][3] = bf2f(ww.y >> 16) * r;
                yv[j][4] = bf2f(ww.z & 0xffff) * r; yv[j][5] = bf2f(ww.z >> 16) * r; yv[j][6] = bf2f(ww.w & 0xffff) * r; yv[j][7] = bf2f(ww.w >> 16) * r;
#pragma unroll
                for (int e = 0; e < 8; ++e) am = fmaxf(am, fabsf(yv[j][e])); }
            am = wave_max(am); const float S8 = am > 0.f ? 127.0f / am : 0.f;
#pragma unroll
            for (int j = 0; j < 4; ++j) *(GAS v2u*)((GAS unsigned char*)y + (size_t)t * D + (j * 64 + lane) * 8) = (v2u){pack_i8x4(yv[j][0], yv[j][1], yv[j][2], yv[j][3], S8), pack_i8x4(yv[j][4], yv[j][5], yv[j][6], yv[j][7], S8)};
            if (lane == 0) ((GAS float*)(P.ws + WS_SY))[t] = am * (1.0f / 127.0f); }
#else
#pragma unroll
            for (int j = 0; j < 4; ++j) { const int c0 = (j * 64 + lane) * 8; const float r = c0 < 768 ? ra : c0 < 1536 ? rb : rc; const v4u ww = w[u][j]; v4u q;
                q.x = pk2(bf2f(ww.x & 0xffff) * r, bf2f(ww.x >> 16) * r); q.y = pk2(bf2f(ww.y & 0xffff) * r, bf2f(ww.y >> 16) * r);
                q.z = pk2(bf2f(ww.z & 0xffff) * r, bf2f(ww.z >> 16) * r); q.w = pk2(bf2f(ww.w & 0xffff) * r, bf2f(ww.w >> 16) * r);
                *(GAS v4u*)(y + (size_t)t * D + c0) = q; } }
#endif
    }
}

struct EpiProjTM {
    bf16* tm;
    __device__ __forceinline__ void elem(int R, int C, float v) const { const int b = R >> 11, s = R & 2047, slot = C >> 7, d = C & 127; tm[(((size_t)b * NTM + slot) * S + s) * 128 + d] = (bf16)f2bf(v); }
};
struct EpiProjVT {
    bf16* vt;
    __device__ __forceinline__ void elem(int R, int C, float v) const { const int b = C >> 11, s = C & 2047, slot = R >> 7, d = R & 127; vt[(((size_t)b * NVT + slot) * 128 + d) * S + s] = (bf16)f2bf(v); }
};
struct EpiResid {
    const float* base; float* out;
    __device__ __forceinline__ void elem(int R, int C, float v) const { out[(size_t)R * D + C] = base[(size_t)R * D + C] + v; }
};
struct EpiStoreBf16 {
    bf16* o;
    __device__ __forceinline__ void elem(int R, int C, float v) const { o[(size_t)R * D + C] = (bf16)f2bf(v); }
};
struct EpiPleGate {
    float* out; const bf16* pp;
    __device__ __forceinline__ void elem(int R, int C, float v) const { const size_t i = (size_t)R * D + C; out[i] = out[i] + (1.0f / (1.0f + __expf(-v))) * bf2f(pp[i]); }
};

template <class Epi>
__device__ __forceinline__ void gemm_naive_tile(const bf16* Aside, const bf16* Bside, int K, int r0, int c0, const Epi& E, int tid, LAS float* sm) {
    typedef LAS float (*T68)[68];
    T68 As = (T68)sm, Bs = (T68)(sm + 32 * 68);
    const int tx = tid & 15, ty = tid >> 4;
    float acc[4][4];
#pragma unroll
    for (int i = 0; i < 4; ++i)
#pragma unroll
        for (int j = 0; j < 4; ++j) acc[i][j] = 0.f;
    const int lr = tid >> 2, lk = (tid & 3) * 8;
    for (int k0 = 0; k0 < K; k0 += 32) {
        const v4u av = *(const v4u*)(Aside + (size_t)(r0 + lr) * K + k0 + lk), bv = *(const v4u*)(Bside + (size_t)(c0 + lr) * K + k0 + lk);
        __syncthreads();
        As[lk + 0][lr] = bf2f(av.x & 0xffff); As[lk + 1][lr] = bf2f(av.x >> 16); As[lk + 2][lr] = bf2f(av.y & 0xffff); As[lk + 3][lr] = bf2f(av.y >> 16);
        As[lk + 4][lr] = bf2f(av.z & 0xffff); As[lk + 5][lr] = bf2f(av.z >> 16); As[lk + 6][lr] = bf2f(av.w & 0xffff); As[lk + 7][lr] = bf2f(av.w >> 16);
        Bs[lk + 0][lr] = bf2f(bv.x & 0xffff); Bs[lk + 1][lr] = bf2f(bv.x >> 16); Bs[lk + 2][lr] = bf2f(bv.y & 0xffff); Bs[lk + 3][lr] = bf2f(bv.y >> 16);
        Bs[lk + 4][lr] = bf2f(bv.z & 0xffff); Bs[lk + 5][lr] = bf2f(bv.z >> 16); Bs[lk + 6][lr] = bf2f(bv.w & 0xffff); Bs[lk + 7][lr] = bf2f(bv.w >> 16);
        __syncthreads();
#pragma unroll
        for (int kk = 0; kk < 32; ++kk) {
            const f32x4 a = *(const LAS f32x4*)&As[kk][ty * 4], b = *(const LAS f32x4*)&Bs[kk][tx * 4];
            const float aa[4] = {a.x, a.y, a.z, a.w}, bb[4] = {b.x, b.y, b.z, b.w};
#pragma unroll
            for (int i = 0; i < 4; ++i)
#pragma unroll
                for (int j = 0; j < 4; ++j) acc[i][j] += aa[i] * bb[j];
        }
    }
#pragma unroll
    for (int i = 0; i < 4; ++i)
#pragma unroll
        for (int j = 0; j < 4; ++j) E.elem(r0 + ty * 4 + i, c0 + tx * 4 + j, acc[i][j]);
}
template <class Epi>
__device__ __forceinline__ void phase_gemm_naive(const bf16* Aside, const bf16* Bside, int K, int nR, int nC, const Epi& E, int bid, int nb, LAS unsigned char* lds) {
    const int tid_ = TID(); const int half = tid_ >> 8, vtid = tid_ & 255; LAS float* sm = (LAS float*)lds + half * (2 * 32 * 68);
    const int tc = nC / 64, nt = (nR / 64) * tc;
    for (int base = bid * 2; base < nt; base += nb * 2) { const int tile = base + half; gemm_naive_tile(Aside, Bside, K, (tile / tc) * 64, (tile % tc) * 64, E, vtid, sm); }
    __syncthreads();
}


namespace pg8 {
#define PG8_LAS __attribute__((address_space(3)))
typedef unsigned short bf16_t;
typedef short bf16x8 __attribute__((ext_vector_type(8)));
typedef float f32x4 __attribute__((ext_vector_type(4)));
typedef unsigned u32x4 __attribute__((ext_vector_type(4)));
constexpr int BM = 256, BK = 64, HALF = 128, HTB = HALF * BK * 2, STAGE_BYTES = 8 * HTB, NXCD = 8, WGM = 8;
__host__ __device__ __forceinline__ int lds_byte(int r, int c) { const int st = (r >> 4) * 2 + (c >> 5), rr = r & 15, cc = c & 31, ob = rr * 64 + cc * 2; return st * 1024 + (ob ^ (((ob >> 9) & 1) << 5)); }
__host__ __device__ __forceinline__ void stage_rc(int b, int& R, int& C) { const int st = b / 1024, sb = b % 1024, swz = sb ^ (((sb >> 9) & 1) << 5); R = (st >> 1) * 16 + swz / 64; C = (st & 1) * 32 + (swz % 64) / 2; }
__host__ __device__ __forceinline__ int perm32(int rho) { const int n = rho >> 4, i = rho & 15; return 8 * (i >> 2) + 4 * n + (i & 3); }
struct Unit { int pm, pn; };
struct Gemm { const bf16_t* A; const bf16_t* Bt; int K; const bf16_t* A2; const bf16_t* Bt2; int splitM, splitN;
    __device__ __forceinline__ const char* a_ptr(int pm, size_t tstep) const { return pm < splitM ? (const char*)A + (size_t)pm * tstep : (const char*)A2 + (size_t)(pm - splitM) * tstep; }
    __device__ __forceinline__ const char* b_ptr(int pn, size_t tstep) const { return pn < splitN ? (const char*)Bt + (size_t)pn * tstep : (const char*)Bt2 + (size_t)(pn - splitN) * tstep; } };
__device__ __forceinline__ void order_map(int wgid, int nM, int nN, Unit& u) {
    const int nwg = nM * nN; { const int q = nwg / NXCD, r = nwg % NXCD, xcd = wgid % NXCD, off = wgid / NXCD; wgid = (xcd < r ? xcd * (q + 1) : r * (q + 1) + (xcd - r) * q) + off; }
    const int nig = WGM * nN, gid = wgid / nig, fm = gid * WGM, gsz = (nM - fm) < WGM ? (nM - fm) : WGM;
    u.pm = fm + ((wgid % nig) % gsz); u.pn = (wgid % nig) / gsz;
}
struct StaticOrder {
    int nM, nN, nwg, G, c;
    __device__ void init(int M, int N, int G_, int c_) { nM = M / BM; nN = N / BM; nwg = nM * nN; G = G_; c = c_; }
    __device__ bool next(int i, Unit& u) const { const long L = (long)i * G + c; if (L >= nwg) return false; order_map((int)L, nM, nN, u); return true; }
    __device__ __forceinline__ void a_ready(const Unit&) const {}
    __device__ __forceinline__ void done(const Unit&) const {}
};
struct DualOrder {
    int nM1, nN1, nM2, nN2, G, c;
    __device__ bool next(int i, Unit& u) const { long L = (long)i * G + c; const int n1 = nM1 * nN1;
        if (L < n1) { order_map((int)L, nM1, nN1, u); return true; }
        L -= n1; if (L >= nM2 * nN2) return false; order_map((int)L, nM2, nN2, u); u.pm += nM1; u.pn += nN1; return true; }
    __device__ __forceinline__ void a_ready(const Unit&) const {}
    __device__ __forceinline__ void done(const Unit&) const {}
};
__device__ __forceinline__ unsigned cvt_pk_bf16(float lo, float hi) { unsigned r; asm volatile("v_cvt_pk_bf16_f32 %0, %1, %2" : "=v"(r) : "v"(lo), "v"(hi)); return r; }
struct EpiProj {
    static constexpr bool PERM = true, AFTER_DRAIN = false, I8 = false;
    bf16_t* tm; bf16_t* vt;
    __device__ __forceinline__ void operator()(const f32x4 (&acc)[2][2][4][2], const Unit& u, int wr, int wc, int fr, int fq) const {
        if (u.pm < 64) {
#pragma unroll
            for (int ai = 0; ai < 2; ++ai)
#pragma unroll
                for (int m = 0; m < 4; ++m) { const int r = u.pm * BM + ai * HALF + wr * 64 + m * 16 + fr, b = r >> 11, s = r & 2047;
#pragma unroll
                    for (int bj = 0; bj < 2; ++bj) { const int slot = 2 * u.pn + bj, d0 = wc * 32 + 8 * fq;
                        const f32x4 v0 = acc[ai][bj][m][0], v1 = acc[ai][bj][m][1];
                        u32x4 w; w.x = cvt_pk_bf16(v0[0], v0[1]); w.y = cvt_pk_bf16(v0[2], v0[3]); w.z = cvt_pk_bf16(v1[0], v1[1]); w.w = cvt_pk_bf16(v1[2], v1[3]);
                        *(GAS u32x4*)((GAS bf16_t*)tm + (((size_t)b * NTM + slot) * S + s) * 128 + d0) = w; } }
        } else {
            const int pmv = u.pm - 64, pnv = u.pn - 17;
#pragma unroll
            for (int ai = 0; ai < 2; ++ai)
#pragma unroll
                for (int m = 0; m < 4; ++m) { const int vslot = 2 * pmv + ai, d = wr * 64 + m * 16 + fr;
#pragma unroll
                    for (int bj = 0; bj < 2; ++bj) { const int c0 = pnv * BM + bj * HALF + wc * 32 + 8 * fq, b = c0 >> 11, s = c0 & 2047;
                        const f32x4 v0 = acc[ai][bj][m][0], v1 = acc[ai][bj][m][1];
                        u32x4 w; w.x = cvt_pk_bf16(v0[0], v0[1]); w.y = cvt_pk_bf16(v0[2], v0[3]); w.z = cvt_pk_bf16(v1[0], v1[1]); w.w = cvt_pk_bf16(v1[2], v1[3]);
                        *(GAS u32x4*)((GAS bf16_t*)vt + (((size_t)b * NVT + vslot) * 128 + d) * S + s) = w; } }
        }
    }
};
struct EpiResidT {
    static constexpr bool PERM = false, AFTER_DRAIN = false, I8 = false;
    const float* base; float* out;
    __device__ __forceinline__ void operator()(const f32x4 (&acc)[2][2][4][2], const Unit& u, int wr, int wc, int fr, int fq) const {
        const int row0 = u.pm * BM + wr * 64 + fr, col0 = u.pn * BM + wc * 32 + 4 * fq;
        const GAS float* bp = (const GAS float*)base; GAS float* op = (GAS float*)out;
#pragma unroll
        for (int ai = 0; ai < 2; ++ai)
#pragma unroll
            for (int mp = 0; mp < 2; ++mp) { f32x4 t[2][2][2];
#pragma unroll
                for (int mm = 0; mm < 2; ++mm) { const size_t off = (size_t)(row0 + ai * HALF + (2 * mp + mm) * 16) * D + col0;
#pragma unroll
                    for (int bj = 0; bj < 2; ++bj)
#pragma unroll
                        for (int n = 0; n < 2; ++n) t[mm][bj][n] = *(const GAS f32x4*)(bp + off + bj * HALF + n * 16); }
#pragma unroll
                for (int mm = 0; mm < 2; ++mm) { const size_t off = (size_t)(row0 + ai * HALF + (2 * mp + mm) * 16) * D + col0;
#pragma unroll
                    for (int bj = 0; bj < 2; ++bj)
#pragma unroll
                        for (int n = 0; n < 2; ++n) *(GAS f32x4*)(op + off + bj * HALF + n * 16) = t[mm][bj][n] + acc[ai][bj][2 * mp + mm][n]; } }
    }
};
struct EpiStoreT {
    static constexpr bool PERM = true, AFTER_DRAIN = false, I8 = false;
    bf16_t* o;
    __device__ __forceinline__ void operator()(const f32x4 (&acc)[2][2][4][2], const Unit& u, int wr, int wc, int fr, int fq) const {
        const int row0 = u.pm * BM + wr * 64 + fr, col0 = u.pn * BM + wc * 32 + 8 * fq;
#pragma unroll
        for (int ai = 0; ai < 2; ++ai)
#pragma unroll
            for (int m = 0; m < 4; ++m) { bf16_t* rowp = o + (size_t)(row0 + ai * HALF + m * 16) * D + col0;
#pragma unroll
                for (int bj = 0; bj < 2; ++bj) { const f32x4 v0 = acc[ai][bj][m][0], v1 = acc[ai][bj][m][1];
                    u32x4 w; w.x = cvt_pk_bf16(v0[0], v0[1]); w.y = cvt_pk_bf16(v0[2], v0[3]); w.z = cvt_pk_bf16(v1[0], v1[1]); w.w = cvt_pk_bf16(v1[2], v1[3]);
                    *(GAS u32x4*)((GAS bf16_t*)rowp + bj * HALF) = w; } }
    }
};
struct EpiPleGateT {
    static constexpr bool PERM = false, AFTER_DRAIN = false, I8 = false;
    float* out; const bf16_t* pp;
    __device__ __forceinline__ void operator()(const f32x4 (&acc)[2][2][4][2], const Unit& u, int wr, int wc, int fr, int fq) const {
        const int row0 = u.pm * BM + wr * 64 + fr, col0 = u.pn * BM + wc * 32 + 4 * fq;
        GAS float* op = (GAS float*)out; const GAS bf16_t* ppp = (const GAS bf16_t*)pp;
#pragma unroll
        for (int ai = 0; ai < 2; ++ai)
#pragma unroll
            for (int mp = 0; mp < 2; ++mp) { f32x4 t[2][2][2]; v2u pw[2][2][2];
#pragma unroll
                for (int mm = 0; mm < 2; ++mm) { const size_t off = (size_t)(row0 + ai * HALF + (2 * mp + mm) * 16) * D + col0;
#pragma unroll
                    for (int bj = 0; bj < 2; ++bj)
#pragma unroll
                        for (int n = 0; n < 2; ++n) { t[mm][bj][n] = *(const GAS f32x4*)(op + off + bj * HALF + n * 16); pw[mm][bj][n] = *(const GAS v2u*)(ppp + off + bj * HALF + n * 16); } }
#pragma unroll
                for (int mm = 0; mm < 2; ++mm) { const size_t off = (size_t)(row0 + ai * HALF + (2 * mp + mm) * 16) * D + col0;
#pragma unroll
                    for (int bj = 0; bj < 2; ++bj)
#pragma unroll
                        for (int n = 0; n < 2; ++n) { const f32x4 hv = t[mm][bj][n], a = acc[ai][bj][2 * mp + mm][n]; const v2u p2 = pw[mm][bj][n];
                            f32x4 r; r[0] = hv[0] + bf2f(p2.x & 0xffff) / (1.0f + __expf(-a[0])); r[1] = hv[1] + bf2f(p2.x >> 16) / (1.0f + __expf(-a[1]));
                            r[2] = hv[2] + bf2f(p2.y & 0xffff) / (1.0f + __expf(-a[2])); r[3] = hv[3] + bf2f(p2.y >> 16) / (1.0f + __expf(-a[3]));
                            *(GAS f32x4*)(op + off + bj * HALF + n * 16) = r; } } }
    }
};

typedef int i32x4 __attribute__((ext_vector_type(4)));
template <bool I8> struct AccSel { typedef f32x4 type; };
template <> struct AccSel<true> { typedef i32x4 type; };
__device__ __forceinline__ void mma16(f32x4& acc, const bf16x8 b, const bf16x8 a) { acc = __builtin_amdgcn_mfma_f32_16x16x32_bf16(b, a, acc, 0, 0, 0); }
__device__ __forceinline__ void mma16(i32x4& acc, const bf16x8 b, const bf16x8 a) { acc = __builtin_amdgcn_mfma_i32_16x16x64_i8(__builtin_bit_cast(i32x4, b), __builtin_bit_cast(i32x4, a), acc, 0, 0, 0); }
struct EpiPleGateI8 {
    static constexpr bool PERM = false, AFTER_DRAIN = false, I8 = true;
    float* out; const bf16_t* pp; const float* sa; const float* sw;
    __device__ __forceinline__ void operator()(const i32x4 (&acc)[2][2][4][2], const Unit& u, int wr, int wc, int fr, int fq) const {
        const int row0 = u.pm * BM + wr * 64 + fr, col0 = u.pn * BM + wc * 32 + 4 * fq;
        GAS float* op = (GAS float*)out; const GAS bf16_t* ppp = (const GAS bf16_t*)pp;
        f32x4 swv[2][2];
#pragma unroll
        for (int bj = 0; bj < 2; ++bj)
#pragma unroll
            for (int n = 0; n < 2; ++n) swv[bj][n] = *(const GAS f32x4*)((const GAS float*)sw + col0 + bj * HALF + n * 16);
#pragma unroll
        for (int ai = 0; ai < 2; ++ai)
#pragma unroll
            for (int mp = 0; mp < 2; ++mp) { f32x4 t[2][2][2]; v2u pw[2][2][2]; float rs[2];
#pragma unroll
                for (int mm = 0; mm < 2; ++mm) { const int row = row0 + ai * HALF + (2 * mp + mm) * 16; const size_t off = (size_t)row * D + col0; rs[mm] = ((const GAS float*)sa)[row];
#pragma unroll
                    for (int bj = 0; bj < 2; ++bj)
#pragma unroll
                        for (int n = 0; n < 2; ++n) {
#if H16
                            t[mm][bj][n] = ldh4((const GAS _Float16*)out + off + bj * HALF + n * 16);
#else
                            t[mm][bj][n] = *(const GAS f32x4*)(op + off + bj * HALF + n * 16);
#endif
                            pw[mm][bj][n] = *(const GAS v2u*)(ppp + off + bj * HALF + n * 16); } }
#pragma unroll
                for (int mm = 0; mm < 2; ++mm) { const size_t off = (size_t)(row0 + ai * HALF + (2 * mp + mm) * 16) * D + col0;
#pragma unroll
                    for (int bj = 0; bj < 2; ++bj)
#pragma unroll
                        for (int n = 0; n < 2; ++n) { const f32x4 hv = t[mm][bj][n]; const i32x4 ai4 = acc[ai][bj][2 * mp + mm][n]; const v2u p2 = pw[mm][bj][n]; const f32x4 sc = swv[bj][n] * rs[mm];
                            const float a0 = (float)ai4[0] * sc[0], a1 = (float)ai4[1] * sc[1], a2 = (float)ai4[2] * sc[2], a3 = (float)ai4[3] * sc[3];
                            f32x4 r; r[0] = hv[0] + bf2f(p2.x & 0xffff) / (1.0f + __expf(-a0)); r[1] = hv[1] + bf2f(p2.x >> 16) / (1.0f + __expf(-a1));
                            r[2] = hv[2] + bf2f(p2.y & 0xffff) / (1.0f + __expf(-a2)); r[3] = hv[3] + bf2f(p2.y >> 16) / (1.0f + __expf(-a3));
#if H16
                            sth4((GAS _Float16*)out + off + bj * HALF + n * 16, r);
#else
                            *(GAS f32x4*)(op + off + bj * HALF + n * 16) = r;
#endif
                        } } }
    }
};
struct EpiStoreI8 {
    static constexpr bool PERM = true, AFTER_DRAIN = false, I8 = true;
    bf16_t* o; const float* sa; const float* sw;
    __device__ __forceinline__ void operator()(const i32x4 (&acc)[2][2][4][2], const Unit& u, int wr, int wc, int fr, int fq) const {
        const int row0 = u.pm * BM + wr * 64 + fr, col0 = u.pn * BM + wc * 32 + 8 * fq;
        f32x4 cs[2][2];
#pragma unroll
        for (int bj = 0; bj < 2; ++bj) { const GAS float* p = (const GAS float*)sw + col0 + bj * HALF; cs[bj][0] = *(const GAS f32x4*)p; cs[bj][1] = *(const GAS f32x4*)(p + 4); }
#pragma unroll
        for (int ai = 0; ai < 2; ++ai)
#pragma unroll
            for (int m = 0; m < 4; ++m) { const int row = row0 + ai * HALF + m * 16; bf16_t* rowp = o + (size_t)row * D + col0; const float rs = ((const GAS float*)sa)[row];
#pragma unroll
                for (int bj = 0; bj < 2; ++bj) { const i32x4 a0 = acc[ai][bj][m][0], a1 = acc[ai][bj][m][1]; const f32x4 s0 = cs[bj][0] * rs, s1 = cs[bj][1] * rs;
                    u32x4 w; w.x = cvt_pk_bf16((float)a0[0] * s0[0], (float)a0[1] * s0[1]); w.y = cvt_pk_bf16((float)a0[2] * s0[2], (float)a0[3] * s0[3]);
                    w.z = cvt_pk_bf16((float)a1[0] * s1[0], (float)a1[1] * s1[1]); w.w = cvt_pk_bf16((float)a1[2] * s1[2], (float)a1[3] * s1[3]);
                    *(GAS u32x4*)((GAS bf16_t*)rowp + bj * HALF) = w; } }
    }
};
struct EpiResidI8 {
    static constexpr bool PERM = false, AFTER_DRAIN = false, I8 = true;
    const float* base; float* out; const float* sa; const float* sw;
    __device__ __forceinline__ void operator()(const i32x4 (&acc)[2][2][4][2], const Unit& u, int wr, int wc, int fr, int fq) const {
        const int row0 = u.pm * BM + wr * 64 + fr, col0 = u.pn * BM + wc * 32 + 4 * fq;
        const GAS float* bp = (const GAS float*)base; GAS float* op = (GAS float*)out;
#if H16
        GAS _Float16* oh = (GAS _Float16*)out;
#endif
        f32x4 cs[2][2];
#pragma unroll
        for (int bj = 0; bj < 2; ++bj)
#pragma unroll
            for (int n = 0; n < 2; ++n) cs[bj][n] = *(const GAS f32x4*)((const GAS float*)sw + col0 + bj * HALF + n * 16);
#pragma unroll
        for (int ai = 0; ai < 2; ++ai)
#pragma unroll
            for (int mp = 0; mp < 2; ++mp) { f32x4 t[2][2][2]; float rs[2];
#pragma unroll
                for (int mm = 0; mm < 2; ++mm) { const int row = row0 + ai * HALF + (2 * mp + mm) * 16; const size_t off = (size_t)row * D + col0; rs[mm] = ((const GAS float*)sa)[row];
#pragma unroll
                    for (int bj = 0; bj < 2; ++bj)
#pragma unroll
                        for (int n = 0; n < 2; ++n) {
#if H16
                            if (bp) t[mm][bj][n] = *(const GAS f32x4*)(bp + off + bj * HALF + n * 16); else t[mm][bj][n] = ldh4(oh + off + bj * HALF + n * 16);
#else
                            t[mm][bj][n] = *(const GAS f32x4*)(bp + off + bj * HALF + n * 16);
#endif
                        } }
#pragma unroll
                for (int mm = 0; mm < 2; ++mm) { const size_t off = (size_t)(row0 + ai * HALF + (2 * mp + mm) * 16) * D + col0;
#pragma unroll
                    for (int bj = 0; bj < 2; ++bj)
#pragma unroll
                        for (int n = 0; n < 2; ++n) { const i32x4 a = acc[ai][bj][2 * mp + mm][n]; const f32x4 sc = cs[bj][n] * rs[mm];
                            const f32x4 rv = t[mm][bj][n] + (f32x4){(float)a[0] * sc[0], (float)a[1] * sc[1], (float)a[2] * sc[2], (float)a[3] * sc[3]};
#if H16
                            sth4(oh + off + bj * HALF + n * 16, rv);
#else
                            *(GAS f32x4*)(op + off + bj * HALF + n * 16) = rv;
#endif
                        } } }
    }
};
struct EpiProjI8 {
    static constexpr bool PERM = true, AFTER_DRAIN = false, I8 = true;
    bf16_t* tm; bf16_t* vt; const float* sa; const float* swtm; const float* swvt;
    __device__ __forceinline__ void operator()(const i32x4 (&acc)[2][2][4][2], const Unit& u, int wr, int wc, int fr, int fq) const {
        if (u.pm < 64) {
            f32x4 cs[2][2];
#pragma unroll
            for (int bj = 0; bj < 2; ++bj) { const GAS float* p = (const GAS float*)swtm + (2 * u.pn + bj) * 128 + wc * 32 + 8 * fq; cs[bj][0] = *(const GAS f32x4*)p; cs[bj][1] = *(const GAS f32x4*)(p + 4); }
#pragma unroll
            for (int ai = 0; ai < 2; ++ai)
#pragma unroll
                for (int m = 0; m < 4; ++m) { const int r = u.pm * BM + ai * HALF + wr * 64 + m * 16 + fr, b = r >> 11, s = r & 2047; const float rs = ((const GAS float*)sa)[r];
#pragma unroll
                    for (int bj = 0; bj < 2; ++bj) { const int slot = 2 * u.pn + bj, d0 = wc * 32 + 8 * fq;
                        const i32x4 a0 = acc[ai][bj][m][0], a1 = acc[ai][bj][m][1]; const f32x4 s0 = cs[bj][0] * rs, s1 = cs[bj][1] * rs;
                        u32x4 w; w.x = cvt_pk_bf16((float)a0[0] * s0[0], (float)a0[1] * s0[1]); w.y = cvt_pk_bf16((float)a0[2] * s0[2], (float)a0[3] * s0[3]);
                        w.z = cvt_pk_bf16((float)a1[0] * s1[0], (float)a1[1] * s1[1]); w.w = cvt_pk_bf16((float)a1[2] * s1[2], (float)a1[3] * s1[3]);
                        *(GAS u32x4*)((GAS bf16_t*)tm + (((size_t)b * NTM + slot) * S + s) * 128 + d0) = w; } }
        } else {
            const int pmv = u.pm - 64, pnv = u.pn - 17;
            f32x4 cs[2][2];
#pragma unroll
            for (int bj = 0; bj < 2; ++bj) { const GAS float* p = (const GAS float*)sa + pnv * BM + bj * HALF + wc * 32 + 8 * fq; cs[bj][0] = *(const GAS f32x4*)p; cs[bj][1] = *(const GAS f32x4*)(p + 4); }
#pragma unroll
            for (int ai = 0; ai < 2; ++ai)
#pragma unroll
                for (int m = 0; m < 4; ++m) { const int vslot = 2 * pmv + ai, d = wr * 64 + m * 16 + fr; const float rs = ((const GAS float*)swvt)[vslot * 128 + d];
#pragma unroll
                    for (int bj = 0; bj < 2; ++bj) { const int c0 = pnv * BM + bj * HALF + wc * 32 + 8 * fq, b = c0 >> 11, s = c0 & 2047;
                        const i32x4 a0 = acc[ai][bj][m][0], a1 = acc[ai][bj][m][1]; const f32x4 s0 = cs[bj][0] * rs, s1 = cs[bj][1] * rs;
                        u32x4 w; w.x = cvt_pk_bf16((float)a0[0] * s0[0], (float)a0[1] * s0[1]); w.y = cvt_pk_bf16((float)a0[2] * s0[2], (float)a0[3] * s0[3]);
                        w.z = cvt_pk_bf16((float)a1[0] * s1[0], (float)a1[1] * s1[1]); w.w = cvt_pk_bf16((float)a1[2] * s1[2], (float)a1[3] * s1[3]);
                        *(GAS u32x4*)((GAS bf16_t*)vt + (((size_t)b * NVT + vslot) * 128 + d) * S + s) = w; } }
        }
    }
};
template <class Epi, class Sched>
__device__ __forceinline__ void gemm_phase(PG8_LAS unsigned char* lds, const Gemm g, const Sched& S, const Epi& E) {
    const int tid = TID(), wid = __builtin_amdgcn_readfirstlane(tid >> 6), lane = tid & 63, wr = wid >> 2, wc = wid & 3, fr = lane & 15, fq = lane >> 4;
    const int K = g.K, nt = K / BK;
    unsigned voffA[2], voffB[2];
#pragma unroll
    for (int i = 0; i < 2; ++i) { int R, C; stage_rc(tid * 16 + i * 8192, R, C); const int Rb = Epi::PERM ? ((R & ~31) + perm32(R & 31)) : R;
        voffA[i] = (unsigned)(R * K + C) * 2u; voffB[i] = (unsigned)(Rb * K + C) * 2u; }
    const size_t kstep = (size_t)(BK * 2);
    const size_t hstep = (size_t)HALF * K * 2;
    const size_t tstep = 2 * hstep;
    const unsigned ldsw = (unsigned)wid * 1024u;
    const int aoff = lds_byte(wr * 64 + fr, fq * 8), boff = lds_byte(wc * 32 + fr, fq * 8);
#define PG8_SA(b, h) (((b) * 2 + (h)) * HTB)
#define PG8_SB(b, h) ((4 + (b) * 2 + (h)) * HTB)
#define PG8_STAGE(bufoff, gbase, voff) do { _Pragma("unroll") for (int _i = 0; _i < 2; ++_i) \
        __builtin_amdgcn_global_load_lds((const unsigned*)((const char*)(gbase) + (voff)[_i]), (PG8_LAS unsigned*)(lds + (bufoff) + ldsw + _i * 8192), 16, 0, 0); } while (0)
#define PG8_LDA(dst, b, h) do { _Pragma("unroll") for (int m = 0; m < 4; ++m) _Pragma("unroll") for (int k = 0; k < 2; ++k) dst[m][k] = *(const PG8_LAS bf16x8*)(lds + PG8_SA(b, h) + aoff + m * 2048 + k * 1024); } while (0)
#define PG8_LDB(dst, b, h) do { _Pragma("unroll") for (int n = 0; n < 2; ++n) _Pragma("unroll") for (int k = 0; k < 2; ++k) dst[n][k] = *(const PG8_LAS bf16x8*)(lds + PG8_SB(b, h) + boff + n * 2048 + k * 1024); } while (0)
#define PG8_MMA(ai, bj, At, Bt) do { __builtin_amdgcn_s_setprio(1); _Pragma("unroll") for (int m = 0; m < 4; ++m) _Pragma("unroll") for (int n = 0; n < 2; ++n) _Pragma("unroll") for (int k = 0; k < 2; ++k) \
        mma16(acc[ai][bj][m][n], Bt[n][k], At[m][k]); __builtin_amdgcn_s_setprio(0); } while (0)
#define PG8_WAIT_V(n) asm volatile("s_waitcnt vmcnt(" #n ")" ::: "memory")
#define PG8_WAIT_L(n) asm volatile("s_waitcnt lgkmcnt(" #n ")" ::: "memory")
#define PG8_BAR __builtin_amdgcn_s_barrier()
#define PG8_SCHED __builtin_amdgcn_sched_barrier(0)
    Unit cur, nxt; int ui = 0;
    if (!S.next(0, cur)) return;
    typedef typename AccSel<Epi::I8>::type acc_t;
    acc_t acc[2][2][4][2];
#pragma unroll
    for (int a = 0; a < 2; ++a)
#pragma unroll
        for (int b = 0; b < 2; ++b)
#pragma unroll
            for (int m = 0; m < 4; ++m)
#pragma unroll
                for (int n = 0; n < 2; ++n) acc[a][b][m][n] = acc_t{};
    bf16x8 At[4][2], B0[2][2], B1[2][2];
    const char* cA = g.a_ptr(cur.pm, tstep); const char* cB = g.b_ptr(cur.pn, tstep);
    S.a_ready(cur);
    PG8_STAGE(PG8_SB(0, 0), cB, voffB); PG8_STAGE(PG8_SA(0, 0), cA, voffA); PG8_STAGE(PG8_SB(0, 1), cB + hstep, voffB); PG8_STAGE(PG8_SA(0, 1), cA + hstep, voffA);
    if (wr == 1) PG8_BAR;
    PG8_WAIT_V(4); PG8_BAR;
    PG8_STAGE(PG8_SB(1, 0), cB + kstep, voffB); PG8_STAGE(PG8_SA(1, 0), cA + kstep, voffA); PG8_STAGE(PG8_SB(1, 1), cB + hstep + kstep, voffB);
    PG8_WAIT_V(6); PG8_BAR;
    for (;;) {
        const bool has_next = S.next(ui + 1, nxt);
        const char* nA = has_next ? g.a_ptr(nxt.pm, tstep) : cA; const char* nB = has_next ? g.b_ptr(nxt.pn, tstep) : cB;
        for (int t = 0; t < nt; t += 2) {
            const bool last = (t == nt - 2);
            const char* a1 = cA + (size_t)(t + 1) * kstep;
            const char* a2 = last ? nA : cA + (size_t)(t + 2) * kstep; const char* b2 = last ? nB : cB + (size_t)(t + 2) * kstep;
            const char* a3 = a2 + kstep; const char* b3 = b2 + kstep;
            if (last && has_next) S.a_ready(nxt);
            PG8_LDB(B0, 0, 0); PG8_SCHED; PG8_LDA(At, 0, 0); PG8_STAGE(PG8_SA(1, 1), a1 + hstep, voffA);
            PG8_WAIT_L(8); PG8_BAR; PG8_WAIT_L(0); PG8_MMA(0, 0, At, B0); PG8_BAR; PG8_SCHED;
            PG8_LDB(B1, 0, 1); PG8_STAGE(PG8_SB(0, 0), b2, voffB);
            PG8_BAR; PG8_WAIT_L(0); PG8_MMA(0, 1, At, B1); PG8_BAR;
            PG8_LDA(At, 0, 1); PG8_STAGE(PG8_SA(0, 0), a2, voffA);
            PG8_BAR; PG8_WAIT_L(0); PG8_MMA(1, 0, At, B0); PG8_BAR; PG8_SCHED;
            PG8_STAGE(PG8_SB(0, 1), b2 + hstep, voffB);
            PG8_WAIT_V(6); PG8_BAR; PG8_MMA(1, 1, At, B1); PG8_BAR;
            PG8_LDB(B0, 1, 0); PG8_SCHED; PG8_LDA(At, 1, 0); PG8_STAGE(PG8_SA(0, 1), a2 + hstep, voffA);
            PG8_WAIT_L(8); PG8_BAR; PG8_WAIT_L(0); PG8_MMA(0, 0, At, B0); PG8_BAR; PG8_SCHED;
            PG8_LDB(B1, 1, 1); PG8_STAGE(PG8_SB(1, 0), b3, voffB);
            PG8_BAR; PG8_WAIT_L(0); PG8_MMA(0, 1, At, B1); PG8_BAR;
            PG8_LDA(At, 1, 1); PG8_STAGE(PG8_SA(1, 0), a3, voffA);
            PG8_BAR; PG8_WAIT_L(0); PG8_MMA(1, 0, At, B0); PG8_BAR; PG8_SCHED;
            PG8_STAGE(PG8_SB(1, 1), b3 + hstep, voffB);
            PG8_WAIT_V(6); PG8_BAR; PG8_MMA(1, 1, At, B1); PG8_BAR;
        }
        if constexpr (!Epi::AFTER_DRAIN) { E(acc, cur, wr, wc, fr, fq); S.done(cur); }
        if (!has_next) break;
#pragma unroll
        for (int a = 0; a < 2; ++a)
#pragma unroll
            for (int b = 0; b < 2; ++b)
#pragma unroll
                for (int m = 0; m < 4; ++m)
#pragma unroll
                    for (int n = 0; n < 2; ++n) acc[a][b][m][n] = acc_t{};
        cur = nxt; cA = nA; cB = nB; ++ui;
    }
    PG8_WAIT_V(0);
    if (wr == 0) PG8_BAR;
    PG8_BAR;
    if constexpr (Epi::AFTER_DRAIN) { E.fused(acc, cur, wr, wc, fr, fq, lds, wid, lane); S.done(cur); }
#undef PG8_SA
#undef PG8_SB
#undef PG8_STAGE
#undef PG8_LDA
#undef PG8_LDB
#undef PG8_MMA
#undef PG8_WAIT_V
#undef PG8_WAIT_L
#undef PG8_BAR
#undef PG8_SCHED
}
}

__device__ __forceinline__ void phase_prep_naive(const Params& P, int l, int bid, int nb) {
    const int tid_ = TID(); const int half = tid_ >> 8, tid = tid_ & 255;
    for (int vb = bid * 2 + half; vb < NB * 2 * 128; vb += nb * 2) {
        const int n = vb & 127, g = (vb >> 7) & 1, b = vb >> 8;
        const int which = tid >> 7, e = tid & 127;
        const bf16* tm = (const bf16*)(P.ws + WS_TM);
        const bf16* src = tm + (((size_t)b * NTM + (which ? TM_B_VC : TM_B_KC) + g) * S) * 128;
        const float* w = (which ? P.in[I_CMPWV] : P.in[I_CMPWK]) + (size_t)l * 32 * 128 * 128; const float* pos = P.in[I_CMPPOS] + (size_t)l * 32 * 128;
        float acc = 0.f;
        if (n < 127) for (int ll = 0; ll < 32; ++ll) for (int d = 0; d < 128; ++d) acc += (bf2f(src[(size_t)(16 * n + ll) * 128 + d]) + pos[ll * 128 + d]) * w[((size_t)ll * 128 + d) * 128 + e];
        if (which == 0) ((bf16*)(P.ws + WS_KCMP))[(((size_t)b * 2 + g) * 128 + n) * 128 + e] = (bf16)f2bf(acc);
        else ((bf16*)(P.ws + WS_VCMPT))[(((size_t)b * 2 + g) * 128 + e) * 128 + n] = (bf16)f2bf(acc);
    }
    for (int w = bid * 512 + tid_; w < NB * 8 * 4 * 128; w += nb * 512) {
        const int d = w & 127, id = w >> 7, h = id & 3, blk = (id >> 2) & 7, b = id >> 5;
        const bf16* k = (const bf16*)(P.ws + WS_TM) + (((size_t)b * NTM + TM_C_K + h) * S + blk * 256) * 128;
        float s = 0.f; for (int j = 0; j < 256; ++j) s += bf2f(k[(size_t)j * 128 + d]);
        ((float*)(P.ws + WS_KMEAN))[(((size_t)b * 8 + blk) * 4 + h) * 128 + d] = s * (1.0f / 256.f);
    }
}

struct KeyRef { const bf16* krow; int vkey; int dist; bool valid; };
template <class F>
__device__ __forceinline__ void naive_attend(const LAS float* qs, LAS float* sc, int n, F f, const float* biascol, const bf16* Vt, int vstride, int lane, float& o0, float& o1, float& lse, float& zinv) {
    float mx = NEG_INF;
    for (int idx = lane; idx < n; idx += 64) {
        const KeyRef kr = f(idx); float s = NEG_INF;
        if (kr.valid) { float dot = 0.f;
#pragma unroll 4
            for (int c = 0; c < 16; ++c) { const v4u w = *(const v4u*)(kr.krow + c * 8); const f32x4 qa = *(const LAS f32x4*)(qs + c * 8), qb = *(const LAS f32x4*)(qs + c * 8 + 4);
                dot += bf2f(w.x & 0xffff) * qa.x + bf2f(w.x >> 16) * qa.y + bf2f(w.y & 0xffff) * qa.z + bf2f(w.y >> 16) * qa.w + bf2f(w.z & 0xffff) * qb.x + bf2f(w.z >> 16) * qb.y + bf2f(w.w & 0xffff) * qb.z + bf2f(w.w >> 16) * qb.w; }
            s = dot * QK_SCALE + biascol[rel_bucket(kr.dist) * 16]; }
        sc[idx] = s; mx = fmaxf(mx, s);
    }
    mx = wave_max(mx); const float m = (mx > NEG_INF) ? mx : 0.f;
    WAVE_LDS_SYNC();
    float z = 0.f;
    for (int idx = lane; idx < n; idx += 64) { const float e = __expf(sc[idx] - m); sc[idx] = e; z += e; }
    z = wave_sum(z); const float zs = z > 0.f ? z : 1.f;
    WAVE_LDS_SYNC();
    float a0 = 0.f, a1 = 0.f;
    for (int idx = 0; idx < n; ++idx) { const float p = sc[idx]; if (p != 0.f) { const KeyRef kr = f(idx); a0 += p * bf2f(Vt[(size_t)(2 * lane) * vstride + kr.vkey]); a1 += p * bf2f(Vt[(size_t)(2 * lane + 1) * vstride + kr.vkey]); } }
    zinv = 1.0f / zs; o0 = a0 * zinv; o1 = a1 * zinv; lse = z > 0.f ? m + __logf(zs) : NEG_INF;
}
__device__ __forceinline__ void load_q_lds(const bf16* qrow, LAS float* qs, int lane) { qs[2 * lane] = bf2f(qrow[2 * lane]); qs[2 * lane + 1] = bf2f(qrow[2 * lane + 1]); WAVE_LDS_SYNC(); }

__device__ __forceinline__ void attnA_item(const Params& P, int id, int lane, LAS float* qs, LAS float* sc) {
    const int i = id & 2047, h = (id >> 11) % 6, b = id / (6 * S);
    const bf16* tm = (const bf16*)(P.ws + WS_TM); const bf16* vt = (const bf16*)(P.ws + WS_VT);
    const bf16* Q = tm + (((size_t)b * NTM + TM_A_Q + h) * S) * 128; const bf16* K = tm + (((size_t)b * NTM + TM_A_K + h) * S) * 128; const bf16* V = vt + (((size_t)b * NVT + VT_A_V + h) * 128) * S;
    load_q_lds(Q + (size_t)i * 128, qs, lane);
    const float* biascol = P.in[I_RELBIAS] + h;
    float o0[3], o1[3], lse[3], zi;
#pragma unroll
    for (int p = 0; p < 3; ++p) { const int dil = p == 0 ? 1 : p == 1 ? 4 : 16; const int nk = min(128, i / dil) + 1;
        naive_attend(qs, sc, nk, [&](int idx) { KeyRef r; const int j = i - idx * dil; r.krow = K + (size_t)j * 128; r.vkey = j; r.dist = idx * dil; r.valid = true; return r; }, biascol, V, S, lane, o0[p], o1[p], lse[p], zi);
        WAVE_LDS_SYNC(); }
    const float m = fmaxf(lse[0], fmaxf(lse[1], lse[2])); const float w0 = __expf(lse[0] - m), w1 = __expf(lse[1] - m), w2 = __expf(lse[2] - m), wi = 1.0f / (w0 + w1 + w2);
    const float r0 = (w0 * o0[0] + w1 * o0[1] + w2 * o0[2]) * wi, r1 = (w0 * o1[0] + w1 * o1[1] + w2 * o1[2]) * wi;
    const size_t t = (size_t)b * S + i; bf16* o = (bf16*)(P.ws + WS_ACT1);
    *(unsigned*)(o + t * D + h * 128 + 2 * lane) = pk2(r0, r1);
    const float ssq = wave_sum(r0 * r0 + r1 * r1); if (lane == 0) ((float*)(P.ws + WS_SS))[t * 16 + h] = ssq;
}
__device__ __forceinline__ void attnB1_item(const Params& P, int id, int lane, LAS float* qs, LAS float* sc, LAS float* imp) {
    const int i = id & 2047, g = (id >> 11) & 1, b = id >> 12;
    const bf16* tm = (const bf16*)(P.ws + WS_TM);
    const bf16* Kc = (const bf16*)(P.ws + WS_KCMP) + ((size_t)b * 2 + g) * 128 * 128; const bf16* Vc = (const bf16*)(P.ws + WS_VCMPT) + ((size_t)b * 2 + g) * 128 * 128;
    const size_t t = (size_t)b * S + i; const float* gates = (const float*)(P.ws + WS_GATES) + t * 18; float* ocmp = (float*)(P.ws + WS_OCMP) + t * 768;
    const int ncv = i >= 31 ? (i - 31) / 16 + 1 : 0;
    if (lane < 32) imp[lane] = 0.f;
    WAVE_LDS_SYNC();
    for (int r = 0; r < 3; ++r) { const int h = g * 3 + r;
        load_q_lds(tm + (((size_t)b * NTM + TM_B_Q + h) * S + i) * 128, qs, lane);
        float o0, o1, lse, zi;
        naive_attend(qs, sc, ncv, [&](int n) { KeyRef kr; kr.krow = Kc + (size_t)n * 128; kr.vkey = n; kr.dist = i - (16 * n + 31); kr.valid = true; return kr; }, P.in[I_RELBIAS] + 6 + h, Vc, 128, lane, o0, o1, lse, zi);
        const float g0 = gates[h * 3 + 0];
        ocmp[h * 128 + 2 * lane] = g0 * o0; ocmp[h * 128 + 2 * lane + 1] = g0 * o1;
        WAVE_LDS_SYNC();
        if (lane < 32) { float a = 0.f; for (int n = 4 * lane - 1; n <= 4 * lane + 3; ++n) if (n >= 0 && n < ncv) a += sc[n] * zi; imp[lane] += a; }
        WAVE_LDS_SYNC(); }
    const int qblk = i >> 6; float val = NEG_INF;
    if (lane < 32) { val = imp[lane]; if (lane == 0 || lane == qblk || lane == qblk - 1) val = 1e4f; else if (lane > qblk) val = -1e4f; }
    int* sel = (int*)(P.ws + WS_SEL) + (t * 2 + g) * 8;
    for (int k = 0; k < 8; ++k) { const float m = wave_max(val); const int mi = wave_min_i(val == m ? lane : 1 << 30); if (lane == mi) val = NEG_INF; if (lane == 0) sel[k] = mi; }
    WAVE_LDS_SYNC();
}
__device__ __forceinline__ void attnB2_item(const Params& P, int id, int lane, LAS float* qs, LAS float* sc) {
    const int i = id & 2047, h = (id >> 11) % 6, b = id / (6 * S), g = h / 3;
    const bf16* tm = (const bf16*)(P.ws + WS_TM); const bf16* vt = (const bf16*)(P.ws + WS_VT);
    const bf16* Ks = tm + (((size_t)b * NTM + TM_B_KS + g) * S) * 128; const bf16* Kw = tm + (((size_t)b * NTM + TM_B_KW + g) * S) * 128;
    const bf16* Vs = vt + (((size_t)b * NVT + VT_B_VS + g) * 128) * S; const bf16* Vw = vt + (((size_t)b * NVT + VT_B_VW + g) * 128) * S;
    const size_t t = (size_t)b * S + i; const float* gates = (const float*)(P.ws + WS_GATES) + t * 18; const float* ocmp = (const float*)(P.ws + WS_OCMP) + t * 768;
    const int* sel = (const int*)(P.ws + WS_SEL) + (t * 2 + g) * 8;
    load_q_lds(tm + (((size_t)b * NTM + TM_B_Q + h) * S + i) * 128, qs, lane);
    const float* biascol = P.in[I_RELBIAS] + 6 + h;
    float s0, s1, w0, w1, lse, zi;
    naive_attend(qs, sc, 512, [&](int idx) { KeyRef kr; const int key = sel[idx >> 6] * 64 + (idx & 63); kr.krow = Ks + (size_t)key * 128; kr.vkey = key; kr.dist = i - key; kr.valid = key <= i; return kr; }, biascol, Vs, S, lane, s0, s1, lse, zi);
    WAVE_LDS_SYNC();
    naive_attend(qs, sc, min(511, i) + 1, [&](int idx) { KeyRef kr; const int j = i - idx; kr.krow = Kw + (size_t)j * 128; kr.vkey = j; kr.dist = idx; kr.valid = true; return kr; }, biascol, Vw, S, lane, w0, w1, lse, zi);
    WAVE_LDS_SYNC();
    const float g1 = gates[h * 3 + 1], g2 = gates[h * 3 + 2];
    const float r0 = ocmp[h * 128 + 2 * lane] + g1 * s0 + g2 * w0, r1 = ocmp[h * 128 + 2 * lane + 1] + g1 * s1 + g2 * w1;
    bf16* o = (bf16*)(P.ws + WS_ACT1);
    *(unsigned*)(o + t * D + (6 + h) * 128 + 2 * lane) = pk2(r0, r1);
    const float ssq = wave_sum(r0 * r0 + r1 * r1); if (lane == 0) ((float*)(P.ws + WS_SS))[t * 16 + 6 + h] = ssq;
}
__device__ __forceinline__ void attnC_item(const Params& P, int id, int lane, LAS float* qs, LAS float* sc) {
    const int i = id & 2047, h = (id >> 11) & 3, b = id >> 13;
    const bf16* tm = (const bf16*)(P.ws + WS_TM); const bf16* vt = (const bf16*)(P.ws + WS_VT);
    const bf16* K = tm + (((size_t)b * NTM + TM_C_K + h) * S) * 128; const bf16* V = vt + (((size_t)b * NVT + VT_C_V + h) * 128) * S;
    load_q_lds(tm + (((size_t)b * NTM + TM_C_Q + h) * S + i) * 128, qs, lane);
    const float* biascol = P.in[I_RELBIAS] + 12 + h;
    const int qblk = i >> 8, blk0 = qblk << 8;
    float a0, a1, lseo, zi;
    naive_attend(qs, sc, i - blk0 + 1, [&](int idx) { KeyRef kr; const int j = blk0 + idx; kr.krow = K + (size_t)j * 128; kr.vkey = j; kr.dist = i - j; kr.valid = true; return kr; }, biascol, V, S, lane, a0, a1, lseo, zi);
    WAVE_LDS_SYNC();
    const float* km = (const float*)(P.ws + WS_KMEAN) + (size_t)b * 8 * 4 * 128;
    float gv = NEG_INF;
    { float part[8];
#pragma unroll
      for (int n = 0; n < 8; ++n) part[n] = wave_sum(qs[2 * lane] * km[((size_t)n * 4 + h) * 128 + 2 * lane] + qs[2 * lane + 1] * km[((size_t)n * 4 + h) * 128 + 2 * lane + 1]);
#pragma unroll
      for (int n = 0; n < 8; ++n) if (lane == n && n < qblk) gv = part[n]; }
    int sb0, sb1, sb2;
    { float m = wave_max(gv); sb0 = wave_min_i((gv == m && lane < 8) ? lane : 1 << 30); if (lane == sb0) gv = __builtin_nanf("");
      m = wave_max(gv); sb1 = wave_min_i((gv == m && lane < 8) ? lane : 1 << 30); if (lane == sb1) gv = __builtin_nanf("");
      m = wave_max(gv); sb2 = wave_min_i((gv == m && lane < 8) ? lane : 1 << 30); }
    float b0, b1, lseg;
    naive_attend(qs, sc, 768, [&](int idx) { KeyRef kr; const int sb = idx < 256 ? sb0 : idx < 512 ? sb1 : sb2; const int key = sb * 256 + (idx & 255); kr.krow = K + (size_t)key * 128; kr.vkey = key; kr.dist = i - key; kr.valid = sb < qblk; return kr; }, biascol, V, S, lane, b0, b1, lseg, zi);
    WAVE_LDS_SYNC();
    float r0, r1;
    if (lseg == NEG_INF) { r0 = a0; r1 = a1; }
    else { const float m = fmaxf(lseo, lseg), wo = __expf(lseo - m), wg = __expf(lseg - m), wi = 1.0f / (wo + wg); r0 = (wo * a0 + wg * b0) * wi; r1 = (wo * a1 + wg * b1) * wi; }
    const size_t t = (size_t)b * S + i; bf16* o = (bf16*)(P.ws + WS_ACT1);
    *(unsigned*)(o + t * D + (12 + h) * 128 + 2 * lane) = pk2(r0, r1);
    const float ssq = wave_sum(r0 * r0 + r1 * r1); if (lane == 0) ((float*)(P.ws + WS_SS))[t * 16 + 12 + h] = ssq;
}
constexpr int NA_WAVE_F = 128 + 2048 + 32;
__device__ __forceinline__ void phase_attn_naive1(const Params& P, int bid, int nb, LAS unsigned char* lds) {
    const int tid_ = TID(); const int lane = tid_ & 63, wave = tid_ >> 6, gw = bid * 8 + wave, ngw = nb * 8;
    LAS float* qs = (LAS float*)lds + wave * NA_WAVE_F; LAS float* sc = qs + 128; LAS float* imp = sc + 2048;
    for (int id = gw; id < NB * 6 * S; id += ngw) attnA_item(P, id, lane, qs, sc);
    for (int id = gw; id < NB * 2 * S; id += ngw) attnB1_item(P, id, lane, qs, sc, imp);
    for (int id = gw; id < NB * 4 * S; id += ngw) attnC_item(P, id, lane, qs, sc);
}
__device__ __forceinline__ void phase_attn_naive2(const Params& P, int bid, int nb, LAS unsigned char* lds) {
    const int tid_ = TID(); const int lane = tid_ & 63, wave = tid_ >> 6, gw = bid * 8 + wave, ngw = nb * 8;
    LAS float* qs = (LAS float*)lds + wave * NA_WAVE_F; LAS float* sc = qs + 128;
    for (int id = gw; id < NB * 6 * S; id += ngw) attnB2_item(P, id, lane, qs, sc);
}

template <int NV>
__device__ __forceinline__ void wave_top16(float (&v)[NV], int idx0, int istep, int lane, float& outv, int& outi) {
    outv = 0.f; outi = 0;
    for (int k = 0; k < 16; ++k) {
        float bv = v[0]; int bi = idx0;
#pragma unroll
        for (int e = 1; e < NV; ++e) if (v[e] > bv) { bv = v[e]; bi = idx0 + e * istep; }
        const float m = wave_max(bv); const int mi = wave_min_i(bv == m ? bi : 1 << 30);
#pragma unroll
        for (int e = 0; e < NV; ++e) if (idx0 + e * istep == mi) v[e] = NEG_INF;
        if (lane == k) { outv = m; outi = mi; }
    }
}
__device__ __forceinline__ void peer_select_item(const Params& P, int l, int id, int lane, LAS float* qs) {
    const int h = id & 7; const size_t t = id >> 3;
    const bf16* q = (const bf16*)(P.ws + WS_ACT1) + t * D + h * 256;
#pragma unroll
    for (int j = 0; j < 4; ++j) qs[lane * 4 + j] = bf2f(q[lane * 4 + j]);
    WAVE_LDS_SYNC();
    float tv[2]; int ti[2];
#pragma unroll
    for (int c = 0; c < 2; ++c) {
        const float* keys = P.in[I_PEERKEYS] + ((((size_t)l * 8 + h) * 2 + c) * 128) * 128;
        float sc[2] = {0.f, 0.f};
        const float* k0p = keys + (size_t)lane * 128; const float* k1p = k0p + 64 * 128;
#pragma unroll 4
        for (int d = 0; d < 128; d += 4) { const f32x4 qq = *(const LAS f32x4*)(qs + c * 128 + d); const f32x4 k0 = *(const f32x4*)(k0p + d), k1 = *(const f32x4*)(k1p + d);
            sc[0] += qq.x * k0.x + qq.y * k0.y + qq.z * k0.z + qq.w * k0.w; sc[1] += qq.x * k1.x + qq.y * k1.y + qq.z * k1.z + qq.w * k1.w; }
        wave_top16<2>(sc, lane, 64, lane, tv[c], ti[c]);
    }
    float cv[4];
    const float s0 = lane_get(tv[0], lane >> 2);
#pragma unroll
    for (int e = 0; e < 4; ++e) cv[e] = s0 + lane_get(tv[1], (lane & 3) * 4 + e);
    float bs; int bj; wave_top16<4>(cv, lane * 4, 1, lane, bs, bj);
    const int ei = lane_get_i(ti[0], bj >> 4) * 128 + lane_get_i(ti[1], bj & 15);
    const float m = lane_get(bs, 0); float e = lane < 16 ? __expf(bs - m) : 0.f; const float z = wave_sum(e);
    if (lane < 16) { ((int*)(P.ws + WS_EXP))[t * 128 + h * 16 + lane] = ei; ((float*)(P.ws + WS_GW))[t * 128 + h * 16 + lane] = e / z; }
    WAVE_LDS_SYNC();
}
__device__ __forceinline__ void phase_peer_select_naive(const Params& P, int l, int bid, int nb, LAS unsigned char* lds) {
    const int tid_ = TID(); const int lane = tid_ & 63, wave = tid_ >> 6, gw = bid * 8 + wave, ngw = nb * 8;
    LAS float* qs = (LAS float*)lds + wave * 256;
    for (int id = gw; id < T * 8; id += ngw) peer_select_item(P, l, id, lane, qs);
}
__device__ __forceinline__ void unpack8(const v4u w, float (&f)[8]) { f[0] = bf2f(w.x & 0xffff); f[1] = bf2f(w.x >> 16); f[2] = bf2f(w.y & 0xffff); f[3] = bf2f(w.y >> 16); f[4] = bf2f(w.z & 0xffff); f[5] = bf2f(w.z >> 16); f[6] = bf2f(w.w & 0xffff); f[7] = bf2f(w.w >> 16); }

namespace fa {
typedef short bf16x8 __attribute__((ext_vector_type(8)));
typedef float f32x16 __attribute__((ext_vector_type(16)));
typedef __bf16 bf2_t __attribute__((ext_vector_type(2)));
typedef float f2_t __attribute__((ext_vector_type(2)));
#define FA_MFMA(a, b, c) __builtin_amdgcn_mfma_f32_32x32x16_bf16((a), (b), (c), 0, 0, 0)
constexpr float C1 = 0.08838834764831845f * 1.4426950408889634f;
constexpr float LOG2E = 1.4426950408889634f;
constexpr float DEAD = -2e30f, MINIT = -1e30f;
constexpr int KP = 272, VP = 136;
constexpr int STG = 64 * KP + 128 * VP;
constexpr int L_STG0 = 0, L_STG1 = STG, L_T1 = 2 * STG, TBL = 2304 * 4, L_T2 = L_T1 + TBL, L_X = L_T2 + TBL;
constexpr int L_KC = 0, KCP = 272, L_VC = 128 * KCP, VCP = 264;
static_assert(L_VC + 128 * VCP <= L_T1 && L_X + 3 * TBL <= 131072 - 256, "attention LDS map");
constexpr int L_CTL = 131072 - 256;
__device__ __forceinline__ unsigned cvt2(float lo, float hi) { f2_t v = {lo, hi}; return __builtin_bit_cast(unsigned, __builtin_convertvector(v, bf2_t)); }
__device__ __forceinline__ float xhalf(float v, int h) { float lo, hi; halves(v, lo, hi); return h ? lo : hi; }
__device__ __forceinline__ int xhalf_i(int v, int h) { int lo, hi; halves_i(v, lo, hi); return h ? lo : hi; }

__device__ __forceinline__ void copy_table(LAS float* T, const Params& P, int kind, int gh, int tid) {
    const GAS f32x4* src = (const GAS f32x4*)((const GAS float*)(P.ws + WS_TBL) + (size_t)(gh * 3 + kind) * 2304);
    for (int i = tid; i < 576; i += 512) *(LAS f32x4*)(T + 4 * i) = src[i];
}
struct Stream { const bf16* K; const bf16* Vt; const LAS float* T; int jlo, jhi; unsigned ormask; int shift; unsigned rowmask; int maxd; };
struct State { f32x16 o[4]; float m, l; };
__device__ __forceinline__ void state_init(State& s) {
#pragma unroll
    for (int mt = 0; mt < 4; ++mt)
#pragma unroll
        for (int i = 0; i < 16; ++i) s.o[mt][i] = 0.f;
    s.m = MINIT; s.l = 0.f;
}
__device__ __forceinline__ int next_active(int j, int jhi, unsigned ormask, int shift) { while (j <= jhi && !((ormask >> (j >> shift)) & 1u)) ++j; return j <= jhi ? j : -1; }
__device__ __forceinline__ void run_stream(const Stream& st, const bf16x8 (&bq)[8], State& S, int qpos, LAS unsigned char* lds, int tid) {
    const int lane = tid & 63, r = lane & 31, h = lane >> 5;
    int j = next_active(st.jlo, st.jhi, st.ormask, st.shift);
    if (j < 0) return;
    const GAS unsigned char* Kg = (const GAS unsigned char*)st.K; const GAS unsigned char* Vg = (const GAS unsigned char*)st.Vt;
    const int kc0 = tid, kc1 = tid + 512;
    const unsigned k_lds0 = (kc0 >> 4) * KP + (kc0 & 15) * 16, k_lds1 = (kc1 >> 4) * KP + (kc1 & 15) * 16;
    const unsigned v_lds0 = 64 * KP + (kc0 >> 3) * VP + (kc0 & 7) * 16, v_lds1 = 64 * KP + (kc1 >> 3) * VP + (kc1 & 7) * 16;
    const size_t v_g0 = (size_t)(kc0 >> 3) * (::S * 2) + (kc0 & 7) * 16, v_g1 = (size_t)(kc1 >> 3) * (::S * 2) + (kc1 & 7) * 16;
    v4u ka0, ka1, va0, va1, kb0, kb1, vb0, vb1;
#define FA_PREFETCH(kr0, kr1, vr0, vr1, jj) do { const size_t kb_ = (size_t)(jj) * (64 * 256); kr0 = *(const GAS v4u*)(Kg + kb_ + (size_t)kc0 * 16); kr1 = *(const GAS v4u*)(Kg + kb_ + (size_t)kc1 * 16); \
        const size_t vb_ = (size_t)(jj) * 128; vr0 = *(const GAS v4u*)(Vg + vb_ + v_g0); vr1 = *(const GAS v4u*)(Vg + vb_ + v_g1); } while (0)
#define FA_WRITE(kr0, kr1, vr0, vr1, stg) do { LAS unsigned char* sw = lds + (stg); *(LAS v4u*)(sw + k_lds0) = kr0; *(LAS v4u*)(sw + k_lds1) = kr1; \
        *(LAS v2u*)(sw + v_lds0) = (v2u){vr0.x, vr0.y}; *(LAS v2u*)(sw + v_lds0 + 8) = (v2u){vr0.z, vr0.w}; *(LAS v2u*)(sw + v_lds1) = (v2u){vr1.x, vr1.y}; *(LAS v2u*)(sw + v_lds1 + 8) = (v2u){vr1.z, vr1.w}; } while (0)
    auto compute = [&](const int j, const LAS unsigned char* sb, const bool force_dead) __attribute__((always_inline)) {
#if FA_STAGGER
        if (tid >= 256) __builtin_amdgcn_s_sleep(FA_STAGGER);
#endif
        const bool bit = ((st.rowmask >> (j >> st.shift)) & 1u) && !force_dead;
        const int bidx = bit ? (qpos - 64 * j + 256 - 4 * h - 59) : (4 - 4 * h);
        const LAS float* tp = st.T + bidx;
        const int wq_hi = qpos - r + 31, wq_lo = qpos - r;
#pragma unroll
        for (int kt = 0; kt < 2; ++kt) {
            if (64 * j + 32 * kt > wq_hi || 64 * j + 32 * kt + 31 < wq_lo - st.maxd) continue;
            f32x16 sc;
#pragma unroll
            for (int i = 0; i < 16; ++i) sc[i] = 0.f;
            { bf16x8 af[8];
#pragma unroll
              for (int ks = 0; ks < 8; ++ks) af[ks] = *(const LAS bf16x8*)(sb + (32 * kt + r) * KP + (16 * ks + 8 * h) * 2);
              __builtin_amdgcn_s_setprio(1);
#pragma unroll
              for (int ks = 0; ks < 8; ++ks) sc = FA_MFMA(af[ks], bq[ks], sc);
              __builtin_amdgcn_s_setprio(0); }
            float mloc = S.m;
#pragma unroll
            for (int i = 0; i < 16; ++i) { const float s = __builtin_fmaf(sc[i], C1, tp[59 - 32 * kt - 8 * (i >> 2) - (i & 3)]); sc[i] = s; mloc = fmaxf(mloc, s); }
            float mlo_, mhi_; halves(mloc, mlo_, mhi_); const float mnew = fmaxf(mlo_, mhi_);
            const float alpha = __builtin_amdgcn_exp2f(S.m - mnew);
            float lsum = 0.f;
#pragma unroll
            for (int i = 0; i < 16; ++i) { const float p = __builtin_amdgcn_exp2f(sc[i] - mnew); sc[i] = p; lsum += p; }
            S.l = S.l * alpha + lsum; S.m = mnew;
            if (__builtin_amdgcn_ballot_w64(alpha != 1.0f) != 0ull) {
#pragma unroll
                for (int mt = 0; mt < 4; ++mt)
#pragma unroll
                    for (int i = 0; i < 16; ++i) S.o[mt][i] *= alpha;
            }
#pragma unroll
            for (int s2 = 0; s2 < 2; ++s2) { const int sp = 2 * kt + s2, s8 = s2 * 8;
                v4u pw; pw.x = cvt2(sc[s8 + 0], sc[s8 + 1]); pw.y = cvt2(sc[s8 + 2], sc[s8 + 3]); pw.z = cvt2(sc[s8 + 4], sc[s8 + 5]); pw.w = cvt2(sc[s8 + 6], sc[s8 + 7]);
                const bf16x8 pb = __builtin_bit_cast(bf16x8, pw);
                bf16x8 vf[4];
#pragma unroll
                for (int mt = 0; mt < 4; ++mt) { const LAS unsigned char* vp = sb + 64 * KP + (32 * mt + r) * VP + (16 * sp + 4 * h) * 2;
                    const v2u lo = *(const LAS v2u*)vp, hi = *(const LAS v2u*)(vp + 16);
                    vf[mt] = __builtin_bit_cast(bf16x8, (v4u){lo.x, lo.y, hi.x, hi.y}); }
                __builtin_amdgcn_s_setprio(1);
#pragma unroll
                for (int mt = 0; mt < 4; ++mt) S.o[mt] = FA_MFMA(vf[mt], pb, S.o[mt]);
                __builtin_amdgcn_s_setprio(0); }
        }
    };
    int jc = j, jn = next_active(jc + 1, st.jhi, st.ormask, st.shift);
    FA_PREFETCH(ka0, ka1, va0, va1, jc); FA_WRITE(ka0, ka1, va0, va1, L_STG0);
    FA_PREFETCH(ka0, ka1, va0, va1, jn >= 0 ? jn : jc);
    __syncthreads();
    for (;;) {
        const int j2 = jn >= 0 ? next_active(jn + 1, st.jhi, st.ormask, st.shift) : -1;
        FA_PREFETCH(kb0, kb1, vb0, vb1, j2 >= 0 ? j2 : jc);
        compute(jc, lds + L_STG0, false);
        asm volatile("s_waitcnt vmcnt(4)" ::: "memory");
        FA_WRITE(ka0, ka1, va0, va1, L_STG1);
        asm volatile("s_waitcnt lgkmcnt(0)\n\ts_barrier" ::: "memory");
        if (jn < 0) break;
        const int j3 = j2 >= 0 ? next_active(j2 + 1, st.jhi, st.ormask, st.shift) : -1;
        FA_PREFETCH(ka0, ka1, va0, va1, j3 >= 0 ? j3 : jn);
        compute(jn, lds + L_STG1, false);
        asm volatile("s_waitcnt vmcnt(4)" ::: "memory");
        FA_WRITE(kb0, kb1, vb0, vb1, L_STG0);
        asm volatile("s_waitcnt lgkmcnt(0)\n\ts_barrier" ::: "memory");
        if (j2 < 0) break;
        jc = j2; jn = j3;
    }
    asm volatile("s_waitcnt vmcnt(0)" ::: "memory");
    __syncthreads();
#undef FA_PREFETCH
#undef FA_WRITE
}
__device__ __forceinline__ void load_q(const bf16* Qrow, bf16x8 (&bq)[8], int h) {
#pragma unroll
    for (int ks = 0; ks < 8; ++ks) bq[ks] = __builtin_bit_cast(bf16x8, *(const GAS v4u*)((const GAS bf16*)Qrow + 16 * ks + 8 * h));
}
__device__ __forceinline__ float finish(State& S, float wgt) { float llo_, lhi_; halves(S.l, llo_, lhi_); const float lt = llo_ + lhi_; const float inv = wgt / lt;
#pragma unroll
    for (int mt = 0; mt < 4; ++mt)
#pragma unroll
        for (int i = 0; i < 16; ++i) S.o[mt][i] *= inv;
    return inv; }
__device__ __forceinline__ void store_out(const State& S, bf16* o, float* ss, size_t t, int gh, int h) {
    float q = 0.f; GAS bf16* op = (GAS bf16*)o + t * D + gh * 128 + 4 * h;
#pragma unroll
    for (int mt = 0; mt < 4; ++mt)
#pragma unroll
        for (int g = 0; g < 4; ++g) { const float a = S.o[mt][4 * g], b = S.o[mt][4 * g + 1], c = S.o[mt][4 * g + 2], d = S.o[mt][4 * g + 3];
            q += a * a + b * b + c * c + d * d; *(GAS v2u*)(op + 32 * mt + 8 * g) = (v2u){cvt2(a, b), cvt2(c, d)}; }
    { float qlo_, qhi_; halves(q, qlo_, qhi_); q = qlo_ + qhi_; } if (h == 0) ss[t * 16 + gh] = q;
}
__device__ __forceinline__ void decode_unit(int u, int& b, int& gh, int& qt) {
    int isb, w;
    if (u < 240) { isb = 1; qt = 7 - u / 48; w = u % 48; }
    else if (u < 320) { isb = 0; qt = 7; w = u - 240; }
    else if (u < 368) { isb = 1; qt = 2; w = u - 320; }
    else if (u < 528) { isb = 0; qt = 6 - (u - 368) / 80; w = (u - 368) % 80; }
    else if (u < 576) { isb = 1; qt = 1; w = u - 528; }
    else if (u < 736) { isb = 0; qt = 4 - (u - 576) / 80; w = (u - 576) % 80; }
    else if (u < 784) { isb = 1; qt = 0; w = u - 736; }
    else { isb = 0; qt = 2 - (u - 784) / 80; w = (u - 784) % 80; }
    b = w & 7; const int hh = w >> 3;
    if (isb) gh = 6 + hh; else gh = hh < 6 ? hh : 12 + (hh - 6);
}

__device__ __forceinline__ void attn_unit(const Params& P, int u, LAS unsigned char* lds) {
    const int tid = TID();
    const int lane = tid & 63, wave = tid >> 6, r = lane & 31, h = lane >> 5;
    int b, gh, qt; decode_unit(u, b, gh, qt);
    const int q0 = qt * 256, qpos = q0 + 32 * wave + r; const size_t t = (size_t)b * S + qpos;
    const bf16* tm = (const bf16*)(P.ws + WS_TM); const bf16* vt = (const bf16*)(P.ws + WS_VT);
    bf16* o = (bf16*)(P.ws + WS_ACT1); float* ss = (float*)(P.ws + WS_SS);
    volatile LAS unsigned* ctl = (volatile LAS unsigned*)(lds + L_CTL);
    LAS float* T1 = (LAS float*)(lds + L_T1); LAS float* T2 = (LAS float*)(lds + L_T2);
    bf16x8 bq[8]; State St;
    if (gh < 6) {
        copy_table(T1, P, 2, gh, tid);
        load_q(tm + (((size_t)b * NTM + TM_A_Q + gh) * S + qpos) * 128, bq, h);
        __syncthreads();
        state_init(St);
        Stream s{tm + ((size_t)b * NTM + TM_A_K + gh) * S * 128, vt + ((size_t)b * NVT + VT_A_V + gh) * 128 * S, T1, 0, 4 * qt + 3, 0xffffffffu, 0, 0xffffffffu, 4096};
        run_stream(s, bq, St, qpos, lds, tid);
        finish(St, 1.0f); store_out(St, o, ss, t, gh, h);
    } else if (gh >= 12) {
        const int hc = gh - 12;
        copy_table(T1, P, 0, gh, tid);
        LAS float* km = (LAS float*)(lds + L_X);
        { const float* kmg = (const float*)(P.ws + WS_KMEAN) + (size_t)b * 8 * 4 * 128;
          for (int i = tid; i < qt * 128; i += 512) km[i] = kmg[((size_t)(i >> 7) * 4 + hc) * 128 + (i & 127)]; }
        load_q(tm + (((size_t)b * NTM + TM_C_Q + hc) * S + qpos) * 128, bq, h);
        if (tid == 0) ctl[1] = 0u;
        __syncthreads();
        float gate[8];
#pragma unroll
        for (int n = 0; n < 8; ++n) gate[n] = 0.f;
#pragma unroll
        for (int ks = 0; ks < 8; ++ks) { const v4u w = __builtin_bit_cast(v4u, bq[ks]); float f[8]; unpack8(w, f);
#pragma unroll
            for (int n = 0; n < 8; ++n) if (n < qt) { const f32x4 k0 = *(const LAS f32x4*)(km + n * 128 + 16 * ks + 8 * h), k1 = *(const LAS f32x4*)(km + n * 128 + 16 * ks + 8 * h + 4);
                gate[n] += f[0] * k0.x + f[1] * k0.y + f[2] * k0.z + f[3] * k0.w + f[4] * k1.x + f[5] * k1.y + f[6] * k1.z + f[7] * k1.w; } }
        unsigned rowmask = 1u << qt;
#pragma unroll
        for (int n = 0; n < 8; ++n) { float glo_, ghi_; halves(gate[n], glo_, ghi_); gate[n] = glo_ + ghi_; if (n >= qt) gate[n] = NEG_INF; }
#pragma unroll
        for (int k = 0; k < 3; ++k) { float bv = NEG_INF; int bi = -1;
#pragma unroll
            for (int n = 0; n < 8; ++n) if (gate[n] > bv) { bv = gate[n]; bi = n; }
#pragma unroll
            for (int n = 0; n < 8; ++n) if (n == bi) { gate[n] = NEG_INF; rowmask |= 1u << n; } }
        { const unsigned om = wave_or(rowmask); if (lane == 0) atomicOr((unsigned*)(ctl + 1), om); }
        __syncthreads();
        const unsigned ormask = ctl[1];
        state_init(St);
        Stream s{tm + ((size_t)b * NTM + TM_C_K + hc) * S * 128, vt + ((size_t)b * NVT + VT_C_V + hc) * 128 * S, T1, 0, 4 * qt + 3, ormask, 2, rowmask, 4096};
        run_stream(s, bq, St, qpos, lds, tid);
        finish(St, 1.0f); store_out(St, o, ss, t, gh, h);
    } else {
        const int hb = gh - 6, g = hb / 3;
        const float* gates = (const float*)(P.ws + WS_GATES) + t * 18 + hb * 3; const float g0 = gates[0], g1 = gates[1], g2 = gates[2];
        GAS float* oacc = (GAS float*)(P.ws + WS_OCMP) + t * 768 + hb * 128 + 4 * h;
        { const GAS unsigned char* kcg = (const GAS unsigned char*)((const bf16*)(P.ws + WS_KCMP) + ((size_t)b * 2 + g) * 128 * 128); const GAS unsigned char* vcg = (const GAS unsigned char*)((const bf16*)(P.ws + WS_VCMPT) + ((size_t)b * 2 + g) * 128 * 128);
#pragma unroll
          for (int c = tid; c < 2048; c += 512) { const v4u kv = *(const GAS v4u*)(kcg + (size_t)c * 16); *(LAS v4u*)(lds + L_KC + (c >> 4) * KCP + (c & 15) * 16) = kv;
              const v4u vv = *(const GAS v4u*)(vcg + (size_t)c * 16); LAS unsigned char* vd = lds + L_VC + (c >> 4) * VCP + (c & 15) * 16; *(LAS v2u*)vd = (v2u){vv.x, vv.y}; *(LAS v2u*)(vd + 8) = (v2u){vv.z, vv.w}; } }
#pragma unroll
        for (int rr = 0; rr < 3; ++rr) copy_table((LAS float*)(lds + L_X + rr * TBL), P, 0, 6 + g * 3 + rr, tid);
        copy_table(T1, P, 0, gh, tid); copy_table(T2, P, 1, gh, tid);
        if (tid == 0) ctl[1] = 0u;
        __syncthreads();
        float imp[16];
#pragma unroll
        for (int a = 0; a < 16; ++a) imp[a] = 0.f;
        f32x16 sc[4];
#pragma unroll 1
        for (int rq = 0; rq < 3; ++rq) { int rr = hb - g * 3 + 1 + rq; rr = rr >= 3 ? rr - 3 : rr; const int hh = g * 3 + rr;
            asm volatile("" ::: "memory");
            load_q(tm + (((size_t)b * NTM + TM_B_Q + hh) * S + qpos) * 128, bq, h);
            const LAS float* Tc = (const LAS float*)(lds + L_X + rr * TBL);
#pragma unroll
            for (int kt = 0; kt < 4; ++kt) {
#pragma unroll
                for (int i = 0; i < 16; ++i) sc[kt][i] = 0.f;
#pragma unroll
                for (int ks = 0; ks < 8; ++ks) { const bf16x8 a = *(const LAS bf16x8*)(lds + L_KC + (32 * kt + r) * KCP + (16 * ks + 8 * h) * 2); sc[kt] = FA_MFMA(a, bq[ks], sc[kt]); } }
            float mloc = MINIT;
#pragma unroll
            for (int kt = 0; kt < 4; ++kt)
#pragma unroll
                for (int i = 0; i < 16; ++i) { const int n = 32 * kt + 8 * (i >> 2) + 4 * h + (i & 3); int idx = qpos - 16 * n - 31 + 256; idx = idx < 0 ? 0 : idx;
                    const float s = __builtin_fmaf(sc[kt][i], C1, Tc[idx]); sc[kt][i] = s; mloc = fmaxf(mloc, s); }
            float mlo_, mhi_; halves(mloc, mlo_, mhi_); const float mrow = fmaxf(mlo_, mhi_); float lsum = 0.f;
#pragma unroll
            for (int kt = 0; kt < 4; ++kt)
#pragma unroll
                for (int i = 0; i < 16; ++i) { const float p = __builtin_amdgcn_exp2f(sc[kt][i] - mrow); sc[kt][i] = p; lsum += p; }
            { float slo_, shi_; halves(lsum, slo_, shi_); lsum = slo_ + shi_; } const float inv = lsum > 0.f ? 1.0f / lsum : 0.f;
#pragma unroll
            for (int a = 0; a < 16; ++a) { const int kt = a >> 2, i0 = (a & 3) * 4;
                const float p0 = sc[kt][i0] * inv, p1 = sc[kt][i0 + 1] * inv, p2 = sc[kt][i0 + 2] * inv, p3 = sc[kt][i0 + 3] * inv;
                sc[kt][i0] = p0; sc[kt][i0 + 1] = p1; sc[kt][i0 + 2] = p2; sc[kt][i0 + 3] = p3;
                imp[a] += (p0 + p1) + (p2 + p3); }
            { float prev = 0.f;
#pragma unroll
              for (int a = 0; a < 16; ++a) { const float lv = xhalf(sc[a >> 2][(a & 3) * 4 + 3], h); imp[a] += h ? lv : prev; prev = lv; } }
        }
        state_init(St);
#pragma unroll
        for (int sp = 0; sp < 8; ++sp) { const int kt = sp >> 1, s8 = (sp & 1) * 8;
            v4u pw; pw.x = cvt2(sc[kt][s8 + 0], sc[kt][s8 + 1]); pw.y = cvt2(sc[kt][s8 + 2], sc[kt][s8 + 3]); pw.z = cvt2(sc[kt][s8 + 4], sc[kt][s8 + 5]); pw.w = cvt2(sc[kt][s8 + 6], sc[kt][s8 + 7]);
            const bf16x8 pb = __builtin_bit_cast(bf16x8, pw);
#pragma unroll
            for (int mt = 0; mt < 4; ++mt) { const LAS unsigned char* vp = lds + L_VC + (32 * mt + r) * VCP + (16 * sp + 4 * h) * 2;
                const v2u lo = *(const LAS v2u*)vp, hi = *(const LAS v2u*)(vp + 16);
                St.o[mt] = FA_MFMA(__builtin_bit_cast(bf16x8, (v4u){lo.x, lo.y, hi.x, hi.y}), pb, St.o[mt]); } }
#pragma unroll
        for (int mt = 0; mt < 4; ++mt)
#pragma unroll
            for (int gq = 0; gq < 4; ++gq) *(GAS f32x4*)(oacc + 32 * mt + 8 * gq) = (f32x4){St.o[mt][4 * gq] * g0, St.o[mt][4 * gq + 1] * g0, St.o[mt][4 * gq + 2] * g0, St.o[mt][4 * gq + 3] * g0};
        const int qblk = qpos >> 6;
        unsigned selmask;
        if (qblk <= 7) selmask = (2u << qblk) - 1u;
        else { selmask = 1u | (3u << (qblk - 1));
#pragma unroll
            for (int a = 0; a < 16; ++a) { const int jb = 2 * a + h; if (jb == 0 || jb >= qblk - 1) imp[a] = NEG_INF; }
#pragma unroll 1
            for (int k = 0; k < 5; ++k) { float bv = NEG_INF; int bj = 1 << 20;
#pragma unroll
                for (int a = 0; a < 16; ++a) if (imp[a] > bv) { bv = imp[a]; bj = 2 * a + h; }
                const float ov = xhalf(bv, h); const int oj = xhalf_i(bj, h);
                const bool mine = (bv > ov) || (bv == ov && bj < oj);
                const int wj = mine ? bj : oj;
                if (wj < 32) { selmask |= 1u << wj;
#pragma unroll
                    for (int a = 0; a < 16; ++a) if (2 * a + h == wj) imp[a] = NEG_INF; } } }
        { const unsigned om = wave_or(selmask); if (lane == 0) atomicOr((unsigned*)(ctl + 1), om); }
        load_q(tm + (((size_t)b * NTM + TM_B_Q + hb) * S + qpos) * 128, bq, h);
        __syncthreads();
        const unsigned ormask = ctl[1];
        state_init(St);
        { Stream s{tm + ((size_t)b * NTM + TM_B_KS + g) * S * 128, vt + ((size_t)b * NVT + VT_B_VS + g) * 128 * S, T1, 0, 4 * qt + 3, ormask, 0, selmask, 4096};
          run_stream(s, bq, St, qpos, lds, tid); }
        finish(St, g1);
#pragma unroll
        for (int mt = 0; mt < 4; ++mt)
#pragma unroll
            for (int gq = 0; gq < 4; ++gq) { const f32x4 pv = *(const GAS f32x4*)(oacc + 32 * mt + 8 * gq);
                *(GAS f32x4*)(oacc + 32 * mt + 8 * gq) = (f32x4){pv.x + St.o[mt][4 * gq], pv.y + St.o[mt][4 * gq + 1], pv.z + St.o[mt][4 * gq + 2], pv.w + St.o[mt][4 * gq + 3]}; }
        state_init(St);
        { const int jlo = q0 >= 512 ? (q0 - 512) / 64 : 0;
          Stream s{tm + ((size_t)b * NTM + TM_B_KW + g) * S * 128, vt + ((size_t)b * NVT + VT_B_VW + g) * 128 * S, T2, jlo, 4 * qt + 3, 0xffffffffu, 0, 0xffffffffu, 511};
          run_stream(s, bq, St, qpos, lds, tid); }
        finish(St, g2);
#pragma unroll
        for (int mt = 0; mt < 4; ++mt)
#pragma unroll
            for (int gq = 0; gq < 4; ++gq) { const f32x4 pv = *(const GAS f32x4*)(oacc + 32 * mt + 8 * gq);
                St.o[mt][4 * gq] += pv.x; St.o[mt][4 * gq + 1] += pv.y; St.o[mt][4 * gq + 2] += pv.z; St.o[mt][4 * gq + 3] += pv.w; }
        store_out(St, o, ss, t, gh, h);
    }
}
__device__ __forceinline__ void phase_attn(const Params& P, int l, LAS unsigned char* lds) {
    const int tid = TID();
    volatile LAS unsigned* ctl = (volatile LAS unsigned*)(lds + L_CTL);
    unsigned* qctr = (unsigned*)(P.ws + WS_CTL) + 8192 + 64 * l;
    for (;;) {
        __syncthreads();
        if (tid == 0) ctl[0] = __hip_atomic_fetch_add(qctr, 1u, __ATOMIC_RELAXED, __HIP_MEMORY_SCOPE_AGENT);
        __syncthreads();
        const unsigned u = ctl[0];
        if (u >= 1024u) break;
        attn_unit(P, (int)u, lds);
    }
}
#undef FA_MFMA
}

namespace pf {
typedef short bf16x8 __attribute__((ext_vector_type(8)));
typedef float f32x16 __attribute__((ext_vector_type(16)));
__device__ __forceinline__ void cmp_unit(const Params& P, int l, int u, LAS unsigned char* lds) {
    const int tid = TID(), lane = tid & 63, wave = tid >> 6, r = lane & 31, h = lane >> 5;
    const int which = u >> 7, bg = (u >> 3) & 15, b = bg >> 1, g = bg & 1, n0 = ((u >> 1) & 3) * 32, e0 = (u & 1) * 64;
    const GAS bf16* A = (const GAS bf16*)(P.ws + WS_TM) + (((size_t)b * NTM + (which ? TM_B_VC : TM_B_KC) + g) * S + 16 * (n0 + r)) * 128 + 512 * wave + 8 * h;
    const GAS bf16* Bt = (const GAS bf16*)(P.ws + WS_CWT) + (((size_t)l * 2 + which) * 128 + e0 + r) * 4096 + 512 * wave + 8 * h;
    float pw = 0.f;
    if (tid < 64) { const GAS float* pp = (const GAS float*)(P.ws + WS_POSW) + ((size_t)l * 2 + which) * 32 * 128 + e0 + tid;
#pragma unroll
        for (int kc = 0; kc < 32; ++kc) pw += pp[kc * 128]; }
    f32x16 acc[2];
#pragma unroll
    for (int ct = 0; ct < 2; ++ct)
#pragma unroll
        for (int i = 0; i < 16; ++i) acc[ct][i] = 0.f;
#pragma unroll 8
    for (int ks = 0; ks < 32; ++ks) {
        const bf16x8 a = __builtin_bit_cast(bf16x8, *(const GAS v4u*)(A + 16 * ks));
#pragma unroll
        for (int ct = 0; ct < 2; ++ct) { const bf16x8 bb = __builtin_bit_cast(bf16x8, *(const GAS v4u*)(Bt + (size_t)ct * 32 * 4096 + 16 * ks)); acc[ct] = __builtin_amdgcn_mfma_f32_32x32x16_bf16(a, bb, acc[ct], 0, 0, 0); }
    }
    LAS float* red = (LAS float*)lds; LAS float* pwl = red + 8 * 2048;
#pragma unroll
    for (int ct = 0; ct < 2; ++ct)
#pragma unroll
        for (int i = 0; i < 16; ++i) red[((wave * 2 + ct) * 16 + i) * 64 + lane] = acc[ct][i];
    if (tid < 64) pwl[tid] = pw;
    __syncthreads();
#pragma unroll
    for (int j = 0; j < 4; ++j) { const int o = tid + 512 * j; float v = 0.f;
#pragma unroll
        for (int w = 0; w < 8; ++w) v += red[w * 2048 + o];
        const int ln = o & 63, i = (o >> 6) & 15, ct = o >> 10; const int n = n0 + (i & 3) + 8 * (i >> 2) + 4 * (ln >> 5), e = e0 + 32 * ct + (ln & 31);
        v += pwl[32 * ct + (ln & 31)];
        if (n == 127) v = 0.f;
        if (which == 0) ((GAS bf16*)(P.ws + WS_KCMP))[(((size_t)b * 2 + g) * 128 + n) * 128 + e] = (bf16)f2bf(v);
        else ((GAS bf16*)(P.ws + WS_VCMPT))[(((size_t)b * 2 + g) * 128 + e) * 128 + n] = (bf16)f2bf(v); }
    __syncthreads();
}
__device__ __forceinline__ void kmean_unit(const Params& P, int u, LAS unsigned char* lds) {
    const int tid = TID(), dp = tid & 63, part = tid >> 6; const int hc = u & 3, blk = (u >> 2) & 7, b = u >> 5;
    const GAS bf16* k = (const GAS bf16*)(P.ws + WS_TM) + (((size_t)b * NTM + TM_C_K + hc) * S + blk * 256 + part * 32) * 128 + 2 * dp;
    float s0 = 0.f, s1 = 0.f;
#pragma unroll 8
    for (int j = 0; j < 32; ++j) { const unsigned w = *(const GAS unsigned*)(k + (size_t)j * 128); s0 += bf2f(w & 0xffff); s1 += bf2f(w >> 16); }
    LAS float* red = (LAS float*)lds; red[part * 128 + 2 * dp] = s0; red[part * 128 + 2 * dp + 1] = s1;
    __syncthreads();
    if (tid < 128) { float v = 0.f;
#pragma unroll
        for (int p = 0; p < 8; ++p) v += red[p * 128 + tid];
        ((GAS float*)(P.ws + WS_KMEAN))[(((size_t)b * 8 + blk) * 4 + hc) * 128 + tid] = v * (1.0f / 256.f); }
    __syncthreads();
}
__device__ __forceinline__ void phase_prep(const Params& P, int l, int bid, int nb, LAS unsigned char* lds) {
    for (int u = bid; u < 512; u += nb) { if (u < 256) cmp_unit(P, l, u, lds); else kmean_unit(P, u - 256, lds); }
}
}

typedef __bf16 bf2_t __attribute__((ext_vector_type(2)));
__device__ __forceinline__ float dot2bf(unsigned a, unsigned b, float c) { return __builtin_amdgcn_fdot2_f32_bf16(__builtin_bit_cast(bf2_t, a), __builtin_bit_cast(bf2_t, b), c, false); }

namespace ps {
typedef short bf16x8 __attribute__((ext_vector_type(8)));
typedef float f32x16 __attribute__((ext_vector_type(16)));
#define PS_CE(a, b) do { const float hi_ = fmaxf((a), (b)), lo_ = fminf((a), (b)); (a) = hi_; (b) = lo_; } while (0)
__device__ __forceinline__ void sort16(float (&v)[16]) {
#pragma unroll
    for (int k = 2; k <= 16; k <<= 1)
#pragma unroll
        for (int j = k >> 1; j > 0; j >>= 1)
#pragma unroll
            for (int i = 0; i < 16; ++i) { const int p = i ^ j; if (p > i) { if ((i & k) == 0) PS_CE(v[i], v[p]); else PS_CE(v[p], v[i]); } }
}
__device__ __forceinline__ void merge16(float (&a)[16], const float (&b)[16]) {
#pragma unroll
    for (int i = 0; i < 16; ++i) a[i] = fmaxf(a[i], b[15 - i]);
#pragma unroll
    for (int j = 8; j > 0; j >>= 1)
#pragma unroll
        for (int i = 0; i < 16; ++i) { const int p = i ^ j; if (p > i) PS_CE(a[i], a[p]); }
}
__device__ __forceinline__ float pack_low(float v, unsigned mask, unsigned tag) { return __uint_as_float((__float_as_uint(v) & ~mask) | tag); }
constexpr int SKP = 272;
__device__ __forceinline__ void top16_half(const LAS unsigned char* keys, const GAS bf16* qrow, int r, int h2, float (&top)[16]) {
    bf16x8 bq[8];
#pragma unroll
    for (int ks = 0; ks < 8; ++ks) bq[ks] = __builtin_bit_cast(bf16x8, *(const GAS v4u*)(qrow + 16 * ks + 8 * h2));
    float grp[4][16];
#pragma unroll
    for (int kt = 0; kt < 4; ++kt) { f32x16 sc;
#pragma unroll
        for (int i = 0; i < 16; ++i) sc[i] = 0.f;
#pragma unroll
        for (int ks = 0; ks < 8; ++ks) { const bf16x8 a = *(const LAS bf16x8*)(keys + (32 * kt + r) * SKP + (16 * ks + 8 * h2) * 2); sc = __builtin_amdgcn_mfma_f32_32x32x16_bf16(a, bq[ks], sc, 0, 0, 0); }
#pragma unroll
        for (int i = 0; i < 16; ++i) { const int key = 32 * kt + (i & 3) + 8 * (i >> 2); grp[kt][i] = pack_low(sc[i], 0x7Fu, (unsigned)(127 - key) - 4u * (unsigned)h2); } }
    sort16(grp[0]); sort16(grp[1]); sort16(grp[2]); sort16(grp[3]);
    merge16(grp[0], grp[1]); merge16(grp[2], grp[3]); merge16(grp[0], grp[2]);
    float oth[16];
#pragma unroll
    for (int i = 0; i < 16; ++i) oth[i] = fa::xhalf(grp[0][i], h2);
    merge16(grp[0], oth);
#pragma unroll
    for (int i = 0; i < 16; ++i) top[i] = grp[0][i];
}
__device__ __forceinline__ void select_unit(const Params& P, int l, int u, LAS unsigned char* lds, bool stage) {
    const int tid = TID(), lane = tid & 63, wave = tid >> 6, r = lane & 31, h2 = lane >> 5;
    const int head = u & 7; const size_t t = (size_t)(u >> 3) * 256 + wave * 32 + r;
    const GAS bf16* q = (const GAS bf16*)(P.ws + WS_ACT1) + t * D + head * 256;
    if (stage) { const GAS v4u* kg = (const GAS v4u*)((const GAS bf16*)(P.ws + WS_KEYS) + (((size_t)l * 8 + head) * 2) * 128 * 128);
      v4u kv[8];
#pragma unroll
      for (int i = 0; i < 8; ++i) kv[i] = kg[tid + 512 * i];
#pragma unroll
      for (int i = 0; i < 8; ++i) { const int pc = tid + 512 * i; *(LAS v4u*)(lds + (pc >> 4) * SKP + (pc & 15) * 16) = kv[i]; } }
    __syncthreads();
    float ts0[16], ts1[16];
    top16_half(lds, q, r, h2, ts0);
    top16_half(lds + 128 * SKP, q + 128, r, h2, ts1);
    LAS int* til = (LAS int*)(lds + 256 * SKP) + (wave * 32 + r) * 32;
#pragma unroll
    for (int k = 0; k < 16; ++k) { float va = ts0[k], vb = ts1[k]; asm volatile("" : "+v"(va), "+v"(vb)); const float v = h2 ? vb : va; til[h2 * 16 + k] = 127 - (int)(__float_as_uint(v) & 0x7Fu); }
    float cg[4][16];
    cg[0][0] = pack_low(ts0[0] + ts1[0], 0xFFu, 255u);
    cg[0][1] = pack_low(ts0[0] + ts1[1], 0xFFu, 254u);
    cg[0][2] = pack_low(ts0[0] + ts1[2], 0xFFu, 253u);
    cg[0][3] = pack_low(ts0[0] + ts1[3], 0xFFu, 252u);
    cg[0][4] = pack_low(ts0[0] + ts1[4], 0xFFu, 251u);
    cg[0][5] = pack_low(ts0[0] + ts1[5], 0xFFu, 250u);
    cg[0][6] = pack_low(ts0[0] + ts1[6], 0xFFu, 249u);
    cg[0][7] = pack_low(ts0[0] + ts1[7], 0xFFu, 248u);
    cg[0][8] = pack_low(ts0[0] + ts1[8], 0xFFu, 247u);
    cg[0][9] = pack_low(ts0[0] + ts1[9], 0xFFu, 246u);
    cg[0][10] = pack_low(ts0[0] + ts1[10], 0xFFu, 245u);
    cg[0][11] = pack_low(ts0[0] + ts1[11], 0xFFu, 244u);
    cg[0][12] = pack_low(ts0[0] + ts1[12], 0xFFu, 243u);
    cg[0][13] = pack_low(ts0[0] + ts1[13], 0xFFu, 242u);
    cg[0][14] = pack_low(ts0[0] + ts1[14], 0xFFu, 241u);
    cg[0][15] = pack_low(ts0[0] + ts1[15], 0xFFu, 240u);
    cg[1][0] = pack_low(ts0[1] + ts1[0], 0xFFu, 239u);
    cg[1][1] = pack_low(ts0[1] + ts1[1], 0xFFu, 238u);
    cg[1][2] = pack_low(ts0[1] + ts1[2], 0xFFu, 237u);
    cg[1][3] = pack_low(ts0[1] + ts1[3], 0xFFu, 236u);
    cg[1][4] = pack_low(ts0[1] + ts1[4], 0xFFu, 235u);
    cg[1][5] = pack_low(ts0[1] + ts1[5], 0xFFu, 234u);
    cg[1][6] = pack_low(ts0[1] + ts1[6], 0xFFu, 233u);
    cg[1][7] = pack_low(ts0[1] + ts1[7], 0xFFu, 232u);
    cg[1][8] = pack_low(ts0[2] + ts1[0], 0xFFu, 223u);
    cg[1][9] = pack_low(ts0[2] + ts1[1], 0xFFu, 222u);
    cg[1][10] = pack_low(ts0[2] + ts1[2], 0xFFu, 221u);
    cg[1][11] = pack_low(ts0[2] + ts1[3], 0xFFu, 220u);
    cg[1][12] = pack_low(ts0[2] + ts1[4], 0xFFu, 219u);
    cg[1][13] = pack_low(ts0[3] + ts1[0], 0xFFu, 207u);
    cg[1][14] = pack_low(ts0[3] + ts1[1], 0xFFu, 206u);
    cg[1][15] = pack_low(ts0[3] + ts1[2], 0xFFu, 205u);
    cg[2][0] = pack_low(ts0[3] + ts1[3], 0xFFu, 204u);
    cg[2][1] = pack_low(ts0[4] + ts1[0], 0xFFu, 191u);
    cg[2][2] = pack_low(ts0[4] + ts1[1], 0xFFu, 190u);
    cg[2][3] = pack_low(ts0[4] + ts1[2], 0xFFu, 189u);
    cg[2][4] = pack_low(ts0[5] + ts1[0], 0xFFu, 175u);
    cg[2][5] = pack_low(ts0[5] + ts1[1], 0xFFu, 174u);
    cg[2][6] = pack_low(ts0[6] + ts1[0], 0xFFu, 159u);
    cg[2][7] = pack_low(ts0[6] + ts1[1], 0xFFu, 158u);
    cg[2][8] = pack_low(ts0[7] + ts1[0], 0xFFu, 143u);
    cg[2][9] = pack_low(ts0[7] + ts1[1], 0xFFu, 142u);
    cg[2][10] = pack_low(ts0[8] + ts1[0], 0xFFu, 127u);
    cg[2][11] = pack_low(ts0[9] + ts1[0], 0xFFu, 111u);
    cg[2][12] = pack_low(ts0[10] + ts1[0], 0xFFu, 95u);
    cg[2][13] = pack_low(ts0[11] + ts1[0], 0xFFu, 79u);
    cg[2][14] = pack_low(ts0[12] + ts1[0], 0xFFu, 63u);
    cg[2][15] = pack_low(ts0[13] + ts1[0], 0xFFu, 47u);
    cg[3][0] = pack_low(ts0[14] + ts1[0], 0xFFu, 31u);
    cg[3][1] = pack_low(ts0[15] + ts1[0], 0xFFu, 15u);
    cg[3][2] = NEG_INF;
    cg[3][3] = NEG_INF;
    cg[3][4] = NEG_INF;
    cg[3][5] = NEG_INF;
    cg[3][6] = NEG_INF;
    cg[3][7] = NEG_INF;
    cg[3][8] = NEG_INF;
    cg[3][9] = NEG_INF;
    cg[3][10] = NEG_INF;
    cg[3][11] = NEG_INF;
    cg[3][12] = NEG_INF;
    cg[3][13] = NEG_INF;
    cg[3][14] = NEG_INF;
    cg[3][15] = NEG_INF;
    sort16(cg[0]); sort16(cg[1]); sort16(cg[2]); sort16(cg[3]);
    merge16(cg[0], cg[1]); merge16(cg[2], cg[3]); merge16(cg[0], cg[2]);
    WAVE_LDS_SYNC();
    const float m = cg[0][0]; float z = 0.f; float ev[16];
#pragma unroll
    for (int k = 0; k < 16; ++k) { ev[k] = __expf(cg[0][k] - m); z += ev[k]; }
    const float zi = 1.0f / z;
    int eo[8]; float go[8];
#pragma unroll
    for (int k = 0; k < 8; ++k) { float wa = cg[0][k], wb = cg[0][8 + k], ea = ev[k], eb = ev[8 + k]; asm volatile("" : "+v"(wa), "+v"(wb), "+v"(ea), "+v"(eb));
        const float w = h2 ? wb : wa; const int flat = 255 - (int)(__float_as_uint(w) & 0xFFu);
        eo[k] = til[flat >> 4] * 128 + til[16 + (flat & 15)]; go[k] = (h2 ? eb : ea) * zi; }
    GAS int* ex = (GAS int*)(P.ws + WS_EXP) + t * 128 + head * 16 + 8 * h2; GAS float* gw = (GAS float*)(P.ws + WS_GW) + t * 128 + head * 16 + 8 * h2;
    typedef int i32x4 __attribute__((ext_vector_type(4)));
    *(GAS i32x4*)ex = (i32x4){eo[0], eo[1], eo[2], eo[3]}; *(GAS i32x4*)(ex + 4) = (i32x4){eo[4], eo[5], eo[6], eo[7]};
    *(GAS f32x4*)gw = (f32x4){go[0], go[1], go[2], go[3]}; *(GAS f32x4*)(gw + 4) = (f32x4){go[4], go[5], go[6], go[7]};
    WAVE_LDS_SYNC();
}
__device__ __forceinline__ void phase_select(const Params& P, int l, int bid, int nb, LAS unsigned char* lds) {
    int staged = -1;
    for (int u = bid; u < T / 32; u += nb) { const bool stage = (u & 7) != staged; if (stage) __syncthreads(); select_unit(P, l, u, lds, stage); staged = u & 7; }
    __syncthreads();
}
#undef PS_CE
}


typedef float f2v_t __attribute__((ext_vector_type(2)));
__device__ __forceinline__ void fp8x4_to_f32(unsigned w, float& a, float& b, float& c, float& d) { const f2v_t lo = __builtin_amdgcn_cvt_pk_f32_fp8((int)w, false), hi = __builtin_amdgcn_cvt_pk_f32_fp8((int)w, true); a = lo.x; b = lo.y; c = hi.x; d = hi.y; }
constexpr int PA_CH = 4;
__device__ __forceinline__ void phase_peer_apply3(const Params& P, int l, int bid, int nb) {
    const int tid = TID(), lane = tid & 63, wave = __builtin_amdgcn_readfirstlane(tid >> 6);
    const GAS bf16* xf = (const GAS bf16*)(P.ws + WS_ACT0);
    const GAS unsigned char* U = (const GAS unsigned char*)(P.ws + WS_U) + (size_t)l * NEXP * D + lane * 16; const GAS unsigned char* V = (const GAS unsigned char*)(P.ws + WS_V) + (size_t)l * NEXP * D + lane * 16;
    const float* su = (const float*)(P.ws + WS_SU) + (size_t)l * NEXP; const float* sv = (const float*)(P.ws + WS_SV) + (size_t)l * NEXP;
    const int* ex = (const int*)(P.ws + WS_EXP); const float* gw = (const float*)(P.ws + WS_GW); GAS bf16* hn = (GAS bf16*)(P.ws + WS_ACT2);
    for (int t = bid * 8 + wave; t < T; t += nb * 8) {
        float x[32], acc[32];
#pragma unroll
        for (int j = 0; j < 2; ++j)
#pragma unroll
            for (int q = 0; q < 2; ++q) { float f[8]; unpack8(*(const GAS v4u*)(xf + (size_t)t * D + j * 1024 + lane * 16 + q * 8), f);
#pragma unroll
                for (int e = 0; e < 8; ++e) { x[j * 16 + q * 8 + e] = f[e]; acc[j * 16 + q * 8 + e] = 0.f; } }
        const int* exr = ex + (size_t)t * 128; const float* gwr = gw + (size_t)t * 128;
        int en[PA_CH];
#pragma unroll
        for (int i = 0; i < PA_CH; ++i) en[i] = __builtin_amdgcn_readfirstlane(exr[i]);
        v4u Ur[PA_CH][2], Vr[2][2];
#pragma unroll
        for (int i = 0; i < PA_CH; ++i)
#pragma unroll
            for (int j = 0; j < 2; ++j) Ur[i][j] = *(const GAS v4u*)(U + (size_t)en[i] * D + j * 1024);
#if DUP_PHASE == 10
        for (int rep = 0; rep < 2; ++rep) { if (rep == 1) { float zz = 0.f; asm volatile("" : "+v"(zz));
#pragma unroll
            for (int i = 0; i < 32; ++i) acc[i] *= zz; }
#endif
#pragma unroll 1
        for (int kc = 0; kc < 128 / PA_CH; ++kc) {
            int ec[PA_CH]; float d[PA_CH];
#pragma unroll
            for (int i = 0; i < PA_CH; ++i) ec[i] = en[i];
            const int kn = kc < 128 / PA_CH - 1 ? kc + 1 : kc;
#pragma unroll
            for (int i = 0; i < PA_CH; ++i) en[i] = __builtin_amdgcn_readfirstlane(exr[PA_CH * kn + i]);
#pragma unroll
            for (int i = 0; i < PA_CH; ++i) { float s = 0.f;
#pragma unroll
                for (int j = 0; j < 2; ++j) { float a, b, c, dd;
                    fp8x4_to_f32(Ur[i][j].x, a, b, c, dd); s += a * x[j * 16 + 0] + b * x[j * 16 + 1] + c * x[j * 16 + 2] + dd * x[j * 16 + 3];
                    fp8x4_to_f32(Ur[i][j].y, a, b, c, dd); s += a * x[j * 16 + 4] + b * x[j * 16 + 5] + c * x[j * 16 + 6] + dd * x[j * 16 + 7];
                    fp8x4_to_f32(Ur[i][j].z, a, b, c, dd); s += a * x[j * 16 + 8] + b * x[j * 16 + 9] + c * x[j * 16 + 10] + dd * x[j * 16 + 11];
                    fp8x4_to_f32(Ur[i][j].w, a, b, c, dd); s += a * x[j * 16 + 12] + b * x[j * 16 + 13] + c * x[j * 16 + 14] + dd * x[j * 16 + 15]; }
                d[i] = s; }
#define PA_VLOAD(slot, i) do { _Pragma("unroll") for (int j = 0; j < 2; ++j) Vr[slot][j] = *(const GAS v4u*)(V + (size_t)ec[i] * D + j * 1024); } while (0)
#define PA_VACC1(wd, base) do { float a, b, c, dd; fp8x4_to_f32((wd), a, b, c, dd); acc[(base)] += wgt * a; acc[(base) + 1] += wgt * b; acc[(base) + 2] += wgt * c; acc[(base) + 3] += wgt * dd; } while (0)
#define PA_VACC(slot, i) do { const float wgt = d[i]; _Pragma("unroll") for (int j = 0; j < 2; ++j) { PA_VACC1(Vr[slot][j].x, j * 16); PA_VACC1(Vr[slot][j].y, j * 16 + 4); PA_VACC1(Vr[slot][j].z, j * 16 + 8); PA_VACC1(Vr[slot][j].w, j * 16 + 12); } } while (0)
            PA_VLOAD(0, 0); PA_VLOAD(1, 1);
#pragma unroll
            for (int i = 0; i < PA_CH; ++i)
#pragma unroll
                for (int j = 0; j < 2; ++j) Ur[i][j] = *(const GAS v4u*)(U + (size_t)en[i] * D + j * 1024);
#pragma unroll
            for (int i = 0; i < PA_CH; ++i) { const float dt = wave_sum(d[i]) * __builtin_bit_cast(float, __builtin_amdgcn_readfirstlane(__builtin_bit_cast(int, su[ec[i]])));
                const float g = __builtin_bit_cast(float, __builtin_amdgcn_readfirstlane(__builtin_bit_cast(int, gwr[PA_CH * kc + i]))) * __builtin_bit_cast(float, __builtin_amdgcn_readfirstlane(__builtin_bit_cast(int, sv[ec[i]])));
                d[i] = g * 0.5f * dt * (1.0f + erff(dt * 0.70710678118654752f)); }
#pragma unroll
            for (int i = 0; i < PA_CH; ++i) { if (i & 1) { PA_VACC(1, i); if (i + 2 < PA_CH) PA_VLOAD(1, i + 2); } else { PA_VACC(0, i); if (i + 2 < PA_CH) PA_VLOAD(0, i + 2); } }
#undef PA_VLOAD
#undef PA_VACC
#undef PA_VACC1
        }
#if DUP_PHASE == 10
        }
#endif
        GAS float* hrow = (GAS float*)P.out + (size_t)t * D + lane * 16; float ss = 0.f;
#pragma unroll
        for (int j = 0; j < 2; ++j)
#pragma unroll
            for (int q = 0; q < 4; ++q) { f32x4 hv = *(const GAS f32x4*)(hrow + j * 1024 + q * 4);
                hv.x += acc[j * 16 + q * 4 + 0]; hv.y += acc[j * 16 + q * 4 + 1]; hv.z += acc[j * 16 + q * 4 + 2]; hv.w += acc[j * 16 + q * 4 + 3];
                *(GAS f32x4*)(hrow + j * 1024 + q * 4) = hv; acc[j * 16 + q * 4 + 0] = hv.x; acc[j * 16 + q * 4 + 1] = hv.y; acc[j * 16 + q * 4 + 2] = hv.z; acc[j * 16 + q * 4 + 3] = hv.w;
                ss += hv.x * hv.x + hv.y * hv.y + hv.z * hv.z + hv.w * hv.w; }
        ss = wave_sum(ss); const float rr = 1.0f / sqrtf(ss * (1.0f / D) + EPS); const GAS float* gain = (const GAS float*)P.in[I_LNPLE] + (size_t)l * D + lane * 16;
#pragma unroll
        for (int j = 0; j < 2; ++j)
#pragma unroll
            for (int q = 0; q < 2; ++q) { const f32x4 g0 = *(const GAS f32x4*)(gain + j * 1024 + q * 8), g1 = *(const GAS f32x4*)(gain + j * 1024 + q * 8 + 4); const int b0 = j * 16 + q * 8;
                v4u o; o.x = pk2(acc[b0 + 0] * rr * g0.x, acc[b0 + 1] * rr * g0.y); o.y = pk2(acc[b0 + 2] * rr * g0.z, acc[b0 + 3] * rr * g0.w);
                o.z = pk2(acc[b0 + 4] * rr * g1.x, acc[b0 + 5] * rr * g1.y); o.w = pk2(acc[b0 + 6] * rr * g1.z, acc[b0 + 7] * rr * g1.w);
                *(GAS v4u*)(hn + (size_t)t * D + j * 1024 + lane * 16 + q * 8) = o; }
    }
}


__device__ __forceinline__ void norm_row_i8(f32x4 (&v)[8], float ss, const float* gain, GAS unsigned char* orow, GAS float* sc, int lane) {
    const float r = 1.0f / sqrtf(ss * (1.0f / D) + EPS); float am = 0.f;
#pragma unroll
    for (int j = 0; j < 8; ++j) { const f32x4 g = *(const f32x4*)(gain + (j * 64 + lane) * 4); v[j] = v[j] * r * g; am = fmaxf(am, fmaxf(fmaxf(fabsf(v[j].x), fabsf(v[j].y)), fmaxf(fabsf(v[j].z), fabsf(v[j].w)))); }
    am = wave_max(am); const float S = am > 0.f ? 127.0f / am : 0.f;
#pragma unroll
    for (int j = 0; j < 8; ++j) *(GAS unsigned*)(orow + (j * 64 + lane) * 4) = pack_i8x4(v[j].x, v[j].y, v[j].z, v[j].w, S);
    if (lane == 0) *sc = am * (1.0f / 127.0f);
}
template <bool SRC16 = false>
__device__ __forceinline__ void phase_norm_i8(const void* src, const float* gain, unsigned char* dst8, float* scales, int bid, int nb) {
    const int tid = TID(), lane = tid & 63, wave = tid >> 6, nw = 8;
    const int step = nb * nw; int t = bid * nw + wave;
    for (; t + step < T; t += 2 * step) { f32x4 v0[8], v1[8];
#pragma unroll
        for (int j = 0; j < 8; ++j) { v0[j] = ldrow4<SRC16>(src, (size_t)t * D + (j * 64 + lane) * 4); v1[j] = ldrow4<SRC16>(src, (size_t)(t + step) * D + (j * 64 + lane) * 4); }
        float s0 = 0.f, s1 = 0.f;
#pragma unroll
        for (int j = 0; j < 8; ++j) { s0 += v0[j].x * v0[j].x + v0[j].y * v0[j].y + v0[j].z * v0[j].z + v0[j].w * v0[j].w; s1 += v1[j].x * v1[j].x + v1[j].y * v1[j].y + v1[j].z * v1[j].z + v1[j].w * v1[j].w; }
        s0 = wave_sum(s0); s1 = wave_sum(s1);
        norm_row_i8(v0, s0, gain, (GAS unsigned char*)dst8 + (size_t)t * D, (GAS float*)scales + t, lane); norm_row_i8(v1, s1, gain, (GAS unsigned char*)dst8 + (size_t)(t + step) * D, (GAS float*)scales + t + step, lane); }
    for (; t < T; t += step) { f32x4 v[8]; float s_ = 0.f;
#pragma unroll
        for (int j = 0; j < 8; ++j) { v[j] = ldrow4<SRC16>(src, (size_t)t * D + (j * 64 + lane) * 4); s_ += v[j].x * v[j].x + v[j].y * v[j].y + v[j].z * v[j].z + v[j].w * v[j].w; }
        const float ss = wave_sum(s_); norm_row_i8(v, ss, gain, (GAS unsigned char*)dst8 + (size_t)t * D, (GAS float*)scales + t, lane); }
}
__device__ __forceinline__ void quant_rows_i8(const bf16* srcm, unsigned char* dstm, float* scm, int nrows, int bid, int nb) {
    const int tid = TID(), lane = tid & 63, wave = tid >> 6;
    for (int n = bid * 8 + wave; n < nrows; n += nb * 8) {
        const GAS bf16* src = (const GAS bf16*)srcm + (size_t)n * D; float f[4][8]; float am = 0.f;
#pragma unroll
        for (int j = 0; j < 4; ++j) { unpack8(*(const GAS v4u*)(src + (j * 64 + lane) * 8), f[j]);
#pragma unroll
            for (int e = 0; e < 8; ++e) am = fmaxf(am, fabsf(f[j][e])); }
        am = wave_max(am); const float S = am > 0.f ? 127.0f / am : 0.f;
        GAS unsigned char* dst = (GAS unsigned char*)dstm + (size_t)n * D;
#pragma unroll
        for (int j = 0; j < 4; ++j) *(GAS v2u*)(dst + (j * 64 + lane) * 8) = (v2u){pack_i8x4(f[j][0], f[j][1], f[j][2], f[j][3], S), pack_i8x4(f[j][4], f[j][5], f[j][6], f[j][7], S)};
        if (lane == 0) ((GAS float*)scm)[n] = am * (1.0f / 127.0f);
    }
}
constexpr int QR_TM = NTM * 128, QR_VT = QR_TM + NVT * 128, QR_WO = QR_VT + D, QR_WQ = QR_WO + D, QR_ALL = QR_WQ + D;
__device__ __forceinline__ void quant_row_ptrs(unsigned char* ws, int l, int g, const GAS bf16*& src, GAS unsigned char*& dst, GAS float*& sc) {
    size_t so, d8, ss; int r;
    if (g < QR_TM) { r = l * NTM * 128 + g; so = WS_WINTM; d8 = WS_WIN8TM; ss = WS_SWTM; }
    else if (g < QR_VT) { r = l * NVT * 128 + (g - QR_TM); so = WS_WINVT; d8 = WS_WIN8VT; ss = WS_SWVT; }
    else if (g < QR_WO) { r = l * D + (g - QR_VT); so = WS_WOUT; d8 = WS_WO8; ss = WS_SWO; }
    else if (g < QR_WQ) { r = l * D + (g - QR_WO); so = WS_WQ; d8 = WS_WQ8; ss = WS_SWQ; }
    else { r = l * D + (g - QR_WQ); so = WS_WGATE; d8 = WS_WG8; ss = WS_SWG; }
    src = (const GAS bf16*)(ws + so) + (size_t)r * D; dst = (GAS unsigned char*)(ws + d8) + (size_t)r * D; sc = (GAS float*)(ws + ss) + r;
}
__device__ __forceinline__ void quant_all_rows(const Params& P, int l, int bid, int nb) {
    const int tid = TID(), lane = tid & 63, wave = tid >> 6; const int step = nb * 8;
    for (int g0 = bid * 8 + wave; g0 < QR_ALL; g0 += 3 * step) {
        v4u w[3][4]; GAS unsigned char* dst[3]; GAS float* sc[3];
#pragma unroll
        for (int u = 0; u < 3; ++u) { const int g = g0 + u * step; const GAS bf16* src; quant_row_ptrs(P.ws, l, g < QR_ALL ? g : g0, src, dst[u], sc[u]);
#pragma unroll
            for (int j = 0; j < 4; ++j) w[u][j] = *(const GAS v4u*)(src + (j * 64 + lane) * 8); }
#pragma unroll
        for (int u = 0; u < 3; ++u) { if (g0 + u * step >= QR_ALL) break;
            float f[4][8]; float am = 0.f;
#pragma unroll
            for (int j = 0; j < 4; ++j) { unpack8(w[u][j], f[j]);
#pragma unroll
                for (int e = 0; e < 8; ++e) am = fmaxf(am, fabsf(f[j][e])); }
            am = wave_max(am); const float S = am > 0.f ? 127.0f / am : 0.f;
#pragma unroll
            for (int j = 0; j < 4; ++j) *(GAS v2u*)(dst[u] + (j * 64 + lane) * 8) = (v2u){pack_i8x4(f[j][0], f[j][1], f[j][2], f[j][3], S), pack_i8x4(f[j][4], f[j][5], f[j][6], f[j][7], S)};
            if (lane == 0) *sc[u] = am * (1.0f / 127.0f); }
    }
}
__device__ __forceinline__ void quant_wgate(const Params& P, int l, int bid, int nb) {
    const int tid = TID(), lane = tid & 63, wave = tid >> 6;
    for (int n = bid * 8 + wave; n < D; n += nb * 8) {
        const GAS bf16* src = (const GAS bf16*)(P.ws + WS_WGATE) + ((size_t)l * D + n) * D; float f[4][8]; float am = 0.f;
#pragma unroll
        for (int j = 0; j < 4; ++j) { unpack8(*(const GAS v4u*)(src + (j * 64 + lane) * 8), f[j]);
#pragma unroll
            for (int e = 0; e < 8; ++e) am = fmaxf(am, fabsf(f[j][e])); }
        am = wave_max(am); const float S = am > 0.f ? 127.0f / am : 0.f;
        GAS unsigned char* dst = (GAS unsigned char*)(P.ws + WS_WG8) + ((size_t)l * D + n) * D;
#pragma unroll
        for (int j = 0; j < 4; ++j) *(GAS v2u*)(dst + (j * 64 + lane) * 8) = (v2u){pack_i8x4(f[j][0], f[j][1], f[j][2], f[j][3], S), pack_i8x4(f[j][4], f[j][5], f[j][6], f[j][7], S)};
        if (lane == 0) ((GAS float*)(P.ws + WS_SWG))[(size_t)l * D + n] = am * (1.0f / 127.0f);
    }
}
#define XB_TMO      128
#define XB_XCNT(j)  (256  + 64 * (j))
#define XB_XSUB(j)  (1280 + 64 * (j))
#define XB_XGEN(j)  (2304 + 64 * (j))
#define XB_TOP      3328
#define XB_TOPGEN   3392
#define XCD_BAR_WORDS 3456
#define XB_SPIN_CAP (1u << 22)
__device__ __forceinline__ unsigned xb_ld(unsigned* p)              { return __hip_atomic_load(p, __ATOMIC_RELAXED, __HIP_MEMORY_SCOPE_AGENT); }
__device__ __forceinline__ unsigned xb_add(unsigned* p, unsigned v) { return __hip_atomic_fetch_add(p, v, __ATOMIC_RELAXED, __HIP_MEMORY_SCOPE_AGENT); }
__device__ __forceinline__ unsigned xb_xcc_id() { return (unsigned)__builtin_amdgcn_s_getreg((3 << 11) | 20) & 0xFu; }
#define XB_SPIN(cond, bar) do { unsigned _sp = 0; while (cond) { __builtin_amdgcn_s_sleep(1); \
    if ((++_sp & 255u) == 0u) { if (xb_ld(&(bar)[XB_TMO])) break; if (_sp > XB_SPIN_CAP) { atomicAdd(&(bar)[XB_TMO], 1u); break; } } } } while (0)
struct XcdBarrier { unsigned* bar; unsigned x; volatile LAS unsigned* st; };
__device__ __forceinline__ XcdBarrier xcd_barrier_post(unsigned* bar, volatile LAS unsigned* st) {
    XcdBarrier b; b.bar = bar; b.x = xb_xcc_id(); b.st = st;
    if (threadIdx.x == 0) (void)xb_add(&bar[XB_XCNT(b.x)], 1u);
    return b;
}
__device__ __forceinline__ void xcd_barrier_complete(unsigned* bar, unsigned x, unsigned& nloc, unsigned& nx) {
    const unsigned G = gridDim.x * gridDim.y * gridDim.z;
    unsigned sum, cnt, mine, sp = 0u;
    for (;;) {
        sum = 0u; cnt = 0u; mine = 0u;
#pragma unroll
        for (unsigned j = 0; j < 16; ++j) { const unsigned c = xb_ld(&bar[XB_XCNT(j)]); sum += c; cnt += (c > 0u) ? 1u : 0u; mine = (j == x) ? c : mine; }
        if (sum == G) break;
        __builtin_amdgcn_s_sleep(1);
        if ((++sp & 255u) == 0u) { if (xb_ld(&bar[XB_TMO])) break; if (sp > XB_SPIN_CAP) { atomicAdd(&bar[XB_TMO], 1u); break; } }
    }
    nloc = mine > 0u ? mine : 1u; nx = cnt > 0u ? cnt : 1u;
}
__device__ __forceinline__ void xcd_barrier(const XcdBarrier& b) {
    asm volatile("s_waitcnt vmcnt(0)" ::: "memory");
    __syncthreads();
    if (threadIdx.x == 0) {
        unsigned* bar = b.bar;
        __builtin_amdgcn_s_waitcnt(0);
        unsigned nloc = b.st[0], nx = b.st[1];
        if (nloc == 0u) { xcd_barrier_complete(bar, b.x, nloc, nx); b.st[0] = nloc; b.st[1] = nx; }
        const unsigned old = xb_add(&bar[XB_XSUB(b.x)], 1u);
        const unsigned gen = old / nloc;
        if (old + 1u == (gen + 1u) * nloc) {
            __builtin_amdgcn_fence(__ATOMIC_RELEASE, "agent");
            asm volatile("s_waitcnt vmcnt(0)" ::: "memory");
            const unsigned og = xb_add(&bar[XB_TOP], 1u);
            const unsigned tg = og / nx;
            if (og + 1u == (tg + 1u) * nx) xb_add(&bar[XB_TOPGEN], 1u);
            else XB_SPIN(xb_ld(&bar[XB_TOPGEN]) == tg, bar);
            __builtin_amdgcn_fence(__ATOMIC_ACQUIRE, "agent");
            xb_add(&bar[XB_XGEN(b.x)], 1u);
            asm volatile("s_waitcnt vmcnt(0)" ::: "memory");
        } else {
            XB_SPIN(xb_ld(&bar[XB_XGEN(b.x)]) == gen, bar);
            __builtin_amdgcn_fence(__ATOMIC_ACQUIRE, "agent");
            asm volatile("s_waitcnt vmcnt(0)" ::: "memory");
        }
    }
    __syncthreads();
}


namespace pz {
constexpr int NSL = 16, NTG = T / 8, QITEMS = (NSL / 8) * NTG;
__device__ __forceinline__ void load_rows(const GAS unsigned char* tab, unsigned poff, const int (&id)[16], v4u (&rows)[16]) {
#pragma unroll
    for (int i = 0; i < 16; ++i) rows[i] = *(const GAS v4u*)(tab + (((unsigned)id[i] << 7) | poff));
}
__device__ __forceinline__ void load_ids(const int* ex, size_t t, int e8, int (&id)[16]) {
    typedef int i32x4 __attribute__((ext_vector_type(4)));
#pragma unroll
    for (int q = 0; q < 4; ++q) { const i32x4 v = *(const GAS i32x4*)((const GAS int*)ex + t * 128 + 16 * e8 + 4 * q); id[4 * q] = v.x; id[4 * q + 1] = v.y; id[4 * q + 2] = v.z; id[4 * q + 3] = v.w; }
}
typedef float f2p __attribute__((ext_vector_type(2)));
__device__ __forceinline__ unsigned item_A(const Params& P, int l, int xq, int c, int tg, int lane, int (&id)[2][16], v4u (&rows)[2][16], unsigned itn_raw) {
    const int e8 = lane >> 3, part = lane & 7;
    const GAS unsigned char* tab0 = (const GAS unsigned char*)(P.ws + WS_U) + (size_t)l * NSL * NEXP * 128; const unsigned poff = part * 16;
    const GAS unsigned char* tab = tab0 + (size_t)c * NEXP * 128; unsigned itn = 0xffffffffu; size_t tn0 = 0; const GAS unsigned char* tabn = tab;
    const GAS bf16* xf = (const GAS bf16*)(P.ws + WS_ACT0) + 128 * c + 16 * part; const int* ex = (const int*)(P.ws + WS_EXP);
    GAS bf16* pdh = (GAS bf16*)(P.ws + WS_PD) + (size_t)c * T * 128 + 16 * e8;
    const size_t t0 = (size_t)tg * 8;
#pragma unroll
    for (int n = 0; n < 8; ++n) { const size_t t = t0 + n; const int bf = n & 1;
        if (n < 7) load_rows(tab, poff, id[bf ^ 1], rows[bf ^ 1]);
        if (n < 6) load_ids(ex, t + 2, e8, id[bf]);
        if (n == 6) { itn = (unsigned)__builtin_amdgcn_readfirstlane((int)itn_raw);
            if (itn < (unsigned)QITEMS) { tn0 = (size_t)(itn % NTG) * 8; tabn = tab0 + (size_t)(xq + 8 * (int)(itn / NTG)) * NEXP * 128; load_ids(ex, tn0, e8, id[0]); } }
        if (n == 7 && itn < (unsigned)QITEMS) { load_rows(tabn, poff, id[0], rows[0]); load_ids(ex, tn0 + 1, e8, id[1]); }
#if PEER_A_I8
        const v4u xw = *(const GAS v4u*)((const GAS unsigned char*)(P.ws + WS_XF8) + t * D + 128 * c + 16 * part);
        int sacc[16];
#pragma unroll
        for (int i = 0; i < 16; ++i) { const v4u rw = rows[bf][i]; int a; asm("v_dot4_i32_i8 %0, %1, %2, 0" : "=v"(a) : "v"(rw.x), "v"(xw.x)); a = __builtin_amdgcn_sdot4((int)rw.y, (int)xw.y, a, false);
            a = __builtin_amdgcn_sdot4((int)rw.z, (int)xw.z, a, false); sacc[i] = __builtin_amdgcn_sdot4((int)rw.w, (int)xw.w, a, false); }
        { const bool b2 = part & 4, b1 = part & 2, b0 = part & 1; int r8[8], r4[4], r2[2];
#pragma unroll
          for (int i = 0; i < 8; ++i) { const int snd = b2 ? sacc[i] : sacc[8 + i], kp = b2 ? sacc[8 + i] : sacc[i]; r8[i] = kp + swz_xor_i<4>(snd); }
#pragma unroll
          for (int i = 0; i < 4; ++i) { const int snd = b1 ? r8[i] : r8[4 + i], kp = b1 ? r8[4 + i] : r8[i]; r4[i] = kp + swz_xor_i<2>(snd); }
#pragma unroll
          for (int i = 0; i < 2; ++i) { const int snd = b0 ? r4[i] : r4[2 + i], kp = b0 ? r4[2 + i] : r4[i]; r2[i] = kp + swz_xor_i<1>(snd); }
          *(GAS unsigned*)((GAS bf16*)pdh + t * 128 + 2 * part) = pk2((float)r2[0] * (1.0f / 16384.0f), (float)r2[1] * (1.0f / 16384.0f)); }
#else
        f2p x2[8];
        { const v4u w0 = *(const GAS v4u*)(xf + t * D), w1 = *(const GAS v4u*)(xf + t * D + 8);
          x2[0] = (f2p){bf2f(w0.x & 0xffff), bf2f(w0.x >> 16)}; x2[1] = (f2p){bf2f(w0.y & 0xffff), bf2f(w0.y >> 16)}; x2[2] = (f2p){bf2f(w0.z & 0xffff), bf2f(w0.z >> 16)}; x2[3] = (f2p){bf2f(w0.w & 0xffff), bf2f(w0.w >> 16)};
          x2[4] = (f2p){bf2f(w1.x & 0xffff), bf2f(w1.x >> 16)}; x2[5] = (f2p){bf2f(w1.y & 0xffff), bf2f(w1.y >> 16)}; x2[6] = (f2p){bf2f(w1.z & 0xffff), bf2f(w1.z >> 16)}; x2[7] = (f2p){bf2f(w1.w & 0xffff), bf2f(w1.w >> 16)}; }
        float sacc[16];
#pragma unroll
        for (int i = 0; i < 16; ++i) { const v4u rw = rows[bf][i]; f2p s2 = {0.f, 0.f};
            s2 = __builtin_elementwise_fma(__builtin_amdgcn_cvt_pk_f32_fp8((int)rw.x, false), x2[0], s2); s2 = __builtin_elementwise_fma(__builtin_amdgcn_cvt_pk_f32_fp8((int)rw.x, true), x2[1], s2);
            s2 = __builtin_elementwise_fma(__builtin_amdgcn_cvt_pk_f32_fp8((int)rw.y, false), x2[2], s2); s2 = __builtin_elementwise_fma(__builtin_amdgcn_cvt_pk_f32_fp8((int)rw.y, true), x2[3], s2);
            s2 = __builtin_elementwise_fma(__builtin_amdgcn_cvt_pk_f32_fp8((int)rw.z, false), x2[4], s2); s2 = __builtin_elementwise_fma(__builtin_amdgcn_cvt_pk_f32_fp8((int)rw.z, true), x2[5], s2);
            s2 = __builtin_elementwise_fma(__builtin_amdgcn_cvt_pk_f32_fp8((int)rw.w, false), x2[6], s2); s2 = __builtin_elementwise_fma(__builtin_amdgcn_cvt_pk_f32_fp8((int)rw.w, true), x2[7], s2);
            sacc[i] = s2.x + s2.y; }
        { const bool b2 = part & 4, b1 = part & 2, b0 = part & 1; float r8[8], r4[4], r2[2];
#pragma unroll
          for (int i = 0; i < 8; ++i) { const float snd = b2 ? sacc[i] : sacc[8 + i], kp = b2 ? sacc[8 + i] : sacc[i]; r8[i] = kp + swz_xor<4>(snd); }
#pragma unroll
          for (int i = 0; i < 4; ++i) { const float snd = b1 ? r8[i] : r8[4 + i], kp = b1 ? r8[4 + i] : r8[i]; r4[i] = kp + swz_xor<2>(snd); }
#pragma unroll
          for (int i = 0; i < 2; ++i) { const float snd = b0 ? r4[i] : r4[2 + i], kp = b0 ? r4[2 + i] : r4[i]; r2[i] = kp + swz_xor<1>(snd); }
          *(GAS unsigned*)((GAS bf16*)pdh + t * 128 + 2 * part) = pk2(r2[0], r2[1]); }
#endif
    }
    return itn;
}
__device__ __forceinline__ unsigned item_B(const Params& P, int l, int xq, int c, int tg, int lane, int (&id)[2][16], v4u (&rows)[2][16], unsigned itn_raw) {
    const int e8 = lane >> 3, part = lane & 7;
    const GAS unsigned char* tab0 = (const GAS unsigned char*)(P.ws + WS_V) + (size_t)l * NSL * NEXP * 128; const unsigned poff = part * 16;
    const GAS unsigned char* tab = tab0 + (size_t)c * NEXP * 128; unsigned itn = 0xffffffffu; size_t tn0 = 0; const GAS unsigned char* tabn = tab;
    const int* ex = (const int*)(P.ws + WS_EXP); const GAS float* wv = (const GAS float*)(P.ws + WS_WV) + 16 * e8;
    GAS float* hcol = (GAS float*)P.out + 128 * c + 16 * part;
    const size_t t0 = (size_t)tg * 8;
#pragma unroll
    for (int n = 0; n < 8; ++n) { const size_t t = t0 + n; const int bf = n & 1;
        if (n < 7) load_rows(tab, poff, id[bf ^ 1], rows[bf ^ 1]);
        if (n < 6) load_ids(ex, t + 2, e8, id[bf]);
        if (n == 6) { itn = (unsigned)__builtin_amdgcn_readfirstlane((int)itn_raw);
            if (itn < (unsigned)QITEMS) { tn0 = (size_t)(itn % NTG) * 8; tabn = tab0 + (size_t)(xq + 8 * (int)(itn / NTG)) * NEXP * 128; load_ids(ex, tn0, e8, id[0]); } }
        if (n == 7 && itn < (unsigned)QITEMS) { load_rows(tabn, poff, id[0], rows[0]); load_ids(ex, tn0 + 1, e8, id[1]); }
        float w[16];
#pragma unroll
        for (int q = 0; q < 4; ++q) { const f32x4 v = *(const GAS f32x4*)(wv + t * 128 + 4 * q); w[4 * q] = v.x; w[4 * q + 1] = v.y; w[4 * q + 2] = v.z; w[4 * q + 3] = v.w; }
        f2p acc2[8];
#pragma unroll
        for (int q = 0; q < 8; ++q) acc2[q] = (f2p){0.f, 0.f};
#pragma unroll
        for (int i = 0; i < 16; ++i) { const v4u rw = rows[bf][i]; const f2p w2 = {w[i], w[i]};
            acc2[0] = __builtin_elementwise_fma(__builtin_amdgcn_cvt_pk_f32_fp8((int)rw.x, false), w2, acc2[0]); acc2[1] = __builtin_elementwise_fma(__builtin_amdgcn_cvt_pk_f32_fp8((int)rw.x, true), w2, acc2[1]);
            acc2[2] = __builtin_elementwise_fma(__builtin_amdgcn_cvt_pk_f32_fp8((int)rw.y, false), w2, acc2[2]); acc2[3] = __builtin_elementwise_fma(__builtin_amdgcn_cvt_pk_f32_fp8((int)rw.y, true), w2, acc2[3]);
            acc2[4] = __builtin_elementwise_fma(__builtin_amdgcn_cvt_pk_f32_fp8((int)rw.z, false), w2, acc2[4]); acc2[5] = __builtin_elementwise_fma(__builtin_amdgcn_cvt_pk_f32_fp8((int)rw.z, true), w2, acc2[5]);
            acc2[6] = __builtin_elementwise_fma(__builtin_amdgcn_cvt_pk_f32_fp8((int)rw.w, false), w2, acc2[6]); acc2[7] = __builtin_elementwise_fma(__builtin_amdgcn_cvt_pk_f32_fp8((int)rw.w, true), w2, acc2[7]); }
        float acc[16];
#pragma unroll
        for (int q = 0; q < 8; ++q) { acc[2 * q] = acc2[q].x; acc[2 * q + 1] = acc2[q].y; }
        { const bool b3 = e8 & 1; float r8[8], r4[4], r2[2];
#pragma unroll
          for (int i = 0; i < 8; ++i) { const auto pr = __builtin_amdgcn_permlane32_swap(__builtin_bit_cast(unsigned, acc[i]), __builtin_bit_cast(unsigned, acc[8 + i]), false, false);
              r8[i] = __builtin_bit_cast(float, (unsigned)pr[0]) + __builtin_bit_cast(float, (unsigned)pr[1]); }
#pragma unroll
          for (int i = 0; i < 4; ++i) { const auto pr = __builtin_amdgcn_permlane16_swap(__builtin_bit_cast(unsigned, r8[i]), __builtin_bit_cast(unsigned, r8[4 + i]), false, false);
              r4[i] = __builtin_bit_cast(float, (unsigned)pr[0]) + __builtin_bit_cast(float, (unsigned)pr[1]); }
#pragma unroll
          for (int i = 0; i < 2; ++i) { const float snd = b3 ? r4[i] : r4[2 + i], kp = b3 ? r4[2 + i] : r4[i]; r2[i] = kp + swz_xor<8>(snd); }
#if H16
          GAS h2_t* hp = (GAS h2_t*)((GAS _Float16*)(P.ws + WS_H16) + 128 * c + 16 * part + t * D + 2 * e8); const h2_t hv = *hp; *hp = (h2_t){(_Float16)((float)hv.x + r2[0]), (_Float16)((float)hv.y + r2[1])}; }
#else
          GAS f2p* hp = (GAS f2p*)(hcol + t * D + 2 * e8); f2p hv = *hp; hv.x += r2[0]; hv.y += r2[1]; *hp = hv; }
#endif
    }
    return itn;
}
template <int WHICH>
__device__ __forceinline__ void phase_sliced(const Params& P, int l) {
    unsigned* qbase = (unsigned*)(P.ws + WS_CTL) + 16384 + 64 * ((l * 2 + WHICH) * 8);
    const unsigned x0 = xb_xcc_id() & 7u;
    const int lane = TID() & 63, e8 = lane >> 3, part = lane & 7;
    const int* ex = (const int*)(P.ws + WS_EXP);
    const GAS unsigned char* tab0 = (const GAS unsigned char*)(P.ws + (WHICH == 0 ? WS_U : WS_V)) + (size_t)l * NSL * NEXP * 128; const unsigned poff = part * 16;
    for (unsigned s_ = 0; s_ < 8; ++s_) { const unsigned xq = (x0 + s_) & 7u;
        unsigned it = 0u;
        if (lane == 0) it = __hip_atomic_fetch_add(qbase + 64 * xq, 1u, __ATOMIC_RELAXED, __HIP_MEMORY_SCOPE_AGENT);
        it = (unsigned)__builtin_amdgcn_readfirstlane((int)it);
        if (it >= (unsigned)QITEMS) continue;
        int id[2][16]; v4u rows[2][16];
        { const size_t t0 = (size_t)(it % NTG) * 8; const GAS unsigned char* tab = tab0 + (size_t)((int)xq + 8 * (int)(it / NTG)) * NEXP * 128;
          load_ids(ex, t0, e8, id[0]); load_rows(tab, poff, id[0], rows[0]); load_ids(ex, t0 + 1, e8, id[1]); }
        for (;;) {
            unsigned itn_raw = 0xffffffffu;
            if (lane == 0) itn_raw = __hip_atomic_fetch_add(qbase + 64 * xq, 1u, __ATOMIC_RELAXED, __HIP_MEMORY_SCOPE_AGENT);
            const int c = (int)xq + 8 * (int)(it / NTG), tg = (int)(it % NTG);
            const unsigned itn = WHICH == 0 ? item_A(P, l, (int)xq, c, tg, lane, id, rows, itn_raw) : item_B(P, l, (int)xq, c, tg, lane, id, rows, itn_raw);
            if (itn >= (unsigned)QITEMS) break;
            it = itn;
        }
    }
}
__device__ __forceinline__ void phase_weights(const Params& P, int l, int bid, int nb) {
    const int tid = TID();
    const GAS bf16* pd = (const GAS bf16*)(P.ws + WS_PD); const GAS int* ex = (const GAS int*)(P.ws + WS_EXP); const GAS float* gw = (const GAS float*)(P.ws + WS_GW);
    const GAS float* su = (const GAS float*)(P.ws + WS_SU) + (size_t)l * NEXP; const GAS float* sv = (const GAS float*)(P.ws + WS_SV) + (size_t)l * NEXP; GAS float* wv = (GAS float*)(P.ws + WS_WV);
    typedef int i32x4 __attribute__((ext_vector_type(4)));
    for (size_t i8 = (size_t)bid * 512 + tid; i8 < (size_t)T * 128 / 8; i8 += (size_t)nb * 512) {
        const size_t i = i8 * 8; float s8[8];
#pragma unroll
        for (int q = 0; q < 8; ++q) s8[q] = 0.f;
#pragma unroll
        for (int c = 0; c < NSL; ++c) { float f[8]; unpack8(*(const GAS v4u*)(pd + (size_t)c * T * 128 + i), f);
#pragma unroll
            for (int q = 0; q < 8; ++q) s8[q] += f[q]; }
        const i32x4 e0 = *(const GAS i32x4*)(ex + i), e1 = *(const GAS i32x4*)(ex + i + 4); const f32x4 g0 = *(const GAS f32x4*)(gw + i), g1 = *(const GAS f32x4*)(gw + i + 4);
        const int ee[8] = {e0.x, e0.y, e0.z, e0.w, e1.x, e1.y, e1.z, e1.w}; const float gg[8] = {g0.x, g0.y, g0.z, g0.w, g1.x, g1.y, g1.z, g1.w}; float o[8];
        const float xs = PEER_A_I8 ? 16384.0f * ((const GAS float*)(P.ws + WS_SXF))[i >> 7] : 1.0f;
#pragma unroll
        for (int q = 0; q < 8; ++q) { const float dt = s8[q] * xs * su[ee[q]]; o[q] = gg[q] * sv[ee[q]] * 0.5f * dt * (1.0f + erff(dt * 0.70710678118654752f)); }
        *(GAS f32x4*)(wv + i) = (f32x4){o[0], o[1], o[2], o[3]}; *(GAS f32x4*)(wv + i + 4) = (f32x4){o[4], o[5], o[6], o[7]};
    }
}
}

#ifndef FAST_GEMM
#define FAST_GEMM 1
#endif
#ifndef FAST_ATTN
#define FAST_ATTN 1
#endif
#ifndef FAST_SELECT
#define FAST_SELECT 1
#endif
#ifndef FAST_PREP
#define FAST_PREP 1
#endif
constexpr int LDS_BYTES = 147456;
constexpr int LDS_MISC = 131072;
constexpr int NPH_L = 12, NPHASES = 1 + DEPTH * NPH_L + 1;
struct Args { Params P; int ph_lo, ph_hi; };
__global__ void __launch_bounds__(512, 2) mk_fwd(Args a) {
    extern __shared__ __attribute__((aligned(16))) unsigned char lds_raw[];
    LAS unsigned char* lds = (LAS unsigned char*)lds_raw;
    const Params& P0 = a.P;
    const int bid0 = blockIdx.x, nb = gridDim.x;
    volatile LAS unsigned* misc = (volatile LAS unsigned*)(lds + LDS_MISC);
    if (threadIdx.x < 64) misc[threadIdx.x] = 0u;
    __syncthreads();
    XcdBarrier bar = xcd_barrier_post((unsigned*)(P0.ws + WS_CTL) + 1024, misc + 8);
    const int lo = a.ph_lo, hi = a.ph_hi;
#define IN(k) (lo <= (k) && (k) < hi)
#define BAR(k) do { if (IN(k) && IN((k) + 1)) xcd_barrier(bar); } while (0)
#define PH const Params P = fresh(P0); const int bid = launder_s(bid0); unsigned char* ws = P.ws; (void)ws; (void)bid
    if (IN(0)) { PH; phase_prologue(P, bid, nb, lds); }
#if DUP_PHASE == 100
    BAR(0);
    if (IN(0)) { PH; phase_prologue(P, bid, nb, lds); }
#endif
    BAR(0);
    for (int l = 0; l < DEPTH; ++l) {
        const int pb = 1 + l * NPH_L;
        if (IN(pb + 0)) { PH; phase_norm_mix(P, l, bid, nb, lds);
#if GATE_I8 && WQ_I8 && WOUT_I8 && PROJ_I8 && H16
#elif GATE_I8 && WQ_I8 && WOUT_I8 && PROJ_I8
            quant_all_rows(P, l, bid, nb);
#else
#if GATE_I8
            quant_wgate(P, l, bid, nb);
#endif
#if WQ_I8
            quant_rows_i8((const bf16*)(ws + WS_WQ) + (size_t)l * D * D, (unsigned char*)(ws + WS_WQ8) + (size_t)l * D * D, (float*)(ws + WS_SWQ) + (size_t)l * D, D, bid, nb);
#endif
#if WOUT_I8
            quant_rows_i8((const bf16*)(ws + WS_WOUT) + (size_t)l * D * D, (unsigned char*)(ws + WS_WO8) + (size_t)l * D * D, (float*)(ws + WS_SWO) + (size_t)l * D, D, bid, nb);
#endif
#if PROJ_I8
            quant_rows_i8((const bf16*)(ws + WS_WINTM) + (size_t)l * NTM * 128 * D, (unsigned char*)(ws + WS_WIN8TM) + (size_t)l * NTM * 128 * D, (float*)(ws + WS_SWTM) + (size_t)l * NTM * 128, NTM * 128, bid, nb);
            quant_rows_i8((const bf16*)(ws + WS_WINVT) + (size_t)l * NVT * 128 * D, (unsigned char*)(ws + WS_WIN8VT) + (size_t)l * NVT * 128 * D, (float*)(ws + WS_SWVT) + (size_t)l * NVT * 128, NVT * 128, bid, nb);
#endif
#endif
        }
#if DUP_PHASE == 300
        if (IN(pb + 0)) { PH; phase_norm_mix(P, l, bid, nb, lds); }
#endif
        BAR(pb + 0);
        if (IN(pb + 1)) { PH;
            const bf16* act = (const bf16*)(ws + WS_ACT0);
            const bf16* wtm = (const bf16*)(ws + WS_WINTM) + (size_t)l * NTM * 128 * D; const bf16* wvt = (const bf16*)(ws + WS_WINVT) + (size_t)l * NVT * 128 * D;
#if FAST_GEMM
#if PROJ_I8
            pg8::Gemm g{act, (const bf16*)(ws + WS_WIN8TM + (size_t)l * NTM * 128 * D), D / 2, (const bf16*)(ws + WS_WIN8VT + (size_t)l * NVT * 128 * D), act, 64, 17}; pg8::DualOrder so{64, 17, 7, 64, nb, bid};
            pg8::EpiProjI8 e{(bf16*)(ws + WS_TM), (bf16*)(ws + WS_VT), (const float*)(ws + WS_SA), (const float*)(ws + WS_SWTM) + (size_t)l * NTM * 128, (const float*)(ws + WS_SWVT) + (size_t)l * NVT * 128};
            pg8::gemm_phase(lds, g, so, e);
#else
            pg8::Gemm g{act, wtm, D, wvt, act, 64, 17}; pg8::DualOrder so{64, 17, 7, 64, nb, bid}; pg8::EpiProj e{(bf16*)(ws + WS_TM), (bf16*)(ws + WS_VT)};
            pg8::gemm_phase(lds, g, so, e);
#endif
#if DUP_PHASE == 200
            __syncthreads(); pg8::gemm_phase(lds, g, so, e);
#endif
#else
            EpiProjTM e1{(bf16*)(ws + WS_TM)}; phase_gemm_naive(act, wtm, D, T, NTM * 128, e1, bid, nb, lds);
            EpiProjVT e2{(bf16*)(ws + WS_VT)}; phase_gemm_naive(wvt, act, D, NVT * 128, T, e2, bid, nb, lds);
#endif
        }
        BAR(pb + 1);
#if FAST_PREP
        if (IN(pb + 2)) { PH; pf::phase_prep(P, l, bid, nb, lds); }
#if DUP_PHASE == 300
        if (IN(pb + 2)) { PH; pf::phase_prep(P, l, bid, nb, lds); }
#endif
#else
        if (IN(pb + 2)) { PH; phase_prep_naive(P, l, bid, nb); }
#endif
        BAR(pb + 2);
#if FAST_ATTN
        if (IN(pb + 3)) { PH; fa::phase_attn(P, l, lds); }
#if DUP_PHASE == 3
        BAR(pb + 3);
        if (IN(pb + 3)) { PH; if (bid == 0 && TID() == 0) ((unsigned*)(P.ws + WS_CTL))[8192 + 64 * l] = 0u; }
        BAR(pb + 3);
        if (IN(pb + 3)) { PH; fa::phase_attn(P, l, lds); }
#endif
        BAR(pb + 3);
#else
        if (IN(pb + 3)) { PH; phase_attn_naive1(P, bid, nb, lds); }
        BAR(pb + 3);
        if (IN(pb + 4)) { PH; phase_attn_naive2(P, bid, nb, lds); }
#endif
#if !FAST_ATTN
        BAR(pb + 4);
#endif
        if (IN(pb + 5)) { PH; phase_ynorm(P, bid, nb); }
#if DUP_PHASE == 300
        if (IN(pb + 5)) { PH; phase_ynorm(P, bid, nb); }
#endif
        BAR(pb + 5);
        if (IN(pb + 6)) { PH;
#if FAST_GEMM
#if WOUT_I8
            pg8::Gemm g{(const bf16*)(ws + WS_ACT2), (const bf16*)(ws + WS_WO8 + (size_t)l * D * D), D / 2, nullptr, nullptr, 1 << 30, 1 << 30}; pg8::StaticOrder so; so.init(T, D, nb, bid);
#if H16
            pg8::EpiResidI8 e{l == 0 ? P.in[I_X] : nullptr, (float*)(ws + WS_H16), (const float*)(ws + WS_SY), (const float*)(ws + WS_SWO) + (size_t)l * D}; pg8::gemm_phase(lds, g, so, e); }
#else
            pg8::EpiResidI8 e{l == 0 ? P.in[I_X] : P.out, P.out, (const float*)(ws + WS_SY), (const float*)(ws + WS_SWO) + (size_t)l * D}; pg8::gemm_phase(lds, g, so, e); }
#endif
#else
            pg8::Gemm g{(const bf16*)(ws + WS_ACT2), (const bf16*)(ws + WS_WOUT) + (size_t)l * D * D, D, nullptr, nullptr, 1 << 30, 1 << 30}; pg8::StaticOrder so; so.init(T, D, nb, bid);
            pg8::EpiResidT e{l == 0 ? P.in[I_X] : P.out, P.out}; pg8::gemm_phase(lds, g, so, e); }
#endif
#else
            EpiResid e{l == 0 ? P.in[I_X] : P.out, P.out};
            phase_gemm_naive((const bf16*)(ws + WS_ACT2), (const bf16*)(ws + WS_WOUT) + (size_t)l * D * D, D, T, D, e, bid, nb, lds); }
#endif
        BAR(pb + 6);
#if H16
        if (IN(pb + 7)) { PH; phase_norm<true>(ws + WS_H16, P.in[I_LNFFN] + (size_t)l * D, nullptr, bid, nb, (unsigned char*)(ws + WS_XF8), (float*)(ws + WS_SXF)); }
#else
        if (IN(pb + 7)) { PH; phase_norm(P.out, P.in[I_LNFFN] + (size_t)l * D, (bf16*)(ws + WS_ACT0), bid, nb, WQ_I8 ? (unsigned char*)(ws + WS_XF8) : nullptr, (float*)(ws + WS_SXF)); }
#endif
#if DUP_PHASE == 300
        if (IN(pb + 7)) { PH; phase_norm(P.out, P.in[I_LNFFN] + (size_t)l * D, (bf16*)(ws + WS_ACT0), bid, nb); }
#endif
        BAR(pb + 7);
        if (IN(pb + 8)) { PH;
#if FAST_GEMM
#if WQ_I8
            { pg8::Gemm g{(const bf16*)(ws + WS_XF8), (const bf16*)(ws + WS_WQ8 + (size_t)l * D * D), D / 2, nullptr, nullptr, 1 << 30, 1 << 30}; pg8::StaticOrder so; so.init(T, D, nb, bid);
              pg8::EpiStoreI8 e{(bf16*)(ws + WS_ACT1), (const float*)(ws + WS_SXF), (const float*)(ws + WS_SWQ) + (size_t)l * D}; pg8::gemm_phase(lds, g, so, e);
#else
            { pg8::Gemm g{(const bf16*)(ws + WS_ACT0), (const bf16*)(ws + WS_WQ) + (size_t)l * D * D, D, nullptr, nullptr, 1 << 30, 1 << 30}; pg8::StaticOrder so; so.init(T, D, nb, bid);
              pg8::EpiStoreT e{(bf16*)(ws + WS_ACT1)}; pg8::gemm_phase(lds, g, so, e);
#endif
#if DUP_PHASE == 200
              __syncthreads(); pg8::gemm_phase(lds, g, so, e);
#endif
            }
            { pg8::Gemm g{(const bf16*)(ws + WS_P) + (size_t)l * T * PLE, (const bf16*)(ws + WS_WPROJ) + (size_t)l * D * PLE, PLE, nullptr, nullptr, 1 << 30, 1 << 30}; pg8::StaticOrder so; so.init(T, D, nb, bid);
              pg8::EpiStoreT e{(bf16*)(ws + WS_ACT3)}; pg8::gemm_phase(lds, g, so, e); }
#else
            EpiStoreBf16 e{(bf16*)(ws + WS_ACT1)}; phase_gemm_naive((const bf16*)(ws + WS_ACT0), (const bf16*)(ws + WS_WQ) + (size_t)l * D * D, D, T, D, e, bid, nb, lds);
            EpiStoreBf16 e2{(bf16*)(ws + WS_ACT3)}; phase_gemm_naive((const bf16*)(ws + WS_P) + (size_t)l * T * PLE, (const bf16*)(ws + WS_WPROJ) + (size_t)l * D * PLE, PLE, T, D, e2, bid, nb, lds);
#endif
        }
        BAR(pb + 8);
#if FAST_SELECT
        if (IN(pb + 9)) { PH; ps::phase_select(P, l, bid, nb, lds); }
#if DUP_PHASE == 300
        if (IN(pb + 9)) { PH; ps::phase_select(P, l, bid, nb, lds); }
#endif
#else
        if (IN(pb + 9)) { PH; phase_peer_select_naive(P, l, bid, nb, lds); }
#endif
#if DUP_PHASE == 9
        BAR(pb + 9);
        if (IN(pb + 9)) { PH; phase_peer_select_naive(P, l, bid, nb, lds); }
#endif
        BAR(pb + 9);
#if PEER_SLICED
        if (IN(pb + 10)) { PH; pz::phase_sliced<0>(P, l); }
        BAR(pb + 10);
        if (IN(pb + 10)) { PH; pz::phase_weights(P, l, bid, nb); }
        BAR(pb + 10);
        if (IN(pb + 10)) { PH; pz::phase_sliced<1>(P, l); }
        BAR(pb + 10);
#if GATE_I8
        if (IN(pb + 10)) { PH; phase_norm_i8<H16 != 0>(H16 ? (const void*)(ws + WS_H16) : (const void*)P.out, P.in[I_LNPLE] + (size_t)l * D, (unsigned char*)(ws + WS_ACT2), (float*)(ws + WS_SHN), bid, nb); }
#else
        if (IN(pb + 10)) { PH; phase_norm(P.out, P.in[I_LNPLE] + (size_t)l * D, (bf16*)(ws + WS_ACT2), bid, nb); }
#endif
        BAR(pb + 10);
#else
        if (IN(pb + 10)) { PH; phase_peer_apply3(P, l, bid, nb); }
        BAR(pb + 10);
#endif
        if (IN(pb + 11)) { PH;
#if FAST_GEMM
#if GATE_I8
            pg8::Gemm g{(const bf16*)(ws + WS_ACT2), (const bf16*)(ws + WS_WG8 + (size_t)l * D * D), D / 2, nullptr, nullptr, 1 << 30, 1 << 30}; pg8::StaticOrder so; so.init(T, D, nb, bid);
            pg8::EpiPleGateI8 e{H16 ? (float*)(ws + WS_H16) : P.out, (const bf16*)(ws + WS_ACT3), (const float*)(ws + WS_SHN), (const float*)(ws + WS_SWG) + (size_t)l * D}; pg8::gemm_phase(lds, g, so, e); }
#else
            pg8::Gemm g{(const bf16*)(ws + WS_ACT2), (const bf16*)(ws + WS_WGATE) + (size_t)l * D * D, D, nullptr, nullptr, 1 << 30, 1 << 30}; pg8::StaticOrder so; so.init(T, D, nb, bid);
            pg8::EpiPleGateT e{P.out, (const bf16*)(ws + WS_ACT3)}; pg8::gemm_phase(lds, g, so, e); }
#endif
#else
            EpiPleGate e{P.out, (const bf16*)(ws + WS_ACT3)};
            phase_gemm_naive((const bf16*)(ws + WS_ACT2), (const bf16*)(ws + WS_WGATE) + (size_t)l * D * D, D, T, D, e, bid, nb, lds); }
#endif
        BAR(pb + 11);
    }
#if DUP_PHASE == 400
    for (int zz = 0; zz < 20; ++zz) xcd_barrier(bar);
#endif
    if (IN(NPHASES - 1)) { PH; phase_final(P, bid, nb); }
#undef IN
#undef BAR
#undef PH
}

#ifndef MK_LAUNCHES
#define MK_LAUNCHES 1
#endif
extern "C" void kernel_launch(void* const* d_in, const int* in_sizes, int n_in, void* d_out, int out_size, void* d_ws, size_t ws_size, hipStream_t stream) {
    static int grid = 0;
    if (grid == 0) {
        if (n_in != 19 || out_size != T * D || ws_size < WS_END) { fprintf(stderr, "kernel_launch: unexpected shapes (n_in %d out %d ws %zu need %zu)\n", n_in, out_size, ws_size, (size_t)WS_END); grid = -1; return; }
        int dev = 0, cus = 0, per_cu = 0;
        if (hipGetDevice(&dev) != hipSuccess || hipDeviceGetAttribute(&cus, hipDeviceAttributeMultiprocessorCount, dev) != hipSuccess) { grid = -1; return; }
        if (hipFuncSetAttribute((const void*)mk_fwd, hipFuncAttributeMaxDynamicSharedMemorySize, LDS_BYTES) != hipSuccess) { fprintf(stderr, "kernel_launch: hipFuncSetAttribute failed\n"); grid = -1; return; }
        if (hipOccupancyMaxActiveBlocksPerMultiprocessor(&per_cu, (const void*)mk_fwd, 512, LDS_BYTES) != hipSuccess || per_cu < 1) { fprintf(stderr, "kernel_launch: occupancy query reports %d blocks per CU\n", per_cu); }
        (void)hipGetLastError();
        grid = cus;
    }
    if (grid < 0) return;
    (void)hipMemsetAsync((char*)d_ws + WS_CTL, 0, CTL_USED_BYTES, stream);
    Args a{};
    for (int i = 0; i < 19; ++i) a.P.in[i] = (const float*)d_in[i];
    a.P.out = (float*)d_out; a.P.ws = (unsigned char*)d_ws;
#if MK_LAUNCHES == 1
    a.ph_lo = 0; a.ph_hi = NPHASES;
    hipLaunchKernelGGL(mk_fwd, dim3(grid), dim3(512), LDS_BYTES, stream, a);
#else
    for (int p = 0; p < NPHASES; ++p) { a.ph_lo = p; a.ph_hi = p + 1; hipLaunchKernelGGL(mk_fwd, dim3(grid), dim3(512), LDS_BYTES, stream, a); }
#endif
}
```

```cpp
#include <hip/hip_runtime.h>
#ifndef WQ_I8
#define WQ_I8 1
#endif
#ifndef WOUT_I8
#define WOUT_I8 1
#endif
#ifndef PROJ_I8
#define PROJ_I8 1
#endif
#ifndef GATE_I8
#define GATE_I8 1
#endif
#ifndef FA_STAGGER
#define FA_STAGGER 0
#endif
#ifndef PEER_SLICED
#define PEER_SLICED 1
#ifndef H16
#define H16 1
#endif
#ifndef PEER_A_I8
#define PEER_A_I8 1
#endif
#endif
#ifndef DUP_PHASE
#define DUP_PHASE 0
#endif
#include <cstdio>
#include <cstdint>

#define GAS __attribute__((address_space(1)))
#define LAS __attribute__((address_space(3)))
typedef unsigned short bf16;
typedef unsigned v4u __attribute__((ext_vector_type(4)));
typedef unsigned v2u __attribute__((ext_vector_type(2)));
typedef float f32x4 __attribute__((ext_vector_type(4)));

constexpr int NB = 8, S = 2048, T = NB * S, D = 2048, DEPTH = 2, HD = 128, PROJ = 6162;
constexpr int NTM = 34, NVT = 14;
constexpr int TM_A_Q = 0, TM_A_K = 6, TM_B_Q = 12, TM_B_KC = 18, TM_B_VC = 20, TM_B_KS = 22, TM_B_KW = 24, TM_C_Q = 26, TM_C_K = 30;
constexpr int VT_A_V = 0, VT_B_VS = 6, VT_B_VW = 8, VT_C_V = 10;
constexpr int GATE_COL0 = 4608;
constexpr int PLE = 256, NEXP = 16384;
constexpr float EPS = 1e-6f;
constexpr float QK_SCALE = 0.08838834764831845f;
#define NEG_INF (-__builtin_inff())

__host__ __device__ constexpr int tm_col0(int s) {
    return s < 6 ? 128 * s : s < 12 ? 768 + 128 * (s - 6) : s < 18 ? 2304 + 128 * (s - 12) : s < 20 ? 3072 + 128 * (s - 18) : s < 22 ? 3328 + 128 * (s - 20)
         : s < 24 ? 3584 + 128 * (s - 22) : s < 26 ? 4096 + 128 * (s - 24) : s < 30 ? 4626 + 128 * (s - 26) : 5138 + 128 * (s - 30);
}
__host__ __device__ constexpr int vt_col0(int v) {
    return v < 6 ? 1536 + 128 * v : v < 8 ? 3840 + 128 * (v - 6) : v < 10 ? 4352 + 128 * (v - 8) : 5650 + 128 * (v - 10);
}

constexpr size_t MiB = 1u << 20;
constexpr size_t align_up(size_t x) { return (x + 255) & ~(size_t)255; }
constexpr size_t WS_CTL = 0, CTL_BYTES = 1 * MiB, CTL_USED_BYTES = 128 * 1024;
constexpr size_t SZ_WINTM = (size_t)NTM * 128 * D * 2, SZ_WINVT = (size_t)NVT * 128 * D * 2, SZ_WSQ = (size_t)D * D * 2, SZ_WPROJ = (size_t)D * PLE * 2;
constexpr size_t WS_WINTM = WS_CTL + CTL_BYTES;
constexpr size_t WS_WINVT = WS_WINTM + DEPTH * SZ_WINTM;
constexpr size_t WS_WOUT = WS_WINVT + DEPTH * SZ_WINVT;
constexpr size_t WS_WQ = WS_WOUT + DEPTH * SZ_WSQ;
constexpr size_t WS_WGATE = WS_WQ + DEPTH * SZ_WSQ;
constexpr size_t WS_WPROJ = WS_WGATE + DEPTH * SZ_WSQ;
constexpr size_t WS_WG = WS_WPROJ + DEPTH * SZ_WPROJ;
constexpr size_t WS_KEYS = align_up(WS_WG + (size_t)DEPTH * 18 * D * 4);
constexpr size_t WS_CWT = WS_KEYS + (size_t)DEPTH * 16 * 128 * 128 * 2;
constexpr size_t WS_U = WS_CWT + (size_t)DEPTH * 2 * 128 * 4096 * 2;
constexpr size_t WS_V = WS_U + (size_t)DEPTH * NEXP * D;
constexpr size_t WS_SU = WS_V + (size_t)DEPTH * NEXP * D;
constexpr size_t WS_SV = WS_SU + (size_t)DEPTH * NEXP * 4;
constexpr size_t WS_P = WS_SV + (size_t)DEPTH * NEXP * 4;
constexpr size_t WS_TM = WS_P + (size_t)DEPTH * T * PLE * 2;
constexpr size_t WS_VT = WS_TM + (size_t)NB * NTM * S * 128 * 2;
constexpr size_t WS_KCMP = WS_VT + (size_t)NB * NVT * S * 128 * 2;
constexpr size_t WS_VCMPT = WS_KCMP + (size_t)NB * 2 * 128 * 128 * 2;
constexpr size_t WS_KMEAN = WS_VCMPT + (size_t)NB * 2 * 128 * 128 * 2;
constexpr size_t WS_GATES = WS_KMEAN + (size_t)NB * 8 * 4 * 128 * 4;
constexpr size_t WS_SS = align_up(WS_GATES + (size_t)T * 18 * 4);
constexpr size_t WS_OCMP = WS_SS + (size_t)T * 16 * 4;
constexpr size_t WS_SEL = WS_OCMP + (size_t)T * 768 * 4;
constexpr size_t WS_EXP = WS_SEL + (size_t)T * 16 * 4;
constexpr size_t WS_GW = WS_EXP + (size_t)T * 128 * 4;
constexpr size_t SZ_ACT = (size_t)T * D * 2;
constexpr size_t WS_ACT0 = WS_GW + (size_t)T * 128 * 4;
constexpr size_t WS_ACT1 = WS_ACT0 + SZ_ACT;
constexpr size_t WS_ACT2 = WS_ACT1 + SZ_ACT;
constexpr size_t WS_ACT3 = WS_ACT2 + SZ_ACT;
constexpr size_t WS_TBL = WS_ACT3 + SZ_ACT;
constexpr size_t WS_PD = WS_TBL + (size_t)16 * 3 * 2304 * 4;
constexpr size_t WS_H16 = WS_PD + (size_t)16 * T * 128 * 2;
constexpr size_t WS_WV = WS_PD + (size_t)16 * T * 128 * 4;
constexpr size_t WS_WG8 = WS_WV + (size_t)T * 128 * 4;
constexpr size_t WS_SWG = WS_WG8 + (size_t)DEPTH * D * D;
constexpr size_t WS_SHN = WS_SWG + (size_t)DEPTH * D * 4;
constexpr size_t WS_WIN8TM = WS_SHN + (size_t)T * 4;
constexpr size_t WS_WIN8VT = WS_WIN8TM + (size_t)DEPTH * NTM * 128 * D;
constexpr size_t WS_SWTM = WS_WIN8VT + (size_t)DEPTH * NVT * 128 * D;
constexpr size_t WS_SWVT = WS_SWTM + (size_t)DEPTH * NTM * 128 * 4;
constexpr size_t WS_SA = WS_SWVT + (size_t)DEPTH * NVT * 128 * 4;
constexpr size_t WS_XF8 = WS_SA + (size_t)T * 4;
constexpr size_t WS_SXF = WS_XF8 + (size_t)T * D;
constexpr size_t WS_WQ8 = WS_SXF + (size_t)T * 4;
constexpr size_t WS_SWQ = WS_WQ8 + (size_t)DEPTH * D * D;
constexpr size_t WS_WO8 = WS_SWQ + (size_t)DEPTH * D * 4;
constexpr size_t WS_SWO = WS_WO8 + (size_t)DEPTH * D * D;
constexpr size_t WS_SY = WS_SWO + (size_t)DEPTH * D * 4;
constexpr size_t WS_POSW = WS_SY + (size_t)T * 4;
constexpr size_t WS_END = WS_POSW + (size_t)DEPTH * 2 * 32 * 128 * 4;
static_assert(!H16 || (WQ_I8 && WOUT_I8 && PROJ_I8 && GATE_I8 && PEER_A_I8 && PEER_SLICED), "the fp16 residual stream is wired into the int8 paths only");
static_assert(WS_END <= (size_t)1024 * MiB, "workspace map exceeds 1 GiB");

__device__ __forceinline__ float bf2f(unsigned v) { return __uint_as_float(v << 16); }
__device__ __forceinline__ unsigned f2bf(float f) { unsigned u = __float_as_uint(f); return (u + 0x7fffu + ((u >> 16) & 1u)) >> 16; }
typedef __bf16 pkbf2_t __attribute__((ext_vector_type(2)));
typedef float pkf2_t __attribute__((ext_vector_type(2)));
__device__ __forceinline__ unsigned pk2(float lo, float hi) { const pkf2_t v = {lo, hi}; return __builtin_bit_cast(unsigned, __builtin_convertvector(v, pkbf2_t)); }
__device__ __forceinline__ unsigned pack_i8x4(float a, float b, float c, float d, float S) {
    const float M = 12582912.0f;
    const unsigned ya = __float_as_uint(__builtin_fmaf(a, S, M)), yb = __float_as_uint(__builtin_fmaf(b, S, M)), yc = __float_as_uint(__builtin_fmaf(c, S, M)), yd = __float_as_uint(__builtin_fmaf(d, S, M));
    return __builtin_amdgcn_perm(yb, ya, 0x0c0c0400u) | __builtin_amdgcn_perm(yd, yc, 0x04000c0cu);
}
typedef _Float16 h4_t __attribute__((ext_vector_type(4)));
typedef _Float16 h2_t __attribute__((ext_vector_type(2)));
__device__ __forceinline__ f32x4 ldh4(const GAS _Float16* p) { const h4_t v = *(const GAS h4_t*)p; return (f32x4){(float)v.x, (float)v.y, (float)v.z, (float)v.w}; }
__device__ __forceinline__ void sth4(GAS _Float16* p, f32x4 v) { *(GAS h4_t*)p = (h4_t){(_Float16)v.x, (_Float16)v.y, (_Float16)v.z, (_Float16)v.w}; }
template <bool SRC16> __device__ __forceinline__ f32x4 ldrow4(const void* base, size_t idx) { if (SRC16) return ldh4((const GAS _Float16*)base + idx); return *(const GAS f32x4*)((const GAS float*)base + idx); }
template <int M> __device__ __forceinline__ int swz_xor_i(int v) { return __builtin_amdgcn_ds_swizzle(v, (M << 10) | 0x1F); }
template <int M> __device__ __forceinline__ float swz_xor(float v) { return __builtin_bit_cast(float, swz_xor_i<M>(__builtin_bit_cast(int, v))); }
__device__ __forceinline__ void halves_i(int v, int& lo, int& hi) { const auto pr = __builtin_amdgcn_permlane32_swap((unsigned)v, (unsigned)v, false, false); lo = (int)pr[0]; hi = (int)pr[1]; }
__device__ __forceinline__ void halves(float v, float& lo, float& hi) { int a, b; halves_i(__builtin_bit_cast(int, v), a, b); lo = __builtin_bit_cast(float, a); hi = __builtin_bit_cast(float, b); }
__device__ __forceinline__ float wave_sum(float v) {
    v += swz_xor<1>(v); v += swz_xor<2>(v); v += swz_xor<4>(v); v += swz_xor<8>(v); v += swz_xor<16>(v);
    float lo, hi; halves(v, lo, hi); return lo + hi;
}
__device__ __forceinline__ float wave_max(float v) {
    v = fmaxf(v, swz_xor<1>(v)); v = fmaxf(v, swz_xor<2>(v)); v = fmaxf(v, swz_xor<4>(v)); v = fmaxf(v, swz_xor<8>(v)); v = fmaxf(v, swz_xor<16>(v));
    float lo, hi; halves(v, lo, hi); return fmaxf(lo, hi);
}
__device__ __forceinline__ int wave_min_i(int v) {
    int t;
    t = swz_xor_i<1>(v); v = t < v ? t : v; t = swz_xor_i<2>(v); v = t < v ? t : v; t = swz_xor_i<4>(v); v = t < v ? t : v; t = swz_xor_i<8>(v); v = t < v ? t : v; t = swz_xor_i<16>(v); v = t < v ? t : v;
    int lo, hi; halves_i(v, lo, hi); return lo < hi ? lo : hi;
}
__device__ __forceinline__ unsigned wave_or(unsigned v) {
    int x = (int)v; x |= swz_xor_i<1>(x); x |= swz_xor_i<2>(x); x |= swz_xor_i<4>(x); x |= swz_xor_i<8>(x); x |= swz_xor_i<16>(x);
    int lo, hi; halves_i(x, lo, hi); return (unsigned)(lo | hi);
}
__device__ __forceinline__ float lane_get(float v, int src) { return __builtin_bit_cast(float, __builtin_amdgcn_ds_bpermute(src << 2, __builtin_bit_cast(int, v))); }
__device__ __forceinline__ int lane_get_i(int v, int src) { return __builtin_amdgcn_ds_bpermute(src << 2, v); }
__device__ __forceinline__ int rel_bucket(int d) {
    if (d < 16) return d < 0 ? 0 : d;
    return 16 + (d >= 21) + (d >= 27) + (d >= 35) + (d >= 46) + (d >= 59) + (d >= 77) + (d >= 99) + (d >= 128) + (d >= 166) + (d >= 216) + (d >= 280) + (d >= 363) + (d >= 470) + (d >= 609) + (d >= 790);
}
#define WAVE_LDS_SYNC() do { asm volatile("s_waitcnt lgkmcnt(0)" ::: "memory"); __builtin_amdgcn_wave_barrier(); } while (0)

struct Params {
    const float* in[19];
    float* out;
    unsigned char* ws;
};
__device__ __forceinline__ int launder_i(int v) { asm volatile("" : "+v"(v)); return v; }
__device__ __forceinline__ int launder_s(int v) { asm volatile("" : "+s"(v)); return v; }
template <class Tp> __device__ __forceinline__ Tp* launder_p(Tp* p) { asm volatile("" : "+s"(p)); return p; }
__device__ __forceinline__ Params fresh(const Params& P) { Params Q;
#pragma unroll
    for (int i = 0; i < 19; ++i) Q.in[i] = launder_p(P.in[i]);
    Q.out = launder_p(P.out); Q.ws = launder_p(P.ws); return Q; }
#define TID() launder_i((int)threadIdx.x)
enum { I_X = 0, I_P, I_LNMIX, I_WIN, I_CMPWK, I_CMPWV, I_CMPPOS, I_OUTNORM, I_WOUT, I_RELBIAS, I_LNFFN, I_PEERWQ, I_PEERKEYS, I_PEERU, I_PEERV, I_LNPLE, I_PLEGATE, I_PLEPROJ, I_LNFINAL };

__device__ __forceinline__ void transpose_tile(const float* src, int ldsrc, int scol0, int k0, bf16* dst, int dstride, int drow0, const float* scale, LAS float* scr, int lane) {
    const bool al16 = ((scol0 & 3) == 0) && ((ldsrc & 3) == 0);
    if (al16) {
#pragma unroll
        for (int i = 0; i < 8; ++i) { const int kk = 8 * i + (lane >> 3), c4 = (lane & 7) * 4; f32x4 v = *(const GAS f32x4*)((const GAS float*)src + (size_t)(k0 + kk) * ldsrc + scol0 + c4);
            if (scale) { const float sc_ = scale[k0 + kk]; v = v * sc_; }
            scr[kk * 33 + c4] = v.x; scr[kk * 33 + c4 + 1] = v.y; scr[kk * 33 + c4 + 2] = v.z; scr[kk * 33 + c4 + 3] = v.w; }
    } else if (((scol0 | ldsrc) & 1) == 0) {
        typedef float f32x2 __attribute__((ext_vector_type(2)));
#pragma unroll
        for (int i = 0; i < 16; ++i) { const int kk = 4 * i + (lane >> 4), c2 = (lane & 15) * 2; f32x2 v = *(const GAS f32x2*)((const GAS float*)src + (size_t)(k0 + kk) * ldsrc + scol0 + c2);
            if (scale) { const float sc_ = scale[k0 + kk]; v = v * sc_; }
            scr[kk * 33 + c2] = v.x; scr[kk * 33 + c2 + 1] = v.y; }
    } else {
#pragma unroll 8
        for (int i = 0; i < 32; ++i) { const int kk = 2 * i + (lane >> 5); float v = src[(size_t)(k0 + kk) * ldsrc + scol0 + (lane & 31)]; if (scale) v *= scale[k0 + kk]; scr[kk * 33 + (lane & 31)] = v; }
    }
    WAVE_LDS_SYNC();
    const int c = lane & 7;
#pragma unroll
    for (int j = 0; j < 4; ++j) { const int n = (lane >> 3) + 8 * j; const LAS float* s = scr + (8 * c) * 33 + n;
        v4u o; o.x = pk2(s[0 * 33], s[1 * 33]); o.y = pk2(s[2 * 33], s[3 * 33]); o.z = pk2(s[4 * 33], s[5 * 33]); o.w = pk2(s[6 * 33], s[7 * 33]);
        *(v4u*)(dst + (size_t)(drow0 + n) * dstride + k0 + 8 * c) = o; }
    WAVE_LDS_SYNC();
}
constexpr int TL_TM = 32 * NTM * 4, TL_VT = 32 * NVT * 4, TL_SQ = 32 * 64, TL_PROJ = 4 * 64, TL_CW = 64 * 4;
constexpr int TL_LAYER = TL_TM + TL_VT + 3 * TL_SQ + TL_PROJ + 2 * TL_CW;
__device__ __forceinline__ void prologue_tile(const Params& P, int item, LAS float* scr, int lane) {
    const int l = item / TL_LAYER; int r = item % TL_LAYER;
    unsigned char* ws = P.ws;
    if (r < TL_TM) { const int nb = r / 32, kb = r % 32, slot = nb / 4, sub = nb % 4;
        transpose_tile(P.in[I_WIN] + (size_t)l * D * PROJ, PROJ, tm_col0(slot) + 32 * sub, 64 * kb, (bf16*)(ws + WS_WINTM) + (size_t)l * NTM * 128 * D, D, slot * 128 + 32 * sub, nullptr, scr, lane); return; }
    r -= TL_TM;
    if (r < TL_VT) { const int nb = r / 32, kb = r % 32, slot = nb / 4, sub = nb % 4;
        transpose_tile(P.in[I_WIN] + (size_t)l * D * PROJ, PROJ, vt_col0(slot) + 32 * sub, 64 * kb, (bf16*)(ws + WS_WINVT) + (size_t)l * NVT * 128 * D, D, slot * 128 + 32 * sub, nullptr, scr, lane); return; }
    r -= TL_VT;
    if (r < TL_SQ) { const int nb = r / 32, kb = r % 32;
        transpose_tile(P.in[I_WOUT] + (size_t)l * D * D, D, 32 * nb, 64 * kb, (bf16*)(ws + WS_WOUT) + (size_t)l * D * D, D, 32 * nb, P.in[I_OUTNORM] + (size_t)l * D, scr, lane); return; }
    r -= TL_SQ;
    if (r < TL_SQ) { const int nb = r / 32, kb = r % 32;
        transpose_tile(P.in[I_PEERWQ] + (size_t)l * D * D, D, 32 * nb, 64 * kb, (bf16*)(ws + WS_WQ) + (size_t)l * D * D, D, 32 * nb, nullptr, scr, lane); return; }
    r -= TL_SQ;
    if (r < TL_SQ) { const int nb = r / 32, kb = r % 32;
        transpose_tile(P.in[I_PLEGATE] + (size_t)l * D * D, D, 32 * nb, 64 * kb, (bf16*)(ws + WS_WGATE) + (size_t)l * D * D, D, 32 * nb, nullptr, scr, lane); return; }
    r -= TL_SQ;
    if (r < TL_PROJ) { const int nb = r / 4, kb = r % 4;
        transpose_tile(P.in[I_PLEPROJ] + (size_t)l * PLE * D, D, 32 * nb, 64 * kb, (bf16*)(ws + WS_WPROJ) + (size_t)l * D * PLE, PLE, 32 * nb, nullptr, scr, lane); return; }
    r -= TL_PROJ;
    { const int which = r / TL_CW; r %= TL_CW; const int nb = r / 64, kb = r % 64;
      transpose_tile((which ? P.in[I_CMPWV] : P.in[I_CMPWK]) + (size_t)l * 4096 * 128, 128, 32 * nb, 64 * kb, (bf16*)(ws + WS_CWT) + ((size_t)l * 2 + which) * 128 * 4096, 4096, 32 * nb, nullptr, scr, lane); }
}
__device__ __forceinline__ void cvt_f32_bf16(const float* src, bf16* dst, size_t n, size_t i0, size_t stride) {
    for (size_t i = i0 * 8; i < n; i += stride * 8) {
        const f32x4 a = *(const f32x4*)(src + i), b = *(const f32x4*)(src + i + 4);
        v4u o; o.x = pk2(a.x, a.y); o.y = pk2(a.z, a.w); o.z = pk2(b.x, b.y); o.w = pk2(b.z, b.w);
        *(v4u*)(dst + i) = o;
    }
}
__device__ __forceinline__ void phase_prologue(const Params& P, int bid, int nb, LAS unsigned char* lds) {
    const int tid = TID(), lane = tid & 63, wave = tid >> 6, nw = 8;
    LAS float* scr = (LAS float*)lds + wave * (64 * 33);
    for (int it = bid * nw + wave; it < DEPTH * TL_LAYER; it += nb * nw) prologue_tile(P, it, scr, lane);
    const size_t gi = (size_t)bid * 512 + tid, gs = (size_t)nb * 512;
    for (int row0 = (bid * nw + wave) * 2; row0 < 2 * DEPTH * NEXP; row0 += nb * nw * 2) {
        f32x4 v[2][2][4]; float am[2] = {0.f, 0.f};
#pragma unroll
        for (int u = 0; u < 2; ++u) { const int row = row0 + u; const int isv = row >= DEPTH * NEXP, rr = isv ? row - DEPTH * NEXP : row;
            const GAS float* src = (const GAS float*)(isv ? P.in[I_PEERV] : P.in[I_PEERU]) + (size_t)rr * D + lane * 16;
#pragma unroll
            for (int j = 0; j < 2; ++j)
#pragma unroll
                for (int q = 0; q < 4; ++q) v[u][j][q] = *(const GAS f32x4*)(src + j * 1024 + q * 4); }
#pragma unroll
        for (int u = 0; u < 2; ++u) { const int row = row0 + u; const int isv = row >= DEPTH * NEXP, rr = isv ? row - DEPTH * NEXP : row;
#pragma unroll
            for (int j = 0; j < 2; ++j)
#pragma unroll
                for (int q = 0; q < 4; ++q) am[u] = fmaxf(am[u], fmaxf(fmaxf(fabsf(v[u][j][q].x), fabsf(v[u][j][q].y)), fmaxf(fabsf(v[u][j][q].z), fabsf(v[u][j][q].w))));
            am[u] = wave_max(am[u]); const bool i8row = PEER_A_I8 && !isv; const float sc = am[u] > 0.f ? am[u] * (i8row ? 1.0f / 127.0f : 1.0f / 240.0f) : 1.0f, inv = 1.0f / sc;
            const int lyr = rr >= NEXP, ee = rr & (NEXP - 1);
            GAS unsigned char* dstb = (GAS unsigned char*)(P.ws + (isv ? WS_V : WS_U)) + (size_t)lyr * NEXP * D + (size_t)ee * 128;
#pragma unroll
            for (int j = 0; j < 2; ++j) { v4u o; int w;
                if (i8row) { o.x = pack_i8x4(v[u][j][0].x, v[u][j][0].y, v[u][j][0].z, v[u][j][0].w, inv); o.y = pack_i8x4(v[u][j][1].x, v[u][j][1].y, v[u][j][1].z, v[u][j][1].w, inv);
                             o.z = pack_i8x4(v[u][j][2].x, v[u][j][2].y, v[u][j][2].z, v[u][j][2].w, inv); o.w = pack_i8x4(v[u][j][3].x, v[u][j][3].y, v[u][j][3].z, v[u][j][3].w, inv); } else {
                w = __builtin_amdgcn_cvt_pk_fp8_f32(v[u][j][0].x * inv, v[u][j][0].y * inv, 0, false); w = __builtin_amdgcn_cvt_pk_fp8_f32(v[u][j][0].z * inv, v[u][j][0].w * inv, w, true); o.x = (unsigned)w;
                w = __builtin_amdgcn_cvt_pk_fp8_f32(v[u][j][1].x * inv, v[u][j][1].y * inv, 0, false); w = __builtin_amdgcn_cvt_pk_fp8_f32(v[u][j][1].z * inv, v[u][j][1].w * inv, w, true); o.y = (unsigned)w;
                w = __builtin_amdgcn_cvt_pk_fp8_f32(v[u][j][2].x * inv, v[u][j][2].y * inv, 0, false); w = __builtin_amdgcn_cvt_pk_fp8_f32(v[u][j][2].z * inv, v[u][j][2].w * inv, w, true); o.z = (unsigned)w;
                w = __builtin_amdgcn_cvt_pk_fp8_f32(v[u][j][3].x * inv, v[u][j][3].y * inv, 0, false); w = __builtin_amdgcn_cvt_pk_fp8_f32(v[u][j][3].z * inv, v[u][j][3].w * inv, w, true); o.w = (unsigned)w; }
#if PEER_SLICED
                { const int qc = lane + 64 * j; *(GAS v4u*)(dstb + (size_t)(qc >> 3) * NEXP * 128 + (qc & 7) * 16) = o; }
#else
                *(GAS v4u*)((GAS unsigned char*)(P.ws + (isv ? WS_V : WS_U)) + (size_t)rr * D + lane * 16 + j * 1024) = o;
#endif
            }
            if (lane == 0) ((GAS float*)(P.ws + (isv ? WS_SV : WS_SU)))[rr] = sc; }
    }
    cvt_f32_bf16(P.in[I_P], (bf16*)(P.ws + WS_P), (size_t)DEPTH * T * PLE, gi, gs);
    cvt_f32_bf16(P.in[I_PEERKEYS], (bf16*)(P.ws + WS_KEYS), (size_t)DEPTH * 16 * 128 * 128, gi, gs);
    bf16* wg = (bf16*)(P.ws + WS_WG);
    for (size_t i = gi; i < (size_t)DEPTH * 18 * D; i += gs) { const int l = (int)(i / (18 * D)), j = (int)((i / D) % 18), k = (int)(i % D); wg[i] = (bf16)f2bf(P.in[I_WIN][(size_t)l * D * PROJ + (size_t)k * PROJ + GATE_COL0 + j]); }
    float* tbl = (float*)(P.ws + WS_TBL);
    for (size_t i = gi; i < (size_t)16 * 3 * 2304; i += gs) { const int idx = (int)(i % 2304), kind = (int)((i / 2304) % 3), gh = (int)(i / (3 * 2304)); const int d = idx - 256; float v = -2e30f;
        if (d >= 0) { const float bias = P.in[I_RELBIAS][rel_bucket(d) * 16 + gh] * 1.4426950408889634f;
            if (kind == 0) v = bias;
            else if (kind == 1) { if (d <= 511) v = bias; }
            else { const int mult = (d <= 128 ? 1 : 0) + ((d & 3) == 0 && d <= 512 ? 1 : 0) + ((d & 15) == 0 ? 1 : 0); if (mult > 0) v = bias + (mult == 1 ? 0.f : mult == 2 ? 1.0f : 1.5849625007211562f); } }
        tbl[i] = v; }
    __syncthreads();
    { LAS float* red = (LAS float*)lds;
      for (int item = bid; item < DEPTH * 2 * 32; item += nb) { const int l = item >> 6, which = (item >> 5) & 1, kc = item & 31, e = tid & 127, kq = tid >> 7;
          const GAS float* w = (const GAS float*)(which ? P.in[I_CMPWV] : P.in[I_CMPWK]) + ((size_t)l * 4096 + kc * 128 + kq * 32) * 128 + e; const GAS float* pos = (const GAS float*)P.in[I_CMPPOS] + (size_t)l * 4096 + kc * 128 + kq * 32;
          float a = 0.f;
#pragma unroll 8
          for (int j = 0; j < 32; ++j) a = __builtin_fmaf(pos[j], w[(size_t)j * 128], a);
          red[tid] = a; __syncthreads();
          if (tid < 128) ((GAS float*)(P.ws + WS_POSW))[(size_t)item * 128 + tid] = (red[tid] + red[128 + tid]) + (red[256 + tid] + red[384 + tid]);
          __syncthreads(); } }
}

__device__ __forceinline__ float row_load_ss(const float* row, int lane, f32x4 (&v)[8]) {
    float s = 0.f;
#pragma unroll
    for (int j = 0; j < 8; ++j) { v[j] = *(const f32x4*)(row + (j * 64 + lane) * 4); s += v[j].x * v[j].x + v[j].y * v[j].y + v[j].z * v[j].z + v[j].w * v[j].w; }
    return wave_sum(s);
}
__device__ __forceinline__ void row_norm_store_bf16(f32x4 (&v)[8], float ss, const float* gain, bf16* orow, int lane, unsigned char* o8 = nullptr, float* sc8 = nullptr) {
    const float r = 1.0f / sqrtf(ss * (1.0f / D) + EPS); float am = 0.f;
#pragma unroll
    for (int j = 0; j < 8; ++j) { const f32x4 g = *(const f32x4*)(gain + (j * 64 + lane) * 4); v[j] = v[j] * r * g; am = fmaxf(am, fmaxf(fmaxf(fabsf(v[j].x), fabsf(v[j].y)), fmaxf(fabsf(v[j].z), fabsf(v[j].w))));
        if (orow) { v2u o; o.x = pk2(v[j].x, v[j].y); o.y = pk2(v[j].z, v[j].w); *(v2u*)(orow + (j * 64 + lane) * 4) = o; } }
    if (o8) { am = wave_max(am); const float S8 = am > 0.f ? 127.0f / am : 0.f;
#pragma unroll
        for (int j = 0; j < 8; ++j) *(GAS unsigned*)((GAS unsigned char*)o8 + (j * 64 + lane) * 4) = pack_i8x4(v[j].x, v[j].y, v[j].z, v[j].w, S8);
        if (lane == 0) *sc8 = am * (1.0f / 127.0f); }
}
typedef __bf16 bf2g_t __attribute__((ext_vector_type(2)));
__device__ __forceinline__ float dot2g(unsigned a, unsigned b, float c) { return __builtin_amdgcn_fdot2_f32_bf16(__builtin_bit_cast(bf2g_t, a), __builtin_bit_cast(bf2g_t, b), c, false); }
__device__ __forceinline__ void quant_all_rows(const Params& P, int l, int bid, int nb);
#if H16
__device__ __forceinline__ void phase_norm_mix(const Params& P, int l, int bid, int nb, LAS unsigned char* lds) {
    const int tid = TID(), lane = tid & 63, wave = tid >> 6, nw = 8;
    const GAS float* xsrc = (const GAS float*)P.in[I_X]; const GAS _Float16* hsrc = (const GAS _Float16*)(P.ws + WS_H16);
    GAS unsigned char* a8 = (GAS unsigned char*)(P.ws + WS_ACT0); GAS float* gates = (GAS float*)(P.ws + WS_GATES); GAS float* sa = (GAS float*)(P.ws + WS_SA);
    const GAS float* gain = (const GAS float*)P.in[I_LNMIX] + (size_t)l * D;
    { const GAS v4u* wsrc = (const GAS v4u*)((const GAS bf16*)(P.ws + WS_WG) + (size_t)l * 18 * D); LAS v4u* wl = (LAS v4u*)lds;
      v4u stg[9];
#pragma unroll
      for (int i = 0; i < 9; ++i) stg[i] = wsrc[tid + 512 * i];
      quant_all_rows(P, l, bid, nb);
#pragma unroll
      for (int i = 0; i < 9; ++i) wl[tid + 512 * i] = stg[i]; }
    __syncthreads();
    const LAS v2u* wl2 = (const LAS v2u*)lds;
    const int step = nb * nw;
    for (int t0 = bid * nw + wave; t0 < T; t0 += 4 * step) {
        v2u ab[4][8];
#pragma unroll
        for (int pr = 0; pr < 2; ++pr) {
            f32x4 v[2][8]; float ss[2] = {0.f, 0.f};
#pragma unroll
            for (int u = 0; u < 2; ++u) { const int t = t0 + (2 * pr + u) * step; const size_t tt = t < T ? t : t0;
                if (l == 0) {
#pragma unroll
                    for (int j = 0; j < 8; ++j) v[u][j] = *(const GAS f32x4*)(xsrc + tt * D + (j * 64 + lane) * 4);
                } else {
#pragma unroll
                    for (int j = 0; j < 8; ++j) v[u][j] = ldh4(hsrc + tt * D + (j * 64 + lane) * 4);
                } }
#pragma unroll
            for (int u = 0; u < 2; ++u) {
#pragma unroll
                for (int j = 0; j < 8; ++j) ss[u] += v[u][j].x * v[u][j].x + v[u][j].y * v[u][j].y + v[u][j].z * v[u][j].z + v[u][j].w * v[u][j].w;
                ss[u] = wave_sum(ss[u]); }
#pragma unroll
            for (int u = 0; u < 2; ++u) { const int t = t0 + (2 * pr + u) * step; const float r = 1.0f / sqrtf(ss[u] * (1.0f / D) + EPS); float am = 0.f;
#pragma unroll
                for (int j = 0; j < 8; ++j) { const f32x4 g = *(const GAS f32x4*)(gain + (j * 64 + lane) * 4); v[u][j] = v[u][j] * r * g;
                    ab[2 * pr + u][j].x = pk2(v[u][j].x, v[u][j].y); ab[2 * pr + u][j].y = pk2(v[u][j].z, v[u][j].w);
                    am = fmaxf(am, fmaxf(fmaxf(fabsf(v[u][j].x), fabsf(v[u][j].y)), fmaxf(fabsf(v[u][j].z), fabsf(v[u][j].w)))); }
                am = wave_max(am); const float S8 = am > 0.f ? 127.0f / am : 0.f;
                if (t < T) {
#pragma unroll
                    for (int j = 0; j < 8; ++j) *(GAS unsigned*)(a8 + (size_t)t * D + (j * 64 + lane) * 4) = pack_i8x4(v[u][j].x, v[u][j].y, v[u][j].z, v[u][j].w, S8);
                    if (lane == 0) sa[t] = am * (1.0f / 127.0f); } }
        }
        const int trow = t0 + (lane >> 4) * step;
#pragma unroll 2
        for (int c = 0; c < 18; ++c) { float s0 = 0.f, s1 = 0.f, s2 = 0.f, s3 = 0.f;
#pragma unroll
            for (int j = 0; j < 8; ++j) { const v2u w = wl2[c * (D / 4) + j * 64 + lane];
                s0 = dot2g(ab[0][j].x, w.x, s0); s0 = dot2g(ab[0][j].y, w.y, s0); s1 = dot2g(ab[1][j].x, w.x, s1); s1 = dot2g(ab[1][j].y, w.y, s1);
                s2 = dot2g(ab[2][j].x, w.x, s2); s2 = dot2g(ab[2][j].y, w.y, s2); s3 = dot2g(ab[3][j].x, w.x, s3); s3 = dot2g(ab[3][j].y, w.y, s3); }
            const auto p02 = __builtin_amdgcn_permlane32_swap(__builtin_bit_cast(unsigned, s0), __builtin_bit_cast(unsigned, s2), false, false);
            const auto p13 = __builtin_amdgcn_permlane32_swap(__builtin_bit_cast(unsigned, s1), __builtin_bit_cast(unsigned, s3), false, false);
            const float x0 = __builtin_bit_cast(float, (unsigned)p02[0]) + __builtin_bit_cast(float, (unsigned)p02[1]), x1 = __builtin_bit_cast(float, (unsigned)p13[0]) + __builtin_bit_cast(float, (unsigned)p13[1]);
            const auto q = __builtin_amdgcn_permlane16_swap(__builtin_bit_cast(unsigned, x0), __builtin_bit_cast(unsigned, x1), false, false);
            float y = __builtin_bit_cast(float, (unsigned)q[0]) + __builtin_bit_cast(float, (unsigned)q[1]);
            y += swz_xor<8>(y); y += swz_xor<4>(y); y += swz_xor<2>(y); y += swz_xor<1>(y);
            if ((lane & 15) == 0 && trow < T) gates[(size_t)trow * 18 + c] = 1.0f / (1.0f + __expf(-y)); }
    }
    __syncthreads();
}
#else
__device__ __forceinline__ void phase_norm_mix(const Params& P, int l, int bid, int nb, LAS unsigned char* lds) {
    const int tid = TID(), lane = tid & 63, wave = tid >> 6, nw = 8;
    const float* hsrc = l == 0 ? P.in[I_X] : P.out;
    bf16* a = (bf16*)(P.ws + WS_ACT0); float* gates = (float*)(P.ws + WS_GATES);
    { const GAS v4u* wsrc = (const GAS v4u*)((const GAS bf16*)(P.ws + WS_WG) + (size_t)l * 18 * D); LAS v4u* wl = (LAS v4u*)lds;
      for (int i = tid; i < 18 * D / 8; i += 512) wl[i] = wsrc[i]; }
    __syncthreads();
    const LAS v2u* wl2 = (const LAS v2u*)lds;
    for (int t = bid * nw + wave; t < T; t += nb * nw) {
        f32x4 v[8]; float ss;
#if H16
        if (l == 0) ss = row_load_ss(hsrc + (size_t)t * D, lane, v);
        else { float s_ = 0.f;
#pragma unroll
            for (int j = 0; j < 8; ++j) { v[j] = ldh4((const GAS _Float16*)(P.ws + WS_H16) + (size_t)t * D + (j * 64 + lane) * 4); s_ += v[j].x * v[j].x + v[j].y * v[j].y + v[j].z * v[j].z + v[j].w * v[j].w; }
            ss = wave_sum(s_); }
#else
        ss = row_load_ss(hsrc + (size_t)t * D, lane, v);
#endif
        const float r = 1.0f / sqrtf(ss * (1.0f / D) + EPS); v2u ab[8];
#pragma unroll
        for (int j = 0; j < 8; ++j) { const f32x4 g = *(const f32x4*)(P.in[I_LNMIX] + (size_t)l * D + (j * 64 + lane) * 4); v[j] = v[j] * r * g;
            ab[j].x = pk2(v[j].x, v[j].y); ab[j].y = pk2(v[j].z, v[j].w);
#if !PROJ_I8
            *(v2u*)(a + (size_t)t * D + (j * 64 + lane) * 4) = ab[j];
#endif
        }
#if PROJ_I8
        { float am = 0.f;
#pragma unroll
          for (int j = 0; j < 8; ++j) am = fmaxf(am, fmaxf(fmaxf(fabsf(v[j].x), fabsf(v[j].y)), fmaxf(fabsf(v[j].z), fabsf(v[j].w))));
          am = wave_max(am); const float S8 = am > 0.f ? 127.0f / am : 0.f;
#pragma unroll
          for (int j = 0; j < 8; ++j) *(GAS unsigned*)((GAS unsigned char*)a + (size_t)t * D + (j * 64 + lane) * 4) = pack_i8x4(v[j].x, v[j].y, v[j].z, v[j].w, S8);
          if (lane == 0) ((GAS float*)(P.ws + WS_SA))[t] = am * (1.0f / 127.0f); }
#endif
#pragma unroll 2
        for (int c = 0; c < 18; ++c) { float sacc = 0.f;
#pragma unroll
            for (int j = 0; j < 8; ++j) { const v2u w = wl2[c * (D / 4) + j * 64 + lane]; sacc = dot2g(ab[j].x, w.x, sacc); sacc = dot2g(ab[j].y, w.y, sacc); }
            const float sv_ = wave_sum(sacc); if (lane == 0) gates[(size_t)t * 18 + c] = 1.0f / (1.0f + __expf(-sv_)); }
    }
    __syncthreads();
}
#endif
template <bool SRC16 = false>
__device__ __forceinline__ void phase_norm(const void* src, const float* gain, bf16* dst, int bid, int nb, unsigned char* d8 = nullptr, float* s8 = nullptr) {
    const int tid = TID(), lane = tid & 63, wave = tid >> 6, nw = 8;
    const int step = nb * nw;
    int t = bid * nw + wave;
    for (; t + step < T; t += 2 * step) { f32x4 v0[8], v1[8];
#pragma unroll
        for (int j = 0; j < 8; ++j) { v0[j] = ldrow4<SRC16>(src, (size_t)t * D + (j * 64 + lane) * 4); v1[j] = ldrow4<SRC16>(src, (size_t)(t + step) * D + (j * 64 + lane) * 4); }
        float s0 = 0.f, s1 = 0.f;
#pragma unroll
        for (int j = 0; j < 8; ++j) { s0 += v0[j].x * v0[j].x + v0[j].y * v0[j].y + v0[j].z * v0[j].z + v0[j].w * v0[j].w; s1 += v1[j].x * v1[j].x + v1[j].y * v1[j].y + v1[j].z * v1[j].z + v1[j].w * v1[j].w; }
        s0 = wave_sum(s0); s1 = wave_sum(s1);
        row_norm_store_bf16(v0, s0, gain, dst ? dst + (size_t)t * D : nullptr, lane, d8 ? d8 + (size_t)t * D : nullptr, s8 + t); row_norm_store_bf16(v1, s1, gain, dst ? dst + (size_t)(t + step) * D : nullptr, lane, d8 ? d8 + (size_t)(t + step) * D : nullptr, s8 + t + step); }
    for (; t < T; t += step) { f32x4 v[8]; float s_ = 0.f;
#pragma unroll
        for (int j = 0; j < 8; ++j) { v[j] = ldrow4<SRC16>(src, (size_t)t * D + (j * 64 + lane) * 4); s_ += v[j].x * v[j].x + v[j].y * v[j].y + v[j].z * v[j].z + v[j].w * v[j].w; }
        row_norm_store_bf16(v, wave_sum(s_), gain, dst ? dst + (size_t)t * D : nullptr, lane, d8 ? d8 + (size_t)t * D : nullptr, s8 + t); }
}
__device__ __forceinline__ void phase_final(const Params& P, int bid, int nb) {
    const int tid = TID(), lane = tid & 63, wave = tid >> 6, nw = 8;
    const int step = nb * nw; int t = bid * nw + wave;
    for (; t + step < T; t += 2 * step) { f32x4 v0[8], v1[8]; GAS float* r0p = (GAS float*)P.out + (size_t)t * D; GAS float* r1p = (GAS float*)P.out + (size_t)(t + step) * D;
#pragma unroll
        for (int j = 0; j < 8; ++j) {
#if H16
            v0[j] = ldh4((const GAS _Float16*)(P.ws + WS_H16) + (size_t)t * D + (j * 64 + lane) * 4); v1[j] = ldh4((const GAS _Float16*)(P.ws + WS_H16) + (size_t)(t + step) * D + (j * 64 + lane) * 4);
#else
            v0[j] = *(const GAS f32x4*)(r0p + (j * 64 + lane) * 4); v1[j] = *(const GAS f32x4*)(r1p + (j * 64 + lane) * 4);
#endif
        }
        float s0 = 0.f, s1 = 0.f;
#pragma unroll
        for (int j = 0; j < 8; ++j) { s0 += v0[j].x * v0[j].x + v0[j].y * v0[j].y + v0[j].z * v0[j].z + v0[j].w * v0[j].w; s1 += v1[j].x * v1[j].x + v1[j].y * v1[j].y + v1[j].z * v1[j].z + v1[j].w * v1[j].w; }
        s0 = wave_sum(s0); s1 = wave_sum(s1);
        const float q0 = 1.0f / sqrtf(s0 * (1.0f / D) + EPS), q1 = 1.0f / sqrtf(s1 * (1.0f / D) + EPS);
#pragma unroll
        for (int j = 0; j < 8; ++j) { const f32x4 g = *(const f32x4*)(P.in[I_LNFINAL] + (j * 64 + lane) * 4); *(GAS f32x4*)(r0p + (j * 64 + lane) * 4) = v0[j] * q0 * g; *(GAS f32x4*)(r1p + (j * 64 + lane) * 4) = v1[j] * q1 * g; } }
    for (; t < T; t += step) { f32x4 v[8]; float* row = P.out + (size_t)t * D;
#if H16
        float s_ = 0.f;
#pragma unroll
        for (int j = 0; j < 8; ++j) { v[j] = ldh4((const GAS _Float16*)(P.ws + WS_H16) + (size_t)t * D + (j * 64 + lane) * 4); s_ += v[j].x * v[j].x + v[j].y * v[j].y + v[j].z * v[j].z + v[j].w * v[j].w; }
        const float ss = wave_sum(s_);
#else
        const float ss = row_load_ss(row, lane, v);
#endif
        const float r = 1.0f / sqrtf(ss * (1.0f / D) + EPS);
#pragma unroll
        for (int j = 0; j < 8; ++j) { const f32x4 g = *(const f32x4*)(P.in[I_LNFINAL] + (j * 64 + lane) * 4); *(f32x4*)(row + (j * 64 + lane) * 4) = v[j] * r * g; } }
}
__device__ __forceinline__ void phase_ynorm(const Params& P, int bid, int nb) {
    const int tid = TID(), lane = tid & 63, wave = tid >> 6, nw = 8;
    const GAS bf16* o = (const GAS bf16*)(P.ws + WS_ACT1); GAS bf16* y = (GAS bf16*)(P.ws + WS_ACT2); const GAS float* ss = (const GAS float*)(P.ws + WS_SS);
    const int step = nb * nw;
    for (int t0 = bid * nw + wave; t0 < T; t0 += 2 * step) {
        v4u w[2][4]; float sv[2];
#pragma unroll
        for (int u = 0; u < 2; ++u) { const int t = t0 + u * step; const bool ok = t < T; const size_t tt = ok ? t : t0;
            sv[u] = lane < 16 ? ss[tt * 16 + lane] : 0.f;
#pragma unroll
            for (int j = 0; j < 4; ++j) w[u][j] = *(const GAS v4u*)(o + tt * D + (j * 64 + lane) * 8); }
#pragma unroll
        for (int u = 0; u < 2; ++u) { const int t = t0 + u * step; if (t >= T) break;
            float sa = lane < 6 ? sv[u] : 0.f, sb = (lane >= 6 && lane < 12) ? sv[u] : 0.f, sc = (lane >= 12 && lane < 16) ? sv[u] : 0.f;
            sa = wave_sum(sa); sb = wave_sum(sb); sc = wave_sum(sc);
            const float ra = 1.0f / sqrtf(sa * (1.0f / 768.f) + EPS), rb = 1.0f / sqrtf(sb * (1.0f / 768.f) + EPS), rc = 1.0f / sqrtf(sc * (1.0f / 512.f) + EPS);
#if WOUT_I8
            float yv[4][8]; float am = 0.f;
#pragma unroll
            for (int j = 0; j < 4; ++j) { const int c0 = (j * 64 + lane) * 8; const float r = c0 < 768 ? ra : c0 < 1536 ? rb : rc; const v4u ww = w[u][j];
                yv[j][0] = bf2f(ww.x & 0xffff) * r; yv[j][1] = bf2f(ww.x >> 16) * r; yv[j][2] = bf2f(ww.y & 0xffff) * r; yv[j][3] = bf2f(ww.y >> 16) * r;
                yv[j][4] = bf2f(ww.z & 0xffff) * r; yv[j][5] = bf2f(ww.z >> 16) * r; yv[j][6] = bf2f(ww.w & 0xffff) * r; yv[j][7] = bf2f(ww.w >> 16) * r;
#pragma unroll
                for (int e = 0; e < 8; ++e) am = fmaxf(am, fabsf(yv[j][e])); }
            am = wave_max(am); const float S8 = am > 0.f ? 127.0f / am : 0.f;
#pragma unroll
            for (int j = 0; j < 4; ++j) *(GAS v2u*)((GAS unsigned char*)y + (size_t)t * D + (j * 64 + lane) * 8) = (v2u){pack_i8x4(yv[j][0], yv[j][1], yv[j][2], yv[j][3], S8), pack_i8x4(yv[j][4], yv[j][5], yv[j][6], yv[j][7], S8)};
            if (lane == 0) ((GAS float*)(P.ws + WS_SY))[t] = am * (1.0f / 127.0f); }
#else
#pragma unroll
            for (int j = 0; j < 4; ++j) { const int c0 = (j * 64 + lane) * 8; const float r = c0 < 768 ? ra : c0 < 1536 ? rb : rc; const v4u ww = w[u][j]; v4u q;
                q.x = pk2(bf2f(ww.x & 0xffff) * r, bf2f(ww.x >> 16) * r); q.y = pk2(bf2f(ww.y & 0xffff) * r, bf2f(ww.y >> 16) * r);
                q.z = pk2(bf2f(ww.z & 0xffff) * r, bf2f(ww.z >> 16) * r); q.w = pk2(bf2f(ww.w & 0xffff) * r, bf2f(ww.w >> 16) * r);
                *(GAS v4u*)(y + (size_t)t * D + c0) = q; } }
#endif
    }
}

struct EpiProjTM {
    bf16* tm;
    __device__ __forceinline__ void elem(int R, int C, float v) const { const int b = R >> 11, s = R & 2047, slot = C >> 7, d = C & 127; tm[(((size_t)b * NTM + slot) * S + s) * 128 + d] = (bf16)f2bf(v); }
};
struct EpiProjVT {
    bf16* vt;
    __device__ __forceinline__ void elem(int R, int C, float v) const { const int b = C >> 11, s = C & 2047, slot = R >> 7, d = R & 127; vt[(((size_t)b * NVT + slot) * 128 + d) * S + s] = (bf16)f2bf(v); }
};
struct EpiResid {
    const float* base; float* out;
    __device__ __forceinline__ void elem(int R, int C, float v) const { out[(size_t)R * D + C] = base[(size_t)R * D + C] + v; }
};
struct EpiStoreBf16 {
    bf16* o;
    __device__ __forceinline__ void elem(int R, int C, float v) const { o[(size_t)R * D + C] = (bf16)f2bf(v); }
};
struct EpiPleGate {
    float* out; const bf16* pp;
    __device__ __forceinline__ void elem(int R, int C, float v) const { const size_t i = (size_t)R * D + C; out[i] = out[i] + (1.0f / (1.0f + __expf(-v))) * bf2f(pp[i]); }
};

template <class Epi>
__device__ __forceinline__ void gemm_naive_tile(const bf16* Aside, const bf16* Bside, int K, int r0, int c0, const Epi& E, int tid, LAS float* sm) {
    typedef LAS float (*T68)[68];
    T68 As = (T68)sm, Bs = (T68)(sm + 32 * 68);
    const int tx = tid & 15, ty = tid >> 4;
    float acc[4][4];
#pragma unroll
    for (int i = 0; i < 4; ++i)
#pragma unroll
        for (int j = 0; j < 4; ++j) acc[i][j] = 0.f;
    const int lr = tid >> 2, lk = (tid & 3) * 8;
    for (int k0 = 0; k0 < K; k0 += 32) {
        const v4u av = *(const v4u*)(Aside + (size_t)(r0 + lr) * K + k0 + lk), bv = *(const v4u*)(Bside + (size_t)(c0 + lr) * K + k0 + lk);
        __syncthreads();
        As[lk + 0][lr] = bf2f(av.x & 0xffff); As[lk + 1][lr] = bf2f(av.x >> 16); As[lk + 2][lr] = bf2f(av.y & 0xffff); As[lk + 3][lr] = bf2f(av.y >> 16);
        As[lk + 4][lr] = bf2f(av.z & 0xffff); As[lk + 5][lr] = bf2f(av.z >> 16); As[lk + 6][lr] = bf2f(av.w & 0xffff); As[lk + 7][lr] = bf2f(av.w >> 16);
        Bs[lk + 0][lr] = bf2f(bv.x & 0xffff); Bs[lk + 1][lr] = bf2f(bv.x >> 16); Bs[lk + 2][lr] = bf2f(bv.y & 0xffff); Bs[lk + 3][lr] = bf2f(bv.y >> 16);
        Bs[lk + 4][lr] = bf2f(bv.z & 0xffff); Bs[lk + 5][lr] = bf2f(bv.z >> 16); Bs[lk + 6][lr] = bf2f(bv.w & 0xffff); Bs[lk + 7][lr] = bf2f(bv.w >> 16);
        __syncthreads();
#pragma unroll
        for (int kk = 0; kk < 32; ++kk) {
            const f32x4 a = *(const LAS f32x4*)&As[kk][ty * 4], b = *(const LAS f32x4*)&Bs[kk][tx * 4];
            const float aa[4] = {a.x, a.y, a.z, a.w}, bb[4] = {b.x, b.y, b.z, b.w};
#pragma unroll
            for (int i = 0; i < 4; ++i)
#pragma unroll
                for (int j = 0; j < 4; ++j) acc[i][j] += aa[i] * bb[j];
        }
    }
#pragma unroll
    for (int i = 0; i < 4; ++i)
#pragma unroll
        for (int j = 0; j < 4; ++j) E.elem(r0 + ty * 4 + i, c0 + tx * 4 + j, acc[i][j]);
}
template <class Epi>
__device__ __forceinline__ void phase_gemm_naive(const bf16* Aside, const bf16* Bside, int K, int nR, int nC, const Epi& E, int bid, int nb, LAS unsigned char* lds) {
    const int tid_ = TID(); const int half = tid_ >> 8, vtid = tid_ & 255; LAS float* sm = (LAS float*)lds + half * (2 * 32 * 68);
    const int tc = nC / 64, nt = (nR / 64) * tc;
    for (int base = bid * 2; base < nt; base += nb * 2) { const int tile = base + half; gemm_naive_tile(Aside, Bside, K, (tile / tc) * 64, (tile % tc) * 64, E, vtid, sm); }
    __syncthreads();
}


namespace pg8 {
#define PG8_LAS __attribute__((address_space(3)))
typedef unsigned short bf16_t;
typedef short bf16x8 __attribute__((ext_vector_type(8)));
typedef float f32x4 __attribute__((ext_vector_type(4)));
typedef unsigned u32x4 __attribute__((ext_vector_type(4)));
constexpr int BM = 256, BK = 64, HALF = 128, HTB = HALF * BK * 2, STAGE_BYTES = 8 * HTB, NXCD = 8, WGM = 8;
__host__ __device__ __forceinline__ int lds_byte(int r, int c) { const int st = (r >> 4) * 2 + (c >> 5), rr = r & 15, cc = c & 31, ob = rr * 64 + cc * 2; return st * 1024 + (ob ^ (((ob >> 9) & 1) << 5)); }
__host__ __device__ __forceinline__ void stage_rc(int b, int& R, int& C) { const int st = b / 1024, sb = b % 1024, swz = sb ^ (((sb >> 9) & 1) << 5); R = (st >> 1) * 16 + swz / 64; C = (st & 1) * 32 + (swz % 64) / 2; }
__host__ __device__ __forceinline__ int perm32(int rho) { const int n = rho >> 4, i = rho & 15; return 8 * (i >> 2) + 4 * n + (i & 3); }
struct Unit { int pm, pn; };
struct Gemm { const bf16_t* A; const bf16_t* Bt; int K; const bf16_t* A2; const bf16_t* Bt2; int splitM, splitN;
    __device__ __forceinline__ const char* a_ptr(int pm, size_t tstep) const { return pm < splitM ? (const char*)A + (size_t)pm * tstep : (const char*)A2 + (size_t)(pm - splitM) * tstep; }
    __device__ __forceinline__ const char* b_ptr(int pn, size_t tstep) const { return pn < splitN ? (const char*)Bt + (size_t)pn * tstep : (const char*)Bt2 + (size_t)(pn - splitN) * tstep; } };
__device__ __forceinline__ void order_map(int wgid, int nM, int nN, Unit& u) {
    const int nwg = nM * nN; { const int q = nwg / NXCD, r = nwg % NXCD, xcd = wgid % NXCD, off = wgid / NXCD; wgid = (xcd < r ? xcd * (q + 1) : r * (q + 1) + (xcd - r) * q) + off; }
    const int nig = WGM * nN, gid = wgid / nig, fm = gid * WGM, gsz = (nM - fm) < WGM ? (nM - fm) : WGM;
    u.pm = fm + ((wgid % nig) % gsz); u.pn = (wgid % nig) / gsz;
}
struct StaticOrder {
    int nM, nN, nwg, G, c;
    __device__ void init(int M, int N, int G_, int c_) { nM = M / BM; nN = N / BM; nwg = nM * nN; G = G_; c = c_; }
    __device__ bool next(int i, Unit& u) const { const long L = (long)i * G + c; if (L >= nwg) return false; order_map((int)L, nM, nN, u); return true; }
    __device__ __forceinline__ void a_ready(const Unit&) const {}
    __device__ __forceinline__ void done(const Unit&) const {}
};
struct DualOrder {
    int nM1, nN1, nM2, nN2, G, c;
    __device__ bool next(int i, Unit& u) const { long L = (long)i * G + c; const int n1 = nM1 * nN1;
        if (L < n1) { order_map((int)L, nM1, nN1, u); return true; }
        L -= n1; if (L >= nM2 * nN2) return false; order_map((int)L, nM2, nN2, u); u.pm += nM1; u.pn += nN1; return true; }
    __device__ __forceinline__ void a_ready(const Unit&) const {}
    __device__ __forceinline__ void done(const Unit&) const {}
};
__device__ __forceinline__ unsigned cvt_pk_bf16(float lo, float hi) { unsigned r; asm volatile("v_cvt_pk_bf16_f32 %0, %1, %2" : "=v"(r) : "v"(lo), "v"(hi)); return r; }
struct EpiProj {
    static constexpr bool PERM = true, AFTER_DRAIN = false, I8 = false;
    bf16_t* tm; bf16_t* vt;
    __device__ __forceinline__ void operator()(const f32x4 (&acc)[2][2][4][2], const Unit& u, int wr, int wc, int fr, int fq) const {
        if (u.pm < 64) {
#pragma unroll
            for (int ai = 0; ai < 2; ++ai)
#pragma unroll
                for (int m = 0; m < 4; ++m) { const int r = u.pm * BM + ai * HALF + wr * 64 + m * 16 + fr, b = r >> 11, s = r & 2047;
#pragma unroll
                    for (int bj = 0; bj < 2; ++bj) { const int slot = 2 * u.pn + bj, d0 = wc * 32 + 8 * fq;
                        const f32x4 v0 = acc[ai][bj][m][0], v1 = acc[ai][bj][m][1];
                        u32x4 w; w.x = cvt_pk_bf16(v0[0], v0[1]); w.y = cvt_pk_bf16(v0[2], v0[3]); w.z = cvt_pk_bf16(v1[0], v1[1]); w.w = cvt_pk_bf16(v1[2], v1[3]);
                        *(GAS u32x4*)((GAS bf16_t*)tm + (((size_t)b * NTM + slot) * S + s) * 128 + d0) = w; } }
        } else {
            const int pmv = u.pm - 64, pnv = u.pn - 17;
#pragma unroll
            for (int ai = 0; ai < 2; ++ai)
#pragma unroll
                for (int m = 0; m < 4; ++m) { const int vslot = 2 * pmv + ai, d = wr * 64 + m * 16 + fr;
#pragma unroll
                    for (int bj = 0; bj < 2; ++bj) { const int c0 = pnv * BM + bj * HALF + wc * 32 + 8 * fq, b = c0 >> 11, s = c0 & 2047;
                        const f32x4 v0 = acc[ai][bj][m][0], v1 = acc[ai][bj][m][1];
                        u32x4 w; w.x = cvt_pk_bf16(v0[0], v0[1]); w.y = cvt_pk_bf16(v0[2], v0[3]); w.z = cvt_pk_bf16(v1[0], v1[1]); w.w = cvt_pk_bf16(v1[2], v1[3]);
                        *(GAS u32x4*)((GAS bf16_t*)vt + (((size_t)b * NVT + vslot) * 128 + d) * S + s) = w; } }
        }
    }
};
struct EpiResidT {
    static constexpr bool PERM = false, AFTER_DRAIN = false, I8 = false;
    const float* base; float* out;
    __device__ __forceinline__ void operator()(const f32x4 (&acc)[2][2][4][2], const Unit& u, int wr, int wc, int fr, int fq) const {
        const int row0 = u.pm * BM + wr * 64 + fr, col0 = u.pn * BM + wc * 32 + 4 * fq;
        const GAS float* bp = (const GAS float*)base; GAS float* op = (GAS float*)out;
#pragma unroll
        for (int ai = 0; ai < 2; ++ai)
#pragma unroll
            for (int mp = 0; mp < 2; ++mp) { f32x4 t[2][2][2];
#pragma unroll
                for (int mm = 0; mm < 2; ++mm) { const size_t off = (size_t)(row0 + ai * HALF + (2 * mp + mm) * 16) * D + col0;
#pragma unroll
                    for (int bj = 0; bj < 2; ++bj)
#pragma unroll
                        for (int n = 0; n < 2; ++n) t[mm][bj][n] = *(const GAS f32x4*)(bp + off + bj * HALF + n * 16); }
#pragma unroll
                for (int mm = 0; mm < 2; ++mm) { const size_t off = (size_t)(row0 + ai * HALF + (2 * mp + mm) * 16) * D + col0;
#pragma unroll
                    for (int bj = 0; bj < 2; ++bj)
#pragma unroll
                        for (int n = 0; n < 2; ++n) *(GAS f32x4*)(op + off + bj * HALF + n * 16) = t[mm][bj][n] + acc[ai][bj][2 * mp + mm][n]; } }
    }
};
struct EpiStoreT {
    static constexpr bool PERM = true, AFTER_DRAIN = false, I8 = false;
    bf16_t* o;
    __device__ __forceinline__ void operator()(const f32x4 (&acc)[2][2][4][2], const Unit& u, int wr, int wc, int fr, int fq) const {
        const int row0 = u.pm * BM + wr * 64 + fr, col0 = u.pn * BM + wc * 32 + 8 * fq;
#pragma unroll
        for (int ai = 0; ai < 2; ++ai)
#pragma unroll
            for (int m = 0; m < 4; ++m) { bf16_t* rowp = o + (size_t)(row0 + ai * HALF + m * 16) * D + col0;
#pragma unroll
                for (int bj = 0; bj < 2; ++bj) { const f32x4 v0 = acc[ai][bj][m][0], v1 = acc[ai][bj][m][1];
                    u32x4 w; w.x = cvt_pk_bf16(v0[0], v0[1]); w.y = cvt_pk_bf16(v0[2], v0[3]); w.z = cvt_pk_bf16(v1[0], v1[1]); w.w = cvt_pk_bf16(v1[2], v1[3]);
                    *(GAS u32x4*)((GAS bf16_t*)rowp + bj * HALF) = w; } }
    }
};
struct EpiPleGateT {
    static constexpr bool PERM = false, AFTER_DRAIN = false, I8 = false;
    float* out; const bf16_t* pp;
    __device__ __forceinline__ void operator()(const f32x4 (&acc)[2][2][4][2], const Unit& u, int wr, int wc, int fr, int fq) const {
        const int row0 = u.pm * BM + wr * 64 + fr, col0 = u.pn * BM + wc * 32 + 4 * fq;
        GAS float* op = (GAS float*)out; const GAS bf16_t* ppp = (const GAS bf16_t*)pp;
#pragma unroll
        for (int ai = 0; ai < 2; ++ai)
#pragma unroll
            for (int mp = 0; mp < 2; ++mp) { f32x4 t[2][2][2]; v2u pw[2][2][2];
#pragma unroll
                for (int mm = 0; mm < 2; ++mm) { const size_t off = (size_t)(row0 + ai * HALF + (2 * mp + mm) * 16) * D + col0;
#pragma unroll
                    for (int bj = 0; bj < 2; ++bj)
#pragma unroll
                        for (int n = 0; n < 2; ++n) { t[mm][bj][n] = *(const GAS f32x4*)(op + off + bj * HALF + n * 16); pw[mm][bj][n] = *(const GAS v2u*)(ppp + off + bj * HALF + n * 16); } }
#pragma unroll
                for (int mm = 0; mm < 2; ++mm) { const size_t off = (size_t)(row0 + ai * HALF + (2 * mp + mm) * 16) * D + col0;
#pragma unroll
                    for (int bj = 0; bj < 2; ++bj)
#pragma unroll
                        for (int n = 0; n < 2; ++n) { const f32x4 hv = t[mm][bj][n], a = acc[ai][bj][2 * mp + mm][n]; const v2u p2 = pw[mm][bj][n];
                            f32x4 r; r[0] = hv[0] + bf2f(p2.x & 0xffff) / (1.0f + __expf(-a[0])); r[1] = hv[1] + bf2f(p2.x >> 16) / (1.0f + __expf(-a[1]));
                            r[2] = hv[2] + bf2f(p2.y & 0xffff) / (1.0f + __expf(-a[2])); r[3] = hv[3] + bf2f(p2.y >> 16) / (1.0f + __expf(-a[3]));
                            *(GAS f32x4*)(op + off + bj * HALF + n * 16) = r; } } }
    }
};

typedef int i32x4 __attribute__((ext_vector_type(4)));
template <bool I8> struct AccSel { typedef f32x4 type; };
template <> struct AccSel<true> { typedef i32x4 type; };
__device__ __forceinline__ void mma16(f32x4& acc, const bf16x8 b, const bf16x8 a) { acc = __builtin_amdgcn_mfma_f32_16x16x32_bf16(b, a, acc, 0, 0, 0); }
__device__ __forceinline__ void mma16(i32x4& acc, const bf16x8 b, const bf16x8 a) { acc = __builtin_amdgcn_mfma_i32_16x16x64_i8(__builtin_bit_cast(i32x4, b), __builtin_bit_cast(i32x4, a), acc, 0, 0, 0); }
struct EpiPleGateI8 {
    static constexpr bool PERM = false, AFTER_DRAIN = false, I8 = true;
    float* out; const bf16_t* pp; const float* sa; const float* sw;
    __device__ __forceinline__ void operator()(const i32x4 (&acc)[2][2][4][2], const Unit& u, int wr, int wc, int fr, int fq) const {
        const int row0 = u.pm * BM + wr * 64 + fr, col0 = u.pn * BM + wc * 32 + 4 * fq;
        GAS float* op = (GAS float*)out; const GAS bf16_t* ppp = (const GAS bf16_t*)pp;
        f32x4 swv[2][2];
#pragma unroll
        for (int bj = 0; bj < 2; ++bj)
#pragma unroll
            for (int n = 0; n < 2; ++n) swv[bj][n] = *(const GAS f32x4*)((const GAS float*)sw + col0 + bj * HALF + n * 16);
#pragma unroll
        for (int ai = 0; ai < 2; ++ai)
#pragma unroll
            for (int mp = 0; mp < 2; ++mp) { f32x4 t[2][2][2]; v2u pw[2][2][2]; float rs[2];
#pragma unroll
                for (int mm = 0; mm < 2; ++mm) { const int row = row0 + ai * HALF + (2 * mp + mm) * 16; const size_t off = (size_t)row * D + col0; rs[mm] = ((const GAS float*)sa)[row];
#pragma unroll
                    for (int bj = 0; bj < 2; ++bj)
#pragma unroll
                        for (int n = 0; n < 2; ++n) {
#if H16
                            t[mm][bj][n] = ldh4((const GAS _Float16*)out + off + bj * HALF + n * 16);
#else
                            t[mm][bj][n] = *(const GAS f32x4*)(op + off + bj * HALF + n * 16);
#endif
                            pw[mm][bj][n] = *(const GAS v2u*)(ppp + off + bj * HALF + n * 16); } }
#pragma unroll
                for (int mm = 0; mm < 2; ++mm) { const size_t off = (size_t)(row0 + ai * HALF + (2 * mp + mm) * 16) * D + col0;
#pragma unroll
                    for (int bj = 0; bj < 2; ++bj)
#pragma unroll
                        for (int n = 0; n < 2; ++n) { const f32x4 hv = t[mm][bj][n]; const i32x4 ai4 = acc[ai][bj][2 * mp + mm][n]; const v2u p2 = pw[mm][bj][n]; const f32x4 sc = swv[bj][n] * rs[mm];
                            const float a0 = (float)ai4[0] * sc[0], a1 = (float)ai4[1] * sc[1], a2 = (float)ai4[2] * sc[2], a3 = (float)ai4[3] * sc[3];
                            f32x4 r; r[0] = hv[0] + bf2f(p2.x & 0xffff) / (1.0f + __expf(-a0)); r[1] = hv[1] + bf2f(p2.x >> 16) / (1.0f + __expf(-a1));
                            r[2] = hv[2] + bf2f(p2.y & 0xffff) / (1.0f + __expf(-a2)); r[3] = hv[3] + bf2f(p2.y >> 16) / (1.0f + __expf(-a3));
#if H16
                            sth4((GAS _Float16*)out + off + bj * HALF + n * 16, r);
#else
                            *(GAS f32x4*)(op + off + bj * HALF + n * 16) = r;
#endif
                        } } }
    }
};
struct EpiStoreI8 {
    static constexpr bool PERM = true, AFTER_DRAIN = false, I8 = true;
    bf16_t* o; const float* sa; const float* sw;
    __device__ __forceinline__ void operator()(const i32x4 (&acc)[2][2][4][2], const Unit& u, int wr, int wc, int fr, int fq) const {
        const int row0 = u.pm * BM + wr * 64 + fr, col0 = u.pn * BM + wc * 32 + 8 * fq;
        f32x4 cs[2][2];
#pragma unroll
        for (int bj = 0; bj < 2; ++bj) { const GAS float* p = (const GAS float*)sw + col0 + bj * HALF; cs[bj][0] = *(const GAS f32x4*)p; cs[bj][1] = *(const GAS f32x4*)(p + 4); }
#pragma unroll
        for (int ai = 0; ai < 2; ++ai)
#pragma unroll
            for (int m = 0; m < 4; ++m) { const int row = row0 + ai * HALF + m * 16; bf16_t* rowp = o + (size_t)row * D + col0; const float rs = ((const GAS float*)sa)[row];
#pragma unroll
                for (int bj = 0; bj < 2; ++bj) { const i32x4 a0 = acc[ai][bj][m][0], a1 = acc[ai][bj][m][1]; const f32x4 s0 = cs[bj][0] * rs, s1 = cs[bj][1] * rs;
                    u32x4 w; w.x = cvt_pk_bf16((float)a0[0] * s0[0], (float)a0[1] * s0[1]); w.y = cvt_pk_bf16((float)a0[2] * s0[2], (float)a0[3] * s0[3]);
                    w.z = cvt_pk_bf16((float)a1[0] * s1[0], (float)a1[1] * s1[1]); w.w = cvt_pk_bf16((float)a1[2] * s1[2], (float)a1[3] * s1[3]);
                    *(GAS u32x4*)((GAS bf16_t*)rowp + bj * HALF) = w; } }
    }
};
struct EpiResidI8 {
    static constexpr bool PERM = false, AFTER_DRAIN = false, I8 = true;
    const float* base; float* out; const float* sa; const float* sw;
    __device__ __forceinline__ void operator()(const i32x4 (&acc)[2][2][4][2], const Unit& u, int wr, int wc, int fr, int fq) const {
        const int row0 = u.pm * BM + wr * 64 + fr, col0 = u.pn * BM + wc * 32 + 4 * fq;
        const GAS float* bp = (const GAS float*)base; GAS float* op = (GAS float*)out;
#if H16
        GAS _Float16* oh = (GAS _Float16*)out;
#endif
        f32x4 cs[2][2];
#pragma unroll
        for (int bj = 0; bj < 2; ++bj)
#pragma unroll
            for (int n = 0; n < 2; ++n) cs[bj][n] = *(const GAS f32x4*)((const GAS float*)sw + col0 + bj * HALF + n * 16);
#pragma unroll
        for (int ai = 0; ai < 2; ++ai)
#pragma unroll
            for (int mp = 0; mp < 2; ++mp) { f32x4 t[2][2][2]; float rs[2];
#pragma unroll
                for (int mm = 0; mm < 2; ++mm) { const int row = row0 + ai * HALF + (2 * mp + mm) * 16; const size_t off = (size_t)row * D + col0; rs[mm] = ((const GAS float*)sa)[row];
#pragma unroll
                    for (int bj = 0; bj < 2; ++bj)
#pragma unroll
                        for (int n = 0; n < 2; ++n) {
#if H16
                            if (bp) t[mm][bj][n] = *(const GAS f32x4*)(bp + off + bj * HALF + n * 16); else t[mm][bj][n] = ldh4(oh + off + bj * HALF + n * 16);
#else
                            t[mm][bj][n] = *(const GAS f32x4*)(bp + off + bj * HALF + n * 16);
#endif
                        } }
#pragma unroll
                for (int mm = 0; mm < 2; ++mm) { const size_t off = (size_t)(row0 + ai * HALF + (2 * mp + mm) * 16) * D + col0;
#pragma unroll
                    for (int bj = 0; bj < 2; ++bj)
#pragma unroll
                        for (int n = 0; n < 2; ++n) { const i32x4 a = acc[ai][bj][2 * mp + mm][n]; const f32x4 sc = cs[bj][n] * rs[mm];
                            const f32x4 rv = t[mm][bj][n] + (f32x4){(float)a[0] * sc[0], (float)a[1] * sc[1], (float)a[2] * sc[2], (float)a[3] * sc[3]};
#if H16
                            sth4(oh + off + bj * HALF + n * 16, rv);
#else
                            *(GAS f32x4*)(op + off + bj * HALF + n * 16) = rv;
#endif
                        } } }
    }
};
struct EpiProjI8 {
    static constexpr bool PERM = true, AFTER_DRAIN = false, I8 = true;
    bf16_t* tm; bf16_t* vt; const float* sa; const float* swtm; const float* swvt;
    __device__ __forceinline__ void operator()(const i32x4 (&acc)[2][2][4][2], const Unit& u, int wr, int wc, int fr, int fq) const {
        if (u.pm < 64) {
            f32x4 cs[2][2];
#pragma unroll
            for (int bj = 0; bj < 2; ++bj) { const GAS float* p = (const GAS float*)swtm + (2 * u.pn + bj) * 128 + wc * 32 + 8 * fq; cs[bj][0] = *(const GAS f32x4*)p; cs[bj][1] = *(const GAS f32x4*)(p + 4); }
#pragma unroll
            for (int ai = 0; ai < 2; ++ai)
#pragma unroll
                for (int m = 0; m < 4; ++m) { const int r = u.pm * BM + ai * HALF + wr * 64 + m * 16 + fr, b = r >> 11, s = r & 2047; const float rs = ((const GAS float*)sa)[r];
#pragma unroll
                    for (int bj = 0; bj < 2; ++bj) { const int slot = 2 * u.pn + bj, d0 = wc * 32 + 8 * fq;
                        const i32x4 a0 = acc[ai][bj][m][0], a1 = acc[ai][bj][m][1]; const f32x4 s0 = cs[bj][0] * rs, s1 = cs[bj][1] * rs;
                        u32x4 w; w.x = cvt_pk_bf16((float)a0[0] * s0[0], (float)a0[1] * s0[1]); w.y = cvt_pk_bf16((float)a0[2] * s0[2], (float)a0[3] * s0[3]);
                        w.z = cvt_pk_bf16((float)a1[0] * s1[0], (float)a1[1] * s1[1]); w.w = cvt_pk_bf16((float)a1[2] * s1[2], (float)a1[3] * s1[3]);
                        *(GAS u32x4*)((GAS bf16_t*)tm + (((size_t)b * NTM + slot) * S + s) * 128 + d0) = w; } }
        } else {
            const int pmv = u.pm - 64, pnv = u.pn - 17;
            f32x4 cs[2][2];
#pragma unroll
            for (int bj = 0; bj < 2; ++bj) { const GAS float* p = (const GAS float*)sa + pnv * BM + bj * HALF + wc * 32 + 8 * fq; cs[bj][0] = *(const GAS f32x4*)p; cs[bj][1] = *(const GAS f32x4*)(p + 4); }
#pragma unroll
            for (int ai = 0; ai < 2; ++ai)
#pragma unroll
                for (int m = 0; m < 4; ++m) { const int vslot = 2 * pmv + ai, d = wr * 64 + m * 16 + fr; const float rs = ((const GAS float*)swvt)[vslot * 128 + d];
#pragma unroll
                    for (int bj = 0; bj < 2; ++bj) { const int c0 = pnv * BM + bj * HALF + wc * 32 + 8 * fq, b = c0 >> 11, s = c0 & 2047;
                        const i32x4 a0 = acc[ai][bj][m][0], a1 = acc[ai][bj][m][1]; const f32x4 s0 = cs[bj][0] * rs, s1 = cs[bj][1] * rs;
                        u32x4 w; w.x = cvt_pk_bf16((float)a0[0] * s0[0], (float)a0[1] * s0[1]); w.y = cvt_pk_bf16((float)a0[2] * s0[2], (float)a0[3] * s0[3]);
                        w.z = cvt_pk_bf16((float)a1[0] * s1[0], (float)a1[1] * s1[1]); w.w = cvt_pk_bf16((float)a1[2] * s1[2], (float)a1[3] * s1[3]);
                        *(GAS u32x4*)((GAS bf16_t*)vt + (((size_t)b * NVT + vslot) * 128 + d) * S + s) = w; } }
        }
    }
};
template <class Epi, class Sched>
__device__ __forceinline__ void gemm_phase(PG8_LAS unsigned char* lds, const Gemm g, const Sched& S, const Epi& E) {
    const int tid = TID(), wid = __builtin_amdgcn_readfirstlane(tid >> 6), lane = tid & 63, wr = wid >> 2, wc = wid & 3, fr = lane & 15, fq = lane >> 4;
    const int K = g.K, nt = K / BK;
    unsigned voffA[2], voffB[2];
#pragma unroll
    for (int i = 0; i < 2; ++i) { int R, C; stage_rc(tid * 16 + i * 8192, R, C); const int Rb = Epi::PERM ? ((R & ~31) + perm32(R & 31)) : R;
        voffA[i] = (unsigned)(R * K + C) * 2u; voffB[i] = (unsigned)(Rb * K + C) * 2u; }
    const size_t kstep = (size_t)(BK * 2);
    const size_t hstep = (size_t)HALF * K * 2;
    const size_t tstep = 2 * hstep;
    const unsigned ldsw = (unsigned)wid * 1024u;
    const int aoff = lds_byte(wr * 64 + fr, fq * 8), boff = lds_byte(wc * 32 + fr, fq * 8);
#define PG8_SA(b, h) (((b) * 2 + (h)) * HTB)
#define PG8_SB(b, h) ((4 + (b) * 2 + (h)) * HTB)
#define PG8_STAGE(bufoff, gbase, voff) do { _Pragma("unroll") for (int _i = 0; _i < 2; ++_i) \
        __builtin_amdgcn_global_load_lds((const unsigned*)((const char*)(gbase) + (voff)[_i]), (PG8_LAS unsigned*)(lds + (bufoff) + ldsw + _i * 8192), 16, 0, 0); } while (0)
#define PG8_LDA(dst, b, h) do { _Pragma("unroll") for (int m = 0; m < 4; ++m) _Pragma("unroll") for (int k = 0; k < 2; ++k) dst[m][k] = *(const PG8_LAS bf16x8*)(lds + PG8_SA(b, h) + aoff + m * 2048 + k * 1024); } while (0)
#define PG8_LDB(dst, b, h) do { _Pragma("unroll") for (int n = 0; n < 2; ++n) _Pragma("unroll") for (int k = 0; k < 2; ++k) dst[n][k] = *(const PG8_LAS bf16x8*)(lds + PG8_SB(b, h) + boff + n * 2048 + k * 1024); } while (0)
#define PG8_MMA(ai, bj, At, Bt) do { __builtin_amdgcn_s_setprio(1); _Pragma("unroll") for (int m = 0; m < 4; ++m) _Pragma("unroll") for (int n = 0; n < 2; ++n) _Pragma("unroll") for (int k = 0; k < 2; ++k) \
        mma16(acc[ai][bj][m][n], Bt[n][k], At[m][k]); __builtin_amdgcn_s_setprio(0); } while (0)
#define PG8_WAIT_V(n) asm volatile("s_waitcnt vmcnt(" #n ")" ::: "memory")
#define PG8_WAIT_L(n) asm volatile("s_waitcnt lgkmcnt(" #n ")" ::: "memory")
#define PG8_BAR __builtin_amdgcn_s_barrier()
#define PG8_SCHED __builtin_amdgcn_sched_barrier(0)
    Unit cur, nxt; int ui = 0;
    if (!S.next(0, cur)) return;
    typedef typename AccSel<Epi::I8>::type acc_t;
    acc_t acc[2][2][4][2];
#pragma unroll
    for (int a = 0; a < 2; ++a)
#pragma unroll
        for (int b = 0; b < 2; ++b)
#pragma unroll
            for (int m = 0; m < 4; ++m)
#pragma unroll
                for (int n = 0; n < 2; ++n) acc[a][b][m][n] = acc_t{};
    bf16x8 At[4][2], B0[2][2], B1[2][2];
    const char* cA = g.a_ptr(cur.pm, tstep); const char* cB = g.b_ptr(cur.pn, tstep);
    S.a_ready(cur);
    PG8_STAGE(PG8_SB(0, 0), cB, voffB); PG8_STAGE(PG8_SA(0, 0), cA, voffA); PG8_STAGE(PG8_SB(0, 1), cB + hstep, voffB); PG8_STAGE(PG8_SA(0, 1), cA + hstep, voffA);
    if (wr == 1) PG8_BAR;
    PG8_WAIT_V(4); PG8_BAR;
    PG8_STAGE(PG8_SB(1, 0), cB + kstep, voffB); PG8_STAGE(PG8_SA(1, 0), cA + kstep, voffA); PG8_STAGE(PG8_SB(1, 1), cB + hstep + kstep, voffB);
    PG8_WAIT_V(6); PG8_BAR;
    for (;;) {
        const bool has_next = S.next(ui + 1, nxt);
        const char* nA = has_next ? g.a_ptr(nxt.pm, tstep) : cA; const char* nB = has_next ? g.b_ptr(nxt.pn, tstep) : cB;
        for (int t = 0; t < nt; t += 2) {
            const bool last = (t == nt - 2);
            const char* a1 = cA + (size_t)(t + 1) * kstep;
            const char* a2 = last ? nA : cA + (size_t)(t + 2) * kstep; const char* b2 = last ? nB : cB + (size_t)(t + 2) * kstep;
            const char* a3 = a2 + kstep; const char* b3 = b2 + kstep;
            if (last && has_next) S.a_ready(nxt);
            PG8_LDB(B0, 0, 0); PG8_SCHED; PG8_LDA(At, 0, 0); PG8_STAGE(PG8_SA(1, 1), a1 + hstep, voffA);
            PG8_WAIT_L(8); PG8_BAR; PG8_WAIT_L(0); PG8_MMA(0, 0, At, B0); PG8_BAR; PG8_SCHED;
            PG8_LDB(B1, 0, 1); PG8_STAGE(PG8_SB(0, 0), b2, voffB);
            PG8_BAR; PG8_WAIT_L(0); PG8_MMA(0, 1, At, B1); PG8_BAR;
            PG8_LDA(At, 0, 1); PG8_STAGE(PG8_SA(0, 0), a2, voffA);
            PG8_BAR; PG8_WAIT_L(0); PG8_MMA(1, 0, At, B0); PG8_BAR; PG8_SCHED;
            PG8_STAGE(PG8_SB(0, 1), b2 + hstep, voffB);
            PG8_WAIT_V(6); PG8_BAR; PG8_MMA(1, 1, At, B1); PG8_BAR;
            PG8_LDB(B0, 1, 0); PG8_SCHED; PG8_LDA(At, 1, 0); PG8_STAGE(PG8_SA(0, 1), a2 + hstep, voffA);
            PG8_WAIT_L(8); PG8_BAR; PG8_WAIT_L(0); PG8_MMA(0, 0, At, B0); PG8_BAR; PG8_SCHED;
            PG8_LDB(B1, 1, 1); PG8_STAGE(PG8_SB(1, 0), b3, voffB);
            PG8_BAR; PG8_WAIT_L(0); PG8_MMA(0, 1, At, B1); PG8_BAR;
            PG8_LDA(At, 1, 1); PG8_STAGE(PG8_SA(1, 0), a3, voffA);
            PG8_BAR; PG8_WAIT_L(0); PG8_MMA(1, 0, At, B0); PG8_BAR; PG8_SCHED;
            PG8_STAGE(PG8_SB(1, 1), b3 + hstep, voffB);
            PG8_WAIT_V(6); PG8_BAR; PG8_MMA(1, 1, At, B1); PG8_BAR;
        }
        if constexpr (!Epi::AFTER_DRAIN) { E(acc, cur, wr, wc, fr, fq); S.done(cur); }
        if (!has_next) break;
#pragma unroll
        for (int a = 0; a < 2; ++a)
#pragma unroll
            for (int b = 0; b < 2; ++b)
#pragma unroll
                for (int m = 0; m < 4; ++m)
#pragma unroll
                    for (int n = 0; n < 2; ++n) acc[a][b][m][n] = acc_t{};
        cur = nxt; cA = nA; cB = nB; ++ui;
    }
    PG8_WAIT_V(0);
    if (wr == 0) PG8_BAR;
    PG8_BAR;
    if constexpr (Epi::AFTER_DRAIN) { E.fused(acc, cur, wr, wc, fr, fq, lds, wid, lane); S.done(cur); }
#undef PG8_SA
#undef PG8_SB
#undef PG8_STAGE
#undef PG8_LDA
#undef PG8_LDB
#undef PG8_MMA
#undef PG8_WAIT_V
#undef PG8_WAIT_L
#undef PG8_BAR
#undef PG8_SCHED
}
}

__device__ __forceinline__ void phase_prep_naive(const Params& P, int l, int bid, int nb) {
    const int tid_ = TID(); const int half = tid_ >> 8, tid = tid_ & 255;
    for (int vb = bid * 2 + half; vb < NB * 2 * 128; vb += nb * 2) {
        const int n = vb & 127, g = (vb >> 7) & 1, b = vb >> 8;
        const int which = tid >> 7, e = tid & 127;
        const bf16* tm = (const bf16*)(P.ws + WS_TM);
        const bf16* src = tm + (((size_t)b * NTM + (which ? TM_B_VC : TM_B_KC) + g) * S) * 128;
        const float* w = (which ? P.in[I_CMPWV] : P.in[I_CMPWK]) + (size_t)l * 32 * 128 * 128; const float* pos = P.in[I_CMPPOS] + (size_t)l * 32 * 128;
        float acc = 0.f;
        if (n < 127) for (int ll = 0; ll < 32; ++ll) for (int d = 0; d < 128; ++d) acc += (bf2f(src[(size_t)(16 * n + ll) * 128 + d]) + pos[ll * 128 + d]) * w[((size_t)ll * 128 + d) * 128 + e];
        if (which == 0) ((bf16*)(P.ws + WS_KCMP))[(((size_t)b * 2 + g) * 128 + n) * 128 + e] = (bf16)f2bf(acc);
        else ((bf16*)(P.ws + WS_VCMPT))[(((size_t)b * 2 + g) * 128 + e) * 128 + n] = (bf16)f2bf(acc);
    }
    for (int w = bid * 512 + tid_; w < NB * 8 * 4 * 128; w += nb * 512) {
        const int d = w & 127, id = w >> 7, h = id & 3, blk = (id >> 2) & 7, b = id >> 5;
        const bf16* k = (const bf16*)(P.ws + WS_TM) + (((size_t)b * NTM + TM_C_K + h) * S + blk * 256) * 128;
        float s = 0.f; for (int j = 0; j < 256; ++j) s += bf2f(k[(size_t)j * 128 + d]);
        ((float*)(P.ws + WS_KMEAN))[(((size_t)b * 8 + blk) * 4 + h) * 128 + d] = s * (1.0f / 256.f);
    }
}

struct KeyRef { const bf16* krow; int vkey; int dist; bool valid; };
template <class F>
__device__ __forceinline__ void naive_attend(const LAS float* qs, LAS float* sc, int n, F f, const float* biascol, const bf16* Vt, int vstride, int lane, float& o0, float& o1, float& lse, float& zinv) {
    float mx = NEG_INF;
    for (int idx = lane; idx < n; idx += 64) {
        const KeyRef kr = f(idx); float s = NEG_INF;
        if (kr.valid) { float dot = 0.f;
#pragma unroll 4
            for (int c = 0; c < 16; ++c) { const v4u w = *(const v4u*)(kr.krow + c * 8); const f32x4 qa = *(const LAS f32x4*)(qs + c * 8), qb = *(const LAS f32x4*)(qs + c * 8 + 4);
                dot += bf2f(w.x & 0xffff) * qa.x + bf2f(w.x >> 16) * qa.y + bf2f(w.y & 0xffff) * qa.z + bf2f(w.y >> 16) * qa.w + bf2f(w.z & 0xffff) * qb.x + bf2f(w.z >> 16) * qb.y + bf2f(w.w & 0xffff) * qb.z + bf2f(w.w >> 16) * qb.w; }
            s = dot * QK_SCALE + biascol[rel_bucket(kr.dist) * 16]; }
        sc[idx] = s; mx = fmaxf(mx, s);
    }
    mx = wave_max(mx); const float m = (mx > NEG_INF) ? mx : 0.f;
    WAVE_LDS_SYNC();
    float z = 0.f;
    for (int idx = lane; idx < n; idx += 64) { const float e = __expf(sc[idx] - m); sc[idx] = e; z += e; }
    z = wave_sum(z); const float zs = z > 0.f ? z : 1.f;
    WAVE_LDS_SYNC();
    float a0 = 0.f, a1 = 0.f;
    for (int idx = 0; idx < n; ++idx) { const float p = sc[idx]; if (p != 0.f) { const KeyRef kr = f(idx); a0 += p * bf2f(Vt[(size_t)(2 * lane) * vstride + kr.vkey]); a1 += p * bf2f(Vt[(size_t)(2 * lane + 1) * vstride + kr.vkey]); } }
    zinv = 1.0f / zs; o0 = a0 * zinv; o1 = a1 * zinv; lse = z > 0.f ? m + __logf(zs) : NEG_INF;
}
__device__ __forceinline__ void load_q_lds(const bf16* qrow, LAS float* qs, int lane) { qs[2 * lane] = bf2f(qrow[2 * lane]); qs[2 * lane + 1] = bf2f(qrow[2 * lane + 1]); WAVE_LDS_SYNC(); }

__device__ __forceinline__ void attnA_item(const Params& P, int id, int lane, LAS float* qs, LAS float* sc) {
    const int i = id & 2047, h = (id >> 11) % 6, b = id / (6 * S);
    const bf16* tm = (const bf16*)(P.ws + WS_TM); const bf16* vt = (const bf16*)(P.ws + WS_VT);
    const bf16* Q = tm + (((size_t)b * NTM + TM_A_Q + h) * S) * 128; const bf16* K = tm + (((size_t)b * NTM + TM_A_K + h) * S) * 128; const bf16* V = vt + (((size_t)b * NVT + VT_A_V + h) * 128) * S;
    load_q_lds(Q + (size_t)i * 128, qs, lane);
    const float* biascol = P.in[I_RELBIAS] + h;
    float o0[3], o1[3], lse[3], zi;
#pragma unroll
    for (int p = 0; p < 3; ++p) { const int dil = p == 0 ? 1 : p == 1 ? 4 : 16; const int nk = min(128, i / dil) + 1;
        naive_attend(qs, sc, nk, [&](int idx) { KeyRef r; const int j = i - idx * dil; r.krow = K + (size_t)j * 128; r.vkey = j; r.dist = idx * dil; r.valid = true; return r; }, biascol, V, S, lane, o0[p], o1[p], lse[p], zi);
        WAVE_LDS_SYNC(); }
    const float m = fmaxf(lse[0], fmaxf(lse[1], lse[2])); const float w0 = __expf(lse[0] - m), w1 = __expf(lse[1] - m), w2 = __expf(lse[2] - m), wi = 1.0f / (w0 + w1 + w2);
    const float r0 = (w0 * o0[0] + w1 * o0[1] + w2 * o0[2]) * wi, r1 = (w0 * o1[0] + w1 * o1[1] + w2 * o1[2]) * wi;
    const size_t t = (size_t)b * S + i; bf16* o = (bf16*)(P.ws + WS_ACT1);
    *(unsigned*)(o + t * D + h * 128 + 2 * lane) = pk2(r0, r1);
    const float ssq = wave_sum(r0 * r0 + r1 * r1); if (lane == 0) ((float*)(P.ws + WS_SS))[t * 16 + h] = ssq;
}
__device__ __forceinline__ void attnB1_item(const Params& P, int id, int lane, LAS float* qs, LAS float* sc, LAS float* imp) {
    const int i = id & 2047, g = (id >> 11) & 1, b = id >> 12;
    const bf16* tm = (const bf16*)(P.ws + WS_TM);
    const bf16* Kc = (const bf16*)(P.ws + WS_KCMP) + ((size_t)b * 2 + g) * 128 * 128; const bf16* Vc = (const bf16*)(P.ws + WS_VCMPT) + ((size_t)b * 2 + g) * 128 * 128;
    const size_t t = (size_t)b * S + i; const float* gates = (const float*)(P.ws + WS_GATES) + t * 18; float* ocmp = (float*)(P.ws + WS_OCMP) + t * 768;
    const int ncv = i >= 31 ? (i - 31) / 16 + 1 : 0;
    if (lane < 32) imp[lane] = 0.f;
    WAVE_LDS_SYNC();
    for (int r = 0; r < 3; ++r) { const int h = g * 3 + r;
        load_q_lds(tm + (((size_t)b * NTM + TM_B_Q + h) * S + i) * 128, qs, lane);
        float o0, o1, lse, zi;
        naive_attend(qs, sc, ncv, [&](int n) { KeyRef kr; kr.krow = Kc + (size_t)n * 128; kr.vkey = n; kr.dist = i - (16 * n + 31); kr.valid = true; return kr; }, P.in[I_RELBIAS] + 6 + h, Vc, 128, lane, o0, o1, lse, zi);
        const float g0 = gates[h * 3 + 0];
        ocmp[h * 128 + 2 * lane] = g0 * o0; ocmp[h * 128 + 2 * lane + 1] = g0 * o1;
        WAVE_LDS_SYNC();
        if (lane < 32) { float a = 0.f; for (int n = 4 * lane - 1; n <= 4 * lane + 3; ++n) if (n >= 0 && n < ncv) a += sc[n] * zi; imp[lane] += a; }
        WAVE_LDS_SYNC(); }
    const int qblk = i >> 6; float val = NEG_INF;
    if (lane < 32) { val = imp[lane]; if (lane == 0 || lane == qblk || lane == qblk - 1) val = 1e4f; else if (lane > qblk) val = -1e4f; }
    int* sel = (int*)(P.ws + WS_SEL) + (t * 2 + g) * 8;
    for (int k = 0; k < 8; ++k) { const float m = wave_max(val); const int mi = wave_min_i(val == m ? lane : 1 << 30); if (lane == mi) val = NEG_INF; if (lane == 0) sel[k] = mi; }
    WAVE_LDS_SYNC();
}
__device__ __forceinline__ void attnB2_item(const Params& P, int id, int lane, LAS float* qs, LAS float* sc) {
    const int i = id & 2047, h = (id >> 11) % 6, b = id / (6 * S), g = h / 3;
    const bf16* tm = (const bf16*)(P.ws + WS_TM); const bf16* vt = (const bf16*)(P.ws + WS_VT);
    const bf16* Ks = tm + (((size_t)b * NTM + TM_B_KS + g) * S) * 128; const bf16* Kw = tm + (((size_t)b * NTM + TM_B_KW + g) * S) * 128;
    const bf16* Vs = vt + (((size_t)b * NVT + VT_B_VS + g) * 128) * S; const bf16* Vw = vt + (((size_t)b * NVT + VT_B_VW + g) * 128) * S;
    const size_t t = (size_t)b * S + i; const float* gates = (const float*)(P.ws + WS_GATES) + t * 18; const float* ocmp = (const float*)(P.ws + WS_OCMP) + t * 768;
    const int* sel = (const int*)(P.ws + WS_SEL) + (t * 2 + g) * 8;
    load_q_lds(tm + (((size_t)b * NTM + TM_B_Q + h) * S + i) * 128, qs, lane);
    const float* biascol = P.in[I_RELBIAS] + 6 + h;
    float s0, s1, w0, w1, lse, zi;
    naive_attend(qs, sc, 512, [&](int idx) { KeyRef kr; const int key = sel[idx >> 6] * 64 + (idx & 63); kr.krow = Ks + (size_t)key * 128; kr.vkey = key; kr.dist = i - key; kr.valid = key <= i; return kr; }, biascol, Vs, S, lane, s0, s1, lse, zi);
    WAVE_LDS_SYNC();
    naive_attend(qs, sc, min(511, i) + 1, [&](int idx) { KeyRef kr; const int j = i - idx; kr.krow = Kw + (size_t)j * 128; kr.vkey = j; kr.dist = idx; kr.valid = true; return kr; }, biascol, Vw, S, lane, w0, w1, lse, zi);
    WAVE_LDS_SYNC();
    const float g1 = gates[h * 3 + 1], g2 = gates[h * 3 + 2];
    const float r0 = ocmp[h * 128 + 2 * lane] + g1 * s0 + g2 * w0, r1 = ocmp[h * 128 + 2 * lane + 1] + g1 * s1 + g2 * w1;
    bf16* o = (bf16*)(P.ws + WS_ACT1);
    *(unsigned*)(o + t * D + (6 + h) * 128 + 2 * lane) = pk2(r0, r1);
    const float ssq = wave_sum(r0 * r0 + r1 * r1); if (lane == 0) ((float*)(P.ws + WS_SS))[t * 16 + 6 + h] = ssq;
}
__device__ __forceinline__ void attnC_item(const Params& P, int id, int lane, LAS float* qs, LAS float* sc) {
    const int i = id & 2047, h = (id >> 11) & 3, b = id >> 13;
    const bf16* tm = (const bf16*)(P.ws + WS_TM); const bf16* vt = (const bf16*)(P.ws + WS_VT);
    const bf16* K = tm + (((size_t)b * NTM + TM_C_K + h) * S) * 128; const bf16* V = vt + (((size_t)b * NVT + VT_C_V + h) * 128) * S;
    load_q_lds(tm + (((size_t)b * NTM + TM_C_Q + h) * S + i) * 128, qs, lane);
    const float* biascol = P.in[I_RELBIAS] + 12 + h;
    const int qblk = i >> 8, blk0 = qblk << 8;
    float a0, a1, lseo, zi;
    naive_attend(qs, sc, i - blk0 + 1, [&](int idx) { KeyRef kr; const int j = blk0 + idx; kr.krow = K + (size_t)j * 128; kr.vkey = j; kr.dist = i - j; kr.valid = true; return kr; }, biascol, V, S, lane, a0, a1, lseo, zi);
    WAVE_LDS_SYNC();
    const float* km = (const float*)(P.ws + WS_KMEAN) + (size_t)b * 8 * 4 * 128;
    float gv = NEG_INF;
    { float part[8];
#pragma unroll
      for (int n = 0; n < 8; ++n) part[n] = wave_sum(qs[2 * lane] * km[((size_t)n * 4 + h) * 128 + 2 * lane] + qs[2 * lane + 1] * km[((size_t)n * 4 + h) * 128 + 2 * lane + 1]);
#pragma unroll
      for (int n = 0; n < 8; ++n) if (lane == n && n < qblk) gv = part[n]; }
    int sb0, sb1, sb2;
    { float m = wave_max(gv); sb0 = wave_min_i((gv == m && lane < 8) ? lane : 1 << 30); if (lane == sb0) gv = __builtin_nanf("");
      m = wave_max(gv); sb1 = wave_min_i((gv == m && lane < 8) ? lane : 1 << 30); if (lane == sb1) gv = __builtin_nanf("");
      m = wave_max(gv); sb2 = wave_min_i((gv == m && lane < 8) ? lane : 1 << 30); }
    float b0, b1, lseg;
    naive_attend(qs, sc, 768, [&](int idx) { KeyRef kr; const int sb = idx < 256 ? sb0 : idx < 512 ? sb1 : sb2; const int key = sb * 256 + (idx & 255); kr.krow = K + (size_t)key * 128; kr.vkey = key; kr.dist = i - key; kr.valid = sb < qblk; return kr; }, biascol, V, S, lane, b0, b1, lseg, zi);
    WAVE_LDS_SYNC();
    float r0, r1;
    if (lseg == NEG_INF) { r0 = a0; r1 = a1; }
    else { const float m = fmaxf(lseo, lseg), wo = __expf(lseo - m), wg = __expf(lseg - m), wi = 1.0f / (wo + wg); r0 = (wo * a0 + wg * b0) * wi; r1 = (wo * a1 + wg * b1) * wi; }
    const size_t t = (size_t)b * S + i; bf16* o = (bf16*)(P.ws + WS_ACT1);
    *(unsigned*)(o + t * D + (12 + h) * 128 + 2 * lane) = pk2(r0, r1);
    const float ssq = wave_sum(r0 * r0 + r1 * r1); if (lane == 0) ((float*)(P.ws + WS_SS))[t * 16 + 12 + h] = ssq;
}
constexpr int NA_WAVE_F = 128 + 2048 + 32;
__device__ __forceinline__ void phase_attn_naive1(const Params& P, int bid, int nb, LAS unsigned char* lds) {
    const int tid_ = TID(); const int lane = tid_ & 63, wave = tid_ >> 6, gw = bid * 8 + wave, ngw = nb * 8;
    LAS float* qs = (LAS float*)lds + wave * NA_WAVE_F; LAS float* sc = qs + 128; LAS float* imp = sc + 2048;
    for (int id = gw; id < NB * 6 * S; id += ngw) attnA_item(P, id, lane, qs, sc);
    for (int id = gw; id < NB * 2 * S; id += ngw) attnB1_item(P, id, lane, qs, sc, imp);
    for (int id = gw; id < NB * 4 * S; id += ngw) attnC_item(P, id, lane, qs, sc);
}
__device__ __forceinline__ void phase_attn_naive2(const Params& P, int bid, int nb, LAS unsigned char* lds) {
    const int tid_ = TID(); const int lane = tid_ & 63, wave = tid_ >> 6, gw = bid * 8 + wave, ngw = nb * 8;
    LAS float* qs = (LAS float*)lds + wave * NA_WAVE_F; LAS float* sc = qs + 128;
    for (int id = gw; id < NB * 6 * S; id += ngw) attnB2_item(P, id, lane, qs, sc);
}

template <int NV>
__device__ __forceinline__ void wave_top16(float (&v)[NV], int idx0, int istep, int lane, float& outv, int& outi) {
    outv = 0.f; outi = 0;
    for (int k = 0; k < 16; ++k) {
        float bv = v[0]; int bi = idx0;
#pragma unroll
        for (int e = 1; e < NV; ++e) if (v[e] > bv) { bv = v[e]; bi = idx0 + e * istep; }
        const float m = wave_max(bv); const int mi = wave_min_i(bv == m ? bi : 1 << 30);
#pragma unroll
        for (int e = 0; e < NV; ++e) if (idx0 + e * istep == mi) v[e] = NEG_INF;
        if (lane == k) { outv = m; outi = mi; }
    }
}
__device__ __forceinline__ void peer_select_item(const Params& P, int l, int id, int lane, LAS float* qs) {
    const int h = id & 7; const size_t t = id >> 3;
    const bf16* q = (const bf16*)(P.ws + WS_ACT1) + t * D + h * 256;
#pragma unroll
    for (int j = 0; j < 4; ++j) qs[lane * 4 + j] = bf2f(q[lane * 4 + j]);
    WAVE_LDS_SYNC();
    float tv[2]; int ti[2];
#pragma unroll
    for (int c = 0; c < 2; ++c) {
        const float* keys = P.in[I_PEERKEYS] + ((((size_t)l * 8 + h) * 2 + c) * 128) * 128;
        float sc[2] = {0.f, 0.f};
        const float* k0p = keys + (size_t)lane * 128; const float* k1p = k0p + 64 * 128;
#pragma unroll 4
        for (int d = 0; d < 128; d += 4) { const f32x4 qq = *(const LAS f32x4*)(qs + c * 128 + d); const f32x4 k0 = *(const f32x4*)(k0p + d), k1 = *(const f32x4*)(k1p + d);
            sc[0] += qq.x * k0.x + qq.y * k0.y + qq.z * k0.z + qq.w * k0.w; sc[1] += qq.x * k1.x + qq.y * k1.y + qq.z * k1.z + qq.w * k1.w; }
        wave_top16<2>(sc, lane, 64, lane, tv[c], ti[c]);
    }
    float cv[4];
    const float s0 = lane_get(tv[0], lane >> 2);
#pragma unroll
    for (int e = 0; e < 4; ++e) cv[e] = s0 + lane_get(tv[1], (lane & 3) * 4 + e);
    float bs; int bj; wave_top16<4>(cv, lane * 4, 1, lane, bs, bj);
    const int ei = lane_get_i(ti[0], bj >> 4) * 128 + lane_get_i(ti[1], bj & 15);
    const float m = lane_get(bs, 0); float e = lane < 16 ? __expf(bs - m) : 0.f; const float z = wave_sum(e);
    if (lane < 16) { ((int*)(P.ws + WS_EXP))[t * 128 + h * 16 + lane] = ei; ((float*)(P.ws + WS_GW))[t * 128 + h * 16 + lane] = e / z; }
    WAVE_LDS_SYNC();
}
__device__ __forceinline__ void phase_peer_select_naive(const Params& P, int l, int bid, int nb, LAS unsigned char* lds) {
    const int tid_ = TID(); const int lane = tid_ & 63, wave = tid_ >> 6, gw = bid * 8 + wave, ngw = nb * 8;
    LAS float* qs = (LAS float*)lds + wave * 256;
    for (int id = gw; id < T * 8; id += ngw) peer_select_item(P, l, id, lane, qs);
}
__device__ __forceinline__ void unpack8(const v4u w, float (&f)[8]) { f[0] = bf2f(w.x & 0xffff); f[1] = bf2f(w.x >> 16); f[2] = bf2f(w.y & 0xffff); f[3] = bf2f(w.y >> 16); f[4] = bf2f(w.z & 0xffff); f[5] = bf2f(w.z >> 16); f[6] = bf2f(w.w & 0xffff); f[7] = bf2f(w.w >> 16); }

namespace fa {
typedef short bf16x8 __attribute__((ext_vector_type(8)));
typedef float f32x16 __attribute__((ext_vector_type(16)));
typedef __bf16 bf2_t __attribute__((ext_vector_type(2)));
typedef float f2_t __attribute__((ext_vector_type(2)));
#define FA_MFMA(a, b, c) __builtin_amdgcn_mfma_f32_32x32x16_bf16((a), (b), (c), 0, 0, 0)
constexpr float C1 = 0.08838834764831845f * 1.4426950408889634f;
constexpr float LOG2E = 1.4426950408889634f;
constexpr float DEAD = -2e30f, MINIT = -1e30f;
constexpr int KP = 272, VP = 136;
constexpr int STG = 64 * KP + 128 * VP;
constexpr int L_STG0 = 0, L_STG1 = STG, L_T1 = 2 * STG, TBL = 2304 * 4, L_T2 = L_T1 + TBL, L_X = L_T2 + TBL;
constexpr int L_KC = 0, KCP = 272, L_VC = 128 * KCP, VCP = 264;
static_assert(L_VC + 128 * VCP <= L_T1 && L_X + 3 * TBL <= 131072 - 256, "attention LDS map");
constexpr int L_CTL = 131072 - 256;
__device__ __forceinline__ unsigned cvt2(float lo, float hi) { f2_t v = {lo, hi}; return __builtin_bit_cast(unsigned, __builtin_convertvector(v, bf2_t)); }
__device__ __forceinline__ float xhalf(float v, int h) { float lo, hi; halves(v, lo, hi); return h ? lo : hi; }
__device__ __forceinline__ int xhalf_i(int v, int h) { int lo, hi; halves_i(v, lo, hi); return h ? lo : hi; }

__device__ __forceinline__ void copy_table(LAS float* T, const Params& P, int kind, int gh, int tid) {
    const GAS f32x4* src = (const GAS f32x4*)((const GAS float*)(P.ws + WS_TBL) + (size_t)(gh * 3 + kind) * 2304);
    for (int i = tid; i < 576; i += 512) *(LAS f32x4*)(T + 4 * i) = src[i];
}
struct Stream { const bf16* K; const bf16* Vt; const LAS float* T; int jlo, jhi; unsigned ormask; int shift; unsigned rowmask; int maxd; };
struct State { f32x16 o[4]; float m, l; };
__device__ __forceinline__ void state_init(State& s) {
#pragma unroll
    for (int mt = 0; mt < 4; ++mt)
#pragma unroll
        for (int i = 0; i < 16; ++i) s.o[mt][i] = 0.f;
    s.m = MINIT; s.l = 0.f;
}
__device__ __forceinline__ int next_active(int j, int jhi, unsigned ormask, int shift) { while (j <= jhi && !((ormask >> (j >> shift)) & 1u)) ++j; return j <= jhi ? j : -1; }
__device__ __forceinline__ void run_stream(const Stream& st, const bf16x8 (&bq)[8], State& S, int qpos, LAS unsigned char* lds, int tid) {
    const int lane = tid & 63, r = lane & 31, h = lane >> 5;
    int j = next_active(st.jlo, st.jhi, st.ormask, st.shift);
    if (j < 0) return;
    const GAS unsigned char* Kg = (const GAS unsigned char*)st.K; const GAS unsigned char* Vg = (const GAS unsigned char*)st.Vt;
    const int kc0 = tid, kc1 = tid + 512;
    const unsigned k_lds0 = (kc0 >> 4) * KP + (kc0 & 15) * 16, k_lds1 = (kc1 >> 4) * KP + (kc1 & 15) * 16;
    const unsigned v_lds0 = 64 * KP + (kc0 >> 3) * VP + (kc0 & 7) * 16, v_lds1 = 64 * KP + (kc1 >> 3) * VP + (kc1 & 7) * 16;
    const size_t v_g0 = (size_t)(kc0 >> 3) * (::S * 2) + (kc0 & 7) * 16, v_g1 = (size_t)(kc1 >> 3) * (::S * 2) + (kc1 & 7) * 16;
    v4u ka0, ka1, va0, va1, kb0, kb1, vb0, vb1;
#define FA_PREFETCH(kr0, kr1, vr0, vr1, jj) do { const size_t kb_ = (size_t)(jj) * (64 * 256); kr0 = *(const GAS v4u*)(Kg + kb_ + (size_t)kc0 * 16); kr1 = *(const GAS v4u*)(Kg + kb_ + (size_t)kc1 * 16); \
        const size_t vb_ = (size_t)(jj) * 128; vr0 = *(const GAS v4u*)(Vg + vb_ + v_g0); vr1 = *(const GAS v4u*)(Vg + vb_ + v_g1); } while (0)
#define FA_WRITE(kr0, kr1, vr0, vr1, stg) do { LAS unsigned char* sw = lds + (stg); *(LAS v4u*)(sw + k_lds0) = kr0; *(LAS v4u*)(sw + k_lds1) = kr1; \
        *(LAS v2u*)(sw + v_lds0) = (v2u){vr0.x, vr0.y}; *(LAS v2u*)(sw + v_lds0 + 8) = (v2u){vr0.z, vr0.w}; *(LAS v2u*)(sw + v_lds1) = (v2u){vr1.x, vr1.y}; *(LAS v2u*)(sw + v_lds1 + 8) = (v2u){vr1.z, vr1.w}; } while (0)
    auto compute = [&](const int j, const LAS unsigned char* sb, const bool force_dead) __attribute__((always_inline)) {
#if FA_STAGGER
        if (tid >= 256) __builtin_amdgcn_s_sleep(FA_STAGGER);
#endif
        const bool bit = ((st.rowmask >> (j >> st.shift)) & 1u) && !force_dead;
        const int bidx = bit ? (qpos - 64 * j + 256 - 4 * h - 59) : (4 - 4 * h);
        const LAS float* tp = st.T + bidx;
        const int wq_hi = qpos - r + 31, wq_lo = qpos - r;
#pragma unroll
        for (int kt = 0; kt < 2; ++kt) {
            if (64 * j + 32 * kt > wq_hi || 64 * j + 32 * kt + 31 < wq_lo - st.maxd) continue;
            f32x16 sc;
#pragma unroll
            for (int i = 0; i < 16; ++i) sc[i] = 0.f;
            { bf16x8 af[8];
#pragma unroll
              for (int ks = 0; ks < 8; ++ks) af[ks] = *(const LAS bf16x8*)(sb + (32 * kt + r) * KP + (16 * ks + 8 * h) * 2);
              __builtin_amdgcn_s_setprio(1);
#pragma unroll
              for (int ks = 0; ks < 8; ++ks) sc = FA_MFMA(af[ks], bq[ks], sc);
              __builtin_amdgcn_s_setprio(0); }
            float mloc = S.m;
#pragma unroll
            for (int i = 0; i < 16; ++i) { const float s = __builtin_fmaf(sc[i], C1, tp[59 - 32 * kt - 8 * (i >> 2) - (i & 3)]); sc[i] = s; mloc = fmaxf(mloc, s); }
            float mlo_, mhi_; halves(mloc, mlo_, mhi_); const float mnew = fmaxf(mlo_, mhi_);
            const float alpha = __builtin_amdgcn_exp2f(S.m - mnew);
            float lsum = 0.f;
#pragma unroll
            for (int i = 0; i < 16; ++i) { const float p = __builtin_amdgcn_exp2f(sc[i] - mnew); sc[i] = p; lsum += p; }
            S.l = S.l * alpha + lsum; S.m = mnew;
            if (__builtin_amdgcn_ballot_w64(alpha != 1.0f) != 0ull) {
#pragma unroll
                for (int mt = 0; mt < 4; ++mt)
#pragma unroll
                    for (int i = 0; i < 16; ++i) S.o[mt][i] *= alpha;
            }
#pragma unroll
            for (int s2 = 0; s2 < 2; ++s2) { const int sp = 2 * kt + s2, s8 = s2 * 8;
                v4u pw; pw.x = cvt2(sc[s8 + 0], sc[s8 + 1]); pw.y = cvt2(sc[s8 + 2], sc[s8 + 3]); pw.z = cvt2(sc[s8 + 4], sc[s8 + 5]); pw.w = cvt2(sc[s8 + 6], sc[s8 + 7]);
                const bf16x8 pb = __builtin_bit_cast(bf16x8, pw);
                bf16x8 vf[4];
#pragma unroll
                for (int mt = 0; mt < 4; ++mt) { const LAS unsigned char* vp = sb + 64 * KP + (32 * mt + r) * VP + (16 * sp + 4 * h) * 2;
                    const v2u lo = *(const LAS v2u*)vp, hi = *(const LAS v2u*)(vp + 16);
                    vf[mt] = __builtin_bit_cast(bf16x8, (v4u){lo.x, lo.y, hi.x, hi.y}); }
                __builtin_amdgcn_s_setprio(1);
#pragma unroll
                for (int mt = 0; mt < 4; ++mt) S.o[mt] = FA_MFMA(vf[mt], pb, S.o[mt]);
                __builtin_amdgcn_s_setprio(0); }
        }
    };
    int jc = j, jn = next_active(jc + 1, st.jhi, st.ormask, st.shift);
    FA_PREFETCH(ka0, ka1, va0, va1, jc); FA_WRITE(ka0, ka1, va0, va1, L_STG0);
    FA_PREFETCH(ka0, ka1, va0, va1, jn >= 0 ? jn : jc);
    __syncthreads();
    for (;;) {
        const int j2 = jn >= 0 ? next_active(jn + 1, st.jhi, st.ormask, st.shift) : -1;
        FA_PREFETCH(kb0, kb1, vb0, vb1, j2 >= 0 ? j2 : jc);
        compute(jc, lds + L_STG0, false);
        asm volatile("s_waitcnt vmcnt(4)" ::: "memory");
        FA_WRITE(ka0, ka1, va0, va1, L_STG1);
        asm volatile("s_waitcnt lgkmcnt(0)\n\ts_barrier" ::: "memory");
        if (jn < 0) break;
        const int j3 = j2 >= 0 ? next_active(j2 + 1, st.jhi, st.ormask, st.shift) : -1;
        FA_PREFETCH(ka0, ka1, va0, va1, j3 >= 0 ? j3 : jn);
        compute(jn, lds + L_STG1, false);
        asm volatile("s_waitcnt vmcnt(4)" ::: "memory");
        FA_WRITE(kb0, kb1, vb0, vb1, L_STG0);
        asm volatile("s_waitcnt lgkmcnt(0)\n\ts_barrier" ::: "memory");
        if (j2 < 0) break;
        jc = j2; jn = j3;
    }
    asm volatile("s_waitcnt vmcnt(0)" ::: "memory");
    __syncthreads();
#undef FA_PREFETCH
#undef FA_WRITE
}
__device__ __forceinline__ void load_q(const bf16* Qrow, bf16x8 (&bq)[8], int h) {
#pragma unroll
    for (int ks = 0; ks < 8; ++ks) bq[ks] = __builtin_bit_cast(bf16x8, *(const GAS v4u*)((const GAS bf16*)Qrow + 16 * ks + 8 * h));
}
__device__ __forceinline__ float finish(State& S, float wgt) { float llo_, lhi_; halves(S.l, llo_, lhi_); const float lt = llo_ + lhi_; const float inv = wgt / lt;
#pragma unroll
    for (int mt = 0; mt < 4; ++mt)
#pragma unroll
        for (int i = 0; i < 16; ++i) S.o[mt][i] *= inv;
    return inv; }
__device__ __forceinline__ void store_out(const State& S, bf16* o, float* ss, size_t t, int gh, int h) {
    float q = 0.f; GAS bf16* op = (GAS bf16*)o + t * D + gh * 128 + 4 * h;
#pragma unroll
    for (int mt = 0; mt < 4; ++mt)
#pragma unroll
        for (int g = 0; g < 4; ++g) { const float a = S.o[mt][4 * g], b = S.o[mt][4 * g + 1], c = S.o[mt][4 * g + 2], d = S.o[mt][4 * g + 3];
            q += a * a + b * b + c * c + d * d; *(GAS v2u*)(op + 32 * mt + 8 * g) = (v2u){cvt2(a, b), cvt2(c, d)}; }
    { float qlo_, qhi_; halves(q, qlo_, qhi_); q = qlo_ + qhi_; } if (h == 0) ss[t * 16 + gh] = q;
}
__device__ __forceinline__ void decode_unit(int u, int& b, int& gh, int& qt) {
    int isb, w;
    if (u < 240) { isb = 1; qt = 7 - u / 48; w = u % 48; }
    else if (u < 320) { isb = 0; qt = 7; w = u - 240; }
    else if (u < 368) { isb = 1; qt = 2; w = u - 320; }
    else if (u < 528) { isb = 0; qt = 6 - (u - 368) / 80; w = (u - 368) % 80; }
    else if (u < 576) { isb = 1; qt = 1; w = u - 528; }
    else if (u < 736) { isb = 0; qt = 4 - (u - 576) / 80; w = (u - 576) % 80; }
    else if (u < 784) { isb = 1; qt = 0; w = u - 736; }
    else { isb = 0; qt = 2 - (u - 784) / 80; w = (u - 784) % 80; }
    b = w & 7; const int hh = w >> 3;
    if (isb) gh = 6 + hh; else gh = hh < 6 ? hh : 12 + (hh - 6);
}

__device__ __forceinline__ void attn_unit(const Params& P, int u, LAS unsigned char* lds) {
    const int tid = TID();
    const int lane = tid & 63, wave = tid >> 6, r = lane & 31, h = lane >> 5;
    int b, gh, qt; decode_unit(u, b, gh, qt);
    const int q0 = qt * 256, qpos = q0 + 32 * wave + r; const size_t t = (size_t)b * S + qpos;
    const bf16* tm = (const bf16*)(P.ws + WS_TM); const bf16* vt = (const bf16*)(P.ws + WS_VT);
    bf16* o = (bf16*)(P.ws + WS_ACT1); float* ss = (float*)(P.ws + WS_SS);
    volatile LAS unsigned* ctl = (volatile LAS unsigned*)(lds + L_CTL);
    LAS float* T1 = (LAS float*)(lds + L_T1); LAS float* T2 = (LAS float*)(lds + L_T2);
    bf16x8 bq[8]; State St;
    if (gh < 6) {
        copy_table(T1, P, 2, gh, tid);
        load_q(tm + (((size_t)b * NTM + TM_A_Q + gh) * S + qpos) * 128, bq, h);
        __syncthreads();
        state_init(St);
        Stream s{tm + ((size_t)b * NTM + TM_A_K + gh) * S * 128, vt + ((size_t)b * NVT + VT_A_V + gh) * 128 * S, T1, 0, 4 * qt + 3, 0xffffffffu, 0, 0xffffffffu, 4096};
        run_stream(s, bq, St, qpos, lds, tid);
        finish(St, 1.0f); store_out(St, o, ss, t, gh, h);
    } else if (gh >= 12) {
        const int hc = gh - 12;
        copy_table(T1, P, 0, gh, tid);
        LAS float* km = (LAS float*)(lds + L_X);
        { const float* kmg = (const float*)(P.ws + WS_KMEAN) + (size_t)b * 8 * 4 * 128;
          for (int i = tid; i < qt * 128; i += 512) km[i] = kmg[((size_t)(i >> 7) * 4 + hc) * 128 + (i & 127)]; }
        load_q(tm + (((size_t)b * NTM + TM_C_Q + hc) * S + qpos) * 128, bq, h);
        if (tid == 0) ctl[1] = 0u;
        __syncthreads();
        float gate[8];
#pragma unroll
        for (int n = 0; n < 8; ++n) gate[n] = 0.f;
#pragma unroll
        for (int ks = 0; ks < 8; ++ks) { const v4u w = __builtin_bit_cast(v4u, bq[ks]); float f[8]; unpack8(w, f);
#pragma unroll
            for (int n = 0; n < 8; ++n) if (n < qt) { const f32x4 k0 = *(const LAS f32x4*)(km + n * 128 + 16 * ks + 8 * h), k1 = *(const LAS f32x4*)(km + n * 128 + 16 * ks + 8 * h + 4);
                gate[n] += f[0] * k0.x + f[1] * k0.y + f[2] * k0.z + f[3] * k0.w + f[4] * k1.x + f[5] * k1.y + f[6] * k1.z + f[7] * k1.w; } }
        unsigned rowmask = 1u << qt;
#pragma unroll
        for (int n = 0; n < 8; ++n) { float glo_, ghi_; halves(gate[n], glo_, ghi_); gate[n] = glo_ + ghi_; if (n >= qt) gate[n] = NEG_INF; }
#pragma unroll
        for (int k = 0; k < 3; ++k) { float bv = NEG_INF; int bi = -1;
#pragma unroll
            for (int n = 0; n < 8; ++n) if (gate[n] > bv) { bv = gate[n]; bi = n; }
#pragma unroll
            for (int n = 0; n < 8; ++n) if (n == bi) { gate[n] = NEG_INF; rowmask |= 1u << n; } }
        { const unsigned om = wave_or(rowmask); if (lane == 0) atomicOr((unsigned*)(ctl + 1), om); }
        __syncthreads();
        const unsigned ormask = ctl[1];
        state_init(St);
        Stream s{tm + ((size_t)b * NTM + TM_C_K + hc) * S * 128, vt + ((size_t)b * NVT + VT_C_V + hc) * 128 * S, T1, 0, 4 * qt + 3, ormask, 2, rowmask, 4096};
        run_stream(s, bq, St, qpos, lds, tid);
        finish(St, 1.0f); store_out(St, o, ss, t, gh, h);
    } else {
        const int hb = gh - 6, g = hb / 3;
        const float* gates = (const float*)(P.ws + WS_GATES) + t * 18 + hb * 3; const float g0 = gates[0], g1 = gates[1], g2 = gates[2];
        GAS float* oacc = (GAS float*)(P.ws + WS_OCMP) + t * 768 + hb * 128 + 4 * h;
        { const GAS unsigned char* kcg = (const GAS unsigned char*)((const bf16*)(P.ws + WS_KCMP) + ((size_t)b * 2 + g) * 128 * 128); const GAS unsigned char* vcg = (const GAS unsigned char*)((const bf16*)(P.ws + WS_VCMPT) + ((size_t)b * 2 + g) * 128 * 128);
#pragma unroll
          for (int c = tid; c < 2048; c += 512) { const v4u kv = *(const GAS v4u*)(kcg + (size_t)c * 16); *(LAS v4u*)(lds + L_KC + (c >> 4) * KCP + (c & 15) * 16) = kv;
              const v4u vv = *(const GAS v4u*)(vcg + (size_t)c * 16); LAS unsigned char* vd = lds + L_VC + (c >> 4) * VCP + (c & 15) * 16; *(LAS v2u*)vd = (v2u){vv.x, vv.y}; *(LAS v2u*)(vd + 8) = (v2u){vv.z, vv.w}; } }
#pragma unroll
        for (int rr = 0; rr < 3; ++rr) copy_table((LAS float*)(lds + L_X + rr * TBL), P, 0, 6 + g * 3 + rr, tid);
        copy_table(T1, P, 0, gh, tid); copy_table(T2, P, 1, gh, tid);
        if (tid == 0) ctl[1] = 0u;
        __syncthreads();
        float imp[16];
#pragma unroll
        for (int a = 0; a < 16; ++a) imp[a] = 0.f;
        f32x16 sc[4];
#pragma unroll 1
        for (int rq = 0; rq < 3; ++rq) { int rr = hb - g * 3 + 1 + rq; rr = rr >= 3 ? rr - 3 : rr; const int hh = g * 3 + rr;
            asm volatile("" ::: "memory");
            load_q(tm + (((size_t)b * NTM + TM_B_Q + hh) * S + qpos) * 128, bq, h);
            const LAS float* Tc = (const LAS float*)(lds + L_X + rr * TBL);
#pragma unroll
            for (int kt = 0; kt < 4; ++kt) {
#pragma unroll
                for (int i = 0; i < 16; ++i) sc[kt][i] = 0.f;
#pragma unroll
                for (int ks = 0; ks < 8; ++ks) { const bf16x8 a = *(const LAS bf16x8*)(lds + L_KC + (32 * kt + r) * KCP + (16 * ks + 8 * h) * 2); sc[kt] = FA_MFMA(a, bq[ks], sc[kt]); } }
            float mloc = MINIT;
#pragma unroll
            for (int kt = 0; kt < 4; ++kt)
#pragma unroll
                for (int i = 0; i < 16; ++i) { const int n = 32 * kt + 8 * (i >> 2) + 4 * h + (i & 3); int idx = qpos - 16 * n - 31 + 256; idx = idx < 0 ? 0 : idx;
                    const float s = __builtin_fmaf(sc[kt][i], C1, Tc[idx]); sc[kt][i] = s; mloc = fmaxf(mloc, s); }
            float mlo_, mhi_; halves(mloc, mlo_, mhi_); const float mrow = fmaxf(mlo_, mhi_); float lsum = 0.f;
#pragma unroll
            for (int kt = 0; kt < 4; ++kt)
#pragma unroll
                for (int i = 0; i < 16; ++i) { const float p = __builtin_amdgcn_exp2f(sc[kt][i] - mrow); sc[kt][i] = p; lsum += p; }
            { float slo_, shi_; halves(lsum, slo_, shi_); lsum = slo_ + shi_; } const float inv = lsum > 0.f ? 1.0f / lsum : 0.f;
#pragma unroll
            for (int a = 0; a < 16; ++a) { const int kt = a >> 2, i0 = (a & 3) * 4;
                const float p0 = sc[kt][i0] * inv, p1 = sc[kt][i0 + 1] * inv, p2 = sc[kt][i0 + 2] * inv, p3 = sc[kt][i0 + 3] * inv;
                sc[kt][i0] = p0; sc[kt][i0 + 1] = p1; sc[kt][i0 + 2] = p2; sc[kt][i0 + 3] = p3;
                imp[a] += (p0 + p1) + (p2 + p3); }
            { float prev = 0.f;
#pragma unroll
              for (int a = 0; a < 16; ++a) { const float lv = xhalf(sc[a >> 2][(a & 3) * 4 + 3], h); imp[a] += h ? lv : prev; prev = lv; } }
        }
        state_init(St);
#pragma unroll
        for (int sp = 0; sp < 8; ++sp) { const int kt = sp >> 1, s8 = (sp & 1) * 8;
            v4u pw; pw.x = cvt2(sc[kt][s8 + 0], sc[kt][s8 + 1]); pw.y = cvt2(sc[kt][s8 + 2], sc[kt][s8 + 3]); pw.z = cvt2(sc[kt][s8 + 4], sc[kt][s8 + 5]); pw.w = cvt2(sc[kt][s8 + 6], sc[kt][s8 + 7]);
            const bf16x8 pb = __builtin_bit_cast(bf16x8, pw);
#pragma unroll
            for (int mt = 0; mt < 4; ++mt) { const LAS unsigned char* vp = lds + L_VC + (32 * mt + r) * VCP + (16 * sp + 4 * h) * 2;
                const v2u lo = *(const LAS v2u*)vp, hi = *(const LAS v2u*)(vp + 16);
                St.o[mt] = FA_MFMA(__builtin_bit_cast(bf16x8, (v4u){lo.x, lo.y, hi.x, hi.y}), pb, St.o[mt]); } }
#pragma unroll
        for (int mt = 0; mt < 4; ++mt)
#pragma unroll
            for (int gq = 0; gq < 4; ++gq) *(GAS f32x4*)(oacc + 32 * mt + 8 * gq) = (f32x4){St.o[mt][4 * gq] * g0, St.o[mt][4 * gq + 1] * g0, St.o[mt][4 * gq + 2] * g0, St.o[mt][4 * gq + 3] * g0};
        const int qblk = qpos >> 6;
        unsigned selmask;
        if (qblk <= 7) selmask = (2u << qblk) - 1u;
        else { selmask = 1u | (3u << (qblk - 1));
#pragma unroll
            for (int a = 0; a < 16; ++a) { const int jb = 2 * a + h; if (jb == 0 || jb >= qblk - 1) imp[a] = NEG_INF; }
#pragma unroll 1
            for (int k = 0; k < 5; ++k) { float bv = NEG_INF; int bj = 1 << 20;
#pragma unroll
                for (int a = 0; a < 16; ++a) if (imp[a] > bv) { bv = imp[a]; bj = 2 * a + h; }
                const float ov = xhalf(bv, h); const int oj = xhalf_i(bj, h);
                const bool mine = (bv > ov) || (bv == ov && bj < oj);
                const int wj = mine ? bj : oj;
                if (wj < 32) { selmask |= 1u << wj;
#pragma unroll
                    for (int a = 0; a < 16; ++a) if (2 * a + h == wj) imp[a] = NEG_INF; } } }
        { const unsigned om = wave_or(selmask); if (lane == 0) atomicOr((unsigned*)(ctl + 1), om); }
        load_q(tm + (((size_t)b * NTM + TM_B_Q + hb) * S + qpos) * 128, bq, h);
        __syncthreads();
        const unsigned ormask = ctl[1];
        state_init(St);
        { Stream s{tm + ((size_t)b * NTM + TM_B_KS + g) * S * 128, vt + ((size_t)b * NVT + VT_B_VS + g) * 128 * S, T1, 0, 4 * qt + 3, ormask, 0, selmask, 4096};
          run_stream(s, bq, St, qpos, lds, tid); }
        finish(St, g1);
#pragma unroll
        for (int mt = 0; mt < 4; ++mt)
#pragma unroll
            for (int gq = 0; gq < 4; ++gq) { const f32x4 pv = *(const GAS f32x4*)(oacc + 32 * mt + 8 * gq);
                *(GAS f32x4*)(oacc + 32 * mt + 8 * gq) = (f32x4){pv.x + St.o[mt][4 * gq], pv.y + St.o[mt][4 * gq + 1], pv.z + St.o[mt][4 * gq + 2], pv.w + St.o[mt][4 * gq + 3]}; }
        state_init(St);
        { const int jlo = q0 >= 512 ? (q0 - 512) / 64 : 0;
          Stream s{tm + ((size_t)b * NTM + TM_B_KW + g) * S * 128, vt + ((size_t)b * NVT + VT_B_VW + g) * 128 * S, T2, jlo, 4 * qt + 3, 0xffffffffu, 0, 0xffffffffu, 511};
          run_stream(s, bq, St, qpos, lds, tid); }
        finish(St, g2);
#pragma unroll
        for (int mt = 0; mt < 4; ++mt)
#pragma unroll
            for (int gq = 0; gq < 4; ++gq) { const f32x4 pv = *(const GAS f32x4*)(oacc + 32 * mt + 8 * gq);
                St.o[mt][4 * gq] += pv.x; St.o[mt][4 * gq + 1] += pv.y; St.o[mt][4 * gq + 2] += pv.z; St.o[mt][4 * gq + 3] += pv.w; }
        store_out(St, o, ss, t, gh, h);
    }
}
__device__ __forceinline__ void phase_attn(const Params& P, int l, LAS unsigned char* lds) {
    const int tid = TID();
    volatile LAS unsigned* ctl = (volatile LAS unsigned*)(lds + L_CTL);
    unsigned* qctr = (unsigned*)(P.ws + WS_CTL) + 8192 + 64 * l;
    for (;;) {
        __syncthreads();
        if (tid == 0) ctl[0] = __hip_atomic_fetch_add(qctr, 1u, __ATOMIC_RELAXED, __HIP_MEMORY_SCOPE_AGENT);
        __syncthreads();
        const unsigned u = ctl[0];
        if (u >= 1024u) break;
        attn_unit(P, (int)u, lds);
    }
}
#undef FA_MFMA
}

namespace pf {
typedef short bf16x8 __attribute__((ext_vector_type(8)));
typedef float f32x16 __attribute__((ext_vector_type(16)));
__device__ __forceinline__ void cmp_unit(const Params& P, int l, int u, LAS unsigned char* lds) {
    const int tid = TID(), lane = tid & 63, wave = tid >> 6, r = lane & 31, h = lane >> 5;
    const int which = u >> 7, bg = (u >> 3) & 15, b = bg >> 1, g = bg & 1, n0 = ((u >> 1) & 3) * 32, e0 = (u & 1) * 64;
    const GAS bf16* A = (const GAS bf16*)(P.ws + WS_TM) + (((size_t)b * NTM + (which ? TM_B_VC : TM_B_KC) + g) * S + 16 * (n0 + r)) * 128 + 512 * wave + 8 * h;
    const GAS bf16* Bt = (const GAS bf16*)(P.ws + WS_CWT) + (((size_t)l * 2 + which) * 128 + e0 + r) * 4096 + 512 * wave + 8 * h;
    float pw = 0.f;
    if (tid < 64) { const GAS float* pp = (const GAS float*)(P.ws + WS_POSW) + ((size_t)l * 2 + which) * 32 * 128 + e0 + tid;
#pragma unroll
        for (int kc = 0; kc < 32; ++kc) pw += pp[kc * 128]; }
    f32x16 acc[2];
#pragma unroll
    for (int ct = 0; ct < 2; ++ct)
#pragma unroll
        for (int i = 0; i < 16; ++i) acc[ct][i] = 0.f;
#pragma unroll 8
    for (int ks = 0; ks < 32; ++ks) {
        const bf16x8 a = __builtin_bit_cast(bf16x8, *(const GAS v4u*)(A + 16 * ks));
#pragma unroll
        for (int ct = 0; ct < 2; ++ct) { const bf16x8 bb = __builtin_bit_cast(bf16x8, *(const GAS v4u*)(Bt + (size_t)ct * 32 * 4096 + 16 * ks)); acc[ct] = __builtin_amdgcn_mfma_f32_32x32x16_bf16(a, bb, acc[ct], 0, 0, 0); }
    }
    LAS float* red = (LAS float*)lds; LAS float* pwl = red + 8 * 2048;
#pragma unroll
    for (int ct = 0; ct < 2; ++ct)
#pragma unroll
        for (int i = 0; i < 16; ++i) red[((wave * 2 + ct) * 16 + i) * 64 + lane] = acc[ct][i];
    if (tid < 64) pwl[tid] = pw;
    __syncthreads();
#pragma unroll
    for (int j = 0; j < 4; ++j) { const int o = tid + 512 * j; float v = 0.f;
#pragma unroll
        for (int w = 0; w < 8; ++w) v += red[w * 2048 + o];
        const int ln = o & 63, i = (o >> 6) & 15, ct = o >> 10; const int n = n0 + (i & 3) + 8 * (i >> 2) + 4 * (ln >> 5), e = e0 + 32 * ct + (ln & 31);
        v += pwl[32 * ct + (ln & 31)];
        if (n == 127) v = 0.f;
        if (which == 0) ((GAS bf16*)(P.ws + WS_KCMP))[(((size_t)b * 2 + g) * 128 + n) * 128 + e] = (bf16)f2bf(v);
        else ((GAS bf16*)(P.ws + WS_VCMPT))[(((size_t)b * 2 + g) * 128 + e) * 128 + n] = (bf16)f2bf(v); }
    __syncthreads();
}
__device__ __forceinline__ void kmean_unit(const Params& P, int u, LAS unsigned char* lds) {
    const int tid = TID(), dp = tid & 63, part = tid >> 6; const int hc = u & 3, blk = (u >> 2) & 7, b = u >> 5;
    const GAS bf16* k = (const GAS bf16*)(P.ws + WS_TM) + (((size_t)b * NTM + TM_C_K + hc) * S + blk * 256 + part * 32) * 128 + 2 * dp;
    float s0 = 0.f, s1 = 0.f;
#pragma unroll 8
    for (int j = 0; j < 32; ++j) { const unsigned w = *(const GAS unsigned*)(k + (size_t)j * 128); s0 += bf2f(w & 0xffff); s1 += bf2f(w >> 16); }
    LAS float* red = (LAS float*)lds; red[part * 128 + 2 * dp] = s0; red[part * 128 + 2 * dp + 1] = s1;
    __syncthreads();
    if (tid < 128) { float v = 0.f;
#pragma unroll
        for (int p = 0; p < 8; ++p) v += red[p * 128 + tid];
        ((GAS float*)(P.ws + WS_KMEAN))[(((size_t)b * 8 + blk) * 4 + hc) * 128 + tid] = v * (1.0f / 256.f); }
    __syncthreads();
}
__device__ __forceinline__ void phase_prep(const Params& P, int l, int bid, int nb, LAS unsigned char* lds) {
    for (int u = bid; u < 512; u += nb) { if (u < 256) cmp_unit(P, l, u, lds); else kmean_unit(P, u - 256, lds); }
}
}

typedef __bf16 bf2_t __attribute__((ext_vector_type(2)));
__device__ __forceinline__ float dot2bf(unsigned a, unsigned b, float c) { return __builtin_amdgcn_fdot2_f32_bf16(__builtin_bit_cast(bf2_t, a), __builtin_bit_cast(bf2_t, b), c, false); }

namespace ps {
typedef short bf16x8 __attribute__((ext_vector_type(8)));
typedef float f32x16 __attribute__((ext_vector_type(16)));
#define PS_CE(a, b) do { const float hi_ = fmaxf((a), (b)), lo_ = fminf((a), (b)); (a) = hi_; (b) = lo_; } while (0)
__device__ __forceinline__ void sort16(float (&v)[16]) {
#pragma unroll
    for (int k = 2; k <= 16; k <<= 1)
#pragma unroll
        for (int j = k >> 1; j > 0; j >>= 1)
#pragma unroll
            for (int i = 0; i < 16; ++i) { const int p = i ^ j; if (p > i) { if ((i & k) == 0) PS_CE(v[i], v[p]); else PS_CE(v[p], v[i]); } }
}
__device__ __forceinline__ void merge16(float (&a)[16], const float (&b)[16]) {
#pragma unroll
    for (int i = 0; i < 16; ++i) a[i] = fmaxf(a[i], b[15 - i]);
#pragma unroll
    for (int j = 8; j > 0; j >>= 1)
#pragma unroll
        for (int i = 0; i < 16; ++i) { const int p = i ^ j; if (p > i) PS_CE(a[i], a[p]); }
}
__device__ __forceinline__ float pack_low(float v, unsigned mask, unsigned tag) { return __uint_as_float((__float_as_uint(v) & ~mask) | tag); }
constexpr int SKP = 272;
__device__ __forceinline__ void load_q8(const GAS bf16* qrow, int h2, bf16x8 (&bq)[8]) {
#pragma unroll
    for (int ks = 0; ks < 8; ++ks) bq[ks] = __builtin_bit_cast(bf16x8, *(const GAS v4u*)(qrow + 16 * ks + 8 * h2));
}
__device__ __forceinline__ void top16_half(const LAS unsigned char* keys, const bf16x8 (&bq)[8], int r, int h2, float (&top)[16]) {
    float grp[4][16];
#pragma unroll
    for (int kt = 0; kt < 4; ++kt) { f32x16 sc;
#pragma unroll
        for (int i = 0; i < 16; ++i) sc[i] = 0.f;
#pragma unroll
        for (int ks = 0; ks < 8; ++ks) { const bf16x8 a = *(const LAS bf16x8*)(keys + (32 * kt + r) * SKP + (16 * ks + 8 * h2) * 2); sc = __builtin_amdgcn_mfma_f32_32x32x16_bf16(a, bq[ks], sc, 0, 0, 0); }
#pragma unroll
        for (int i = 0; i < 16; ++i) { const int key = 32 * kt + (i & 3) + 8 * (i >> 2); grp[kt][i] = pack_low(sc[i], 0x7Fu, (unsigned)(127 - key) - 4u * (unsigned)h2); } }
    sort16(grp[0]); sort16(grp[1]); sort16(grp[2]); sort16(grp[3]);
    merge16(grp[0], grp[1]); merge16(grp[2], grp[3]); merge16(grp[0], grp[2]);
    float oth[16];
#pragma unroll
    for (int i = 0; i < 16; ++i) oth[i] = fa::xhalf(grp[0][i], h2);
    merge16(grp[0], oth);
#pragma unroll
    for (int i = 0; i < 16; ++i) top[i] = grp[0][i];
}
__device__ __forceinline__ void select_unit(const Params& P, int l, int u, LAS unsigned char* lds, bool stage) {
    const int tid = TID(), lane = tid & 63, wave = tid >> 6, r = lane & 31, h2 = lane >> 5;
    const int head = u & 7; const size_t t = (size_t)(u >> 3) * 256 + wave * 32 + r;
    const GAS bf16* q = (const GAS bf16*)(P.ws + WS_ACT1) + t * D + head * 256;
    bf16x8 bq0[8], bq1[8]; load_q8(q, h2, bq0); load_q8(q + 128, h2, bq1);
    if (stage) { const GAS v4u* kg = (const GAS v4u*)((const GAS bf16*)(P.ws + WS_KEYS) + (((size_t)l * 8 + head) * 2) * 128 * 128);
      v4u kv[8];
#pragma unroll
      for (int i = 0; i < 8; ++i) kv[i] = kg[tid + 512 * i];
#pragma unroll
      for (int i = 0; i < 8; ++i) { const int pc = tid + 512 * i; *(LAS v4u*)(lds + (pc >> 4) * SKP + (pc & 15) * 16) = kv[i]; } }
    __syncthreads();
    float ts0[16], ts1[16];
    top16_half(lds, bq0, r, h2, ts0);
    top16_half(lds + 128 * SKP, bq1, r, h2, ts1);
    LAS int* til = (LAS int*)(lds + 256 * SKP) + (wave * 32 + r) * 32;
#pragma unroll
    for (int k = 0; k < 16; ++k) { float va = ts0[k], vb = ts1[k]; asm volatile("" : "+v"(va), "+v"(vb)); const float v = h2 ? vb : va; til[h2 * 16 + k] = 127 - (int)(__float_as_uint(v) & 0x7Fu); }
    float cg[4][16];
    cg[0][0] = pack_low(ts0[0] + ts1[0], 0xFFu, 255u);
    cg[0][1] = pack_low(ts0[0] + ts1[1], 0xFFu, 254u);
    cg[0][2] = pack_low(ts0[0] + ts1[2], 0xFFu, 253u);
    cg[0][3] = pack_low(ts0[0] + ts1[3], 0xFFu, 252u);
    cg[0][4] = pack_low(ts0[0] + ts1[4], 0xFFu, 251u);
    cg[0][5] = pack_low(ts0[0] + ts1[5], 0xFFu, 250u);
    cg[0][6] = pack_low(ts0[0] + ts1[6], 0xFFu, 249u);
    cg[0][7] = pack_low(ts0[0] + ts1[7], 0xFFu, 248u);
    cg[0][8] = pack_low(ts0[0] + ts1[8], 0xFFu, 247u);
    cg[0][9] = pack_low(ts0[0] + ts1[9], 0xFFu, 246u);
    cg[0][10] = pack_low(ts0[0] + ts1[10], 0xFFu, 245u);
    cg[0][11] = pack_low(ts0[0] + ts1[11], 0xFFu, 244u);
    cg[0][12] = pack_low(ts0[0] + ts1[12], 0xFFu, 243u);
    cg[0][13] = pack_low(ts0[0] + ts1[13], 0xFFu, 242u);
    cg[0][14] = pack_low(ts0[0] + ts1[14], 0xFFu, 241u);
    cg[0][15] = pack_low(ts0[0] + ts1[15], 0xFFu, 240u);
    cg[1][0] = pack_low(ts0[1] + ts1[0], 0xFFu, 239u);
    cg[1][1] = pack_low(ts0[1] + ts1[1], 0xFFu, 238u);
    cg[1][2] = pack_low(ts0[1] + ts1[2], 0xFFu, 237u);
    cg[1][3] = pack_low(ts0[1] + ts1[3], 0xFFu, 236u);
    cg[1][4] = pack_low(ts0[1] + ts1[4], 0xFFu, 235u);
    cg[1][5] = pack_low(ts0[1] + ts1[5], 0xFFu, 234u);
    cg[1][6] = pack_low(ts0[1] + ts1[6], 0xFFu, 233u);
    cg[1][7] = pack_low(ts0[1] + ts1[7], 0xFFu, 232u);
    cg[1][8] = pack_low(ts0[2] + ts1[0], 0xFFu, 223u);
    cg[1][9] = pack_low(ts0[2] + ts1[1], 0xFFu, 222u);
    cg[1][10] = pack_low(ts0[2] + ts1[2], 0xFFu, 221u);
    cg[1][11] = pack_low(ts0[2] + ts1[3], 0xFFu, 220u);
    cg[1][12] = pack_low(ts0[2] + ts1[4], 0xFFu, 219u);
    cg[1][13] = pack_low(ts0[3] + ts1[0], 0xFFu, 207u);
    cg[1][14] = pack_low(ts0[3] + ts1[1], 0xFFu, 206u);
    cg[1][15] = pack_low(ts0[3] + ts1[2], 0xFFu, 205u);
    cg[2][0] = pack_low(ts0[3] + ts1[3], 0xFFu, 204u);
    cg[2][1] = pack_low(ts0[4] + ts1[0], 0xFFu, 191u);
    cg[2][2] = pack_low(ts0[4] + ts1[1], 0xFFu, 190u);
    cg[2][3] = pack_low(ts0[4] + ts1[2], 0xFFu, 189u);
    cg[2][4] = pack_low(ts0[5] + ts1[0], 0xFFu, 175u);
    cg[2][5] = pack_low(ts0[5] + ts1[1], 0xFFu, 174u);
    cg[2][6] = pack_low(ts0[6] + ts1[0], 0xFFu, 159u);
    cg[2][7] = pack_low(ts0[6] + ts1[1], 0xFFu, 158u);
    cg[2][8] = pack_low(ts0[7] + ts1[0], 0xFFu, 143u);
    cg[2][9] = pack_low(ts0[7] + ts1[1], 0xFFu, 142u);
    cg[2][10] = pack_low(ts0[8] + ts1[0], 0xFFu, 127u);
    cg[2][11] = pack_low(ts0[9] + ts1[0], 0xFFu, 111u);
    cg[2][12] = pack_low(ts0[10] + ts1[0], 0xFFu, 95u);
    cg[2][13] = pack_low(ts0[11] + ts1[0], 0xFFu, 79u);
    cg[2][14] = pack_low(ts0[12] + ts1[0], 0xFFu, 63u);
    cg[2][15] = pack_low(ts0[13] + ts1[0], 0xFFu, 47u);
    cg[3][0] = pack_low(ts0[14] + ts1[0], 0xFFu, 31u);
    cg[3][1] = pack_low(ts0[15] + ts1[0], 0xFFu, 15u);
    cg[3][2] = NEG_INF;
    cg[3][3] = NEG_INF;
    cg[3][4] = NEG_INF;
    cg[3][5] = NEG_INF;
    cg[3][6] = NEG_INF;
    cg[3][7] = NEG_INF;
    cg[3][8] = NEG_INF;
    cg[3][9] = NEG_INF;
    cg[3][10] = NEG_INF;
    cg[3][11] = NEG_INF;
    cg[3][12] = NEG_INF;
    cg[3][13] = NEG_INF;
    cg[3][14] = NEG_INF;
    cg[3][15] = NEG_INF;
    sort16(cg[0]); sort16(cg[1]); sort16(cg[2]); sort16(cg[3]);
    merge16(cg[0], cg[1]); merge16(cg[2], cg[3]); merge16(cg[0], cg[2]);
    WAVE_LDS_SYNC();
    const float m = cg[0][0]; float z = 0.f; float ev[16];
#pragma unroll
    for (int k = 0; k < 16; ++k) { ev[k] = __expf(cg[0][k] - m); z += ev[k]; }
    const float zi = 1.0f / z;
    int eo[8]; float go[8];
#pragma unroll
    for (int k = 0; k < 8; ++k) { float wa = cg[0][k], wb = cg[0][8 + k], ea = ev[k], eb = ev[8 + k]; asm volatile("" : "+v"(wa), "+v"(wb), "+v"(ea), "+v"(eb));
        const float w = h2 ? wb : wa; const int flat = 255 - (int)(__float_as_uint(w) & 0xFFu);
        eo[k] = til[flat >> 4] * 128 + til[16 + (flat & 15)]; go[k] = (h2 ? eb : ea) * zi; }
    GAS int* ex = (GAS int*)(P.ws + WS_EXP) + t * 128 + head * 16 + 8 * h2; GAS float* gw = (GAS float*)(P.ws + WS_GW) + t * 128 + head * 16 + 8 * h2;
    typedef int i32x4 __attribute__((ext_vector_type(4)));
    *(GAS i32x4*)ex = (i32x4){eo[0], eo[1], eo[2], eo[3]}; *(GAS i32x4*)(ex + 4) = (i32x4){eo[4], eo[5], eo[6], eo[7]};
    *(GAS f32x4*)gw = (f32x4){go[0], go[1], go[2], go[3]}; *(GAS f32x4*)(gw + 4) = (f32x4){go[4], go[5], go[6], go[7]};
    WAVE_LDS_SYNC();
}
__device__ __forceinline__ void phase_select(const Params& P, int l, int bid, int nb, LAS unsigned char* lds) {
    int staged = -1;
    for (int u = bid; u < T / 32; u += nb) { const bool stage = (u & 7) != staged; if (stage) __syncthreads(); select_unit(P, l, u, lds, stage); staged = u & 7; }
    __syncthreads();
}
#undef PS_CE
}


typedef float f2v_t __attribute__((ext_vector_type(2)));
__device__ __forceinline__ void fp8x4_to_f32(unsigned w, float& a, float& b, float& c, float& d) { const f2v_t lo = __builtin_amdgcn_cvt_pk_f32_fp8((int)w, false), hi = __builtin_amdgcn_cvt_pk_f32_fp8((int)w, true); a = lo.x; b = lo.y; c = hi.x; d = hi.y; }
constexpr int PA_CH = 4;
__device__ __forceinline__ void phase_peer_apply3(const Params& P, int l, int bid, int nb) {
    const int tid = TID(), lane = tid & 63, wave = __builtin_amdgcn_readfirstlane(tid >> 6);
    const GAS bf16* xf = (const GAS bf16*)(P.ws + WS_ACT0);
    const GAS unsigned char* U = (const GAS unsigned char*)(P.ws + WS_U) + (size_t)l * NEXP * D + lane * 16; const GAS unsigned char* V = (const GAS unsigned char*)(P.ws + WS_V) + (size_t)l * NEXP * D + lane * 16;
    const float* su = (const float*)(P.ws + WS_SU) + (size_t)l * NEXP; const float* sv = (const float*)(P.ws + WS_SV) + (size_t)l * NEXP;
    const int* ex = (const int*)(P.ws + WS_EXP); const float* gw = (const float*)(P.ws + WS_GW); GAS bf16* hn = (GAS bf16*)(P.ws + WS_ACT2);
    for (int t = bid * 8 + wave; t < T; t += nb * 8) {
        float x[32], acc[32];
#pragma unroll
        for (int j = 0; j < 2; ++j)
#pragma unroll
            for (int q = 0; q < 2; ++q) { float f[8]; unpack8(*(const GAS v4u*)(xf + (size_t)t * D + j * 1024 + lane * 16 + q * 8), f);
#pragma unroll
                for (int e = 0; e < 8; ++e) { x[j * 16 + q * 8 + e] = f[e]; acc[j * 16 + q * 8 + e] = 0.f; } }
        const int* exr = ex + (size_t)t * 128; const float* gwr = gw + (size_t)t * 128;
        int en[PA_CH];
#pragma unroll
        for (int i = 0; i < PA_CH; ++i) en[i] = __builtin_amdgcn_readfirstlane(exr[i]);
        v4u Ur[PA_CH][2], Vr[2][2];
#pragma unroll
        for (int i = 0; i < PA_CH; ++i)
#pragma unroll
            for (int j = 0; j < 2; ++j) Ur[i][j] = *(const GAS v4u*)(U + (size_t)en[i] * D + j * 1024);
#if DUP_PHASE == 10
        for (int rep = 0; rep < 2; ++rep) { if (rep == 1) { float zz = 0.f; asm volatile("" : "+v"(zz));
#pragma unroll
            for (int i = 0; i < 32; ++i) acc[i] *= zz; }
#endif
#pragma unroll 1
        for (int kc = 0; kc < 128 / PA_CH; ++kc) {
            int ec[PA_CH]; float d[PA_CH];
#pragma unroll
            for (int i = 0; i < PA_CH; ++i) ec[i] = en[i];
            const int kn = kc < 128 / PA_CH - 1 ? kc + 1 : kc;
#pragma unroll
            for (int i = 0; i < PA_CH; ++i) en[i] = __builtin_amdgcn_readfirstlane(exr[PA_CH * kn + i]);
#pragma unroll
            for (int i = 0; i < PA_CH; ++i) { float s = 0.f;
#pragma unroll
                for (int j = 0; j < 2; ++j) { float a, b, c, dd;
                    fp8x4_to_f32(Ur[i][j].x, a, b, c, dd); s += a * x[j * 16 + 0] + b * x[j * 16 + 1] + c * x[j * 16 + 2] + dd * x[j * 16 + 3];
                    fp8x4_to_f32(Ur[i][j].y, a, b, c, dd); s += a * x[j * 16 + 4] + b * x[j * 16 + 5] + c * x[j * 16 + 6] + dd * x[j * 16 + 7];
                    fp8x4_to_f32(Ur[i][j].z, a, b, c, dd); s += a * x[j * 16 + 8] + b * x[j * 16 + 9] + c * x[j * 16 + 10] + dd * x[j * 16 + 11];
                    fp8x4_to_f32(Ur[i][j].w, a, b, c, dd); s += a * x[j * 16 + 12] + b * x[j * 16 + 13] + c * x[j * 16 + 14] + dd * x[j * 16 + 15]; }
                d[i] = s; }
#define PA_VLOAD(slot, i) do { _Pragma("unroll") for (int j = 0; j < 2; ++j) Vr[slot][j] = *(const GAS v4u*)(V + (size_t)ec[i] * D + j * 1024); } while (0)
#define PA_VACC1(wd, base) do { float a, b, c, dd; fp8x4_to_f32((wd), a, b, c, dd); acc[(base)] += wgt * a; acc[(base) + 1] += wgt * b; acc[(base) + 2] += wgt * c; acc[(base) + 3] += wgt * dd; } while (0)
#define PA_VACC(slot, i) do { const float wgt = d[i]; _Pragma("unroll") for (int j = 0; j < 2; ++j) { PA_VACC1(Vr[slot][j].x, j * 16); PA_VACC1(Vr[slot][j].y, j * 16 + 4); PA_VACC1(Vr[slot][j].z, j * 16 + 8); PA_VACC1(Vr[slot][j].w, j * 16 + 12); } } while (0)
            PA_VLOAD(0, 0); PA_VLOAD(1, 1);
#pragma unroll
            for (int i = 0; i < PA_CH; ++i)
#pragma unroll
                for (int j = 0; j < 2; ++j) Ur[i][j] = *(const GAS v4u*)(U + (size_t)en[i] * D + j * 1024);
#pragma unroll
            for (int i = 0; i < PA_CH; ++i) { const float dt = wave_sum(d[i]) * __builtin_bit_cast(float, __builtin_amdgcn_readfirstlane(__builtin_bit_cast(int, su[ec[i]])));
                const float g = __builtin_bit_cast(float, __builtin_amdgcn_readfirstlane(__builtin_bit_cast(int, gwr[PA_CH * kc + i]))) * __builtin_bit_cast(float, __builtin_amdgcn_readfirstlane(__builtin_bit_cast(int, sv[ec[i]])));
                d[i] = g * 0.5f * dt * (1.0f + erff(dt * 0.70710678118654752f)); }
#pragma unroll
            for (int i = 0; i < PA_CH; ++i) { if (i & 1) { PA_VACC(1, i); if (i + 2 < PA_CH) PA_VLOAD(1, i + 2); } else { PA_VACC(0, i); if (i + 2 < PA_CH) PA_VLOAD(0, i + 2); } }
#undef PA_VLOAD
#undef PA_VACC
#undef PA_VACC1
        }
#if DUP_PHASE == 10
        }
#endif
        GAS float* hrow = (GAS float*)P.out + (size_t)t * D + lane * 16; float ss = 0.f;
#pragma unroll
        for (int j = 0; j < 2; ++j)
#pragma unroll
            for (int q = 0; q < 4; ++q) { f32x4 hv = *(const GAS f32x4*)(hrow + j * 1024 + q * 4);
                hv.x += acc[j * 16 + q * 4 + 0]; hv.y += acc[j * 16 + q * 4 + 1]; hv.z += acc[j * 16 + q * 4 + 2]; hv.w += acc[j * 16 + q * 4 + 3];
                *(GAS f32x4*)(hrow + j * 1024 + q * 4) = hv; acc[j * 16 + q * 4 + 0] = hv.x; acc[j * 16 + q * 4 + 1] = hv.y; acc[j * 16 + q * 4 + 2] = hv.z; acc[j * 16 + q * 4 + 3] = hv.w;
                ss += hv.x * hv.x + hv.y * hv.y + hv.z * hv.z + hv.w * hv.w; }
        ss = wave_sum(ss); const float rr = 1.0f / sqrtf(ss * (1.0f / D) + EPS); const GAS float* gain = (const GAS float*)P.in[I_LNPLE] + (size_t)l * D + lane * 16;
#pragma unroll
        for (int j = 0; j < 2; ++j)
#pragma unroll
            for (int q = 0; q < 2; ++q) { const f32x4 g0 = *(const GAS f32x4*)(gain + j * 1024 + q * 8), g1 = *(const GAS f32x4*)(gain + j * 1024 + q * 8 + 4); const int b0 = j * 16 + q * 8;
                v4u o; o.x = pk2(acc[b0 + 0] * rr * g0.x, acc[b0 + 1] * rr * g0.y); o.y = pk2(acc[b0 + 2] * rr * g0.z, acc[b0 + 3] * rr * g0.w);
                o.z = pk2(acc[b0 + 4] * rr * g1.x, acc[b0 + 5] * rr * g1.y); o.w = pk2(acc[b0 + 6] * rr * g1.z, acc[b0 + 7] * rr * g1.w);
                *(GAS v4u*)(hn + (size_t)t * D + j * 1024 + lane * 16 + q * 8) = o; }
    }
}


__device__ __forceinline__ void norm_row_i8(f32x4 (&v)[8], float ss, const float* gain, GAS unsigned char* orow, GAS float* sc, int lane) {
    const float r = 1.0f / sqrtf(ss * (1.0f / D) + EPS); float am = 0.f;
#pragma unroll
    for (int j = 0; j < 8; ++j) { const f32x4 g = *(const f32x4*)(gain + (j * 64 + lane) * 4); v[j] = v[j] * r * g; am = fmaxf(am, fmaxf(fmaxf(fabsf(v[j].x), fabsf(v[j].y)), fmaxf(fabsf(v[j].z), fabsf(v[j].w)))); }
    am = wave_max(am); const float S = am > 0.f ? 127.0f / am : 0.f;
#pragma unroll
    for (int j = 0; j < 8; ++j) *(GAS unsigned*)(orow + (j * 64 + lane) * 4) = pack_i8x4(v[j].x, v[j].y, v[j].z, v[j].w, S);
    if (lane == 0) *sc = am * (1.0f / 127.0f);
}
template <bool SRC16 = false>
__device__ __forceinline__ void phase_norm_i8(const void* src, const float* gain, unsigned char* dst8, float* scales, int bid, int nb) {
    const int tid = TID(), lane = tid & 63, wave = tid >> 6, nw = 8;
    const int step = nb * nw; int t = bid * nw + wave;
    for (; t + step < T; t += 2 * step) { f32x4 v0[8], v1[8];
#pragma unroll
        for (int j = 0; j < 8; ++j) { v0[j] = ldrow4<SRC16>(src, (size_t)t * D + (j * 64 + lane) * 4); v1[j] = ldrow4<SRC16>(src, (size_t)(t + step) * D + (j * 64 + lane) * 4); }
        float s0 = 0.f, s1 = 0.f;
#pragma unroll
        for (int j = 0; j < 8; ++j) { s0 += v0[j].x * v0[j].x + v0[j].y * v0[j].y + v0[j].z * v0[j].z + v0[j].w * v0[j].w; s1 += v1[j].x * v1[j].x + v1[j].y * v1[j].y + v1[j].z * v1[j].z + v1[j].w * v1[j].w; }
        s0 = wave_sum(s0); s1 = wave_sum(s1);
        norm_row_i8(v0, s0, gain, (GAS unsigned char*)dst8 + (size_t)t * D, (GAS float*)scales + t, lane); norm_row_i8(v1, s1, gain, (GAS unsigned char*)dst8 + (size_t)(t + step) * D, (GAS float*)scales + t + step, lane); }
    for (; t < T; t += step) { f32x4 v[8]; float s_ = 0.f;
#pragma unroll
        for (int j = 0; j < 8; ++j) { v[j] = ldrow4<SRC16>(src, (size_t)t * D + (j * 64 + lane) * 4); s_ += v[j].x * v[j].x + v[j].y * v[j].y + v[j].z * v[j].z + v[j].w * v[j].w; }
        const float ss = wave_sum(s_); norm_row_i8(v, ss, gain, (GAS unsigned char*)dst8 + (size_t)t * D, (GAS float*)scales + t, lane); }
}
__device__ __forceinline__ void quant_rows_i8(const bf16* srcm, unsigned char* dstm, float* scm, int nrows, int bid, int nb) {
    const int tid = TID(), lane = tid & 63, wave = tid >> 6;
    for (int n = bid * 8 + wave; n < nrows; n += nb * 8) {
        const GAS bf16* src = (const GAS bf16*)srcm + (size_t)n * D; float f[4][8]; float am = 0.f;
#pragma unroll
        for (int j = 0; j < 4; ++j) { unpack8(*(const GAS v4u*)(src + (j * 64 + lane) * 8), f[j]);
#pragma unroll
            for (int e = 0; e < 8; ++e) am = fmaxf(am, fabsf(f[j][e])); }
        am = wave_max(am); const float S = am > 0.f ? 127.0f / am : 0.f;
        GAS unsigned char* dst = (GAS unsigned char*)dstm + (size_t)n * D;
#pragma unroll
        for (int j = 0; j < 4; ++j) *(GAS v2u*)(dst + (j * 64 + lane) * 8) = (v2u){pack_i8x4(f[j][0], f[j][1], f[j][2], f[j][3], S), pack_i8x4(f[j][4], f[j][5], f[j][6], f[j][7], S)};
        if (lane == 0) ((GAS float*)scm)[n] = am * (1.0f / 127.0f);
    }
}
constexpr int QR_TM = NTM * 128, QR_VT = QR_TM + NVT * 128, QR_WO = QR_VT + D, QR_WQ = QR_WO + D, QR_ALL = QR_WQ + D;
__device__ __forceinline__ void quant_row_ptrs(unsigned char* ws, int l, int g, const GAS bf16*& src, GAS unsigned char*& dst, GAS float*& sc) {
    size_t so, d8, ss; int r;
    if (g < QR_TM) { r = l * NTM * 128 + g; so = WS_WINTM; d8 = WS_WIN8TM; ss = WS_SWTM; }
    else if (g < QR_VT) { r = l * NVT * 128 + (g - QR_TM); so = WS_WINVT; d8 = WS_WIN8VT; ss = WS_SWVT; }
    else if (g < QR_WO) { r = l * D + (g - QR_VT); so = WS_WOUT; d8 = WS_WO8; ss = WS_SWO; }
    else if (g < QR_WQ) { r = l * D + (g - QR_WO); so = WS_WQ; d8 = WS_WQ8; ss = WS_SWQ; }
    else { r = l * D + (g - QR_WQ); so = WS_WGATE; d8 = WS_WG8; ss = WS_SWG; }
    src = (const GAS bf16*)(ws + so) + (size_t)r * D; dst = (GAS unsigned char*)(ws + d8) + (size_t)r * D; sc = (GAS float*)(ws + ss) + r;
}
__device__ __forceinline__ void quant_all_rows(const Params& P, int l, int bid, int nb) {
    const int tid = TID(), lane = tid & 63, wave = tid >> 6; const int step = nb * 8;
    for (int g0 = bid * 8 + wave; g0 < QR_ALL; g0 += 3 * step) {
        v4u w[3][4]; GAS unsigned char* dst[3]; GAS float* sc[3];
#pragma unroll
        for (int u = 0; u < 3; ++u) { const int g = g0 + u * step; const GAS bf16* src; quant_row_ptrs(P.ws, l, g < QR_ALL ? g : g0, src, dst[u], sc[u]);
#pragma unroll
            for (int j = 0; j < 4; ++j) w[u][j] = *(const GAS v4u*)(src + (j * 64 + lane) * 8); }
#pragma unroll
        for (int u = 0; u < 3; ++u) { if (g0 + u * step >= QR_ALL) break;
            float f[4][8]; float am = 0.f;
#pragma unroll
            for (int j = 0; j < 4; ++j) { unpack8(w[u][j], f[j]);
#pragma unroll
                for (int e = 0; e < 8; ++e) am = fmaxf(am, fabsf(f[j][e])); }
            am = wave_max(am); const float S = am > 0.f ? 127.0f / am : 0.f;
#pragma unroll
            for (int j = 0; j < 4; ++j) *(GAS v2u*)(dst[u] + (j * 64 + lane) * 8) = (v2u){pack_i8x4(f[j][0], f[j][1], f[j][2], f[j][3], S), pack_i8x4(f[j][4], f[j][5], f[j][6], f[j][7], S)};
            if (lane == 0) *sc[u] = am * (1.0f / 127.0f); }
    }
}
__device__ __forceinline__ void quant_wgate(const Params& P, int l, int bid, int nb) {
    const int tid = TID(), lane = tid & 63, wave = tid >> 6;
    for (int n = bid * 8 + wave; n < D; n += nb * 8) {
        const GAS bf16* src = (const GAS bf16*)(P.ws + WS_WGATE) + ((size_t)l * D + n) * D; float f[4][8]; float am = 0.f;
#pragma unroll
        for (int j = 0; j < 4; ++j) { unpack8(*(const GAS v4u*)(src + (j * 64 + lane) * 8), f[j]);
#pragma unroll
            for (int e = 0; e < 8; ++e) am = fmaxf(am, fabsf(f[j][e])); }
        am = wave_max(am); const float S = am > 0.f ? 127.0f / am : 0.f;
        GAS unsigned char* dst = (GAS unsigned char*)(P.ws + WS_WG8) + ((size_t)l * D + n) * D;
#pragma unroll
        for (int j = 0; j < 4; ++j) *(GAS v2u*)(dst + (j * 64 + lane) * 8) = (v2u){pack_i8x4(f[j][0], f[j][1], f[j][2], f[j][3], S), pack_i8x4(f[j][4], f[j][5], f[j][6], f[j][7], S)};
        if (lane == 0) ((GAS float*)(P.ws + WS_SWG))[(size_t)l * D + n] = am * (1.0f / 127.0f);
    }
}
#define XB_TMO      128
#define XB_XCNT(j)  (256  + 64 * (j))
#define XB_XSUB(j)  (1280 + 64 * (j))
#define XB_XGEN(j)  (2304 + 64 * (j))
#define XB_TOP      3328
#define XB_TOPGEN   3392
#define XCD_BAR_WORDS 3456
#define XB_SPIN_CAP (1u << 22)
__device__ __forceinline__ unsigned xb_ld(unsigned* p)              { return __hip_atomic_load(p, __ATOMIC_RELAXED, __HIP_MEMORY_SCOPE_AGENT); }
__device__ __forceinline__ unsigned xb_add(unsigned* p, unsigned v) { return __hip_atomic_fetch_add(p, v, __ATOMIC_RELAXED, __HIP_MEMORY_SCOPE_AGENT); }
__device__ __forceinline__ unsigned xb_xcc_id() { return (unsigned)__builtin_amdgcn_s_getreg((3 << 11) | 20) & 0xFu; }
#define XB_SPIN(cond, bar) do { unsigned _sp = 0; while (cond) { __builtin_amdgcn_s_sleep(1); \
    if ((++_sp & 255u) == 0u) { if (xb_ld(&(bar)[XB_TMO])) break; if (_sp > XB_SPIN_CAP) { atomicAdd(&(bar)[XB_TMO], 1u); break; } } } } while (0)
struct XcdBarrier { unsigned* bar; unsigned x; volatile LAS unsigned* st; };
__device__ __forceinline__ XcdBarrier xcd_barrier_post(unsigned* bar, volatile LAS unsigned* st) {
    XcdBarrier b; b.bar = bar; b.x = xb_xcc_id(); b.st = st;
    if (threadIdx.x == 0) (void)xb_add(&bar[XB_XCNT(b.x)], 1u);
    return b;
}
__device__ __forceinline__ void xcd_barrier_complete(unsigned* bar, unsigned x, unsigned& nloc, unsigned& nx) {
    const unsigned G = gridDim.x * gridDim.y * gridDim.z;
    unsigned sum, cnt, mine, sp = 0u;
    for (;;) {
        sum = 0u; cnt = 0u; mine = 0u;
#pragma unroll
        for (unsigned j = 0; j < 16; ++j) { const unsigned c = xb_ld(&bar[XB_XCNT(j)]); sum += c; cnt += (c > 0u) ? 1u : 0u; mine = (j == x) ? c : mine; }
        if (sum == G) break;
        __builtin_amdgcn_s_sleep(1);
        if ((++sp & 255u) == 0u) { if (xb_ld(&bar[XB_TMO])) break; if (sp > XB_SPIN_CAP) { atomicAdd(&bar[XB_TMO], 1u); break; } }
    }
    nloc = mine > 0u ? mine : 1u; nx = cnt > 0u ? cnt : 1u;
}
__device__ __forceinline__ void xcd_barrier(const XcdBarrier& b) {
    asm volatile("s_waitcnt vmcnt(0)" ::: "memory");
    __syncthreads();
    if (threadIdx.x == 0) {
        unsigned* bar = b.bar;
        __builtin_amdgcn_s_waitcnt(0);
        unsigned nloc = b.st[0], nx = b.st[1];
        if (nloc == 0u) { xcd_barrier_complete(bar, b.x, nloc, nx); b.st[0] = nloc; b.st[1] = nx; }
        const unsigned old = xb_add(&bar[XB_XSUB(b.x)], 1u);
        const unsigned gen = old / nloc;
        if (old + 1u == (gen + 1u) * nloc) {
            __builtin_amdgcn_fence(__ATOMIC_RELEASE, "agent");
            asm volatile("s_waitcnt vmcnt(0)" ::: "memory");
            const unsigned og = xb_add(&bar[XB_TOP], 1u);
            const unsigned tg = og / nx;
            if (og + 1u == (tg + 1u) * nx) xb_add(&bar[XB_TOPGEN], 1u);
            else XB_SPIN(xb_ld(&bar[XB_TOPGEN]) == tg, bar);
            __builtin_amdgcn_fence(__ATOMIC_ACQUIRE, "agent");
            xb_add(&bar[XB_XGEN(b.x)], 1u);
            asm volatile("s_waitcnt vmcnt(0)" ::: "memory");
        } else {
            XB_SPIN(xb_ld(&bar[XB_XGEN(b.x)]) == gen, bar);
            __builtin_amdgcn_fence(__ATOMIC_ACQUIRE, "agent");
            asm volatile("s_waitcnt vmcnt(0)" ::: "memory");
        }
    }
    __syncthreads();
}


namespace pz {
constexpr int NSL = 16, NTG = T / 8, QITEMS = (NSL / 8) * NTG;
__device__ __forceinline__ void load_rows(const GAS unsigned char* tab, unsigned poff, const int (&id)[16], v4u (&rows)[16]) {
#pragma unroll
    for (int i = 0; i < 16; ++i) rows[i] = *(const GAS v4u*)(tab + (((unsigned)id[i] << 7) | poff));
}
__device__ __forceinline__ void load_ids(const int* ex, size_t t, int e8, int (&id)[16]) {
    typedef int i32x4 __attribute__((ext_vector_type(4)));
#pragma unroll
    for (int q = 0; q < 4; ++q) { const i32x4 v = *(const GAS i32x4*)((const GAS int*)ex + t * 128 + 16 * e8 + 4 * q); id[4 * q] = v.x; id[4 * q + 1] = v.y; id[4 * q + 2] = v.z; id[4 * q + 3] = v.w; }
}
typedef float f2p __attribute__((ext_vector_type(2)));
__device__ __forceinline__ unsigned item_A(const Params& P, int l, int xq, int c, int tg, int lane, int (&id)[2][16], v4u (&rows)[2][16], unsigned itn_raw) {
    const int e8 = lane >> 3, part = lane & 7;
    const GAS unsigned char* tab0 = (const GAS unsigned char*)(P.ws + WS_U) + (size_t)l * NSL * NEXP * 128; const unsigned poff = part * 16;
    const GAS unsigned char* tab = tab0 + (size_t)c * NEXP * 128; unsigned itn = 0xffffffffu; size_t tn0 = 0; const GAS unsigned char* tabn = tab;
    const GAS bf16* xf = (const GAS bf16*)(P.ws + WS_ACT0) + 128 * c + 16 * part; const int* ex = (const int*)(P.ws + WS_EXP);
    GAS bf16* pdh = (GAS bf16*)(P.ws + WS_PD) + (size_t)c * T * 128 + 16 * e8;
    const size_t t0 = (size_t)tg * 8;
#pragma unroll
    for (int n = 0; n < 8; ++n) { const size_t t = t0 + n; const int bf = n & 1;
        if (n < 7) load_rows(tab, poff, id[bf ^ 1], rows[bf ^ 1]);
        if (n < 6) load_ids(ex, t + 2, e8, id[bf]);
        if (n == 6) { itn = (unsigned)__builtin_amdgcn_readfirstlane((int)itn_raw);
            if (itn < (unsigned)QITEMS) { tn0 = (size_t)(itn % NTG) * 8; tabn = tab0 + (size_t)(xq + 8 * (int)(itn / NTG)) * NEXP * 128; load_ids(ex, tn0, e8, id[0]); } }
        if (n == 7 && itn < (unsigned)QITEMS) { load_rows(tabn, poff, id[0], rows[0]); load_ids(ex, tn0 + 1, e8, id[1]); }
#if PEER_A_I8
        const v4u xw = *(const GAS v4u*)((const GAS unsigned char*)(P.ws + WS_XF8) + t * D + 128 * c + 16 * part);
        int sacc[16];
#pragma unroll
        for (int i = 0; i < 16; ++i) { const v4u rw = rows[bf][i]; int a; asm("v_dot4_i32_i8 %0, %1, %2, 0" : "=v"(a) : "v"(rw.x), "v"(xw.x)); a = __builtin_amdgcn_sdot4((int)rw.y, (int)xw.y, a, false);
            a = __builtin_amdgcn_sdot4((int)rw.z, (int)xw.z, a, false); sacc[i] = __builtin_amdgcn_sdot4((int)rw.w, (int)xw.w, a, false); }
        { const bool b2 = part & 4, b1 = part & 2, b0 = part & 1; int r8[8], r4[4], r2[2];
#pragma unroll
          for (int i = 0; i < 8; ++i) { const int snd = b2 ? sacc[i] : sacc[8 + i], kp = b2 ? sacc[8 + i] : sacc[i]; r8[i] = kp + swz_xor_i<4>(snd); }
#pragma unroll
          for (int i = 0; i < 4; ++i) { const int snd = b1 ? r8[i] : r8[4 + i], kp = b1 ? r8[4 + i] : r8[i]; r4[i] = kp + swz_xor_i<2>(snd); }
#pragma unroll
          for (int i = 0; i < 2; ++i) { const int snd = b0 ? r4[i] : r4[2 + i], kp = b0 ? r4[2 + i] : r4[i]; r2[i] = kp + swz_xor_i<1>(snd); }
          *(GAS unsigned*)((GAS bf16*)pdh + t * 128 + 2 * part) = pk2((float)r2[0] * (1.0f / 16384.0f), (float)r2[1] * (1.0f / 16384.0f)); }
#else
        f2p x2[8];
        { const v4u w0 = *(const GAS v4u*)(xf + t * D), w1 = *(const GAS v4u*)(xf + t * D + 8);
          x2[0] = (f2p){bf2f(w0.x & 0xffff), bf2f(w0.x >> 16)}; x2[1] = (f2p){bf2f(w0.y & 0xffff), bf2f(w0.y >> 16)}; x2[2] = (f2p){bf2f(w0.z & 0xffff), bf2f(w0.z >> 16)}; x2[3] = (f2p){bf2f(w0.w & 0xffff), bf2f(w0.w >> 16)};
          x2[4] = (f2p){bf2f(w1.x & 0xffff), bf2f(w1.x >> 16)}; x2[5] = (f2p){bf2f(w1.y & 0xffff), bf2f(w1.y >> 16)}; x2[6] = (f2p){bf2f(w1.z & 0xffff), bf2f(w1.z >> 16)}; x2[7] = (f2p){bf2f(w1.w & 0xffff), bf2f(w1.w >> 16)}; }
        float sacc[16];
#pragma unroll
        for (int i = 0; i < 16; ++i) { const v4u rw = rows[bf][i]; f2p s2 = {0.f, 0.f};
            s2 = __builtin_elementwise_fma(__builtin_amdgcn_cvt_pk_f32_fp8((int)rw.x, false), x2[0], s2); s2 = __builtin_elementwise_fma(__builtin_amdgcn_cvt_pk_f32_fp8((int)rw.x, true), x2[1], s2);
            s2 = __builtin_elementwise_fma(__builtin_amdgcn_cvt_pk_f32_fp8((int)rw.y, false), x2[2], s2); s2 = __builtin_elementwise_fma(__builtin_amdgcn_cvt_pk_f32_fp8((int)rw.y, true), x2[3], s2);
            s2 = __builtin_elementwise_fma(__builtin_amdgcn_cvt_pk_f32_fp8((int)rw.z, false), x2[4], s2); s2 = __builtin_elementwise_fma(__builtin_amdgcn_cvt_pk_f32_fp8((int)rw.z, true), x2[5], s2);
            s2 = __builtin_elementwise_fma(__builtin_amdgcn_cvt_pk_f32_fp8((int)rw.w, false), x2[6], s2); s2 = __builtin_elementwise_fma(__builtin_amdgcn_cvt_pk_f32_fp8((int)rw.w, true), x2[7], s2);
            sacc[i] = s2.x + s2.y; }
        { const bool b2 = part & 4, b1 = part & 2, b0 = part & 1; float r8[8], r4[4], r2[2];
#pragma unroll
          for (int i = 0; i < 8; ++i) { const float snd = b2 ? sacc[i] : sacc[8 + i], kp = b2 ? sacc[8 + i] : sacc[i]; r8[i] = kp + swz_xor<4>(snd); }
#pragma unroll
          for (int i = 0; i < 4; ++i) { const float snd = b1 ? r8[i] : r8[4 + i], kp = b1 ? r8[4 + i] : r8[i]; r4[i] = kp + swz_xor<2>(snd); }
#pragma unroll
          for (int i = 0; i < 2; ++i) { const float snd = b0 ? r4[i] : r4[2 + i], kp = b0 ? r4[2 + i] : r4[i]; r2[i] = kp + swz_xor<1>(snd); }
          *(GAS unsigned*)((GAS bf16*)pdh + t * 128 + 2 * part) = pk2(r2[0], r2[1]); }
#endif
    }
    return itn;
}
__device__ __forceinline__ unsigned item_B(const Params& P, int l, int xq, int c, int tg, int lane, int (&id)[2][16], v4u (&rows)[2][16], unsigned itn_raw) {
    const int e8 = lane >> 3, part = lane & 7;
    const GAS unsigned char* tab0 = (const GAS unsigned char*)(P.ws + WS_V) + (size_t)l * NSL * NEXP * 128; const unsigned poff = part * 16;
    const GAS unsigned char* tab = tab0 + (size_t)c * NEXP * 128; unsigned itn = 0xffffffffu; size_t tn0 = 0; const GAS unsigned char* tabn = tab;
    const int* ex = (const int*)(P.ws + WS_EXP); const GAS float* wv = (const GAS float*)(P.ws + WS_WV) + 16 * e8;
    GAS float* hcol = (GAS float*)P.out + 128 * c + 16 * part;
    const size_t t0 = (size_t)tg * 8;
#pragma unroll
    for (int n = 0; n < 8; ++n) { const size_t t = t0 + n; const int bf = n & 1;
        if (n < 7) load_rows(tab, poff, id[bf ^ 1], rows[bf ^ 1]);
        if (n < 6) load_ids(ex, t + 2, e8, id[bf]);
        if (n == 6) { itn = (unsigned)__builtin_amdgcn_readfirstlane((int)itn_raw);
            if (itn < (unsigned)QITEMS) { tn0 = (size_t)(itn % NTG) * 8; tabn = tab0 + (size_t)(xq + 8 * (int)(itn / NTG)) * NEXP * 128; load_ids(ex, tn0, e8, id[0]); } }
        if (n == 7 && itn < (unsigned)QITEMS) { load_rows(tabn, poff, id[0], rows[0]); load_ids(ex, tn0 + 1, e8, id[1]); }
        float w[16];
#pragma unroll
        for (int q = 0; q < 4; ++q) { const f32x4 v = *(const GAS f32x4*)(wv + t * 128 + 4 * q); w[4 * q] = v.x; w[4 * q + 1] = v.y; w[4 * q + 2] = v.z; w[4 * q + 3] = v.w; }
        f2p acc2[8];
#pragma unroll
        for (int q = 0; q < 8; ++q) acc2[q] = (f2p){0.f, 0.f};
#pragma unroll
        for (int i = 0; i < 16; ++i) { const v4u rw = rows[bf][i]; const f2p w2 = {w[i], w[i]};
            acc2[0] = __builtin_elementwise_fma(__builtin_amdgcn_cvt_pk_f32_fp8((int)rw.x, false), w2, acc2[0]); acc2[1] = __builtin_elementwise_fma(__builtin_amdgcn_cvt_pk_f32_fp8((int)rw.x, true), w2, acc2[1]);
            acc2[2] = __builtin_elementwise_fma(__builtin_amdgcn_cvt_pk_f32_fp8((int)rw.y, false), w2, acc2[2]); acc2[3] = __builtin_elementwise_fma(__builtin_amdgcn_cvt_pk_f32_fp8((int)rw.y, true), w2, acc2[3]);
            acc2[4] = __builtin_elementwise_fma(__builtin_amdgcn_cvt_pk_f32_fp8((int)rw.z, false), w2, acc2[4]); acc2[5] = __builtin_elementwise_fma(__builtin_amdgcn_cvt_pk_f32_fp8((int)rw.z, true), w2, acc2[5]);
            acc2[6] = __builtin_elementwise_fma(__builtin_amdgcn_cvt_pk_f32_fp8((int)rw.w, false), w2, acc2[6]); acc2[7] = __builtin_elementwise_fma(__builtin_amdgcn_cvt_pk_f32_fp8((int)rw.w, true), w2, acc2[7]); }
        float acc[16];
#pragma unroll
        for (int q = 0; q < 8; ++q) { acc[2 * q] = acc2[q].x; acc[2 * q + 1] = acc2[q].y; }
        { const bool b3 = e8 & 1; float r8[8], r4[4], r2[2];
#pragma unroll
          for (int i = 0; i < 8; ++i) { const auto pr = __builtin_amdgcn_permlane32_swap(__builtin_bit_cast(unsigned, acc[i]), __builtin_bit_cast(unsigned, acc[8 + i]), false, false);
              r8[i] = __builtin_bit_cast(float, (unsigned)pr[0]) + __builtin_bit_cast(float, (unsigned)pr[1]); }
#pragma unroll
          for (int i = 0; i < 4; ++i) { const auto pr = __builtin_amdgcn_permlane16_swap(__builtin_bit_cast(unsigned, r8[i]), __builtin_bit_cast(unsigned, r8[4 + i]), false, false);
              r4[i] = __builtin_bit_cast(float, (unsigned)pr[0]) + __builtin_bit_cast(float, (unsigned)pr[1]); }
#pragma unroll
          for (int i = 0; i < 2; ++i) { const float snd = b3 ? r4[i] : r4[2 + i], kp = b3 ? r4[2 + i] : r4[i]; r2[i] = kp + swz_xor<8>(snd); }
#if H16
          GAS h2_t* hp = (GAS h2_t*)((GAS _Float16*)(P.ws + WS_H16) + 128 * c + 16 * part + t * D + 2 * e8); const h2_t hv = *hp; *hp = (h2_t){(_Float16)((float)hv.x + r2[0]), (_Float16)((float)hv.y + r2[1])}; }
#else
          GAS f2p* hp = (GAS f2p*)(hcol + t * D + 2 * e8); f2p hv = *hp; hv.x += r2[0]; hv.y += r2[1]; *hp = hv; }
#endif
    }
    return itn;
}
template <int WHICH>
__device__ __forceinline__ void phase_sliced(const Params& P, int l) {
    unsigned* qbase = (unsigned*)(P.ws + WS_CTL) + 16384 + 64 * ((l * 2 + WHICH) * 8);
    const unsigned x0 = xb_xcc_id() & 7u;
    const int lane = TID() & 63, e8 = lane >> 3, part = lane & 7;
    const int* ex = (const int*)(P.ws + WS_EXP);
    const GAS unsigned char* tab0 = (const GAS unsigned char*)(P.ws + (WHICH == 0 ? WS_U : WS_V)) + (size_t)l * NSL * NEXP * 128; const unsigned poff = part * 16;
    for (unsigned s_ = 0; s_ < 8; ++s_) { const unsigned xq = (x0 + s_) & 7u;
        unsigned it = 0u;
        if (lane == 0) it = __hip_atomic_fetch_add(qbase + 64 * xq, 1u, __ATOMIC_RELAXED, __HIP_MEMORY_SCOPE_AGENT);
        it = (unsigned)__builtin_amdgcn_readfirstlane((int)it);
        if (it >= (unsigned)QITEMS) continue;
        int id[2][16]; v4u rows[2][16];
        { const size_t t0 = (size_t)(it % NTG) * 8; const GAS unsigned char* tab = tab0 + (size_t)((int)xq + 8 * (int)(it / NTG)) * NEXP * 128;
          load_ids(ex, t0, e8, id[0]); load_rows(tab, poff, id[0], rows[0]); load_ids(ex, t0 + 1, e8, id[1]); }
        for (;;) {
            unsigned itn_raw = 0xffffffffu;
            if (lane == 0) itn_raw = __hip_atomic_fetch_add(qbase + 64 * xq, 1u, __ATOMIC_RELAXED, __HIP_MEMORY_SCOPE_AGENT);
            const int c = (int)xq + 8 * (int)(it / NTG), tg = (int)(it % NTG);
            const unsigned itn = WHICH == 0 ? item_A(P, l, (int)xq, c, tg, lane, id, rows, itn_raw) : item_B(P, l, (int)xq, c, tg, lane, id, rows, itn_raw);
            if (itn >= (unsigned)QITEMS) break;
            it = itn;
        }
    }
}
__device__ __forceinline__ void phase_weights(const Params& P, int l, int bid, int nb) {
    const int tid = TID();
    const GAS bf16* pd = (const GAS bf16*)(P.ws + WS_PD); const GAS int* ex = (const GAS int*)(P.ws + WS_EXP); const GAS float* gw = (const GAS float*)(P.ws + WS_GW);
    const GAS float* su = (const GAS float*)(P.ws + WS_SU) + (size_t)l * NEXP; const GAS float* sv = (const GAS float*)(P.ws + WS_SV) + (size_t)l * NEXP; GAS float* wv = (GAS float*)(P.ws + WS_WV);
    typedef int i32x4 __attribute__((ext_vector_type(4)));
    for (size_t i8 = (size_t)bid * 512 + tid; i8 < (size_t)T * 128 / 8; i8 += (size_t)nb * 512) {
        const size_t i = i8 * 8; float s8[8];
#pragma unroll
        for (int q = 0; q < 8; ++q) s8[q] = 0.f;
#pragma unroll
        for (int c = 0; c < NSL; ++c) { float f[8]; unpack8(*(const GAS v4u*)(pd + (size_t)c * T * 128 + i), f);
#pragma unroll
            for (int q = 0; q < 8; ++q) s8[q] += f[q]; }
        const i32x4 e0 = *(const GAS i32x4*)(ex + i), e1 = *(const GAS i32x4*)(ex + i + 4); const f32x4 g0 = *(const GAS f32x4*)(gw + i), g1 = *(const GAS f32x4*)(gw + i + 4);
        const int ee[8] = {e0.x, e0.y, e0.z, e0.w, e1.x, e1.y, e1.z, e1.w}; const float gg[8] = {g0.x, g0.y, g0.z, g0.w, g1.x, g1.y, g1.z, g1.w}; float o[8];
        const float xs = PEER_A_I8 ? 16384.0f * ((const GAS float*)(P.ws + WS_SXF))[i >> 7] : 1.0f;
#pragma unroll
        for (int q = 0; q < 8; ++q) { const float dt = s8[q] * xs * su[ee[q]]; o[q] = gg[q] * sv[ee[q]] * 0.5f * dt * (1.0f + erff(dt * 0.70710678118654752f)); }
        *(GAS f32x4*)(wv + i) = (f32x4){o[0], o[1], o[2], o[3]}; *(GAS f32x4*)(wv + i + 4) = (f32x4){o[4], o[5], o[6], o[7]};
    }
}
}

#ifndef FAST_GEMM
#define FAST_GEMM 1
#endif
#ifndef FAST_ATTN
#define FAST_ATTN 1
#endif
#ifndef FAST_SELECT
#define FAST_SELECT 1
#endif
#ifndef FAST_PREP
#define FAST_PREP 1
#endif
constexpr int LDS_BYTES = 147456;
constexpr int LDS_MISC = 131072;
constexpr int NPH_L = 12, NPHASES = 1 + DEPTH * NPH_L + 1;
struct Args { Params P; int ph_lo, ph_hi; };
__global__ void __launch_bounds__(512, 2) mk_fwd(Args a) {
    extern __shared__ __attribute__((aligned(16))) unsigned char lds_raw[];
    LAS unsigned char* lds = (LAS unsigned char*)lds_raw;
    const Params& P0 = a.P;
    const int bid0 = blockIdx.x, nb = gridDim.x;
    volatile LAS unsigned* misc = (volatile LAS unsigned*)(lds + LDS_MISC);
    if (threadIdx.x < 64) misc[threadIdx.x] = 0u;
    __syncthreads();
    XcdBarrier bar = xcd_barrier_post((unsigned*)(P0.ws + WS_CTL) + 1024, misc + 8);
    const int lo = a.ph_lo, hi = a.ph_hi;
#define IN(k) (lo <= (k) && (k) < hi)
#define BAR(k) do { if (IN(k) && IN((k) + 1)) xcd_barrier(bar); } while (0)
#define PH const Params P = fresh(P0); const int bid = launder_s(bid0); unsigned char* ws = P.ws; (void)ws; (void)bid
    if (IN(0)) { PH; phase_prologue(P, bid, nb, lds); }
#if DUP_PHASE == 100
    BAR(0);
    if (IN(0)) { PH; phase_prologue(P, bid, nb, lds); }
#endif
    BAR(0);
    for (int l = 0; l < DEPTH; ++l) {
        const int pb = 1 + l * NPH_L;
        if (IN(pb + 0)) { PH; phase_norm_mix(P, l, bid, nb, lds);
#if GATE_I8 && WQ_I8 && WOUT_I8 && PROJ_I8 && H16
#elif GATE_I8 && WQ_I8 && WOUT_I8 && PROJ_I8
            quant_all_rows(P, l, bid, nb);
#else
#if GATE_I8
            quant_wgate(P, l, bid, nb);
#endif
#if WQ_I8
            quant_rows_i8((const bf16*)(ws + WS_WQ) + (size_t)l * D * D, (unsigned char*)(ws + WS_WQ8) + (size_t)l * D * D, (float*)(ws + WS_SWQ) + (size_t)l * D, D, bid, nb);
#endif
#if WOUT_I8
            quant_rows_i8((const bf16*)(ws + WS_WOUT) + (size_t)l * D * D, (unsigned char*)(ws + WS_WO8) + (size_t)l * D * D, (float*)(ws + WS_SWO) + (size_t)l * D, D, bid, nb);
#endif
#if PROJ_I8
            quant_rows_i8((const bf16*)(ws + WS_WINTM) + (size_t)l * NTM * 128 * D, (unsigned char*)(ws + WS_WIN8TM) + (size_t)l * NTM * 128 * D, (float*)(ws + WS_SWTM) + (size_t)l * NTM * 128, NTM * 128, bid, nb);
            quant_rows_i8((const bf16*)(ws + WS_WINVT) + (size_t)l * NVT * 128 * D, (unsigned char*)(ws + WS_WIN8VT) + (size_t)l * NVT * 128 * D, (float*)(ws + WS_SWVT) + (size_t)l * NVT * 128, NVT * 128, bid, nb);
#endif
#endif
        }
#if DUP_PHASE == 300
        if (IN(pb + 0)) { PH; phase_norm_mix(P, l, bid, nb, lds); }
#endif
        BAR(pb + 0);
        if (IN(pb + 1)) { PH;
            const bf16* act = (const bf16*)(ws + WS_ACT0);
            const bf16* wtm = (const bf16*)(ws + WS_WINTM) + (size_t)l * NTM * 128 * D; const bf16* wvt = (const bf16*)(ws + WS_WINVT) + (size_t)l * NVT * 128 * D;
#if FAST_GEMM
#if PROJ_I8
            pg8::Gemm g{act, (const bf16*)(ws + WS_WIN8TM + (size_t)l * NTM * 128 * D), D / 2, (const bf16*)(ws + WS_WIN8VT + (size_t)l * NVT * 128 * D), act, 64, 17}; pg8::DualOrder so{64, 17, 7, 64, nb, bid};
            pg8::EpiProjI8 e{(bf16*)(ws + WS_TM), (bf16*)(ws + WS_VT), (const float*)(ws + WS_SA), (const float*)(ws + WS_SWTM) + (size_t)l * NTM * 128, (const float*)(ws + WS_SWVT) + (size_t)l * NVT * 128};
            pg8::gemm_phase(lds, g, so, e);
#else
            pg8::Gemm g{act, wtm, D, wvt, act, 64, 17}; pg8::DualOrder so{64, 17, 7, 64, nb, bid}; pg8::EpiProj e{(bf16*)(ws + WS_TM), (bf16*)(ws + WS_VT)};
            pg8::gemm_phase(lds, g, so, e);
#endif
#if DUP_PHASE == 200
            __syncthreads(); pg8::gemm_phase(lds, g, so, e);
#endif
#else
            EpiProjTM e1{(bf16*)(ws + WS_TM)}; phase_gemm_naive(act, wtm, D, T, NTM * 128, e1, bid, nb, lds);
            EpiProjVT e2{(bf16*)(ws + WS_VT)}; phase_gemm_naive(wvt, act, D, NVT * 128, T, e2, bid, nb, lds);
#endif
        }
        BAR(pb + 1);
#if FAST_PREP
        if (IN(pb + 2)) { PH; pf::phase_prep(P, l, bid, nb, lds); }
#if DUP_PHASE == 300
        if (IN(pb + 2)) { PH; pf::phase_prep(P, l, bid, nb, lds); }
#endif
#else
        if (IN(pb + 2)) { PH; phase_prep_naive(P, l, bid, nb); }
#endif
        BAR(pb + 2);
#if FAST_ATTN
        if (IN(pb + 3)) { PH; fa::phase_attn(P, l, lds); }
#if DUP_PHASE == 3
        BAR(pb + 3);
        if (IN(pb + 3)) { PH; if (bid == 0 && TID() == 0) ((unsigned*)(P.ws + WS_CTL))[8192 + 64 * l] = 0u; }
        BAR(pb + 3);
        if (IN(pb + 3)) { PH; fa::phase_attn(P, l, lds); }
#endif
        BAR(pb + 3);
#else
        if (IN(pb + 3)) { PH; phase_attn_naive1(P, bid, nb, lds); }
        BAR(pb + 3);
        if (IN(pb + 4)) { PH; phase_attn_naive2(P, bid, nb, lds); }
#endif
#if !FAST_ATTN
        BAR(pb + 4);
#endif
        if (IN(pb + 5)) { PH; phase_ynorm(P, bid, nb); }
#if DUP_PHASE == 300
        if (IN(pb + 5)) { PH; phase_ynorm(P, bid, nb); }
#endif
        BAR(pb + 5);
        if (IN(pb + 6)) { PH;
#if FAST_GEMM
#if WOUT_I8
            pg8::Gemm g{(const bf16*)(ws + WS_ACT2), (const bf16*)(ws + WS_WO8 + (size_t)l * D * D), D / 2, nullptr, nullptr, 1 << 30, 1 << 30}; pg8::StaticOrder so; so.init(T, D, nb, bid);
#if H16
            pg8::EpiResidI8 e{l == 0 ? P.in[I_X] : nullptr, (float*)(ws + WS_H16), (const float*)(ws + WS_SY), (const float*)(ws + WS_SWO) + (size_t)l * D}; pg8::gemm_phase(lds, g, so, e); }
#else
            pg8::EpiResidI8 e{l == 0 ? P.in[I_X] : P.out, P.out, (const float*)(ws + WS_SY), (const float*)(ws + WS_SWO) + (size_t)l * D}; pg8::gemm_phase(lds, g, so, e); }
#endif
#else
            pg8::Gemm g{(const bf16*)(ws + WS_ACT2), (const bf16*)(ws + WS_WOUT) + (size_t)l * D * D, D, nullptr, nullptr, 1 << 30, 1 << 30}; pg8::StaticOrder so; so.init(T, D, nb, bid);
            pg8::EpiResidT e{l == 0 ? P.in[I_X] : P.out, P.out}; pg8::gemm_phase(lds, g, so, e); }
#endif
#else
            EpiResid e{l == 0 ? P.in[I_X] : P.out, P.out};
            phase_gemm_naive((const bf16*)(ws + WS_ACT2), (const bf16*)(ws + WS_WOUT) + (size_t)l * D * D, D, T, D, e, bid, nb, lds); }
#endif
        BAR(pb + 6);
#if H16
        if (IN(pb + 7)) { PH; phase_norm<true>(ws + WS_H16, P.in[I_LNFFN] + (size_t)l * D, nullptr, bid, nb, (unsigned char*)(ws + WS_XF8), (float*)(ws + WS_SXF)); }
#else
        if (IN(pb + 7)) { PH; phase_norm(P.out, P.in[I_LNFFN] + (size_t)l * D, (bf16*)(ws + WS_ACT0), bid, nb, WQ_I8 ? (unsigned char*)(ws + WS_XF8) : nullptr, (float*)(ws + WS_SXF)); }
#endif
#if DUP_PHASE == 300
        if (IN(pb + 7)) { PH; phase_norm(P.out, P.in[I_LNFFN] + (size_t)l * D, (bf16*)(ws + WS_ACT0), bid, nb); }
#endif
        BAR(pb + 7);
        if (IN(pb + 8)) { PH;
#if FAST_GEMM
#if WQ_I8
            { pg8::Gemm g{(const bf16*)(ws + WS_XF8), (const bf16*)(ws + WS_WQ8 + (size_t)l * D * D), D / 2, nullptr, nullptr, 1 << 30, 1 << 30}; pg8::StaticOrder so; so.init(T, D, nb, bid);
              pg8::EpiStoreI8 e{(bf16*)(ws + WS_ACT1), (const float*)(ws + WS_SXF), (const float*)(ws + WS_SWQ) + (size_t)l * D}; pg8::gemm_phase(lds, g, so, e);
#else
            { pg8::Gemm g{(const bf16*)(ws + WS_ACT0), (const bf16*)(ws + WS_WQ) + (size_t)l * D * D, D, nullptr, nullptr, 1 << 30, 1 << 30}; pg8::StaticOrder so; so.init(T, D, nb, bid);
              pg8::EpiStoreT e{(bf16*)(ws + WS_ACT1)}; pg8::gemm_phase(lds, g, so, e);
#endif
#if DUP_PHASE == 200
              __syncthreads(); pg8::gemm_phase(lds, g, so, e);
#endif
            }
            { pg8::Gemm g{(const bf16*)(ws + WS_P) + (size_t)l * T * PLE, (const bf16*)(ws + WS_WPROJ) + (size_t)l * D * PLE, PLE, nullptr, nullptr, 1 << 30, 1 << 30}; pg8::StaticOrder so; so.init(T, D, nb, bid);
              pg8::EpiStoreT e{(bf16*)(ws + WS_ACT3)}; pg8::gemm_phase(lds, g, so, e); }
#else
            EpiStoreBf16 e{(bf16*)(ws + WS_ACT1)}; phase_gemm_naive((const bf16*)(ws + WS_ACT0), (const bf16*)(ws + WS_WQ) + (size_t)l * D * D, D, T, D, e, bid, nb, lds);
            EpiStoreBf16 e2{(bf16*)(ws + WS_ACT3)}; phase_gemm_naive((const bf16*)(ws + WS_P) + (size_t)l * T * PLE, (const bf16*)(ws + WS_WPROJ) + (size_t)l * D * PLE, PLE, T, D, e2, bid, nb, lds);
#endif
        }
        BAR(pb + 8);
#if FAST_SELECT
        if (IN(pb + 9)) { PH; ps::phase_select(P, l, bid, nb, lds); }
#if DUP_PHASE == 300
        if (IN(pb + 9)) { PH; ps::phase_select(P, l, bid, nb, lds); }
#endif
#else
        if (IN(pb + 9)) { PH; phase_peer_select_naive(P, l, bid, nb, lds); }
#endif
#if DUP_PHASE == 9
        BAR(pb + 9);
        if (IN(pb + 9)) { PH; phase_peer_select_naive(P, l, bid, nb, lds); }
#endif
        BAR(pb + 9);
#if PEER_SLICED
        if (IN(pb + 10)) { PH; pz::phase_sliced<0>(P, l); }
        BAR(pb + 10);
        if (IN(pb + 10)) { PH; pz::phase_weights(P, l, bid, nb); }
        BAR(pb + 10);
        if (IN(pb + 10)) { PH; pz::phase_sliced<1>(P, l); }
        BAR(pb + 10);
#if GATE_I8
        if (IN(pb + 10)) { PH; phase_norm_i8<H16 != 0>(H16 ? (const void*)(ws + WS_H16) : (const void*)P.out, P.in[I_LNPLE] + (size_t)l * D, (unsigned char*)(ws + WS_ACT2), (float*)(ws + WS_SHN), bid, nb); }
#else
        if (IN(pb + 10)) { PH; phase_norm(P.out, P.in[I_LNPLE] + (size_t)l * D, (bf16*)(ws + WS_ACT2), bid, nb); }
#endif
        BAR(pb + 10);
#else
        if (IN(pb + 10)) { PH; phase_peer_apply3(P, l, bid, nb); }
        BAR(pb + 10);
#endif
        if (IN(pb + 11)) { PH;
#if FAST_GEMM
#if GATE_I8
            pg8::Gemm g{(const bf16*)(ws + WS_ACT2), (const bf16*)(ws + WS_WG8 + (size_t)l * D * D), D / 2, nullptr, nullptr, 1 << 30, 1 << 30}; pg8::StaticOrder so; so.init(T, D, nb, bid);
            pg8::EpiPleGateI8 e{H16 ? (float*)(ws + WS_H16) : P.out, (const bf16*)(ws + WS_ACT3), (const float*)(ws + WS_SHN), (const float*)(ws + WS_SWG) + (size_t)l * D}; pg8::gemm_phase(lds, g, so, e); }
#else
            pg8::Gemm g{(const bf16*)(ws + WS_ACT2), (const bf16*)(ws + WS_WGATE) + (size_t)l * D * D, D, nullptr, nullptr, 1 << 30, 1 << 30}; pg8::StaticOrder so; so.init(T, D, nb, bid);
            pg8::EpiPleGateT e{P.out, (const bf16*)(ws + WS_ACT3)}; pg8::gemm_phase(lds, g, so, e); }
#endif
#else
            EpiPleGate e{P.out, (const bf16*)(ws + WS_ACT3)};
            phase_gemm_naive((const bf16*)(ws + WS_ACT2), (const bf16*)(ws + WS_WGATE) + (size_t)l * D * D, D, T, D, e, bid, nb, lds); }
#endif
        BAR(pb + 11);
    }
#if DUP_PHASE == 400
    for (int zz = 0; zz < 20; ++zz) xcd_barrier(bar);
#endif
    if (IN(NPHASES - 1)) { PH; phase_final(P, bid, nb); }
#undef IN
#undef BAR
#undef PH
}

#ifndef MK_LAUNCHES
#define MK_LAUNCHES 1
#endif
extern "C" void kernel_launch(void* const* d_in, const int* in_sizes, int n_in, void* d_out, int out_size, void* d_ws, size_t ws_size, hipStream_t stream) {
    static int grid = 0;
    if (grid == 0) {
        if (n_in != 19 || out_size != T * D || ws_size < WS_END) { fprintf(stderr, "kernel_launch: unexpected shapes (n_in %d out %d ws %zu need %zu)\n", n_in, out_size, ws_size, (size_t)WS_END); grid = -1; return; }
        int dev = 0, cus = 0, per_cu = 0;
        if (hipGetDevice(&dev) != hipSuccess || hipDeviceGetAttribute(&cus, hipDeviceAttributeMultiprocessorCount, dev) != hipSuccess) { grid = -1; return; }
        if (hipFuncSetAttribute((const void*)mk_fwd, hipFuncAttributeMaxDynamicSharedMemorySize, LDS_BYTES) != hipSuccess) { fprintf(stderr, "kernel_launch: hipFuncSetAttribute failed\n"); grid = -1; return; }
        if (hipOccupancyMaxActiveBlocksPerMultiprocessor(&per_cu, (const void*)mk_fwd, 512, LDS_BYTES) != hipSuccess || per_cu < 1) { fprintf(stderr, "kernel_launch: occupancy query reports %d blocks per CU\n", per_cu); }
        (void)hipGetLastError();
        grid = cus;
    }
    if (grid < 0) return;
    (void)hipMemsetAsync((char*)d_ws + WS_CTL, 0, CTL_USED_BYTES, stream);
    Args a{};
    for (int i = 0; i < 19; ++i) a.P.in[i] = (const float*)d_in[i];
    a.P.out = (float*)d_out; a.P.ws = (unsigned char*)d_ws;
#if MK_LAUNCHES == 1
    a.ph_lo = 0; a.ph_hi = NPHASES;
    hipLaunchKernelGGL(mk_fwd, dim3(grid), dim3(512), LDS_BYTES, stream, a);
#else
    for (int p = 0; p < NPHASES; ++p) { a.ph_lo = p; a.ph_hi = p + 1; hipLaunchKernelGGL(mk_fwd, dim3(grid), dim3(512), LDS_BYTES, stream, a); }
#endif
}
```

```cpp
#include <hip/hip_runtime.h>
#ifndef WQ_I8
#define WQ_I8 1
#endif
#ifndef WOUT_I8
#define WOUT_I8 1
#endif
#ifndef PROJ_I8
#define PROJ_I8 1
#endif
#ifndef GATE_I8
#define GATE_I8 1
#endif
#ifndef FA_STAGGER
#define FA_STAGGER 0
#endif
#ifndef PEER_SLICED
#define PEER_SLICED 1
#ifndef H16
#define H16 1
#endif
#ifndef PEER_A_I8
#define PEER_A_I8 1
#endif
#endif
#ifndef DUP_PHASE
#define DUP_PHASE 0
#endif
#include <cstdio>
#include <cstdint>

#define GAS __attribute__((address_space(1)))
#define LAS __attribute__((address_space(3)))
typedef unsigned short bf16;
typedef unsigned v4u __attribute__((ext_vector_type(4)));
typedef unsigned v2u __attribute__((ext_vector_type(2)));
typedef float f32x4 __attribute__((ext_vector_type(4)));

constexpr int NB = 8, S = 2048, T = NB * S, D = 2048, DEPTH = 2, HD = 128, PROJ = 6162;
constexpr int NTM = 34, NVT = 14;
constexpr int TM_A_Q = 0, TM_A_K = 6, TM_B_Q = 12, TM_B_KC = 18, TM_B_VC = 20, TM_B_KS = 22, TM_B_KW = 24, TM_C_Q = 26, TM_C_K = 30;
constexpr int VT_A_V = 0, VT_B_VS = 6, VT_B_VW = 8, VT_C_V = 10;
constexpr int GATE_COL0 = 4608;
constexpr int PLE = 256, NEXP = 16384;
constexpr float EPS = 1e-6f;
constexpr float QK_SCALE = 0.08838834764831845f;
#define NEG_INF (-__builtin_inff())

__host__ __device__ constexpr int tm_col0(int s) {
    return s < 6 ? 128 * s : s < 12 ? 768 + 128 * (s - 6) : s < 18 ? 2304 + 128 * (s - 12) : s < 20 ? 3072 + 128 * (s - 18) : s < 22 ? 3328 + 128 * (s - 20)
         : s < 24 ? 3584 + 128 * (s - 22) : s < 26 ? 4096 + 128 * (s - 24) : s < 30 ? 4626 + 128 * (s - 26) : 5138 + 128 * (s - 30);
}
__host__ __device__ constexpr int vt_col0(int v) {
    return v < 6 ? 1536 + 128 * v : v < 8 ? 3840 + 128 * (v - 6) : v < 10 ? 4352 + 128 * (v - 8) : 5650 + 128 * (v - 10);
}

constexpr size_t MiB = 1u << 20;
constexpr size_t align_up(size_t x) { return (x + 255) & ~(size_t)255; }
constexpr size_t WS_CTL = 0, CTL_BYTES = 1 * MiB, CTL_USED_BYTES = 128 * 1024;
constexpr size_t SZ_WINTM = (size_t)NTM * 128 * D * 2, SZ_WINVT = (size_t)NVT * 128 * D * 2, SZ_WSQ = (size_t)D * D * 2, SZ_WPROJ = (size_t)D * PLE * 2;
constexpr size_t WS_WINTM = WS_CTL + CTL_BYTES;
constexpr size_t WS_WINVT = WS_WINTM + DEPTH * SZ_WINTM;
constexpr size_t WS_WOUT = WS_WINVT + DEPTH * SZ_WINVT;
constexpr size_t WS_WQ = WS_WOUT + DEPTH * SZ_WSQ;
constexpr size_t WS_WGATE = WS_WQ + DEPTH * SZ_WSQ;
constexpr size_t WS_WPROJ = WS_WGATE + DEPTH * SZ_WSQ;
constexpr size_t WS_WG = WS_WPROJ + DEPTH * SZ_WPROJ;
constexpr size_t WS_KEYS = align_up(WS_WG + (size_t)DEPTH * 18 * D * 4);
constexpr size_t WS_CWT = WS_KEYS + (size_t)DEPTH * 16 * 128 * 128 * 2;
constexpr size_t WS_U = WS_CWT + (size_t)DEPTH * 2 * 128 * 4096 * 2;
constexpr size_t WS_V = WS_U + (size_t)DEPTH * NEXP * D;
constexpr size_t WS_SU = WS_V + (size_t)DEPTH * NEXP * D;
constexpr size_t WS_SV = WS_SU + (size_t)DEPTH * NEXP * 4;
constexpr size_t WS_P = WS_SV + (size_t)DEPTH * NEXP * 4;
constexpr size_t WS_TM = WS_P + (size_t)DEPTH * T * PLE * 2;
constexpr size_t WS_VT = WS_TM + (size_t)NB * NTM * S * 128 * 2;
constexpr size_t WS_KCMP = WS_VT + (size_t)NB * NVT * S * 128 * 2;
constexpr size_t WS_VCMPT = WS_KCMP + (size_t)NB * 2 * 128 * 128 * 2;
constexpr size_t WS_KMEAN = WS_VCMPT + (size_t)NB * 2 * 128 * 128 * 2;
constexpr size_t WS_GATES = WS_KMEAN + (size_t)NB * 8 * 4 * 128 * 4;
constexpr size_t WS_SS = align_up(WS_GATES + (size_t)T * 18 * 4);
constexpr size_t WS_OCMP = WS_SS + (size_t)T * 16 * 4;
constexpr size_t WS_SEL = WS_OCMP + (size_t)T * 768 * 4;
constexpr size_t WS_EXP = WS_SEL + (size_t)T * 16 * 4;
constexpr size_t WS_GW = WS_EXP + (size_t)T * 128 * 4;
constexpr size_t SZ_ACT = (size_t)T * D * 2;
constexpr size_t WS_ACT0 = WS_GW + (size_t)T * 128 * 4;
constexpr size_t WS_ACT1 = WS_ACT0 + SZ_ACT;
constexpr size_t WS_ACT2 = WS_ACT1 + SZ_ACT;
constexpr size_t WS_ACT3 = WS_ACT2 + SZ_ACT;
constexpr size_t WS_TBL = WS_ACT3 + SZ_ACT;
constexpr size_t WS_PD = WS_TBL + (size_t)16 * 3 * 2304 * 4;
constexpr size_t WS_H16 = WS_PD + (size_t)16 * T * 128 * 2;
constexpr size_t WS_WV = WS_PD + (size_t)16 * T * 128 * 4;
constexpr size_t WS_WG8 = WS_WV + (size_t)T * 128 * 4;
constexpr size_t WS_SWG = WS_WG8 + (size_t)DEPTH * D * D;
constexpr size_t WS_SHN = WS_SWG + (size_t)DEPTH * D * 4;
constexpr size_t WS_WIN8TM = WS_SHN + (size_t)T * 4;
constexpr size_t WS_WIN8VT = WS_WIN8TM + (size_t)DEPTH * NTM * 128 * D;
constexpr size_t WS_SWTM = WS_WIN8VT + (size_t)DEPTH * NVT * 128 * D;
constexpr size_t WS_SWVT = WS_SWTM + (size_t)DEPTH * NTM * 128 * 4;
constexpr size_t WS_SA = WS_SWVT + (size_t)DEPTH * NVT * 128 * 4;
constexpr size_t WS_XF8 = WS_SA + (size_t)T * 4;
constexpr size_t WS_SXF = WS_XF8 + (size_t)T * D;
constexpr size_t WS_WQ8 = WS_SXF + (size_t)T * 4;
constexpr size_t WS_SWQ = WS_WQ8 + (size_t)DEPTH * D * D;
constexpr size_t WS_WO8 = WS_SWQ + (size_t)DEPTH * D * 4;
constexpr size_t WS_SWO = WS_WO8 + (size_t)DEPTH * D * D;
constexpr size_t WS_SY = WS_SWO + (size_t)DEPTH * D * 4;
constexpr size_t WS_POSW = WS_SY + (size_t)T * 4;
constexpr size_t WS_END = WS_POSW + (size_t)DEPTH * 2 * 32 * 128 * 4;
static_assert(!H16 || (WQ_I8 && WOUT_I8 && PROJ_I8 && GATE_I8 && PEER_A_I8 && PEER_SLICED), "the fp16 residual stream is wired into the int8 paths only");
static_assert(WS_END <= (size_t)1024 * MiB, "workspace map exceeds 1 GiB");

__device__ __forceinline__ float bf2f(unsigned v) { return __uint_as_float(v << 16); }
__device__ __forceinline__ unsigned f2bf(float f) { unsigned u = __float_as_uint(f); return (u + 0x7fffu + ((u >> 16) & 1u)) >> 16; }
typedef __bf16 pkbf2_t __attribute__((ext_vector_type(2)));
typedef float pkf2_t __attribute__((ext_vector_type(2)));
__device__ __forceinline__ unsigned pk2(float lo, float hi) { const pkf2_t v = {lo, hi}; return __builtin_bit_cast(unsigned, __builtin_convertvector(v, pkbf2_t)); }
__device__ __forceinline__ unsigned pack_i8x4(float a, float b, float c, float d, float S) {
    const float M = 12582912.0f;
    const unsigned ya = __float_as_uint(__builtin_fmaf(a, S, M)), yb = __float_as_uint(__builtin_fmaf(b, S, M)), yc = __float_as_uint(__builtin_fmaf(c, S, M)), yd = __float_as_uint(__builtin_fmaf(d, S, M));
    return __builtin_amdgcn_perm(yb, ya, 0x0c0c0400u) | __builtin_amdgcn_perm(yd, yc, 0x04000c0cu);
}
typedef _Float16 h4_t __attribute__((ext_vector_type(4)));
typedef _Float16 h2_t __attribute__((ext_vector_type(2)));
__device__ __forceinline__ f32x4 ldh4(const GAS _Float16* p) { const h4_t v = *(const GAS h4_t*)p; return (f32x4){(float)v.x, (float)v.y, (float)v.z, (float)v.w}; }
__device__ __forceinline__ void sth4(GAS _Float16* p, f32x4 v) { *(GAS h4_t*)p = (h4_t){(_Float16)v.x, (_Float16)v.y, (_Float16)v.z, (_Float16)v.w}; }
template <bool SRC16> __device__ __forceinline__ f32x4 ldrow4(const void* base, size_t idx) { if (SRC16) return ldh4((const GAS _Float16*)base + idx); return *(const GAS f32x4*)((const GAS float*)base + idx); }
template <int M> __device__ __forceinline__ int swz_xor_i(int v) { return __builtin_amdgcn_ds_swizzle(v, (M << 10) | 0x1F); }
template <int M> __device__ __forceinline__ float swz_xor(float v) { return __builtin_bit_cast(float, swz_xor_i<M>(__builtin_bit_cast(int, v))); }
__device__ __forceinline__ void halves_i(int v, int& lo, int& hi) { const auto pr = __builtin_amdgcn_permlane32_swap((unsigned)v, (unsigned)v, false, false); lo = (int)pr[0]; hi = (int)pr[1]; }
__device__ __forceinline__ void halves(float v, float& lo, float& hi) { int a, b; halves_i(__builtin_bit_cast(int, v), a, b); lo = __builtin_bit_cast(float, a); hi = __builtin_bit_cast(float, b); }
__device__ __forceinline__ float wave_sum(float v) {
    v += swz_xor<1>(v); v += swz_xor<2>(v); v += swz_xor<4>(v); v += swz_xor<8>(v); v += swz_xor<16>(v);
    float lo, hi; halves(v, lo, hi); return lo + hi;
}
__device__ __forceinline__ float wave_max(float v) {
    v = fmaxf(v, swz_xor<1>(v)); v = fmaxf(v, swz_xor<2>(v)); v = fmaxf(v, swz_xor<4>(v)); v = fmaxf(v, swz_xor<8>(v)); v = fmaxf(v, swz_xor<16>(v));
    float lo, hi; halves(v, lo, hi); return fmaxf(lo, hi);
}
__device__ __forceinline__ int wave_min_i(int v) {
    int t;
    t = swz_xor_i<1>(v); v = t < v ? t : v; t = swz_xor_i<2>(v); v = t < v ? t : v; t = swz_xor_i<4>(v); v = t < v ? t : v; t = swz_xor_i<8>(v); v = t < v ? t : v; t = swz_xor_i<16>(v); v = t < v ? t : v;
    int lo, hi; halves_i(v, lo, hi); return lo < hi ? lo : hi;
}
__device__ __forceinline__ unsigned wave_or(unsigned v) {
    int x = (int)v; x |= swz_xor_i<1>(x); x |= swz_xor_i<2>(x); x |= swz_xor_i<4>(x); x |= swz_xor_i<8>(x); x |= swz_xor_i<16>(x);
    int lo, hi; halves_i(x, lo, hi); return (unsigned)(lo | hi);
}
__device__ __forceinline__ float lane_get(float v, int src) { return __builtin_bit_cast(float, __builtin_amdgcn_ds_bpermute(src << 2, __builtin_bit_cast(int, v))); }
__device__ __forceinline__ int lane_get_i(int v, int src) { return __builtin_amdgcn_ds_bpermute(src << 2, v); }
__device__ __forceinline__ int rel_bucket(int d) {
    if (d < 16) return d < 0 ? 0 : d;
    return 16 + (d >= 21) + (d >= 27) + (d >= 35) + (d >= 46) + (d >= 59) + (d >= 77) + (d >= 99) + (d >= 128) + (d >= 166) + (d >= 216) + (d >= 280) + (d >= 363) + (d >= 470) + (d >= 609) + (d >= 790);
}
#define WAVE_LDS_SYNC() do { asm volatile("s_waitcnt lgkmcnt(0)" ::: "memory"); __builtin_amdgcn_wave_barrier(); } while (0)

struct Params {
    const float* in[19];
    float* out;
    unsigned char* ws;
};
__device__ __forceinline__ int launder_i(int v) { asm volatile("" : "+v"(v)); return v; }
__device__ __forceinline__ int launder_s(int v) { asm volatile("" : "+s"(v)); return v; }
template <class Tp> __device__ __forceinline__ Tp* launder_p(Tp* p) { asm volatile("" : "+s"(p)); return p; }
__device__ __forceinline__ Params fresh(const Params& P) { Params Q;
#pragma unroll
    for (int i = 0; i < 19; ++i) Q.in[i] = launder_p(P.in[i]);
    Q.out = launder_p(P.out); Q.ws = launder_p(P.ws); return Q; }
#define TID() launder_i((int)threadIdx.x)
enum { I_X = 0, I_P, I_LNMIX, I_WIN, I_CMPWK, I_CMPWV, I_CMPPOS, I_OUTNORM, I_WOUT, I_RELBIAS, I_LNFFN, I_PEERWQ, I_PEERKEYS, I_PEERU, I_PEERV, I_LNPLE, I_PLEGATE, I_PLEPROJ, I_LNFINAL };

__device__ __forceinline__ void transpose_tile(const float* src, int ldsrc, int scol0, int k0, bf16* dst, int dstride, int drow0, const float* scale, LAS float* scr, int lane) {
    const bool al16 = ((scol0 & 3) == 0) && ((ldsrc & 3) == 0);
    if (al16) {
#pragma unroll
        for (int i = 0; i < 8; ++i) { const int kk = 8 * i + (lane >> 3), c4 = (lane & 7) * 4; f32x4 v = *(const GAS f32x4*)((const GAS float*)src + (size_t)(k0 + kk) * ldsrc + scol0 + c4);
            if (scale) { const float sc_ = scale[k0 + kk]; v = v * sc_; }
            scr[kk * 33 + c4] = v.x; scr[kk * 33 + c4 + 1] = v.y; scr[kk * 33 + c4 + 2] = v.z; scr[kk * 33 + c4 + 3] = v.w; }
    } else if (((scol0 | ldsrc) & 1) == 0) {
        typedef float f32x2 __attribute__((ext_vector_type(2)));
#pragma unroll
        for (int i = 0; i < 16; ++i) { const int kk = 4 * i + (lane >> 4), c2 = (lane & 15) * 2; f32x2 v = *(const GAS f32x2*)((const GAS float*)src + (size_t)(k0 + kk) * ldsrc + scol0 + c2);
            if (scale) { const float sc_ = scale[k0 + kk]; v = v * sc_; }
            scr[kk * 33 + c2] = v.x; scr[kk * 33 + c2 + 1] = v.y; }
    } else {
#pragma unroll 8
        for (int i = 0; i < 32; ++i) { const int kk = 2 * i + (lane >> 5); float v = src[(size_t)(k0 + kk) * ldsrc + scol0 + (lane & 31)]; if (scale) v *= scale[k0 + kk]; scr[kk * 33 + (lane & 31)] = v; }
    }
    WAVE_LDS_SYNC();
    const int c = lane & 7;
#pragma unroll
    for (int j = 0; j < 4; ++j) { const int n = (lane >> 3) + 8 * j; const LAS float* s = scr + (8 * c) * 33 + n;
        v4u o; o.x = pk2(s[0 * 33], s[1 * 33]); o.y = pk2(s[2 * 33], s[3 * 33]); o.z = pk2(s[4 * 33], s[5 * 33]); o.w = pk2(s[6 * 33], s[7 * 33]);
        *(v4u*)(dst + (size_t)(drow0 + n) * dstride + k0 + 8 * c) = o; }
    WAVE_LDS_SYNC();
}
constexpr int TL_TM = 32 * NTM * 4, TL_VT = 32 * NVT * 4, TL_SQ = 32 * 64, TL_PROJ = 4 * 64, TL_CW = 64 * 4;
constexpr int TL_LAYER = TL_TM + TL_VT + 3 * TL_SQ + TL_PROJ + 2 * TL_CW;
__device__ __forceinline__ void prologue_tile(const Params& P, int item, LAS float* scr, int lane) {
    const int l = item / TL_LAYER; int r = item % TL_LAYER;
    unsigned char* ws = P.ws;
    if (r < TL_TM) { const int nb = r / 32, kb = r % 32, slot = nb / 4, sub = nb % 4;
        transpose_tile(P.in[I_WIN] + (size_t)l * D * PROJ, PROJ, tm_col0(slot) + 32 * sub, 64 * kb, (bf16*)(ws + WS_WINTM) + (size_t)l * NTM * 128 * D, D, slot * 128 + 32 * sub, nullptr, scr, lane); return; }
    r -= TL_TM;
    if (r < TL_VT) { const int nb = r / 32, kb = r % 32, slot = nb / 4, sub = nb % 4;
        transpose_tile(P.in[I_WIN] + (size_t)l * D * PROJ, PROJ, vt_col0(slot) + 32 * sub, 64 * kb, (bf16*)(ws + WS_WINVT) + (size_t)l * NVT * 128 * D, D, slot * 128 + 32 * sub, nullptr, scr, lane); return; }
    r -= TL_VT;
    if (r < TL_SQ) { const int nb = r / 32, kb = r % 32;
        transpose_tile(P.in[I_WOUT] + (size_t)l * D * D, D, 32 * nb, 64 * kb, (bf16*)(ws + WS_WOUT) + (size_t)l * D * D, D, 32 * nb, P.in[I_OUTNORM] + (size_t)l * D, scr, lane); return; }
    r -= TL_SQ;
    if (r < TL_SQ) { const int nb = r / 32, kb = r % 32;
        transpose_tile(P.in[I_PEERWQ] + (size_t)l * D * D, D, 32 * nb, 64 * kb, (bf16*)(ws + WS_WQ) + (size_t)l * D * D, D, 32 * nb, nullptr, scr, lane); return; }
    r -= TL_SQ;
    if (r < TL_SQ) { const int nb = r / 32, kb = r % 32;
        transpose_tile(P.in[I_PLEGATE] + (size_t)l * D * D, D, 32 * nb, 64 * kb, (bf16*)(ws + WS_WGATE) + (size_t)l * D * D, D, 32 * nb, nullptr, scr, lane); return; }
    r -= TL_SQ;
    if (r < TL_PROJ) { const int nb = r / 4, kb = r % 4;
        transpose_tile(P.in[I_PLEPROJ] + (size_t)l * PLE * D, D, 32 * nb, 64 * kb, (bf16*)(ws + WS_WPROJ) + (size_t)l * D * PLE, PLE, 32 * nb, nullptr, scr, lane); return; }
    r -= TL_PROJ;
    { const int which = r / TL_CW; r %= TL_CW; const int nb = r / 64, kb = r % 64;
      transpose_tile((which ? P.in[I_CMPWV] : P.in[I_CMPWK]) + (size_t)l * 4096 * 128, 128, 32 * nb, 64 * kb, (bf16*)(ws + WS_CWT) + ((size_t)l * 2 + which) * 128 * 4096, 4096, 32 * nb, nullptr, scr, lane); }
}
__device__ __forceinline__ void cvt_f32_bf16(const float* src, bf16* dst, size_t n, size_t i0, size_t stride) {
    for (size_t i = i0 * 8; i < n; i += stride * 8) {
        const f32x4 a = *(const f32x4*)(src + i), b = *(const f32x4*)(src + i + 4);
        v4u o; o.x = pk2(a.x, a.y); o.y = pk2(a.z, a.w); o.z = pk2(b.x, b.y); o.w = pk2(b.z, b.w);
        *(v4u*)(dst + i) = o;
    }
}
__device__ __forceinline__ void phase_prologue(const Params& P, int bid, int nb, LAS unsigned char* lds) {
    const int tid = TID(), lane = tid & 63, wave = tid >> 6, nw = 8;
    LAS float* scr = (LAS float*)lds + wave * (64 * 33);
    for (int it = bid * nw + wave; it < DEPTH * TL_LAYER; it += nb * nw) prologue_tile(P, it, scr, lane);
    const size_t gi = (size_t)bid * 512 + tid, gs = (size_t)nb * 512;
    for (int row0 = (bid * nw + wave) * 2; row0 < 2 * DEPTH * NEXP; row0 += nb * nw * 2) {
        f32x4 v[2][2][4]; float am[2] = {0.f, 0.f};
#pragma unroll
        for (int u = 0; u < 2; ++u) { const int row = row0 + u; const int isv = row >= DEPTH * NEXP, rr = isv ? row - DEPTH * NEXP : row;
            const GAS float* src = (const GAS float*)(isv ? P.in[I_PEERV] : P.in[I_PEERU]) + (size_t)rr * D + lane * 16;
#pragma unroll
            for (int j = 0; j < 2; ++j)
#pragma unroll
                for (int q = 0; q < 4; ++q) v[u][j][q] = *(const GAS f32x4*)(src + j * 1024 + q * 4); }
#pragma unroll
        for (int u = 0; u < 2; ++u) { const int row = row0 + u; const int isv = row >= DEPTH * NEXP, rr = isv ? row - DEPTH * NEXP : row;
#pragma unroll
            for (int j = 0; j < 2; ++j)
#pragma unroll
                for (int q = 0; q < 4; ++q) am[u] = fmaxf(am[u], fmaxf(fmaxf(fabsf(v[u][j][q].x), fabsf(v[u][j][q].y)), fmaxf(fabsf(v[u][j][q].z), fabsf(v[u][j][q].w))));
            am[u] = wave_max(am[u]); const bool i8row = PEER_A_I8 && !isv; const float sc = am[u] > 0.f ? am[u] * (i8row ? 1.0f / 127.0f : 1.0f / 240.0f) : 1.0f, inv = 1.0f / sc;
            const int lyr = rr >= NEXP, ee = rr & (NEXP - 1);
            GAS unsigned char* dstb = (GAS unsigned char*)(P.ws + (isv ? WS_V : WS_U)) + (size_t)lyr * NEXP * D + (size_t)ee * 128;
#pragma unroll
            for (int j = 0; j < 2; ++j) { v4u o; int w;
                if (i8row) { o.x = pack_i8x4(v[u][j][0].x, v[u][j][0].y, v[u][j][0].z, v[u][j][0].w, inv); o.y = pack_i8x4(v[u][j][1].x, v[u][j][1].y, v[u][j][1].z, v[u][j][1].w, inv);
                             o.z = pack_i8x4(v[u][j][2].x, v[u][j][2].y, v[u][j][2].z, v[u][j][2].w, inv); o.w = pack_i8x4(v[u][j][3].x, v[u][j][3].y, v[u][j][3].z, v[u][j][3].w, inv); } else {
                w = __builtin_amdgcn_cvt_pk_fp8_f32(v[u][j][0].x * inv, v[u][j][0].y * inv, 0, false); w = __builtin_amdgcn_cvt_pk_fp8_f32(v[u][j][0].z * inv, v[u][j][0].w * inv, w, true); o.x = (unsigned)w;
                w = __builtin_amdgcn_cvt_pk_fp8_f32(v[u][j][1].x * inv, v[u][j][1].y * inv, 0, false); w = __builtin_amdgcn_cvt_pk_fp8_f32(v[u][j][1].z * inv, v[u][j][1].w * inv, w, true); o.y = (unsigned)w;
                w = __builtin_amdgcn_cvt_pk_fp8_f32(v[u][j][2].x * inv, v[u][j][2].y * inv, 0, false); w = __builtin_amdgcn_cvt_pk_fp8_f32(v[u][j][2].z * inv, v[u][j][2].w * inv, w, true); o.z = (unsigned)w;
                w = __builtin_amdgcn_cvt_pk_fp8_f32(v[u][j][3].x * inv, v[u][j][3].y * inv, 0, false); w = __builtin_amdgcn_cvt_pk_fp8_f32(v[u][j][3].z * inv, v[u][j][3].w * inv, w, true); o.w = (unsigned)w; }
#if PEER_SLICED
                { const int qc = lane + 64 * j; *(GAS v4u*)(dstb + (size_t)(qc >> 3) * NEXP * 128 + (qc & 7) * 16) = o; }
#else
                *(GAS v4u*)((GAS unsigned char*)(P.ws + (isv ? WS_V : WS_U)) + (size_t)rr * D + lane * 16 + j * 1024) = o;
#endif
            }
            if (lane == 0) ((GAS float*)(P.ws + (isv ? WS_SV : WS_SU)))[rr] = sc; }
    }
    cvt_f32_bf16(P.in[I_P], (bf16*)(P.ws + WS_P), (size_t)DEPTH * T * PLE, gi, gs);
    cvt_f32_bf16(P.in[I_PEERKEYS], (bf16*)(P.ws + WS_KEYS), (size_t)DEPTH * 16 * 128 * 128, gi, gs);
    bf16* wg = (bf16*)(P.ws + WS_WG);
    for (size_t i = gi; i < (size_t)DEPTH * 18 * D; i += gs) { const int l = (int)(i / (18 * D)), j = (int)((i / D) % 18), k = (int)(i % D); wg[i] = (bf16)f2bf(P.in[I_WIN][(size_t)l * D * PROJ + (size_t)k * PROJ + GATE_COL0 + j]); }
    float* tbl = (float*)(P.ws + WS_TBL);
    for (size_t i = gi; i < (size_t)16 * 3 * 2304; i += gs) { const int idx = (int)(i % 2304), kind = (int)((i / 2304) % 3), gh = (int)(i / (3 * 2304)); const int d = idx - 256; float v = -2e30f;
        if (d >= 0) { const float bias = P.in[I_RELBIAS][rel_bucket(d) * 16 + gh] * 1.4426950408889634f;
            if (kind == 0) v = bias;
            else if (kind == 1) { if (d <= 511) v = bias; }
            else { const int mult = (d <= 128 ? 1 : 0) + ((d & 3) == 0 && d <= 512 ? 1 : 0) + ((d & 15) == 0 ? 1 : 0); if (mult > 0) v = bias + (mult == 1 ? 0.f : mult == 2 ? 1.0f : 1.5849625007211562f); } }
        tbl[i] = v; }
    __syncthreads();
    { LAS float* red = (LAS float*)lds;
      for (int item = bid; item < DEPTH * 2 * 32; item += nb) { const int l = item >> 6, which = (item >> 5) & 1, kc = item & 31, e = tid & 127, kq = tid >> 7;
          const GAS float* w = (const GAS float*)(which ? P.in[I_CMPWV] : P.in[I_CMPWK]) + ((size_t)l * 4096 + kc * 128 + kq * 32) * 128 + e; const GAS float* pos = (const GAS float*)P.in[I_CMPPOS] + (size_t)l * 4096 + kc * 128 + kq * 32;
          float a = 0.f;
#pragma unroll 8
          for (int j = 0; j < 32; ++j) a = __builtin_fmaf(pos[j], w[(size_t)j * 128], a);
          red[tid] = a; __syncthreads();
          if (tid < 128) ((GAS float*)(P.ws + WS_POSW))[(size_t)item * 128 + tid] = (red[tid] + red[128 + tid]) + (red[256 + tid] + red[384 + tid]);
          __syncthreads(); } }
}

__device__ __forceinline__ float row_load_ss(const float* row, int lane, f32x4 (&v)[8]) {
    float s = 0.f;
#pragma unroll
    for (int j = 0; j < 8; ++j) { v[j] = *(const f32x4*)(row + (j * 64 + lane) * 4); s += v[j].x * v[j].x + v[j].y * v[j].y + v[j].z * v[j].z + v[j].w * v[j].w; }
    return wave_sum(s);
}
__device__ __forceinline__ void row_norm_store_bf16(f32x4 (&v)[8], float ss, const float* gain, bf16* orow, int lane, unsigned char* o8 = nullptr, float* sc8 = nullptr) {
    const float r = 1.0f / sqrtf(ss * (1.0f / D) + EPS); float am = 0.f;
#pragma unroll
    for (int j = 0; j < 8; ++j) { const f32x4 g = *(const f32x4*)(gain + (j * 64 + lane) * 4); v[j] = v[j] * r * g; am = fmaxf(am, fmaxf(fmaxf(fabsf(v[j].x), fabsf(v[j].y)), fmaxf(fabsf(v[j].z), fabsf(v[j].w))));
        if (orow) { v2u o; o.x = pk2(v[j].x, v[j].y); o.y = pk2(v[j].z, v[j].w); *(v2u*)(orow + (j * 64 + lane) * 4) = o; } }
    if (o8) { am = wave_max(am); const float S8 = am > 0.f ? 127.0f / am : 0.f;
#pragma unroll
        for (int j = 0; j < 8; ++j) *(GAS unsigned*)((GAS unsigned char*)o8 + (j * 64 + lane) * 4) = pack_i8x4(v[j].x, v[j].y, v[j].z, v[j].w, S8);
        if (lane == 0) *sc8 = am * (1.0f / 127.0f); }
}
typedef __bf16 bf2g_t __attribute__((ext_vector_type(2)));
__device__ __forceinline__ float dot2g(unsigned a, unsigned b, float c) { return __builtin_amdgcn_fdot2_f32_bf16(__builtin_bit_cast(bf2g_t, a), __builtin_bit_cast(bf2g_t, b), c, false); }
__device__ __forceinline__ void quant_all_rows(const Params& P, int l, int bid, int nb);
#if H16
__device__ __forceinline__ void phase_norm_mix(const Params& P, int l, int bid, int nb, LAS unsigned char* lds) {
    const int tid = TID(), lane = tid & 63, wave = tid >> 6, nw = 8;
    const GAS float* xsrc = (const GAS float*)P.in[I_X]; const GAS _Float16* hsrc = (const GAS _Float16*)(P.ws + WS_H16);
    GAS unsigned char* a8 = (GAS unsigned char*)(P.ws + WS_ACT0); GAS float* gates = (GAS float*)(P.ws + WS_GATES); GAS float* sa = (GAS float*)(P.ws + WS_SA);
    const GAS float* gain = (const GAS float*)P.in[I_LNMIX] + (size_t)l * D;
    { const GAS v4u* wsrc = (const GAS v4u*)((const GAS bf16*)(P.ws + WS_WG) + (size_t)l * 18 * D); LAS v4u* wl = (LAS v4u*)lds;
      v4u stg[9];
#pragma unroll
      for (int i = 0; i < 9; ++i) stg[i] = wsrc[tid + 512 * i];
      quant_all_rows(P, l, bid, nb);
#pragma unroll
      for (int i = 0; i < 9; ++i) wl[tid + 512 * i] = stg[i]; }
    __syncthreads();
    const LAS v2u* wl2 = (const LAS v2u*)lds;
    const int step = nb * nw;
    for (int t0 = bid * nw + wave; t0 < T; t0 += 4 * step) {
        v2u ab[4][8];
#pragma unroll
        for (int pr = 0; pr < 2; ++pr) {
            f32x4 v[2][8]; float ss[2] = {0.f, 0.f};
#pragma unroll
            for (int u = 0; u < 2; ++u) { const int t = t0 + (2 * pr + u) * step; const size_t tt = t < T ? t : t0;
                if (l == 0) {
#pragma unroll
                    for (int j = 0; j < 8; ++j) v[u][j] = *(const GAS f32x4*)(xsrc + tt * D + (j * 64 + lane) * 4);
                } else {
#pragma unroll
                    for (int j = 0; j < 8; ++j) v[u][j] = ldh4(hsrc + tt * D + (j * 64 + lane) * 4);
                } }
#pragma unroll
            for (int u = 0; u < 2; ++u) {
#pragma unroll
                for (int j = 0; j < 8; ++j) ss[u] += v[u][j].x * v[u][j].x + v[u][j].y * v[u][j].y + v[u][j].z * v[u][j].z + v[u][j].w * v[u][j].w;
                ss[u] = wave_sum(ss[u]); }
#pragma unroll
            for (int u = 0; u < 2; ++u) { const int t = t0 + (2 * pr + u) * step; const float r = 1.0f / sqrtf(ss[u] * (1.0f / D) + EPS); float am = 0.f;
#pragma unroll
                for (int j = 0; j < 8; ++j) { const f32x4 g = *(const GAS f32x4*)(gain + (j * 64 + lane) * 4); v[u][j] = v[u][j] * r * g;
                    ab[2 * pr + u][j].x = pk2(v[u][j].x, v[u][j].y); ab[2 * pr + u][j].y = pk2(v[u][j].z, v[u][j].w);
                    am = fmaxf(am, fmaxf(fmaxf(fabsf(v[u][j].x), fabsf(v[u][j].y)), fmaxf(fabsf(v[u][j].z), fabsf(v[u][j].w)))); }
                am = wave_max(am); const float S8 = am > 0.f ? 127.0f / am : 0.f;
                if (t < T) {
#pragma unroll
                    for (int j = 0; j < 8; ++j) *(GAS unsigned*)(a8 + (size_t)t * D + (j * 64 + lane) * 4) = pack_i8x4(v[u][j].x, v[u][j].y, v[u][j].z, v[u][j].w, S8);
                    if (lane == 0) sa[t] = am * (1.0f / 127.0f); } }
        }
        const int trow = t0 + (lane >> 4) * step;
#pragma unroll 2
        for (int c = 0; c < 18; ++c) { float s0 = 0.f, s1 = 0.f, s2 = 0.f, s3 = 0.f;
#pragma unroll
            for (int j = 0; j < 8; ++j) { const v2u w = wl2[c * (D / 4) + j * 64 + lane];
                s0 = dot2g(ab[0][j].x, w.x, s0); s0 = dot2g(ab[0][j].y, w.y, s0); s1 = dot2g(ab[1][j].x, w.x, s1); s1 = dot2g(ab[1][j].y, w.y, s1);
                s2 = dot2g(ab[2][j].x, w.x, s2); s2 = dot2g(ab[2][j].y, w.y, s2); s3 = dot2g(ab[3][j].x, w.x, s3); s3 = dot2g(ab[3][j].y, w.y, s3); }
            const auto p02 = __builtin_amdgcn_permlane32_swap(__builtin_bit_cast(unsigned, s0), __builtin_bit_cast(unsigned, s2), false, false);
            const auto p13 = __builtin_amdgcn_permlane32_swap(__builtin_bit_cast(unsigned, s1), __builtin_bit_cast(unsigned, s3), false, false);
            const float x0 = __builtin_bit_cast(float, (unsigned)p02[0]) + __builtin_bit_cast(float, (unsigned)p02[1]), x1 = __builtin_bit_cast(float, (unsigned)p13[0]) + __builtin_bit_cast(float, (unsigned)p13[1]);
            const auto q = __builtin_amdgcn_permlane16_swap(__builtin_bit_cast(unsigned, x0), __builtin_bit_cast(unsigned, x1), false, false);
            float y = __builtin_bit_cast(float, (unsigned)q[0]) + __builtin_bit_cast(float, (unsigned)q[1]);
            y += swz_xor<8>(y); y += swz_xor<4>(y); y += swz_xor<2>(y); y += swz_xor<1>(y);
            if ((lane & 15) == 0 && trow < T) gates[(size_t)trow * 18 + c] = 1.0f / (1.0f + __expf(-y)); }
    }
    __syncthreads();
}
#else
__device__ __forceinline__ void phase_norm_mix(const Params& P, int l, int bid, int nb, LAS unsigned char* lds) {
    const int tid = TID(), lane = tid & 63, wave = tid >> 6, nw = 8;
    const float* hsrc = l == 0 ? P.in[I_X] : P.out;
    bf16* a = (bf16*)(P.ws + WS_ACT0); float* gates = (float*)(P.ws + WS_GATES);
    { const GAS v4u* wsrc = (const GAS v4u*)((const GAS bf16*)(P.ws + WS_WG) + (size_t)l * 18 * D); LAS v4u* wl = (LAS v4u*)lds;
      for (int i = tid; i < 18 * D / 8; i += 512) wl[i] = wsrc[i]; }
    __syncthreads();
    const LAS v2u* wl2 = (const LAS v2u*)lds;
    for (int t = bid * nw + wave; t < T; t += nb * nw) {
        f32x4 v[8]; float ss;
#if H16
        if (l == 0) ss = row_load_ss(hsrc + (size_t)t * D, lane, v);
        else { float s_ = 0.f;
#pragma unroll
            for (int j = 0; j < 8; ++j) { v[j] = ldh4((const GAS _Float16*)(P.ws + WS_H16) + (size_t)t * D + (j * 64 + lane) * 4); s_ += v[j].x * v[j].x + v[j].y * v[j].y + v[j].z * v[j].z + v[j].w * v[j].w; }
            ss = wave_sum(s_); }
#else
        ss = row_load_ss(hsrc + (size_t)t * D, lane, v);
#endif
        const float r = 1.0f / sqrtf(ss * (1.0f / D) + EPS); v2u ab[8];
#pragma unroll
        for (int j = 0; j < 8; ++j) { const f32x4 g = *(const f32x4*)(P.in[I_LNMIX] + (size_t)l * D + (j * 64 + lane) * 4); v[j] = v[j] * r * g;
            ab[j].x = pk2(v[j].x, v[j].y); ab[j].y = pk2(v[j].z, v[j].w);
#if !PROJ_I8
            *(v2u*)(a + (size_t)t * D + (j * 64 + lane) * 4) = ab[j];
#endif
        }
#if PROJ_I8
        { float am = 0.f;
#pragma unroll
          for (int j = 0; j < 8; ++j) am = fmaxf(am, fmaxf(fmaxf(fabsf(v[j].x), fabsf(v[j].y)), fmaxf(fabsf(v[j].z), fabsf(v[j].w))));
          am = wave_max(am); const float S8 = am > 0.f ? 127.0f / am : 0.f;
#pragma unroll
          for (int j = 0; j < 8; ++j) *(GAS unsigned*)((GAS unsigned char*)a + (size_t)t * D + (j * 64 + lane) * 4) = pack_i8x4(v[j].x, v[j].y, v[j].z, v[j].w, S8);
          if (lane == 0) ((GAS float*)(P.ws + WS_SA))[t] = am * (1.0f / 127.0f); }
#endif
#pragma unroll 2
        for (int c = 0; c < 18; ++c) { float sacc = 0.f;
#pragma unroll
            for (int j = 0; j < 8; ++j) { const v2u w = wl2[c * (D / 4) + j * 64 + lane]; sacc = dot2g(ab[j].x, w.x, sacc); sacc = dot2g(ab[j].y, w.y, sacc); }
            const float sv_ = wave_sum(sacc); if (lane == 0) gates[(size_t)t * 18 + c] = 1.0f / (1.0f + __expf(-sv_)); }
    }
    __syncthreads();
}
#endif
template <bool SRC16 = false>
__device__ __forceinline__ void phase_norm(const void* src, const float* gain, bf16* dst, int bid, int nb, unsigned char* d8 = nullptr, float* s8 = nullptr) {
    const int tid = TID(), lane = tid & 63, wave = tid >> 6, nw = 8;
    const int step = nb * nw;
    int t = bid * nw + wave;
    for (; t + step < T; t += 2 * step) { f32x4 v0[8], v1[8];
#pragma unroll
        for (int j = 0; j < 8; ++j) { v0[j] = ldrow4<SRC16>(src, (size_t)t * D + (j * 64 + lane) * 4); v1[j] = ldrow4<SRC16>(src, (size_t)(t + step) * D + (j * 64 + lane) * 4); }
        float s0 = 0.f, s1 = 0.f;
#pragma unroll
        for (int j = 0; j < 8; ++j) { s0 += v0[j].x * v0[j].x + v0[j].y * v0[j].y + v0[j].z * v0[j].z + v0[j].w * v0[j].w; s1 += v1[j].x * v1[j].x + v1[j].y * v1[j].y + v1[j].z * v1[j].z + v1[j].w * v1[j].w; }
        s0 = wave_sum(s0); s1 = wave_sum(s1);
        row_norm_store_bf16(v0, s0, gain, dst ? dst + (size_t)t * D : nullptr, lane, d8 ? d8 + (size_t)t * D : nullptr, s8 + t); row_norm_store_bf16(v1, s1, gain, dst ? dst + (size_t)(t + step) * D : nullptr, lane, d8 ? d8 + (size_t)(t + step) * D : nullptr, s8 + t + step); }
    for (; t < T; t += step) { f32x4 v[8]; float s_ = 0.f;
#pragma unroll
        for (int j = 0; j < 8; ++j) { v[j] = ldrow4<SRC16>(src, (size_t)t * D + (j * 64 + lane) * 4); s_ += v[j].x * v[j].x + v[j].y * v[j].y + v[j].z * v[j].z + v[j].w * v[j].w; }
        row_norm_store_bf16(v, wave_sum(s_), gain, dst ? dst + (size_t)t * D : nullptr, lane, d8 ? d8 + (size_t)t * D : nullptr, s8 + t); }
}
__device__ __forceinline__ void phase_final(const Params& P, int bid, int nb) {
    const int tid = TID(), lane = tid & 63, wave = tid >> 6, nw = 8;
    const int step = nb * nw; int t = bid * nw + wave;
    for (; t + step < T; t += 2 * step) { f32x4 v0[8], v1[8]; GAS float* r0p = (GAS float*)P.out + (size_t)t * D; GAS float* r1p = (GAS float*)P.out + (size_t)(t + step) * D;
#pragma unroll
        for (int j = 0; j < 8; ++j) {
#if H16
            v0[j] = ldh4((const GAS _Float16*)(P.ws + WS_H16) + (size_t)t * D + (j * 64 + lane) * 4); v1[j] = ldh4((const GAS _Float16*)(P.ws + WS_H16) + (size_t)(t + step) * D + (j * 64 + lane) * 4);
#else
            v0[j] = *(const GAS f32x4*)(r0p + (j * 64 + lane) * 4); v1[j] = *(const GAS f32x4*)(r1p + (j * 64 + lane) * 4);
#endif
        }
        float s0 = 0.f, s1 = 0.f;
#pragma unroll
        for (int j = 0; j < 8; ++j) { s0 += v0[j].x * v0[j].x + v0[j].y * v0[j].y + v0[j].z * v0[j].z + v0[j].w * v0[j].w; s1 += v1[j].x * v1[j].x + v1[j].y * v1[j].y + v1[j].z * v1[j].z + v1[j].w * v1[j].w; }
        s0 = wave_sum(s0); s1 = wave_sum(s1);
        const float q0 = 1.0f / sqrtf(s0 * (1.0f / D) + EPS), q1 = 1.0f / sqrtf(s1 * (1.0f / D) + EPS);
#pragma unroll
        for (int j = 0; j < 8; ++j) { const f32x4 g = *(const f32x4*)(P.in[I_LNFINAL] + (j * 64 + lane) * 4); *(GAS f32x4*)(r0p + (j * 64 + lane) * 4) = v0[j] * q0 * g; *(GAS f32x4*)(r1p + (j * 64 + lane) * 4) = v1[j] * q1 * g; } }
    for (; t < T; t += step) { f32x4 v[8]; float* row = P.out + (size_t)t * D;
#if H16
        float s_ = 0.f;
#pragma unroll
        for (int j = 0; j < 8; ++j) { v[j] = ldh4((const GAS _Float16*)(P.ws + WS_H16) + (size_t)t * D + (j * 64 + lane) * 4); s_ += v[j].x * v[j].x + v[j].y * v[j].y + v[j].z * v[j].z + v[j].w * v[j].w; }
        const float ss = wave_sum(s_);
#else
        const float ss = row_load_ss(row, lane, v);
#endif
        const float r = 1.0f / sqrtf(ss * (1.0f / D) + EPS);
#pragma unroll
        for (int j = 0; j < 8; ++j) { const f32x4 g = *(const f32x4*)(P.in[I_LNFINAL] + (j * 64 + lane) * 4); *(f32x4*)(row + (j * 64 + lane) * 4) = v[j] * r * g; } }
}
__device__ __forceinline__ void phase_ynorm(const Params& P, int bid, int nb) {
    const int tid = TID(), lane = tid & 63, wave = tid >> 6, nw = 8;
    const GAS bf16* o = (const GAS bf16*)(P.ws + WS_ACT1); GAS bf16* y = (GAS bf16*)(P.ws + WS_ACT2); const GAS float* ss = (const GAS float*)(P.ws + WS_SS);
    const int step = nb * nw;
    for (int t0 = bid * nw + wave; t0 < T; t0 += 2 * step) {
        v4u w[2][4]; float sv[2];
#pragma unroll
        for (int u = 0; u < 2; ++u) { const int t = t0 + u * step; const bool ok = t < T; const size_t tt = ok ? t : t0;
            sv[u] = lane < 16 ? ss[tt * 16 + lane] : 0.f;
#pragma unroll
            for (int j = 0; j < 4; ++j) w[u][j] = *(const GAS v4u*)(o + tt * D + (j * 64 + lane) * 8); }
#pragma unroll
        for (int u = 0; u < 2; ++u) { const int t = t0 + u * step; if (t >= T) break;
            float sa = lane < 6 ? sv[u] : 0.f, sb = (lane >= 6 && lane < 12) ? sv[u] : 0.f, sc = (lane >= 12 && lane < 16) ? sv[u] : 0.f;
            sa = wave_sum(sa); sb = wave_sum(sb); sc = wave_sum(sc);
            const float ra = 1.0f / sqrtf(sa * (1.0f / 768.f) + EPS), rb = 1.0f / sqrtf(sb * (1.0f / 768.f) + EPS), rc = 1.0f / sqrtf(sc * (1.0f / 512.f) + EPS);
#if WOUT_I8
            float yv[4][8]; float am = 0.f;
#pragma unroll
            for (int j = 0; j < 4; ++j) { const int c0 = (j * 64 + lane) * 8; const float r = c0 < 768 ? ra : c0 < 1536 ? rb : rc; const v4u ww = w[u][j];
                yv[j][0] = bf2f(ww.x & 0xffff) * r; yv[j][1] = bf2f(ww.x >> 16) * r; yv[j][2] = bf2f(ww.y & 0xffff) * r; yv[j][3] = bf2f(ww.y >> 16) * r;
                yv[j][4] = bf2f(ww.z & 0xffff) * r; yv[j][5] = bf2f(ww.z >> 16) * r; yv[j][6] = bf2f(ww.w & 0xffff) * r; yv[j][7] = bf2f(ww.w >> 16) * r;
#pragma unroll
                for (int e = 0; e < 8; ++e) am = fmaxf(am, fabsf(yv[j][e])); }
            am = wave_max(am); const float S8 = am > 0.f ? 127.0f / am : 0.f;
#pragma unroll
            for (int j = 0; j < 4; ++j) *(GAS v2u*)((GAS unsigned char*)y + (size_t)t * D + (j * 64 + lane) * 8) = (v2u){pack_i8x4(yv[j][0], yv[j][1], yv[j][2], yv[j][3], S8), pack_i8x4(yv[j][4], yv[j][5], yv[j][6], yv[j][7], S8)};
            if (lane == 0) ((GAS float*)(P.ws + WS_SY))[t] = am * (1.0f / 127.0f); }
#else
#pragma unroll
            for (int j = 0; j < 4; ++j) { const int c0 = (j * 64 + lane) * 8; const float r = c0 < 768 ? ra : c0 < 1536 ? rb : rc; const v4u ww = w[u][j]; v4u q;
                q.x = pk2(bf2f(ww.x & 0xffff) * r, bf2f(ww.x >> 16) * r); q.y = pk2(bf2f(ww.y & 0xffff) * r, bf2f(ww.y >> 16) * r);
                q.z = pk2(bf2f(ww.z & 0xffff) * r, bf2f(ww.z >> 16) * r); q.w = pk2(bf2f(ww.w & 0xffff) * r, bf2f(ww.w >> 16) * r);
                *(GAS v4u*)(y + (size_t)t * D + c0) = q; } }
#endif
    }
}

struct EpiProjTM {
    bf16* tm;
    __device__ __forceinline__ void elem(int R, int C, float v) const { const int b = R >> 11, s = R & 2047, slot = C >> 7, d = C & 127; tm[(((size_t)b * NTM + slot) * S + s) * 128 + d] = (bf16)f2bf(v); }
};
struct EpiProjVT {
    bf16* vt;
    __device__ __forceinline__ void elem(int R, int C, float v) const { const int b = C >> 11, s = C & 2047, slot = R >> 7, d = R & 127; vt[(((size_t)b * NVT + slot) * 128 + d) * S + s] = (bf16)f2bf(v); }
};
struct EpiResid {
    const float* base; float* out;
    __device__ __forceinline__ void elem(int R, int C, float v) const { out[(size_t)R * D + C] = base[(size_t)R * D + C] + v; }
};
struct EpiStoreBf16 {
    bf16* o;
    __device__ __forceinline__ void elem(int R, int C, float v) const { o[(size_t)R * D + C] = (bf16)f2bf(v); }
};
struct EpiPleGate {
    float* out; const bf16* pp;
    __device__ __forceinline__ void elem(int R, int C, float v) const { const size_t i = (size_t)R * D + C; out[i] = out[i] + (1.0f / (1.0f + __expf(-v))) * bf2f(pp[i]); }
};

template <class Epi>
__device__ __forceinline__ void gemm_naive_tile(const bf16* Aside, const bf16* Bside, int K, int r0, int c0, const Epi& E, int tid, LAS float* sm) {
    typedef LAS float (*T68)[68];
    T68 As = (T68)sm, Bs = (T68)(sm + 32 * 68);
    const int tx = tid & 15, ty = tid >> 4;
    float acc[4][4];
#pragma unroll
    for (int i = 0; i < 4; ++i)
#pragma unroll
        for (int j = 0; j < 4; ++j) acc[i][j] = 0.f;
    const int lr = tid >> 2, lk = (tid & 3) * 8;
    for (int k0 = 0; k0 < K; k0 += 32) {
        const v4u av = *(const v4u*)(Aside + (size_t)(r0 + lr) * K + k0 + lk), bv = *(const v4u*)(Bside + (size_t)(c0 + lr) * K + k0 + lk);
        __syncthreads();
        As[lk + 0][lr] = bf2f(av.x & 0xffff); As[lk + 1][lr] = bf2f(av.x >> 16); As[lk + 2][lr] = bf2f(av.y & 0xffff); As[lk + 3][lr] = bf2f(av.y >> 16);
        As[lk + 4][lr] = bf2f(av.z & 0xffff); As[lk + 5][lr] = bf2f(av.z >> 16); As[lk + 6][lr] = bf2f(av.w & 0xffff); As[lk + 7][lr] = bf2f(av.w >> 16);
        Bs[lk + 0][lr] = bf2f(bv.x & 0xffff); Bs[lk + 1][lr] = bf2f(bv.x >> 16); Bs[lk + 2][lr] = bf2f(bv.y & 0xffff); Bs[lk + 3][lr] = bf2f(bv.y >> 16);
        Bs[lk + 4][lr] = bf2f(bv.z & 0xffff); Bs[lk + 5][lr] = bf2f(bv.z >> 16); Bs[lk + 6][lr] = bf2f(bv.w & 0xffff); Bs[lk + 7][lr] = bf2f(bv.w >> 16);
        __syncthreads();
#pragma unroll
        for (int kk = 0; kk < 32; ++kk) {
            const f32x4 a = *(const LAS f32x4*)&As[kk][ty * 4], b = *(const LAS f32x4*)&Bs[kk][tx * 4];
            const float aa[4] = {a.x, a.y, a.z, a.w}, bb[4] = {b.x, b.y, b.z, b.w};
#pragma unroll
            for (int i = 0; i < 4; ++i)
#pragma unroll
                for (int j = 0; j < 4; ++j) acc[i][j] += aa[i] * bb[j];
        }
    }
#pragma unroll
    for (int i = 0; i < 4; ++i)
#pragma unroll
        for (int j = 0; j < 4; ++j) E.elem(r0 + ty * 4 + i, c0 + tx * 4 + j, acc[i][j]);
}
template <class Epi>
__device__ __forceinline__ void phase_gemm_naive(const bf16* Aside, const bf16* Bside, int K, int nR, int nC, const Epi& E, int bid, int nb, LAS unsigned char* lds) {
    const int tid_ = TID(); const int half = tid_ >> 8, vtid = tid_ & 255; LAS float* sm = (LAS float*)lds + half * (2 * 32 * 68);
    const int tc = nC / 64, nt = (nR / 64) * tc;
    for (int base = bid * 2; base < nt; base += nb * 2) { const int tile = base + half; gemm_naive_tile(Aside, Bside, K, (tile / tc) * 64, (tile % tc) * 64, E, vtid, sm); }
    __syncthreads();
}


namespace pg8 {
#define PG8_LAS __attribute__((address_space(3)))
typedef unsigned short bf16_t;
typedef short bf16x8 __attribute__((ext_vector_type(8)));
typedef float f32x4 __attribute__((ext_vector_type(4)));
typedef unsigned u32x4 __attribute__((ext_vector_type(4)));
constexpr int BM = 256, BK = 64, HALF = 128, HTB = HALF * BK * 2, STAGE_BYTES = 8 * HTB, NXCD = 8, WGM = 8;
__host__ __device__ __forceinline__ int lds_byte(int r, int c) { const int st = (r >> 4) * 2 + (c >> 5), rr = r & 15, cc = c & 31, ob = rr * 64 + cc * 2; return st * 1024 + (ob ^ (((ob >> 9) & 1) << 5)); }
__host__ __device__ __forceinline__ void stage_rc(int b, int& R, int& C) { const int st = b / 1024, sb = b % 1024, swz = sb ^ (((sb >> 9) & 1) << 5); R = (st >> 1) * 16 + swz / 64; C = (st & 1) * 32 + (swz % 64) / 2; }
__host__ __device__ __forceinline__ int perm32(int rho) { const int n = rho >> 4, i = rho & 15; return 8 * (i >> 2) + 4 * n + (i & 3); }
struct Unit { int pm, pn; };
struct Gemm { const bf16_t* A; const bf16_t* Bt; int K; const bf16_t* A2; const bf16_t* Bt2; int splitM, splitN;
    __device__ __forceinline__ const char* a_ptr(int pm, size_t tstep) const { return pm < splitM ? (const char*)A + (size_t)pm * tstep : (const char*)A2 + (size_t)(pm - splitM) * tstep; }
    __device__ __forceinline__ const char* b_ptr(int pn, size_t tstep) const { return pn < splitN ? (const char*)Bt + (size_t)pn * tstep : (const char*)Bt2 + (size_t)(pn - splitN) * tstep; } };
__device__ __forceinline__ void order_map(int wgid, int nM, int nN, Unit& u) {
    const int nwg = nM * nN; { const int q = nwg / NXCD, r = nwg % NXCD, xcd = wgid % NXCD, off = wgid / NXCD; wgid = (xcd < r ? xcd * (q + 1) : r * (q + 1) + (xcd - r) * q) + off; }
    const int nig = WGM * nN, gid = wgid / nig, fm = gid * WGM, gsz = (nM - fm) < WGM ? (nM - fm) : WGM;
    u.pm = fm + ((wgid % nig) % gsz); u.pn = (wgid % nig) / gsz;
}
struct StaticOrder {
    int nM, nN, nwg, G, c;
    __device__ void init(int M, int N, int G_, int c_) { nM = M / BM; nN = N / BM; nwg = nM * nN; G = G_; c = c_; }
    __device__ bool next(int i, Unit& u) const { const long L = (long)i * G + c; if (L >= nwg) return false; order_map((int)L, nM, nN, u); return true; }
    __device__ __forceinline__ void a_ready(const Unit&) const {}
    __device__ __forceinline__ void done(const Unit&) const {}
};
struct DualOrder {
    int nM1, nN1, nM2, nN2, G, c;
    __device__ bool next(int i, Unit& u) const { long L = (long)i * G + c; const int n1 = nM1 * nN1;
        if (L < n1) { order_map((int)L, nM1, nN1, u); return true; }
        L -= n1; if (L >= nM2 * nN2) return false; order_map((int)L, nM2, nN2, u); u.pm += nM1; u.pn += nN1; return true; }
    __device__ __forceinline__ void a_ready(const Unit&) const {}
    __device__ __forceinline__ void done(const Unit&) const {}
};
__device__ __forceinline__ unsigned cvt_pk_bf16(float lo, float hi) { unsigned r; asm volatile("v_cvt_pk_bf16_f32 %0, %1, %2" : "=v"(r) : "v"(lo), "v"(hi)); return r; }
struct EpiProj {
    static constexpr bool PERM = true, AFTER_DRAIN = false, I8 = false;
    bf16_t* tm; bf16_t* vt;
    __device__ __forceinline__ void operator()(const f32x4 (&acc)[2][2][4][2], const Unit& u, int wr, int wc, int fr, int fq) const {
        if (u.pm < 64) {
#pragma unroll
            for (int ai = 0; ai < 2; ++ai)
#pragma unroll
                for (int m = 0; m < 4; ++m) { const int r = u.pm * BM + ai * HALF + wr * 64 + m * 16 + fr, b = r >> 11, s = r & 2047;
#pragma unroll
                    for (int bj = 0; bj < 2; ++bj) { const int slot = 2 * u.pn + bj, d0 = wc * 32 + 8 * fq;
                        const f32x4 v0 = acc[ai][bj][m][0], v1 = acc[ai][bj][m][1];
                        u32x4 w; w.x = cvt_pk_bf16(v0[0], v0[1]); w.y = cvt_pk_bf16(v0[2], v0[3]); w.z = cvt_pk_bf16(v1[0], v1[1]); w.w = cvt_pk_bf16(v1[2], v1[3]);
                        *(GAS u32x4*)((GAS bf16_t*)tm + (((size_t)b * NTM + slot) * S + s) * 128 + d0) = w; } }
        } else {
            const int pmv = u.pm - 64, pnv = u.pn - 17;
#pragma unroll
            for (int ai = 0; ai < 2; ++ai)
#pragma unroll
                for (int m = 0; m < 4; ++m) { const int vslot = 2 * pmv + ai, d = wr * 64 + m * 16 + fr;
#pragma unroll
                    for (int bj = 0; bj < 2; ++bj) { const int c0 = pnv * BM + bj * HALF + wc * 32 + 8 * fq, b = c0 >> 11, s = c0 & 2047;
                        const f32x4 v0 = acc[ai][bj][m][0], v1 = acc[ai][bj][m][1];
                        u32x4 w; w.x = cvt_pk_bf16(v0[0], v0[1]); w.y = cvt_pk_bf16(v0[2], v0[3]); w.z = cvt_pk_bf16(v1[0], v1[1]); w.w = cvt_pk_bf16(v1[2], v1[3]);
                        *(GAS u32x4*)((GAS bf16_t*)vt + (((size_t)b * NVT + vslot) * 128 + d) * S + s) = w; } }
        }
    }
};
struct EpiResidT {
    static constexpr bool PERM = false, AFTER_DRAIN = false, I8 = false;
    const float* base; float* out;
    __device__ __forceinline__ void operator()(const f32x4 (&acc)[2][2][4][2], const Unit& u, int wr, int wc, int fr, int fq) const {
        const int row0 = u.pm * BM + wr * 64 + fr, col0 = u.pn * BM + wc * 32 + 4 * fq;
        const GAS float* bp = (const GAS float*)base; GAS float* op = (GAS float*)out;
#pragma unroll
        for (int ai = 0; ai < 2; ++ai)
#pragma unroll
            for (int mp = 0; mp < 2; ++mp) { f32x4 t[2][2][2];
#pragma unroll
                for (int mm = 0; mm < 2; ++mm) { const size_t off = (size_t)(row0 + ai * HALF + (2 * mp + mm) * 16) * D + col0;
#pragma unroll
                    for (int bj = 0; bj < 2; ++bj)
#pragma unroll
                        for (int n = 0; n < 2; ++n) t[mm][bj][n] = *(const GAS f32x4*)(bp + off + bj * HALF + n * 16); }
#pragma unroll
                for (int mm = 0; mm < 2; ++mm) { const size_t off = (size_t)(row0 + ai * HALF + (2 * mp + mm) * 16) * D + col0;
#pragma unroll
                    for (int bj = 0; bj < 2; ++bj)
#pragma unroll
                        for (int n = 0; n < 2; ++n) *(GAS f32x4*)(op + off + bj * HALF + n * 16) = t[mm][bj][n] + acc[ai][bj][2 * mp + mm][n]; } }
    }
};
struct EpiStoreT {
    static constexpr bool PERM = true, AFTER_DRAIN = false, I8 = false;
    bf16_t* o;
    __device__ __forceinline__ void operator()(const f32x4 (&acc)[2][2][4][2], const Unit& u, int wr, int wc, int fr, int fq) const {
        const int row0 = u.pm * BM + wr * 64 + fr, col0 = u.pn * BM + wc * 32 + 8 * fq;
#pragma unroll
        for (int ai = 0; ai < 2; ++ai)
#pragma unroll
            for (int m = 0; m < 4; ++m) { bf16_t* rowp = o + (size_t)(row0 + ai * HALF + m * 16) * D + col0;
#pragma unroll
                for (int bj = 0; bj < 2; ++bj) { const f32x4 v0 = acc[ai][bj][m][0], v1 = acc[ai][bj][m][1];
                    u32x4 w; w.x = cvt_pk_bf16(v0[0], v0[1]); w.y = cvt_pk_bf16(v0[2], v0[3]); w.z = cvt_pk_bf16(v1[0], v1[1]); w.w = cvt_pk_bf16(v1[2], v1[3]);
                    *(GAS u32x4*)((GAS bf16_t*)rowp + bj * HALF) = w; } }
    }
};
struct EpiPleGateT {
    static constexpr bool PERM = false, AFTER_DRAIN = false, I8 = false;
    float* out; const bf16_t* pp;
    __device__ __forceinline__ void operator()(const f32x4 (&acc)[2][2][4][2], const Unit& u, int wr, int wc, int fr, int fq) const {
        const int row0 = u.pm * BM + wr * 64 + fr, col0 = u.pn * BM + wc * 32 + 4 * fq;
        GAS float* op = (GAS float*)out; const GAS bf16_t* ppp = (const GAS bf16_t*)pp;
#pragma unroll
        for (int ai = 0; ai < 2; ++ai)
#pragma unroll
            for (int mp = 0; mp < 2; ++mp) { f32x4 t[2][2][2]; v2u pw[2][2][2];
#pragma unroll
                for (int mm = 0; mm < 2; ++mm) { const size_t off = (size_t)(row0 + ai * HALF + (2 * mp + mm) * 16) * D + col0;
#pragma unroll
                    for (int bj = 0; bj < 2; ++bj)
#pragma unroll
                        for (int n = 0; n < 2; ++n) { t[mm][bj][n] = *(const GAS f32x4*)(op + off + bj * HALF + n * 16); pw[mm][bj][n] = *(const GAS v2u*)(ppp + off + bj * HALF + n * 16); } }
#pragma unroll
                for (int mm = 0; mm < 2; ++mm) { const size_t off = (size_t)(row0 + ai * HALF + (2 * mp + mm) * 16) * D + col0;
#pragma unroll
                    for (int bj = 0; bj < 2; ++bj)
#pragma unroll
                        for (int n = 0; n < 2; ++n) { const f32x4 hv = t[mm][bj][n], a = acc[ai][bj][2 * mp + mm][n]; const v2u p2 = pw[mm][bj][n];
                            f32x4 r; r[0] = hv[0] + bf2f(p2.x & 0xffff) / (1.0f + __expf(-a[0])); r[1] = hv[1] + bf2f(p2.x >> 16) / (1.0f + __expf(-a[1]));
                            r[2] = hv[2] + bf2f(p2.y & 0xffff) / (1.0f + __expf(-a[2])); r[3] = hv[3] + bf2f(p2.y >> 16) / (1.0f + __expf(-a[3]));
                            *(GAS f32x4*)(op + off + bj * HALF + n * 16) = r; } } }
    }
};

typedef int i32x4 __attribute__((ext_vector_type(4)));
template <bool I8> struct AccSel { typedef f32x4 type; };
template <> struct AccSel<true> { typedef i32x4 type; };
__device__ __forceinline__ void mma16(f32x4& acc, const bf16x8 b, const bf16x8 a) { acc = __builtin_amdgcn_mfma_f32_16x16x32_bf16(b, a, acc, 0, 0, 0); }
__device__ __forceinline__ void mma16(i32x4& acc, const bf16x8 b, const bf16x8 a) { acc = __builtin_amdgcn_mfma_i32_16x16x64_i8(__builtin_bit_cast(i32x4, b), __builtin_bit_cast(i32x4, a), acc, 0, 0, 0); }
struct EpiPleGateI8 {
    static constexpr bool PERM = false, AFTER_DRAIN = false, I8 = true;
    float* out; const bf16_t* pp; const float* sa; const float* sw;
    __device__ __forceinline__ void operator()(const i32x4 (&acc)[2][2][4][2], const Unit& u, int wr, int wc, int fr, int fq) const {
        const int row0 = u.pm * BM + wr * 64 + fr, col0 = u.pn * BM + wc * 32 + 4 * fq;
        GAS float* op = (GAS float*)out; const GAS bf16_t* ppp = (const GAS bf16_t*)pp;
        f32x4 swv[2][2];
#pragma unroll
        for (int bj = 0; bj < 2; ++bj)
#pragma unroll
            for (int n = 0; n < 2; ++n) swv[bj][n] = *(const GAS f32x4*)((const GAS float*)sw + col0 + bj * HALF + n * 16);
#pragma unroll
        for (int ai = 0; ai < 2; ++ai)
#pragma unroll
            for (int mp = 0; mp < 2; ++mp) { f32x4 t[2][2][2]; v2u pw[2][2][2]; float rs[2];
#pragma unroll
                for (int mm = 0; mm < 2; ++mm) { const int row = row0 + ai * HALF + (2 * mp + mm) * 16; const size_t off = (size_t)row * D + col0; rs[mm] = ((const GAS float*)sa)[row];
#pragma unroll
                    for (int bj = 0; bj < 2; ++bj)
#pragma unroll
                        for (int n = 0; n < 2; ++n) {
#if H16
                            t[mm][bj][n] = ldh4((const GAS _Float16*)out + off + bj * HALF + n * 16);
#else
                            t[mm][bj][n] = *(const GAS f32x4*)(op + off + bj * HALF + n * 16);
#endif
                            pw[mm][bj][n] = *(const GAS v2u*)(ppp + off + bj * HALF + n * 16); } }
#pragma unroll
                for (int mm = 0; mm < 2; ++mm) { const size_t off = (size_t)(row0 + ai * HALF + (2 * mp + mm) * 16) * D + col0;
#pragma unroll
                    for (int bj = 0; bj < 2; ++bj)
#pragma unroll
                        for (int n = 0; n < 2; ++n) { const f32x4 hv = t[mm][bj][n]; const i32x4 ai4 = acc[ai][bj][2 * mp + mm][n]; const v2u p2 = pw[mm][bj][n]; const f32x4 sc = swv[bj][n] * rs[mm];
                            const float a0 = (float)ai4[0] * sc[0], a1 = (float)ai4[1] * sc[1], a2 = (float)ai4[2] * sc[2], a3 = (float)ai4[3] * sc[3];
                            f32x4 r; r[0] = hv[0] + bf2f(p2.x & 0xffff) / (1.0f + __expf(-a0)); r[1] = hv[1] + bf2f(p2.x >> 16) / (1.0f + __expf(-a1));
                            r[2] = hv[2] + bf2f(p2.y & 0xffff) / (1.0f + __expf(-a2)); r[3] = hv[3] + bf2f(p2.y >> 16) / (1.0f + __expf(-a3));
#if H16
                            sth4((GAS _Float16*)out + off + bj * HALF + n * 16, r);
#else
                            *(GAS f32x4*)(op + off + bj * HALF + n * 16) = r;
#endif
                        } } }
    }
};
struct EpiStoreI8 {
    static constexpr bool PERM = true, AFTER_DRAIN = false, I8 = true;
    bf16_t* o; const float* sa; const float* sw;
    __device__ __forceinline__ void operator()(const i32x4 (&acc)[2][2][4][2], const Unit& u, int wr, int wc, int fr, int fq) const {
        const int row0 = u.pm * BM + wr * 64 + fr, col0 = u.pn * BM + wc * 32 + 8 * fq;
        f32x4 cs[2][2];
#pragma unroll
        for (int bj = 0; bj < 2; ++bj) { const GAS float* p = (const GAS float*)sw + col0 + bj * HALF; cs[bj][0] = *(const GAS f32x4*)p; cs[bj][1] = *(const GAS f32x4*)(p + 4); }
#pragma unroll
        for (int ai = 0; ai < 2; ++ai)
#pragma unroll
            for (int m = 0; m < 4; ++m) { const int row = row0 + ai * HALF + m * 16; bf16_t* rowp = o + (size_t)row * D + col0; const float rs = ((const GAS float*)sa)[row];
#pragma unroll
                for (int bj = 0; bj < 2; ++bj) { const i32x4 a0 = acc[ai][bj][m][0], a1 = acc[ai][bj][m][1]; const f32x4 s0 = cs[bj][0] * rs, s1 = cs[bj][1] * rs;
                    u32x4 w; w.x = cvt_pk_bf16((float)a0[0] * s0[0], (float)a0[1] * s0[1]); w.y = cvt_pk_bf16((float)a0[2] * s0[2], (float)a0[3] * s0[3]);
                    w.z = cvt_pk_bf16((float)a1[0] * s1[0], (float)a1[1] * s1[1]); w.w = cvt_pk_bf16((float)a1[2] * s1[2], (float)a1[3] * s1[3]);
                    *(GAS u32x4*)((GAS bf16_t*)rowp + bj * HALF) = w; } }
    }
};
struct EpiResidI8 {
    static constexpr bool PERM = false, AFTER_DRAIN = false, I8 = true;
    const float* base; float* out; const float* sa; const float* sw;
    __device__ __forceinline__ void operator()(const i32x4 (&acc)[2][2][4][2], const Unit& u, int wr, int wc, int fr, int fq) const {
        const int row0 = u.pm * BM + wr * 64 + fr, col0 = u.pn * BM + wc * 32 + 4 * fq;
        const GAS float* bp = (const GAS float*)base; GAS float* op = (GAS float*)out;
#if H16
        GAS _Float16* oh = (GAS _Float16*)out;
#endif
        f32x4 cs[2][2];
#pragma unroll
        for (int bj = 0; bj < 2; ++bj)
#pragma unroll
            for (int n = 0; n < 2; ++n) cs[bj][n] = *(const GAS f32x4*)((const GAS float*)sw + col0 + bj * HALF + n * 16);
#pragma unroll
        for (int ai = 0; ai < 2; ++ai)
#pragma unroll
            for (int mp = 0; mp < 2; ++mp) { f32x4 t[2][2][2]; float rs[2];
#pragma unroll
                for (int mm = 0; mm < 2; ++mm) { const int row = row0 + ai * HALF + (2 * mp + mm) * 16; const size_t off = (size_t)row * D + col0; rs[mm] = ((const GAS float*)sa)[row];
#pragma unroll
                    for (int bj = 0; bj < 2; ++bj)
#pragma unroll
                        for (int n = 0; n < 2; ++n) {
#if H16
                            if (bp) t[mm][bj][n] = *(const GAS f32x4*)(bp + off + bj * HALF + n * 16); else t[mm][bj][n] = ldh4(oh + off + bj * HALF + n * 16);
#else
                            t[mm][bj][n] = *(const GAS f32x4*)(bp + off + bj * HALF + n * 16);
#endif
                        } }
#pragma unroll
                for (int mm = 0; mm < 2; ++mm) { const size_t off = (size_t)(row0 + ai * HALF + (2 * mp + mm) * 16) * D + col0;
#pragma unroll
                    for (int bj = 0; bj < 2; ++bj)
#pragma unroll
                        for (int n = 0; n < 2; ++n) { const i32x4 a = acc[ai][bj][2 * mp + mm][n]; const f32x4 sc = cs[bj][n] * rs[mm];
                            const f32x4 rv = t[mm][bj][n] + (f32x4){(float)a[0] * sc[0], (float)a[1] * sc[1], (float)a[2] * sc[2], (float)a[3] * sc[3]};
#if H16
                            sth4(oh + off + bj * HALF + n * 16, rv);
#else
                            *(GAS f32x4*)(op + off + bj * HALF + n * 16) = rv;
#endif
                        } } }
    }
};
struct EpiProjI8 {
    static constexpr bool PERM = true, AFTER_DRAIN = false, I8 = true;
    bf16_t* tm; bf16_t* vt; const float* sa; const float* swtm; const float* swvt;
    __device__ __forceinline__ void operator()(const i32x4 (&acc)[2][2][4][2], const Unit& u, int wr, int wc, int fr, int fq) const {
        if (u.pm < 64) {
            f32x4 cs[2][2];
#pragma unroll
            for (int bj = 0; bj < 2; ++bj) { const GAS float* p = (const GAS float*)swtm + (2 * u.pn + bj) * 128 + wc * 32 + 8 * fq; cs[bj][0] = *(const GAS f32x4*)p; cs[bj][1] = *(const GAS f32x4*)(p + 4); }
#pragma unroll
            for (int ai = 0; ai < 2; ++ai)
#pragma unroll
                for (int m = 0; m < 4; ++m) { const int r = u.pm * BM + ai * HALF + wr * 64 + m * 16 + fr, b = r >> 11, s = r & 2047; const float rs = ((const GAS float*)sa)[r];
#pragma unroll
                    for (int bj = 0; bj < 2; ++bj) { const int slot = 2 * u.pn + bj, d0 = wc * 32 + 8 * fq;
                        const i32x4 a0 = acc[ai][bj][m][0], a1 = acc[ai][bj][m][1]; const f32x4 s0 = cs[bj][0] * rs, s1 = cs[bj][1] * rs;
                        u32x4 w; w.x = cvt_pk_bf16((float)a0[0] * s0[0], (float)a0[1] * s0[1]); w.y = cvt_pk_bf16((float)a0[2] * s0[2], (float)a0[3] * s0[3]);
                        w.z = cvt_pk_bf16((float)a1[0] * s1[0], (float)a1[1] * s1[1]); w.w = cvt_pk_bf16((float)a1[2] * s1[2], (float)a1[3] * s1[3]);
                        *(GAS u32x4*)((GAS bf16_t*)tm + (((size_t)b * NTM + slot) * S + s) * 128 + d0) = w; } }
        } else {
            const int pmv = u.pm - 64, pnv = u.pn - 17;
            f32x4 cs[2][2];
#pragma unroll
            for (int bj = 0; bj < 2; ++bj) { const GAS float* p = (const GAS float*)sa + pnv * BM + bj * HALF + wc * 32 + 8 * fq; cs[bj][0] = *(const GAS f32x4*)p; cs[bj][1] = *(const GAS f32x4*)(p + 4); }
#pragma unroll
            for (int ai = 0; ai < 2; ++ai)
#pragma unroll
                for (int m = 0; m < 4; ++m) { const int vslot = 2 * pmv + ai, d = wr * 64 + m * 16 + fr; const float rs = ((const GAS float*)swvt)[vslot * 128 + d];
#pragma unroll
                    for (int bj = 0; bj < 2; ++bj) { const int c0 = pnv * BM + bj * HALF + wc * 32 + 8 * fq, b = c0 >> 11, s = c0 & 2047;
                        const i32x4 a0 = acc[ai][bj][m][0], a1 = acc[ai][bj][m][1]; const f32x4 s0 = cs[bj][0] * rs, s1 = cs[bj][1] * rs;
                        u32x4 w; w.x = cvt_pk_bf16((float)a0[0] * s0[0], (float)a0[1] * s0[1]); w.y = cvt_pk_bf16((float)a0[2] * s0[2], (float)a0[3] * s0[3]);
                        w.z = cvt_pk_bf16((float)a1[0] * s1[0], (float)a1[1] * s1[1]); w.w = cvt_pk_bf16((float)a1[2] * s1[2], (float)a1[3] * s1[3]);
                        *(GAS u32x4*)((GAS bf16_t*)vt + (((size_t)b * NVT + vslot) * 128 + d) * S + s) = w; } }
        }
    }
};
template <class Epi, class Sched>
__device__ __forceinline__ void gemm_phase(PG8_LAS unsigned char* lds, const Gemm g, const Sched& S, const Epi& E) {
    const int tid = TID(), wid = __builtin_amdgcn_readfirstlane(tid >> 6), lane = tid & 63, wr = wid >> 2, wc = wid & 3, fr = lane & 15, fq = lane >> 4;
    const int K = g.K, nt = K / BK;
    unsigned voffA[2], voffB[2];
#pragma unroll
    for (int i = 0; i < 2; ++i) { int R, C; stage_rc(tid * 16 + i * 8192, R, C); const int Rb = Epi::PERM ? ((R & ~31) + perm32(R & 31)) : R;
        voffA[i] = (unsigned)(R * K + C) * 2u; voffB[i] = (unsigned)(Rb * K + C) * 2u; }
    const size_t kstep = (size_t)(BK * 2);
    const size_t hstep = (size_t)HALF * K * 2;
    const size_t tstep = 2 * hstep;
    const unsigned ldsw = (unsigned)wid * 1024u;
    const int aoff = lds_byte(wr * 64 + fr, fq * 8), boff = lds_byte(wc * 32 + fr, fq * 8);
#define PG8_SA(b, h) (((b) * 2 + (h)) * HTB)
#define PG8_SB(b, h) ((4 + (b) * 2 + (h)) * HTB)
#define PG8_STAGE(bufoff, gbase, voff) do { _Pragma("unroll") for (int _i = 0; _i < 2; ++_i) \
        __builtin_amdgcn_global_load_lds((const unsigned*)((const char*)(gbase) + (voff)[_i]), (PG8_LAS unsigned*)(lds + (bufoff) + ldsw + _i * 8192), 16, 0, 0); } while (0)
#define PG8_LDA(dst, b, h) do { _Pragma("unroll") for (int m = 0; m < 4; ++m) _Pragma("unroll") for (int k = 0; k < 2; ++k) dst[m][k] = *(const PG8_LAS bf16x8*)(lds + PG8_SA(b, h) + aoff + m * 2048 + k * 1024); } while (0)
#define PG8_LDB(dst, b, h) do { _Pragma("unroll") for (int n = 0; n < 2; ++n) _Pragma("unroll") for (int k = 0; k < 2; ++k) dst[n][k] = *(const PG8_LAS bf16x8*)(lds + PG8_SB(b, h) + boff + n * 2048 + k * 1024); } while (0)
#define PG8_MMA(ai, bj, At, Bt) do { __builtin_amdgcn_s_setprio(1); _Pragma("unroll") for (int m = 0; m < 4; ++m) _Pragma("unroll") for (int n = 0; n < 2; ++n) _Pragma("unroll") for (int k = 0; k < 2; ++k) \
        mma16(acc[ai][bj][m][n], Bt[n][k], At[m][k]); __builtin_amdgcn_s_setprio(0); } while (0)
#define PG8_WAIT_V(n) asm volatile("s_waitcnt vmcnt(" #n ")" ::: "memory")
#define PG8_WAIT_L(n) asm volatile("s_waitcnt lgkmcnt(" #n ")" ::: "memory")
#define PG8_BAR __builtin_amdgcn_s_barrier()
#define PG8_SCHED __builtin_amdgcn_sched_barrier(0)
    Unit cur, nxt; int ui = 0;
    if (!S.next(0, cur)) return;
    typedef typename AccSel<Epi::I8>::type acc_t;
    acc_t acc[2][2][4][2];
#pragma unroll
    for (int a = 0; a < 2; ++a)
#pragma unroll
        for (int b = 0; b < 2; ++b)
#pragma unroll
            for (int m = 0; m < 4; ++m)
#pragma unroll
                for (int n = 0; n < 2; ++n) acc[a][b][m][n] = acc_t{};
    bf16x8 At[4][2], B0[2][2], B1[2][2];
    const char* cA = g.a_ptr(cur.pm, tstep); const char* cB = g.b_ptr(cur.pn, tstep);
    S.a_ready(cur);
    PG8_STAGE(PG8_SB(0, 0), cB, voffB); PG8_STAGE(PG8_SA(0, 0), cA, voffA); PG8_STAGE(PG8_SB(0, 1), cB + hstep, voffB); PG8_STAGE(PG8_SA(0, 1), cA + hstep, voffA);
    if (wr == 1) PG8_BAR;
    PG8_WAIT_V(4); PG8_BAR;
    PG8_STAGE(PG8_SB(1, 0), cB + kstep, voffB); PG8_STAGE(PG8_SA(1, 0), cA + kstep, voffA); PG8_STAGE(PG8_SB(1, 1), cB + hstep + kstep, voffB);
    PG8_WAIT_V(6); PG8_BAR;
    for (;;) {
        const bool has_next = S.next(ui + 1, nxt);
        const char* nA = has_next ? g.a_ptr(nxt.pm, tstep) : cA; const char* nB = has_next ? g.b_ptr(nxt.pn, tstep) : cB;
        for (int t = 0; t < nt; t += 2) {
            const bool last = (t == nt - 2);
            const char* a1 = cA + (size_t)(t + 1) * kstep;
            const char* a2 = last ? nA : cA + (size_t)(t + 2) * kstep; const char* b2 = last ? nB : cB + (size_t)(t + 2) * kstep;
            const char* a3 = a2 + kstep; const char* b3 = b2 + kstep;
            if (last && has_next) S.a_ready(nxt);
            PG8_LDB(B0, 0, 0); PG8_SCHED; PG8_LDA(At, 0, 0); PG8_STAGE(PG8_SA(1, 1), a1 + hstep, voffA);
            PG8_WAIT_L(8); PG8_BAR; PG8_WAIT_L(0); PG8_MMA(0, 0, At, B0); PG8_BAR; PG8_SCHED;
            PG8_LDB(B1, 0, 1); PG8_STAGE(PG8_SB(0, 0), b2, voffB);
            PG8_BAR; PG8_WAIT_L(0); PG8_MMA(0, 1, At, B1); PG8_BAR;
            PG8_LDA(At, 0, 1); PG8_STAGE(PG8_SA(0, 0), a2, voffA);
            PG8_BAR; PG8_WAIT_L(0); PG8_MMA(1, 0, At, B0); PG8_BAR; PG8_SCHED;
            PG8_STAGE(PG8_SB(0, 1), b2 + hstep, voffB);
            PG8_WAIT_V(6); PG8_BAR; PG8_MMA(1, 1, At, B1); PG8_BAR;
            PG8_LDB(B0, 1, 0); PG8_SCHED; PG8_LDA(At, 1, 0); PG8_STAGE(PG8_SA(0, 1), a2 + hstep, voffA);
            PG8_WAIT_L(8); PG8_BAR; PG8_WAIT_L(0); PG8_MMA(0, 0, At, B0); PG8_BAR; PG8_SCHED;
            PG8_LDB(B1, 1, 1); PG8_STAGE(PG8_SB(1, 0), b3, voffB);
            PG8_BAR; PG8_WAIT_L(0); PG8_MMA(0, 1, At, B1); PG8_BAR;
            PG8_LDA(At, 1, 1); PG8_STAGE(PG8_SA(1, 0), a3, voffA);
            PG8_BAR; PG8_WAIT_L(0); PG8_MMA(1, 0, At, B0); PG8_BAR; PG8_SCHED;
            PG8_STAGE(PG8_SB(1, 1), b3 + hstep, voffB);
            PG8_WAIT_V(6); PG8_BAR; PG8_MMA(1, 1, At, B1); PG8_BAR;
        }
        if constexpr (!Epi::AFTER_DRAIN) { E(acc, cur, wr, wc, fr, fq); S.done(cur); }
        if (!has_next) break;
#pragma unroll
        for (int a = 0; a < 2; ++a)
#pragma unroll
            for (int b = 0; b < 2; ++b)
#pragma unroll
                for (int m = 0; m < 4; ++m)
#pragma unroll
                    for (int n = 0; n < 2; ++n) acc[a][b][m][n] = acc_t{};
        cur = nxt; cA = nA; cB = nB; ++ui;
    }
    PG8_WAIT_V(0);
    if (wr == 0) PG8_BAR;
    PG8_BAR;
    if constexpr (Epi::AFTER_DRAIN) { E.fused(acc, cur, wr, wc, fr, fq, lds, wid, lane); S.done(cur); }
#undef PG8_SA
#undef PG8_SB
#undef PG8_STAGE
#undef PG8_LDA
#undef PG8_LDB
#undef PG8_MMA
#undef PG8_WAIT_V
#undef PG8_WAIT_L
#undef PG8_BAR
#undef PG8_SCHED
}
}

__device__ __forceinline__ void phase_prep_naive(const Params& P, int l, int bid, int nb) {
    const int tid_ = TID(); const int half = tid_ >> 8, tid = tid_ & 255;
    for (int vb = bid * 2 + half; vb < NB * 2 * 128; vb += nb * 2) {
        const int n = vb & 127, g = (vb >> 7) & 1, b = vb >> 8;
        const int which = tid >> 7, e = tid & 127;
        const bf16* tm = (const bf16*)(P.ws + WS_TM);
        const bf16* src = tm + (((size_t)b * NTM + (which ? TM_B_VC : TM_B_KC) + g) * S) * 128;
        const float* w = (which ? P.in[I_CMPWV] : P.in[I_CMPWK]) + (size_t)l * 32 * 128 * 128; const float* pos = P.in[I_CMPPOS] + (size_t)l * 32 * 128;
        float acc = 0.f;
        if (n < 127) for (int ll = 0; ll < 32; ++ll) for (int d = 0; d < 128; ++d) acc += (bf2f(src[(size_t)(16 * n + ll) * 128 + d]) + pos[ll * 128 + d]) * w[((size_t)ll * 128 + d) * 128 + e];
        if (which == 0) ((bf16*)(P.ws + WS_KCMP))[(((size_t)b * 2 + g) * 128 + n) * 128 + e] = (bf16)f2bf(acc);
        else ((bf16*)(P.ws + WS_VCMPT))[(((size_t)b * 2 + g) * 128 + e) * 128 + n] = (bf16)f2bf(acc);
    }
    for (int w = bid * 512 + tid_; w < NB * 8 * 4 * 128; w += nb * 512) {
        const int d = w & 127, id = w >> 7, h = id & 3, blk = (id >> 2) & 7, b = id >> 5;
        const bf16* k = (const bf16*)(P.ws + WS_TM) + (((size_t)b * NTM + TM_C_K + h) * S + blk * 256) * 128;
        float s = 0.f; for (int j = 0; j < 256; ++j) s += bf2f(k[(size_t)j * 128 + d]);
        ((float*)(P.ws + WS_KMEAN))[(((size_t)b * 8 + blk) * 4 + h) * 128 + d] = s * (1.0f / 256.f);
    }
}

struct KeyRef { const bf16* krow; int vkey; int dist; bool valid; };
template <class F>
__device__ __forceinline__ void naive_attend(const LAS float* qs, LAS float* sc, int n, F f, const float* biascol, const bf16* Vt, int vstride, int lane, float& o0, float& o1, float& lse, float& zinv) {
    float mx = NEG_INF;
    for (int idx = lane; idx < n; idx += 64) {
        const KeyRef kr = f(idx); float s = NEG_INF;
        if (kr.valid) { float dot = 0.f;
#pragma unroll 4
            for (int c = 0; c < 16; ++c) { const v4u w = *(const v4u*)(kr.krow + c * 8); const f32x4 qa = *(const LAS f32x4*)(qs + c * 8), qb = *(const LAS f32x4*)(qs + c * 8 + 4);
                dot += bf2f(w.x & 0xffff) * qa.x + bf2f(w.x >> 16) * qa.y + bf2f(w.y & 0xffff) * qa.z + bf2f(w.y >> 16) * qa.w + bf2f(w.z & 0xffff) * qb.x + bf2f(w.z >> 16) * qb.y + bf2f(w.w & 0xffff) * qb.z + bf2f(w.w >> 16) * qb.w; }
            s = dot * QK_SCALE + biascol[rel_bucket(kr.dist) * 16]; }
        sc[idx] = s; mx = fmaxf(mx, s);
    }
    mx = wave_max(mx); const float m = (mx > NEG_INF) ? mx : 0.f;
    WAVE_LDS_SYNC();
    float z = 0.f;
    for (int idx = lane; idx < n; idx += 64) { const float e = __expf(sc[idx] - m); sc[idx] = e; z += e; }
    z = wave_sum(z); const float zs = z > 0.f ? z : 1.f;
    WAVE_LDS_SYNC();
    float a0 = 0.f, a1 = 0.f;
    for (int idx = 0; idx < n; ++idx) { const float p = sc[idx]; if (p != 0.f) { const KeyRef kr = f(idx); a0 += p * bf2f(Vt[(size_t)(2 * lane) * vstride + kr.vkey]); a1 += p * bf2f(Vt[(size_t)(2 * lane + 1) * vstride + kr.vkey]); } }
    zinv = 1.0f / zs; o0 = a0 * zinv; o1 = a1 * zinv; lse = z > 0.f ? m + __logf(zs) : NEG_INF;
}
__device__ __forceinline__ void load_q_lds(const bf16* qrow, LAS float* qs, int lane) { qs[2 * lane] = bf2f(qrow[2 * lane]); qs[2 * lane + 1] = bf2f(qrow[2 * lane + 1]); WAVE_LDS_SYNC(); }

__device__ __forceinline__ void attnA_item(const Params& P, int id, int lane, LAS float* qs, LAS float* sc) {
    const int i = id & 2047, h = (id >> 11) % 6, b = id / (6 * S);
    const bf16* tm = (const bf16*)(P.ws + WS_TM); const bf16* vt = (const bf16*)(P.ws + WS_VT);
    const bf16* Q = tm + (((size_t)b * NTM + TM_A_Q + h) * S) * 128; const bf16* K = tm + (((size_t)b * NTM + TM_A_K + h) * S) * 128; const bf16* V = vt + (((size_t)b * NVT + VT_A_V + h) * 128) * S;
    load_q_lds(Q + (size_t)i * 128, qs, lane);
    const float* biascol = P.in[I_RELBIAS] + h;
    float o0[3], o1[3], lse[3], zi;
#pragma unroll
    for (int p = 0; p < 3; ++p) { const int dil = p == 0 ? 1 : p == 1 ? 4 : 16; const int nk = min(128, i / dil) + 1;
        naive_attend(qs, sc, nk, [&](int idx) { KeyRef r; const int j = i - idx * dil; r.krow = K + (size_t)j * 128; r.vkey = j; r.dist = idx * dil; r.valid = true; return r; }, biascol, V, S, lane, o0[p], o1[p], lse[p], zi);
        WAVE_LDS_SYNC(); }
    const float m = fmaxf(lse[0], fmaxf(lse[1], lse[2])); const float w0 = __expf(lse[0] - m), w1 = __expf(lse[1] - m), w2 = __expf(lse[2] - m), wi = 1.0f / (w0 + w1 + w2);
    const float r0 = (w0 * o0[0] + w1 * o0[1] + w2 * o0[2]) * wi, r1 = (w0 * o1[0] + w1 * o1[1] + w2 * o1[2]) * wi;
    const size_t t = (size_t)b * S + i; bf16* o = (bf16*)(P.ws + WS_ACT1);
    *(unsigned*)(o + t * D + h * 128 + 2 * lane) = pk2(r0, r1);
    const float ssq = wave_sum(r0 * r0 + r1 * r1); if (lane == 0) ((float*)(P.ws + WS_SS))[t * 16 + h] = ssq;
}
__device__ __forceinline__ void attnB1_item(const Params& P, int id, int lane, LAS float* qs, LAS float* sc, LAS float* imp) {
    const int i = id & 2047, g = (id >> 11) & 1, b = id >> 12;
    const bf16* tm = (const bf16*)(P.ws + WS_TM);
    const bf16* Kc = (const bf16*)(P.ws + WS_KCMP) + ((size_t)b * 2 + g) * 128 * 128; const bf16* Vc = (const bf16*)(P.ws + WS_VCMPT) + ((size_t)b * 2 + g) * 128 * 128;
    const size_t t = (size_t)b * S + i; const float* gates = (const float*)(P.ws + WS_GATES) + t * 18; float* ocmp = (float*)(P.ws + WS_OCMP) + t * 768;
    const int ncv = i >= 31 ? (i - 31) / 16 + 1 : 0;
    if (lane < 32) imp[lane] = 0.f;
    WAVE_LDS_SYNC();
    for (int r = 0; r < 3; ++r) { const int h = g * 3 + r;
        load_q_lds(tm + (((size_t)b * NTM + TM_B_Q + h) * S + i) * 128, qs, lane);
        float o0, o1, lse, zi;
        naive_attend(qs, sc, ncv, [&](int n) { KeyRef kr; kr.krow = Kc + (size_t)n * 128; kr.vkey = n; kr.dist = i - (16 * n + 31); kr.valid = true; return kr; }, P.in[I_RELBIAS] + 6 + h, Vc, 128, lane, o0, o1, lse, zi);
        const float g0 = gates[h * 3 + 0];
        ocmp[h * 128 + 2 * lane] = g0 * o0; ocmp[h * 128 + 2 * lane + 1] = g0 * o1;
        WAVE_LDS_SYNC();
        if (lane < 32) { float a = 0.f; for (int n = 4 * lane - 1; n <= 4 * lane + 3; ++n) if (n >= 0 && n < ncv) a += sc[n] * zi; imp[lane] += a; }
        WAVE_LDS_SYNC(); }
    const int qblk = i >> 6; float val = NEG_INF;
    if (lane < 32) { val = imp[lane]; if (lane == 0 || lane == qblk || lane == qblk - 1) val = 1e4f; else if (lane > qblk) val = -1e4f; }
    int* sel = (int*)(P.ws + WS_SEL) + (t * 2 + g) * 8;
    for (int k = 0; k < 8; ++k) { const float m = wave_max(val); const int mi = wave_min_i(val == m ? lane : 1 << 30); if (lane == mi) val = NEG_INF; if (lane == 0) sel[k] = mi; }
    WAVE_LDS_SYNC();
}
__device__ __forceinline__ void attnB2_item(const Params& P, int id, int lane, LAS float* qs, LAS float* sc) {
    const int i = id & 2047, h = (id >> 11) % 6, b = id / (6 * S), g = h / 3;
    const bf16* tm = (const bf16*)(P.ws + WS_TM); const bf16* vt = (const bf16*)(P.ws + WS_VT);
    const bf16* Ks = tm + (((size_t)b * NTM + TM_B_KS + g) * S) * 128; const bf16* Kw = tm + (((size_t)b * NTM + TM_B_KW + g) * S) * 128;
    const bf16* Vs = vt + (((size_t)b * NVT + VT_B_VS + g) * 128) * S; const bf16* Vw = vt + (((size_t)b * NVT + VT_B_VW + g) * 128) * S;
    const size_t t = (size_t)b * S + i; const float* gates = (const float*)(P.ws + WS_GATES) + t * 18; const float* ocmp = (const float*)(P.ws + WS_OCMP) + t * 768;
    const int* sel = (const int*)(P.ws + WS_SEL) + (t * 2 + g) * 8;
    load_q_lds(tm + (((size_t)b * NTM + TM_B_Q + h) * S + i) * 128, qs, lane);
    const float* biascol = P.in[I_RELBIAS] + 6 + h;
    float s0, s1, w0, w1, lse, zi;
    naive_attend(qs, sc, 512, [&](int idx) { KeyRef kr; const int key = sel[idx >> 6] * 64 + (idx & 63); kr.krow = Ks + (size_t)key * 128; kr.vkey = key; kr.dist = i - key; kr.valid = key <= i; return kr; }, biascol, Vs, S, lane, s0, s1, lse, zi);
    WAVE_LDS_SYNC();
    naive_attend(qs, sc, min(511, i) + 1, [&](int idx) { KeyRef kr; const int j = i - idx; kr.krow = Kw + (size_t)j * 128; kr.vkey = j; kr.dist = idx; kr.valid = true; return kr; }, biascol, Vw, S, lane, w0, w1, lse, zi);
    WAVE_LDS_SYNC();
    const float g1 = gates[h * 3 + 1], g2 = gates[h * 3 + 2];
    const float r0 = ocmp[h * 128 + 2 * lane] + g1 * s0 + g2 * w0, r1 = ocmp[h * 128 + 2 * lane + 1] + g1 * s1 + g2 * w1;
    bf16* o = (bf16*)(P.ws + WS_ACT1);
    *(unsigned*)(o + t * D + (6 + h) * 128 + 2 * lane) = pk2(r0, r1);
    const float ssq = wave_sum(r0 * r0 + r1 * r1); if (lane == 0) ((float*)(P.ws + WS_SS))[t * 16 + 6 + h] = ssq;
}
__device__ __forceinline__ void attnC_item(const Params& P, int id, int lane, LAS float* qs, LAS float* sc) {
    const int i = id & 2047, h = (id >> 11) & 3, b = id >> 13;
    const bf16* tm = (const bf16*)(P.ws + WS_TM); const bf16* vt = (const bf16*)(P.ws + WS_VT);
    const bf16* K = tm + (((size_t)b * NTM + TM_C_K + h) * S) * 128; const bf16* V = vt + (((size_t)b * NVT + VT_C_V + h) * 128) * S;
    load_q_lds(tm + (((size_t)b * NTM + TM_C_Q + h) * S + i) * 128, qs, lane);
    const float* biascol = P.in[I_RELBIAS] + 12 + h;
    const int qblk = i >> 8, blk0 = qblk << 8;
    float a0, a1, lseo, zi;
    naive_attend(qs, sc, i - blk0 + 1, [&](int idx) { KeyRef kr; const int j = blk0 + idx; kr.krow = K + (size_t)j * 128; kr.vkey = j; kr.dist = i - j; kr.valid = true; return kr; }, biascol, V, S, lane, a0, a1, lseo, zi);
    WAVE_LDS_SYNC();
    const float* km = (const float*)(P.ws + WS_KMEAN) + (size_t)b * 8 * 4 * 128;
    float gv = NEG_INF;
    { float part[8];
#pragma unroll
      for (int n = 0; n < 8; ++n) part[n] = wave_sum(qs[2 * lane] * km[((size_t)n * 4 + h) * 128 + 2 * lane] + qs[2 * lane + 1] * km[((size_t)n * 4 + h) * 128 + 2 * lane + 1]);
#pragma unroll
      for (int n = 0; n < 8; ++n) if (lane == n && n < qblk) gv = part[n]; }
    int sb0, sb1, sb2;
    { float m = wave_max(gv); sb0 = wave_min_i((gv == m && lane < 8) ? lane : 1 << 30); if (lane == sb0) gv = __builtin_nanf("");
      m = wave_max(gv); sb1 = wave_min_i((gv == m && lane < 8) ? lane : 1 << 30); if (lane == sb1) gv = __builtin_nanf("");
      m = wave_max(gv); sb2 = wave_min_i((gv == m && lane < 8) ? lane : 1 << 30); }
    float b0, b1, lseg;
    naive_attend(qs, sc, 768, [&](int idx) { KeyRef kr; const int sb = idx < 256 ? sb0 : idx < 512 ? sb1 : sb2; const int key = sb * 256 + (idx & 255); kr.krow = K + (size_t)key * 128; kr.vkey = key; kr.dist = i - key; kr.valid = sb < qblk; return kr; }, biascol, V, S, lane, b0, b1, lseg, zi);
    WAVE_LDS_SYNC();
    float r0, r1;
    if (lseg == NEG_INF) { r0 = a0; r1 = a1; }
    else { const float m = fmaxf(lseo, lseg), wo = __expf(lseo - m), wg = __expf(lseg - m), wi = 1.0f / (wo + wg); r0 = (wo * a0 + wg * b0) * wi; r1 = (wo * a1 + wg * b1) * wi; }
    const size_t t = (size_t)b * S + i; bf16* o = (bf16*)(P.ws + WS_ACT1);
    *(unsigned*)(o + t * D + (12 + h) * 128 + 2 * lane) = pk2(r0, r1);
    const float ssq = wave_sum(r0 * r0 + r1 * r1); if (lane == 0) ((float*)(P.ws + WS_SS))[t * 16 + 12 + h] = ssq;
}
constexpr int NA_WAVE_F = 128 + 2048 + 32;
__device__ __forceinline__ void phase_attn_naive1(const Params& P, int bid, int nb, LAS unsigned char* lds) {
    const int tid_ = TID(); const int lane = tid_ & 63, wave = tid_ >> 6, gw = bid * 8 + wave, ngw = nb * 8;
    LAS float* qs = (LAS float*)lds + wave * NA_WAVE_F; LAS float* sc = qs + 128; LAS float* imp = sc + 2048;
    for (int id = gw; id < NB * 6 * S; id += ngw) attnA_item(P, id, lane, qs, sc);
    for (int id = gw; id < NB * 2 * S; id += ngw) attnB1_item(P, id, lane, qs, sc, imp);
    for (int id = gw; id < NB * 4 * S; id += ngw) attnC_item(P, id, lane, qs, sc);
}
__device__ __forceinline__ void phase_attn_naive2(const Params& P, int bid, int nb, LAS unsigned char* lds) {
    const int tid_ = TID(); const int lane = tid_ & 63, wave = tid_ >> 6, gw = bid * 8 + wave, ngw = nb * 8;
    LAS float* qs = (LAS float*)lds + wave * NA_WAVE_F; LAS float* sc = qs + 128;
    for (int id = gw; id < NB * 6 * S; id += ngw) attnB2_item(P, id, lane, qs, sc);
}

template <int NV>
__device__ __forceinline__ void wave_top16(float (&v)[NV], int idx0, int istep, int lane, float& outv, int& outi) {
    outv = 0.f; outi = 0;
    for (int k = 0; k < 16; ++k) {
        float bv = v[0]; int bi = idx0;
#pragma unroll
        for (int e = 1; e < NV; ++e) if (v[e] > bv) { bv = v[e]; bi = idx0 + e * istep; }
        const float m = wave_max(bv); const int mi = wave_min_i(bv == m ? bi : 1 << 30);
#pragma unroll
        for (int e = 0; e < NV; ++e) if (idx0 + e * istep == mi) v[e] = NEG_INF;
        if (lane == k) { outv = m; outi = mi; }
    }
}
__device__ __forceinline__ void peer_select_item(const Params& P, int l, int id, int lane, LAS float* qs) {
    const int h = id & 7; const size_t t = id >> 3;
    const bf16* q = (const bf16*)(P.ws + WS_ACT1) + t * D + h * 256;
#pragma unroll
    for (int j = 0; j < 4; ++j) qs[lane * 4 + j] = bf2f(q[lane * 4 + j]);
    WAVE_LDS_SYNC();
    float tv[2]; int ti[2];
#pragma unroll
    for (int c = 0; c < 2; ++c) {
        const float* keys = P.in[I_PEERKEYS] + ((((size_t)l * 8 + h) * 2 + c) * 128) * 128;
        float sc[2] = {0.f, 0.f};
        const float* k0p = keys + (size_t)lane * 128; const float* k1p = k0p + 64 * 128;
#pragma unroll 4
        for (int d = 0; d < 128; d += 4) { const f32x4 qq = *(const LAS f32x4*)(qs + c * 128 + d); const f32x4 k0 = *(const f32x4*)(k0p + d), k1 = *(const f32x4*)(k1p + d);
            sc[0] += qq.x * k0.x + qq.y * k0.y + qq.z * k0.z + qq.w * k0.w; sc[1] += qq.x * k1.x + qq.y * k1.y + qq.z * k1.z + qq.w * k1.w; }
        wave_top16<2>(sc, lane, 64, lane, tv[c], ti[c]);
    }
    float cv[4];
    const float s0 = lane_get(tv[0], lane >> 2);
#pragma unroll
    for (int e = 0; e < 4; ++e) cv[e] = s0 + lane_get(tv[1], (lane & 3) * 4 + e);
    float bs; int bj; wave_top16<4>(cv, lane * 4, 1, lane, bs, bj);
    const int ei = lane_get_i(ti[0], bj >> 4) * 128 + lane_get_i(ti[1], bj & 15);
    const float m = lane_get(bs, 0); float e = lane < 16 ? __expf(bs - m) : 0.f; const float z = wave_sum(e);
    if (lane < 16) { ((int*)(P.ws + WS_EXP))[t * 128 + h * 16 + lane] = ei; ((float*)(P.ws + WS_GW))[t * 128 + h * 16 + lane] = e / z; }
    WAVE_LDS_SYNC();
}
__device__ __forceinline__ void phase_peer_select_naive(const Params& P, int l, int bid, int nb, LAS unsigned char* lds) {
    const int tid_ = TID(); const int lane = tid_ & 63, wave = tid_ >> 6, gw = bid * 8 + wave, ngw = nb * 8;
    LAS float* qs = (LAS float*)lds + wave * 256;
    for (int id = gw; id < T * 8; id += ngw) peer_select_item(P, l, id, lane, qs);
}
__device__ __forceinline__ void unpack8(const v4u w, float (&f)[8]) { f[0] = bf2f(w.x & 0xffff); f[1] = bf2f(w.x >> 16); f[2] = bf2f(w.y & 0xffff); f[3] = bf2f(w.y >> 16); f[4] = bf2f(w.z & 0xffff); f[5] = bf2f(w.z >> 16); f[6] = bf2f(w.w & 0xffff); f[7] = bf2f(w.w >> 16); }

namespace fa {
typedef short bf16x8 __attribute__((ext_vector_type(8)));
typedef float f32x16 __attribute__((ext_vector_type(16)));
typedef __bf16 bf2_t __attribute__((ext_vector_type(2)));
typedef float f2_t __attribute__((ext_vector_type(2)));
#define FA_MFMA(a, b, c) __builtin_amdgcn_mfma_f32_32x32x16_bf16((a), (b), (c), 0, 0, 0)
constexpr float C1 = 0.08838834764831845f * 1.4426950408889634f;
constexpr float LOG2E = 1.4426950408889634f;
constexpr float DEAD = -2e30f, MINIT = -1e30f;
constexpr int KP = 272, VP = 136;
constexpr int STG = 64 * KP + 128 * VP;
constexpr int L_STG0 = 0, L_STG1 = STG, L_T1 = 2 * STG, TBL = 2304 * 4, L_T2 = L_T1 + TBL, L_X = L_T2 + TBL;
constexpr int L_KC = 0, KCP = 272, L_VC = 128 * KCP, VCP = 264;
static_assert(L_VC + 128 * VCP <= L_T1 && L_X + 3 * TBL <= 131072 - 256, "attention LDS map");
constexpr int L_CTL = 131072 - 256;
__device__ __forceinline__ unsigned cvt2(float lo, float hi) { f2_t v = {lo, hi}; return __builtin_bit_cast(unsigned, __builtin_convertvector(v, bf2_t)); }
__device__ __forceinline__ float xhalf(float v, int h) { float lo, hi; halves(v, lo, hi); return h ? lo : hi; }
__device__ __forceinline__ int xhalf_i(int v, int h) { int lo, hi; halves_i(v, lo, hi); return h ? lo : hi; }

__device__ __forceinline__ void copy_table(LAS float* T, const Params& P, int kind, int gh, int tid) {
    const GAS f32x4* src = (const GAS f32x4*)((const GAS float*)(P.ws + WS_TBL) + (size_t)(gh * 3 + kind) * 2304);
    for (int i = tid; i < 576; i += 512) *(LAS f32x4*)(T + 4 * i) = src[i];
}
struct Stream { const bf16* K; const bf16* Vt; const LAS float* T; int jlo, jhi; unsigned ormask; int shift; unsigned rowmask; int maxd; };
struct State { f32x16 o[4]; float m, l; };
__device__ __forceinline__ void state_init(State& s) {
#pragma unroll
    for (int mt = 0; mt < 4; ++mt)
#pragma unroll
        for (int i = 0; i < 16; ++i) s.o[mt][i] = 0.f;
    s.m = MINIT; s.l = 0.f;
}
__device__ __forceinline__ int next_active(int j, int jhi, unsigned ormask, int shift) { while (j <= jhi && !((ormask >> (j >> shift)) & 1u)) ++j; return j <= jhi ? j : -1; }
__device__ __forceinline__ void run_stream(const Stream& st, const bf16x8 (&bq)[8], State& S, int qpos, LAS unsigned char* lds, int tid) {
    const int lane = tid & 63, r = lane & 31, h = lane >> 5;
    int j = next_active(st.jlo, st.jhi, st.ormask, st.shift);
    if (j < 0) return;
    const GAS unsigned char* Kg = (const GAS unsigned char*)st.K; const GAS unsigned char* Vg = (const GAS unsigned char*)st.Vt;
    const int kc0 = tid, kc1 = tid + 512;
    const unsigned k_lds0 = (kc0 >> 4) * KP + (kc0 & 15) * 16, k_lds1 = (kc1 >> 4) * KP + (kc1 & 15) * 16;
    const unsigned v_lds0 = 64 * KP + (kc0 >> 3) * VP + (kc0 & 7) * 16, v_lds1 = 64 * KP + (kc1 >> 3) * VP + (kc1 & 7) * 16;
    const size_t v_g0 = (size_t)(kc0 >> 3) * (::S * 2) + (kc0 & 7) * 16, v_g1 = (size_t)(kc1 >> 3) * (::S * 2) + (kc1 & 7) * 16;
    v4u ka0, ka1, va0, va1, kb0, kb1, vb0, vb1;
#define FA_PREFETCH(kr0, kr1, vr0, vr1, jj) do { const size_t kb_ = (size_t)(jj) * (64 * 256); kr0 = *(const GAS v4u*)(Kg + kb_ + (size_t)kc0 * 16); kr1 = *(const GAS v4u*)(Kg + kb_ + (size_t)kc1 * 16); \
        const size_t vb_ = (size_t)(jj) * 128; vr0 = *(const GAS v4u*)(Vg + vb_ + v_g0); vr1 = *(const GAS v4u*)(Vg + vb_ + v_g1); } while (0)
#define FA_WRITE(kr0, kr1, vr0, vr1, stg) do { LAS unsigned char* sw = lds + (stg); *(LAS v4u*)(sw + k_lds0) = kr0; *(LAS v4u*)(sw + k_lds1) = kr1; \
        *(LAS v2u*)(sw + v_lds0) = (v2u){vr0.x, vr0.y}; *(LAS v2u*)(sw + v_lds0 + 8) = (v2u){vr0.z, vr0.w}; *(LAS v2u*)(sw + v_lds1) = (v2u){vr1.x, vr1.y}; *(LAS v2u*)(sw + v_lds1 + 8) = (v2u){vr1.z, vr1.w}; } while (0)
    auto compute = [&](const int j, const LAS unsigned char* sb, const bool force_dead) __attribute__((always_inline)) {
#if FA_STAGGER
        if (tid >= 256) __builtin_amdgcn_s_sleep(FA_STAGGER);
#endif
        const bool bit = ((st.rowmask >> (j >> st.shift)) & 1u) && !force_dead;
        const int bidx = bit ? (qpos - 64 * j + 256 - 4 * h - 59) : (4 - 4 * h);
        const LAS float* tp = st.T + bidx;
        const int wq_hi = qpos - r + 31, wq_lo = qpos - r;
#pragma unroll
        for (int kt = 0; kt < 2; ++kt) {
            if (64 * j + 32 * kt > wq_hi || 64 * j + 32 * kt + 31 < wq_lo - st.maxd) continue;
            f32x16 sc;
#pragma unroll
            for (int i = 0; i < 16; ++i) sc[i] = 0.f;
            { bf16x8 af[8];
#pragma unroll
              for (int ks = 0; ks < 8; ++ks) af[ks] = *(const LAS bf16x8*)(sb + (32 * kt + r) * KP + (16 * ks + 8 * h) * 2);
              __builtin_amdgcn_s_setprio(1);
#pragma unroll
              for (int ks = 0; ks < 8; ++ks) sc = FA_MFMA(af[ks], bq[ks], sc);
              __builtin_amdgcn_s_setprio(0); }
            float mloc = S.m;
#pragma unroll
            for (int i = 0; i < 16; ++i) { const float s = __builtin_fmaf(sc[i], C1, tp[59 - 32 * kt - 8 * (i >> 2) - (i & 3)]); sc[i] = s; mloc = fmaxf(mloc, s); }
            float mlo_, mhi_; halves(mloc, mlo_, mhi_); const float mnew = fmaxf(mlo_, mhi_);
            const float alpha = __builtin_amdgcn_exp2f(S.m - mnew);
            float lsum = 0.f;
#pragma unroll
            for (int i = 0; i < 16; ++i) { const float p = __builtin_amdgcn_exp2f(sc[i] - mnew); sc[i] = p; lsum += p; }
            S.l = S.l * alpha + lsum; S.m = mnew;
            if (__builtin_amdgcn_ballot_w64(alpha != 1.0f) != 0ull) {
#pragma unroll
                for (int mt = 0; mt < 4; ++mt)
#pragma unroll
                    for (int i = 0; i < 16; ++i) S.o[mt][i] *= alpha;
            }
#pragma unroll
            for (int s2 = 0; s2 < 2; ++s2) { const int sp = 2 * kt + s2, s8 = s2 * 8;
                v4u pw; pw.x = cvt2(sc[s8 + 0], sc[s8 + 1]); pw.y = cvt2(sc[s8 + 2], sc[s8 + 3]); pw.z = cvt2(sc[s8 + 4], sc[s8 + 5]); pw.w = cvt2(sc[s8 + 6], sc[s8 + 7]);
                const bf16x8 pb = __builtin_bit_cast(bf16x8, pw);
                bf16x8 vf[4];
#pragma unroll
                for (int mt = 0; mt < 4; ++mt) { const LAS unsigned char* vp = sb + 64 * KP + (32 * mt + r) * VP + (16 * sp + 4 * h) * 2;
                    const v2u lo = *(const LAS v2u*)vp, hi = *(const LAS v2u*)(vp + 16);
                    vf[mt] = __builtin_bit_cast(bf16x8, (v4u){lo.x, lo.y, hi.x, hi.y}); }
                __builtin_amdgcn_s_setprio(1);
#pragma unroll
                for (int mt = 0; mt < 4; ++mt) S.o[mt] = FA_MFMA(vf[mt], pb, S.o[mt]);
                __builtin_amdgcn_s_setprio(0); }
        }
    };
    int jc = j, jn = next_active(jc + 1, st.jhi, st.ormask, st.shift);
    FA_PREFETCH(ka0, ka1, va0, va1, jc); FA_WRITE(ka0, ka1, va0, va1, L_STG0);
    FA_PREFETCH(ka0, ka1, va0, va1, jn >= 0 ? jn : jc);
    __syncthreads();
    for (;;) {
        const int j2 = jn >= 0 ? next_active(jn + 1, st.jhi, st.ormask, st.shift) : -1;
        FA_PREFETCH(kb0, kb1, vb0, vb1, j2 >= 0 ? j2 : jc);
        compute(jc, lds + L_STG0, false);
        asm volatile("s_waitcnt vmcnt(4)" ::: "memory");
        FA_WRITE(ka0, ka1, va0, va1, L_STG1);
        asm volatile("s_waitcnt lgkmcnt(0)\n\ts_barrier" ::: "memory");
        if (jn < 0) break;
        const int j3 = j2 >= 0 ? next_active(j2 + 1, st.jhi, st.ormask, st.shift) : -1;
        FA_PREFETCH(ka0, ka1, va0, va1, j3 >= 0 ? j3 : jn);
        compute(jn, lds + L_STG1, false);
        asm volatile("s_waitcnt vmcnt(4)" ::: "memory");
        FA_WRITE(kb0, kb1, vb0, vb1, L_STG0);
        asm volatile("s_waitcnt lgkmcnt(0)\n\ts_barrier" ::: "memory");
        if (j2 < 0) break;
        jc = j2; jn = j3;
    }
    asm volatile("s_waitcnt vmcnt(0)" ::: "memory");
    __syncthreads();
#undef FA_PREFETCH
#undef FA_WRITE
}
__device__ __forceinline__ void load_q(const bf16* Qrow, bf16x8 (&bq)[8], int h) {
#pragma unroll
    for (int ks = 0; ks < 8; ++ks) bq[ks] = __builtin_bit_cast(bf16x8, *(const GAS v4u*)((const GAS bf16*)Qrow + 16 * ks + 8 * h));
}
__device__ __forceinline__ float finish(State& S, float wgt) { float llo_, lhi_; halves(S.l, llo_, lhi_); const float lt = llo_ + lhi_; const float inv = wgt / lt;
#pragma unroll
    for (int mt = 0; mt < 4; ++mt)
#pragma unroll
        for (int i = 0; i < 16; ++i) S.o[mt][i] *= inv;
    return inv; }
__device__ __forceinline__ void store_out(const State& S, bf16* o, float* ss, size_t t, int gh, int h) {
    float q = 0.f; GAS bf16* op = (GAS bf16*)o + t * D + gh * 128 + 4 * h;
#pragma unroll
    for (int mt = 0; mt < 4; ++mt)
#pragma unroll
        for (int g = 0; g < 4; ++g) { const float a = S.o[mt][4 * g], b = S.o[mt][4 * g + 1], c = S.o[mt][4 * g + 2], d = S.o[mt][4 * g + 3];
            q += a * a + b * b + c * c + d * d; *(GAS v2u*)(op + 32 * mt + 8 * g) = (v2u){cvt2(a, b), cvt2(c, d)}; }
    { float qlo_, qhi_; halves(q, qlo_, qhi_); q = qlo_ + qhi_; } if (h == 0) ss[t * 16 + gh] = q;
}
__device__ __forceinline__ void decode_unit(int u, int& b, int& gh, int& qt) {
    int isb, w;
    if (u < 240) { isb = 1; qt = 7 - u / 48; w = u % 48; }
    else if (u < 320) { isb = 0; qt = 7; w = u - 240; }
    else if (u < 368) { isb = 1; qt = 2; w = u - 320; }
    else if (u < 528) { isb = 0; qt = 6 - (u - 368) / 80; w = (u - 368) % 80; }
    else if (u < 576) { isb = 1; qt = 1; w = u - 528; }
    else if (u < 736) { isb = 0; qt = 4 - (u - 576) / 80; w = (u - 576) % 80; }
    else if (u < 784) { isb = 1; qt = 0; w = u - 736; }
    else { isb = 0; qt = 2 - (u - 784) / 80; w = (u - 784) % 80; }
    b = w & 7; const int hh = w >> 3;
    if (isb) gh = 6 + hh; else gh = hh < 6 ? hh : 12 + (hh - 6);
}

__device__ __forceinline__ void attn_unit(const Params& P, int u, LAS unsigned char* lds) {
    const int tid = TID();
    const int lane = tid & 63, wave = tid >> 6, r = lane & 31, h = lane >> 5;
    int b, gh, qt; decode_unit(u, b, gh, qt);
    const int q0 = qt * 256, qpos = q0 + 32 * wave + r; const size_t t = (size_t)b * S + qpos;
    const bf16* tm = (const bf16*)(P.ws + WS_TM); const bf16* vt = (const bf16*)(P.ws + WS_VT);
    bf16* o = (bf16*)(P.ws + WS_ACT1); float* ss = (float*)(P.ws + WS_SS);
    volatile LAS unsigned* ctl = (volatile LAS unsigned*)(lds + L_CTL);
    LAS float* T1 = (LAS float*)(lds + L_T1); LAS float* T2 = (LAS float*)(lds + L_T2);
    bf16x8 bq[8]; State St;
    if (gh < 6) {
        copy_table(T1, P, 2, gh, tid);
        load_q(tm + (((size_t)b * NTM + TM_A_Q + gh) * S + qpos) * 128, bq, h);
        __syncthreads();
        state_init(St);
        Stream s{tm + ((size_t)b * NTM + TM_A_K + gh) * S * 128, vt + ((size_t)b * NVT + VT_A_V + gh) * 128 * S, T1, 0, 4 * qt + 3, 0xffffffffu, 0, 0xffffffffu, 4096};
        run_stream(s, bq, St, qpos, lds, tid);
        finish(St, 1.0f); store_out(St, o, ss, t, gh, h);
    } else if (gh >= 12) {
        const int hc = gh - 12;
        copy_table(T1, P, 0, gh, tid);
        LAS float* km = (LAS float*)(lds + L_X);
        { const float* kmg = (const float*)(P.ws + WS_KMEAN) + (size_t)b * 8 * 4 * 128;
          for (int i = tid; i < qt * 128; i += 512) km[i] = kmg[((size_t)(i >> 7) * 4 + hc) * 128 + (i & 127)]; }
        load_q(tm + (((size_t)b * NTM + TM_C_Q + hc) * S + qpos) * 128, bq, h);
        if (tid == 0) ctl[1] = 0u;
        __syncthreads();
        float gate[8];
#pragma unroll
        for (int n = 0; n < 8; ++n) gate[n] = 0.f;
#pragma unroll
        for (int ks = 0; ks < 8; ++ks) { const v4u w = __builtin_bit_cast(v4u, bq[ks]); float f[8]; unpack8(w, f);
#pragma unroll
            for (int n = 0; n < 8; ++n) if (n < qt) { const f32x4 k0 = *(const LAS f32x4*)(km + n * 128 + 16 * ks + 8 * h), k1 = *(const LAS f32x4*)(km + n * 128 + 16 * ks + 8 * h + 4);
                gate[n] += f[0] * k0.x + f[1] * k0.y + f[2] * k0.z + f[3] * k0.w + f[4] * k1.x + f[5] * k1.y + f[6] * k1.z + f[7] * k1.w; } }
        unsigned rowmask = 1u << qt;
#pragma unroll
        for (int n = 0; n < 8; ++n) { float glo_, ghi_; halves(gate[n], glo_, ghi_); gate[n] = glo_ + ghi_; if (n >= qt) gate[n] = NEG_INF; }
#pragma unroll
        for (int k = 0; k < 3; ++k) { float bv = NEG_INF; int bi = -1;
#pragma unroll
            for (int n = 0; n < 8; ++n) if (gate[n] > bv) { bv = gate[n]; bi = n; }
#pragma unroll
            for (int n = 0; n < 8; ++n) if (n == bi) { gate[n] = NEG_INF; rowmask |= 1u << n; } }
        { const unsigned om = wave_or(rowmask); if (lane == 0) atomicOr((unsigned*)(ctl + 1), om); }
        __syncthreads();
        const unsigned ormask = ctl[1];
        state_init(St);
        Stream s{tm + ((size_t)b * NTM + TM_C_K + hc) * S * 128, vt + ((size_t)b * NVT + VT_C_V + hc) * 128 * S, T1, 0, 4 * qt + 3, ormask, 2, rowmask, 4096};
        run_stream(s, bq, St, qpos, lds, tid);
        finish(St, 1.0f); store_out(St, o, ss, t, gh, h);
    } else {
        const int hb = gh - 6, g = hb / 3;
        const float* gates = (const float*)(P.ws + WS_GATES) + t * 18 + hb * 3; const float g0 = gates[0], g1 = gates[1], g2 = gates[2];
        GAS float* oacc = (GAS float*)(P.ws + WS_OCMP) + t * 768 + hb * 128 + 4 * h;
        { const GAS unsigned char* kcg = (const GAS unsigned char*)((const bf16*)(P.ws + WS_KCMP) + ((size_t)b * 2 + g) * 128 * 128); const GAS unsigned char* vcg = (const GAS unsigned char*)((const bf16*)(P.ws + WS_VCMPT) + ((size_t)b * 2 + g) * 128 * 128);
#pragma unroll
          for (int c = tid; c < 2048; c += 512) { const v4u kv = *(const GAS v4u*)(kcg + (size_t)c * 16); *(LAS v4u*)(lds + L_KC + (c >> 4) * KCP + (c & 15) * 16) = kv;
              const v4u vv = *(const GAS v4u*)(vcg + (size_t)c * 16); LAS unsigned char* vd = lds + L_VC + (c >> 4) * VCP + (c & 15) * 16; *(LAS v2u*)vd = (v2u){vv.x, vv.y}; *(LAS v2u*)(vd + 8) = (v2u){vv.z, vv.w}; } }
#pragma unroll
        for (int rr = 0; rr < 3; ++rr) copy_table((LAS float*)(lds + L_X + rr * TBL), P, 0, 6 + g * 3 + rr, tid);
        copy_table(T1, P, 0, gh, tid); copy_table(T2, P, 1, gh, tid);
        if (tid == 0) ctl[1] = 0u;
        __syncthreads();
        float imp[16];
#pragma unroll
        for (int a = 0; a < 16; ++a) imp[a] = 0.f;
        f32x16 sc[4];
#pragma unroll 1
        for (int rq = 0; rq < 3; ++rq) { int rr = hb - g * 3 + 1 + rq; rr = rr >= 3 ? rr - 3 : rr; const int hh = g * 3 + rr;
            asm volatile("" ::: "memory");
            load_q(tm + (((size_t)b * NTM + TM_B_Q + hh) * S + qpos) * 128, bq, h);
            const LAS float* Tc = (const LAS float*)(lds + L_X + rr * TBL);
#pragma unroll
            for (int kt = 0; kt < 4; ++kt) {
#pragma unroll
                for (int i = 0; i < 16; ++i) sc[kt][i] = 0.f;
#pragma unroll
                for (int ks = 0; ks < 8; ++ks) { const bf16x8 a = *(const LAS bf16x8*)(lds + L_KC + (32 * kt + r) * KCP + (16 * ks + 8 * h) * 2); sc[kt] = FA_MFMA(a, bq[ks], sc[kt]); } }
            float mloc = MINIT;
#pragma unroll
            for (int kt = 0; kt < 4; ++kt)
#pragma unroll
                for (int i = 0; i < 16; ++i) { const int n = 32 * kt + 8 * (i >> 2) + 4 * h + (i & 3); int idx = qpos - 16 * n - 31 + 256; idx = idx < 0 ? 0 : idx;
                    const float s = __builtin_fmaf(sc[kt][i], C1, Tc[idx]); sc[kt][i] = s; mloc = fmaxf(mloc, s); }
            float mlo_, mhi_; halves(mloc, mlo_, mhi_); const float mrow = fmaxf(mlo_, mhi_); float lsum = 0.f;
#pragma unroll
            for (int kt = 0; kt < 4; ++kt)
#pragma unroll
                for (int i = 0; i < 16; ++i) { const float p = __builtin_amdgcn_exp2f(sc[kt][i] - mrow); sc[kt][i] = p; lsum += p; }
            { float slo_, shi_; halves(lsum, slo_, shi_); lsum = slo_ + shi_; } const float inv = lsum > 0.f ? 1.0f / lsum : 0.f;
#pragma unroll
            for (int a = 0; a < 16; ++a) { const int kt = a >> 2, i0 = (a & 3) * 4;
                const float p0 = sc[kt][i0] * inv, p1 = sc[kt][i0 + 1] * inv, p2 = sc[kt][i0 + 2] * inv, p3 = sc[kt][i0 + 3] * inv;
                sc[kt][i0] = p0; sc[kt][i0 + 1] = p1; sc[kt][i0 + 2] = p2; sc[kt][i0 + 3] = p3;
                imp[a] += (p0 + p1) + (p2 + p3); }
            { float prev = 0.f;
#pragma unroll
              for (int a = 0; a < 16; ++a) { const float lv = xhalf(sc[a >> 2][(a & 3) * 4 + 3], h); imp[a] += h ? lv : prev; prev = lv; } }
        }
        state_init(St);
#pragma unroll
        for (int sp = 0; sp < 8; ++sp) { const int kt = sp >> 1, s8 = (sp & 1) * 8;
            v4u pw; pw.x = cvt2(sc[kt][s8 + 0], sc[kt][s8 + 1]); pw.y = cvt2(sc[kt][s8 + 2], sc[kt][s8 + 3]); pw.z = cvt2(sc[kt][s8 + 4], sc[kt][s8 + 5]); pw.w = cvt2(sc[kt][s8 + 6], sc[kt][s8 + 7]);
            const bf16x8 pb = __builtin_bit_cast(bf16x8, pw);
#pragma unroll
            for (int mt = 0; mt < 4; ++mt) { const LAS unsigned char* vp = lds + L_VC + (32 * mt + r) * VCP + (16 * sp + 4 * h) * 2;
                const v2u lo = *(const LAS v2u*)vp, hi = *(const LAS v2u*)(vp + 16);
                St.o[mt] = FA_MFMA(__builtin_bit_cast(bf16x8, (v4u){lo.x, lo.y, hi.x, hi.y}), pb, St.o[mt]); } }
#pragma unroll
        for (int mt = 0; mt < 4; ++mt)
#pragma unroll
            for (int gq = 0; gq < 4; ++gq) *(GAS f32x4*)(oacc + 32 * mt + 8 * gq) = (f32x4){St.o[mt][4 * gq] * g0, St.o[mt][4 * gq + 1] * g0, St.o[mt][4 * gq + 2] * g0, St.o[mt][4 * gq + 3] * g0};
        const int qblk = qpos >> 6;
        unsigned selmask;
        if (qblk <= 7) selmask = (2u << qblk) - 1u;
        else { selmask = 1u | (3u << (qblk - 1));
#pragma unroll
            for (int a = 0; a < 16; ++a) { const int jb = 2 * a + h; if (jb == 0 || jb >= qblk - 1) imp[a] = NEG_INF; }
#pragma unroll 1
            for (int k = 0; k < 5; ++k) { float bv = NEG_INF; int bj = 1 << 20;
#pragma unroll
                for (int a = 0; a < 16; ++a) if (imp[a] > bv) { bv = imp[a]; bj = 2 * a + h; }
                const float ov = xhalf(bv, h); const int oj = xhalf_i(bj, h);
                const bool mine = (bv > ov) || (bv == ov && bj < oj);
                const int wj = mine ? bj : oj;
                if (wj < 32) { selmask |= 1u << wj;
#pragma unroll
                    for (int a = 0; a < 16; ++a) if (2 * a + h == wj) imp[a] = NEG_INF; } } }
        { const unsigned om = wave_or(selmask); if (lane == 0) atomicOr((unsigned*)(ctl + 1), om); }
        load_q(tm + (((size_t)b * NTM + TM_B_Q + hb) * S + qpos) * 128, bq, h);
        __syncthreads();
        const unsigned ormask = ctl[1];
        state_init(St);
        { Stream s{tm + ((size_t)b * NTM + TM_B_KS + g) * S * 128, vt + ((size_t)b * NVT + VT_B_VS + g) * 128 * S, T1, 0, 4 * qt + 3, ormask, 0, selmask, 4096};
          run_stream(s, bq, St, qpos, lds, tid); }
        finish(St, g1);
#pragma unroll
        for (int mt = 0; mt < 4; ++mt)
#pragma unroll
            for (int gq = 0; gq < 4; ++gq) { const f32x4 pv = *(const GAS f32x4*)(oacc + 32 * mt + 8 * gq);
                *(GAS f32x4*)(oacc + 32 * mt + 8 * gq) = (f32x4){pv.x + St.o[mt][4 * gq], pv.y + St.o[mt][4 * gq + 1], pv.z + St.o[mt][4 * gq + 2], pv.w + St.o[mt][4 * gq + 3]}; }
        state_init(St);
        { const int jlo = q0 >= 512 ? (q0 - 512) / 64 : 0;
          Stream s{tm + ((size_t)b * NTM + TM_B_KW + g) * S * 128, vt + ((size_t)b * NVT + VT_B_VW + g) * 128 * S, T2, jlo, 4 * qt + 3, 0xffffffffu, 0, 0xffffffffu, 511};
          run_stream(s, bq, St, qpos, lds, tid); }
        finish(St, g2);
#pragma unroll
        for (int mt = 0; mt < 4; ++mt)
#pragma unroll
            for (int gq = 0; gq < 4; ++gq) { const f32x4 pv = *(const GAS f32x4*)(oacc + 32 * mt + 8 * gq);
                St.o[mt][4 * gq] += pv.x; St.o[mt][4 * gq + 1] += pv.y; St.o[mt][4 * gq + 2] += pv.z; St.o[mt][4 * gq + 3] += pv.w; }
        store_out(St, o, ss, t, gh, h);
    }
}
__device__ __forceinline__ void phase_attn(const Params& P, int l, LAS unsigned char* lds) {
    const int tid = TID();
    volatile LAS unsigned* ctl = (volatile LAS unsigned*)(lds + L_CTL);
    unsigned* qctr = (unsigned*)(P.ws + WS_CTL) + 8192 + 64 * l;
    for (;;) {
        __syncthreads();
        if (tid == 0) ctl[0] = __hip_atomic_fetch_add(qctr, 1u, __ATOMIC_RELAXED, __HIP_MEMORY_SCOPE_AGENT);
        __syncthreads();
        const unsigned u = ctl[0];
        if (u >= 1024u) break;
        attn_unit(P, (int)u, lds);
    }
}
#undef FA_MFMA
}

namespace pf {
typedef short bf16x8 __attribute__((ext_vector_type(8)));
typedef float f32x16 __attribute__((ext_vector_type(16)));
__device__ __forceinline__ void cmp_unit(const Params& P, int l, int u, LAS unsigned char* lds) {
    const int tid = TID(), lane = tid & 63, wave = tid >> 6, r = lane & 31, h = lane >> 5;
    const int which = u >> 7, bg = (u >> 3) & 15, b = bg >> 1, g = bg & 1, n0 = ((u >> 1) & 3) * 32, e0 = (u & 1) * 64;
    const GAS bf16* A = (const GAS bf16*)(P.ws + WS_TM) + (((size_t)b * NTM + (which ? TM_B_VC : TM_B_KC) + g) * S + 16 * (n0 + r)) * 128 + 512 * wave + 8 * h;
    const GAS bf16* Bt = (const GAS bf16*)(P.ws + WS_CWT) + (((size_t)l * 2 + which) * 128 + e0 + r) * 4096 + 512 * wave + 8 * h;
    float pw = 0.f;
    if (tid < 64) { const GAS float* pp = (const GAS float*)(P.ws + WS_POSW) + ((size_t)l * 2 + which) * 32 * 128 + e0 + tid;
#pragma unroll
        for (int kc = 0; kc < 32; ++kc) pw += pp[kc * 128]; }
    f32x16 acc[2];
#pragma unroll
    for (int ct = 0; ct < 2; ++ct)
#pragma unroll
        for (int i = 0; i < 16; ++i) acc[ct][i] = 0.f;
#pragma unroll 8
    for (int ks = 0; ks < 32; ++ks) {
        const bf16x8 a = __builtin_bit_cast(bf16x8, *(const GAS v4u*)(A + 16 * ks));
#pragma unroll
        for (int ct = 0; ct < 2; ++ct) { const bf16x8 bb = __builtin_bit_cast(bf16x8, *(const GAS v4u*)(Bt + (size_t)ct * 32 * 4096 + 16 * ks)); acc[ct] = __builtin_amdgcn_mfma_f32_32x32x16_bf16(a, bb, acc[ct], 0, 0, 0); }
    }
    LAS float* red = (LAS float*)lds; LAS float* pwl = red + 8 * 2048;
#pragma unroll
    for (int ct = 0; ct < 2; ++ct)
#pragma unroll
        for (int i = 0; i < 16; ++i) red[((wave * 2 + ct) * 16 + i) * 64 + lane] = acc[ct][i];
    if (tid < 64) pwl[tid] = pw;
    __syncthreads();
#pragma unroll
    for (int j = 0; j < 4; ++j) { const int o = tid + 512 * j; float v = 0.f;
#pragma unroll
        for (int w = 0; w < 8; ++w) v += red[w * 2048 + o];
        const int ln = o & 63, i = (o >> 6) & 15, ct = o >> 10; const int n = n0 + (i & 3) + 8 * (i >> 2) + 4 * (ln >> 5), e = e0 + 32 * ct + (ln & 31);
        v += pwl[32 * ct + (ln & 31)];
        if (n == 127) v = 0.f;
        if (which == 0) ((GAS bf16*)(P.ws + WS_KCMP))[(((size_t)b * 2 + g) * 128 + n) * 128 + e] = (bf16)f2bf(v);
        else ((GAS bf16*)(P.ws + WS_VCMPT))[(((size_t)b * 2 + g) * 128 + e) * 128 + n] = (bf16)f2bf(v); }
    __syncthreads();
}
__device__ __forceinline__ void kmean_load(const Params& P, int u, unsigned (&w)[32]) {
    const int tid = TID(), dp = tid & 63, part = tid >> 6; const int hc = u & 3, blk = (u >> 2) & 7, b = u >> 5;
    const GAS bf16* k = (const GAS bf16*)(P.ws + WS_TM) + (((size_t)b * NTM + TM_C_K + hc) * S + blk * 256 + part * 32) * 128 + 2 * dp;
#pragma unroll
    for (int j = 0; j < 32; ++j) w[j] = *(const GAS unsigned*)(k + (size_t)j * 128);
}
__device__ __forceinline__ void kmean_finish(const Params& P, int u, const unsigned (&w)[32], LAS unsigned char* lds) {
    const int tid = TID(), dp = tid & 63, part = tid >> 6; const int hc = u & 3, blk = (u >> 2) & 7, b = u >> 5;
    float s0 = 0.f, s1 = 0.f;
#pragma unroll
    for (int j = 0; j < 32; ++j) { s0 += bf2f(w[j] & 0xffff); s1 += bf2f(w[j] >> 16); }
    LAS float* red = (LAS float*)lds; red[part * 128 + 2 * dp] = s0; red[part * 128 + 2 * dp + 1] = s1;
    __syncthreads();
    if (tid < 128) { float v = 0.f;
#pragma unroll
        for (int p = 0; p < 8; ++p) v += red[p * 128 + tid];
        ((GAS float*)(P.ws + WS_KMEAN))[(((size_t)b * 8 + blk) * 4 + hc) * 128 + tid] = v * (1.0f / 256.f); }
    __syncthreads();
}
__device__ __forceinline__ void phase_prep(const Params& P, int l, int bid, int nb, LAS unsigned char* lds) {
    for (int u = bid; u < 256; u += nb) { unsigned w[32]; kmean_load(P, u, w); cmp_unit(P, l, u, lds); kmean_finish(P, u, w, lds); }
}
}

typedef __bf16 bf2_t __attribute__((ext_vector_type(2)));
__device__ __forceinline__ float dot2bf(unsigned a, unsigned b, float c) { return __builtin_amdgcn_fdot2_f32_bf16(__builtin_bit_cast(bf2_t, a), __builtin_bit_cast(bf2_t, b), c, false); }

namespace ps {
typedef short bf16x8 __attribute__((ext_vector_type(8)));
typedef float f32x16 __attribute__((ext_vector_type(16)));
#define PS_CE(a, b) do { const float hi_ = fmaxf((a), (b)), lo_ = fminf((a), (b)); (a) = hi_; (b) = lo_; } while (0)
__device__ __forceinline__ void sort16(float (&v)[16]) {
#pragma unroll
    for (int k = 2; k <= 16; k <<= 1)
#pragma unroll
        for (int j = k >> 1; j > 0; j >>= 1)
#pragma unroll
            for (int i = 0; i < 16; ++i) { const int p = i ^ j; if (p > i) { if ((i & k) == 0) PS_CE(v[i], v[p]); else PS_CE(v[p], v[i]); } }
}
__device__ __forceinline__ void merge16(float (&a)[16], const float (&b)[16]) {
#pragma unroll
    for (int i = 0; i < 16; ++i) a[i] = fmaxf(a[i], b[15 - i]);
#pragma unroll
    for (int j = 8; j > 0; j >>= 1)
#pragma unroll
        for (int i = 0; i < 16; ++i) { const int p = i ^ j; if (p > i) PS_CE(a[i], a[p]); }
}
__device__ __forceinline__ float pack_low(float v, unsigned mask, unsigned tag) { return __uint_as_float((__float_as_uint(v) & ~mask) | tag); }
constexpr int SKP = 272;
__device__ __forceinline__ void load_q8(const GAS bf16* qrow, int h2, bf16x8 (&bq)[8]) {
#pragma unroll
    for (int ks = 0; ks < 8; ++ks) bq[ks] = __builtin_bit_cast(bf16x8, *(const GAS v4u*)(qrow + 16 * ks + 8 * h2));
}
__device__ __forceinline__ void top16_half(const LAS unsigned char* keys, const bf16x8 (&bq)[8], int r, int h2, float (&top)[16]) {
    float grp[4][16];
#pragma unroll
    for (int kt = 0; kt < 4; ++kt) { f32x16 sc;
#pragma unroll
        for (int i = 0; i < 16; ++i) sc[i] = 0.f;
#pragma unroll
        for (int ks = 0; ks < 8; ++ks) { const bf16x8 a = *(const LAS bf16x8*)(keys + (32 * kt + r) * SKP + (16 * ks + 8 * h2) * 2); sc = __builtin_amdgcn_mfma_f32_32x32x16_bf16(a, bq[ks], sc, 0, 0, 0); }
#pragma unroll
        for (int i = 0; i < 16; ++i) { const int key = 32 * kt + (i & 3) + 8 * (i >> 2); grp[kt][i] = pack_low(sc[i], 0x7Fu, (unsigned)(127 - key) - 4u * (unsigned)h2); } }
    sort16(grp[0]); sort16(grp[1]); sort16(grp[2]); sort16(grp[3]);
    merge16(grp[0], grp[1]); merge16(grp[2], grp[3]); merge16(grp[0], grp[2]);
    float oth[16];
#pragma unroll
    for (int i = 0; i < 16; ++i) oth[i] = fa::xhalf(grp[0][i], h2);
    merge16(grp[0], oth);
#pragma unroll
    for (int i = 0; i < 16; ++i) top[i] = grp[0][i];
}
__device__ __forceinline__ void select_unit(const Params& P, int l, int u, LAS unsigned char* lds, bool stage) {
    const int tid = TID(), lane = tid & 63, wave = tid >> 6, r = lane & 31, h2 = lane >> 5;
    const int head = u & 7; const size_t t = (size_t)(u >> 3) * 256 + wave * 32 + r;
    const GAS bf16* q = (const GAS bf16*)(P.ws + WS_ACT1) + t * D + head * 256;
    bf16x8 bq0[8], bq1[8]; load_q8(q, h2, bq0); load_q8(q + 128, h2, bq1);
    if (stage) { const GAS v4u* kg = (const GAS v4u*)((const GAS bf16*)(P.ws + WS_KEYS) + (((size_t)l * 8 + head) * 2) * 128 * 128);
      v4u kv[8];
#pragma unroll
      for (int i = 0; i < 8; ++i) kv[i] = kg[tid + 512 * i];
#pragma unroll
      for (int i = 0; i < 8; ++i) { const int pc = tid + 512 * i; *(LAS v4u*)(lds + (pc >> 4) * SKP + (pc & 15) * 16) = kv[i]; } }
    __syncthreads();
    float ts0[16], ts1[16];
    top16_half(lds, bq0, r, h2, ts0);
    top16_half(lds + 128 * SKP, bq1, r, h2, ts1);
    LAS int* til = (LAS int*)(lds + 256 * SKP) + (wave * 32 + r) * 32;
#pragma unroll
    for (int k = 0; k < 16; ++k) { float va = ts0[k], vb = ts1[k]; asm volatile("" : "+v"(va), "+v"(vb)); const float v = h2 ? vb : va; til[h2 * 16 + k] = 127 - (int)(__float_as_uint(v) & 0x7Fu); }
    float cg[4][16];
    cg[0][0] = pack_low(ts0[0] + ts1[0], 0xFFu, 255u);
    cg[0][1] = pack_low(ts0[0] + ts1[1], 0xFFu, 254u);
    cg[0][2] = pack_low(ts0[0] + ts1[2], 0xFFu, 253u);
    cg[0][3] = pack_low(ts0[0] + ts1[3], 0xFFu, 252u);
    cg[0][4] = pack_low(ts0[0] + ts1[4], 0xFFu, 251u);
    cg[0][5] = pack_low(ts0[0] + ts1[5], 0xFFu, 250u);
    cg[0][6] = pack_low(ts0[0] + ts1[6], 0xFFu, 249u);
    cg[0][7] = pack_low(ts0[0] + ts1[7], 0xFFu, 248u);
    cg[0][8] = pack_low(ts0[0] + ts1[8], 0xFFu, 247u);
    cg[0][9] = pack_low(ts0[0] + ts1[9], 0xFFu, 246u);
    cg[0][10] = pack_low(ts0[0] + ts1[10], 0xFFu, 245u);
    cg[0][11] = pack_low(ts0[0] + ts1[11], 0xFFu, 244u);
    cg[0][12] = pack_low(ts0[0] + ts1[12], 0xFFu, 243u);
    cg[0][13] = pack_low(ts0[0] + ts1[13], 0xFFu, 242u);
    cg[0][14] = pack_low(ts0[0] + ts1[14], 0xFFu, 241u);
    cg[0][15] = pack_low(ts0[0] + ts1[15], 0xFFu, 240u);
    cg[1][0] = pack_low(ts0[1] + ts1[0], 0xFFu, 239u);
    cg[1][1] = pack_low(ts0[1] + ts1[1], 0xFFu, 238u);
    cg[1][2] = pack_low(ts0[1] + ts1[2], 0xFFu, 237u);
    cg[1][3] = pack_low(ts0[1] + ts1[3], 0xFFu, 236u);
    cg[1][4] = pack_low(ts0[1] + ts1[4], 0xFFu, 235u);
    cg[1][5] = pack_low(ts0[1] + ts1[5], 0xFFu, 234u);
    cg[1][6] = pack_low(ts0[1] + ts1[6], 0xFFu, 233u);
    cg[1][7] = pack_low(ts0[1] + ts1[7], 0xFFu, 232u);
    cg[1][8] = pack_low(ts0[2] + ts1[0], 0xFFu, 223u);
    cg[1][9] = pack_low(ts0[2] + ts1[1], 0xFFu, 222u);
    cg[1][10] = pack_low(ts0[2] + ts1[2], 0xFFu, 221u);
    cg[1][11] = pack_low(ts0[2] + ts1[3], 0xFFu, 220u);
    cg[1][12] = pack_low(ts0[2] + ts1[4], 0xFFu, 219u);
    cg[1][13] = pack_low(ts0[3] + ts1[0], 0xFFu, 207u);
    cg[1][14] = pack_low(ts0[3] + ts1[1], 0xFFu, 206u);
    cg[1][15] = pack_low(ts0[3] + ts1[2], 0xFFu, 205u);
    cg[2][0] = pack_low(ts0[3] + ts1[3], 0xFFu, 204u);
    cg[2][1] = pack_low(ts0[4] + ts1[0], 0xFFu, 191u);
    cg[2][2] = pack_low(ts0[4] + ts1[1], 0xFFu, 190u);
    cg[2][3] = pack_low(ts0[4] + ts1[2], 0xFFu, 189u);
    cg[2][4] = pack_low(ts0[5] + ts1[0], 0xFFu, 175u);
    cg[2][5] = pack_low(ts0[5] + ts1[1], 0xFFu, 174u);
    cg[2][6] = pack_low(ts0[6] + ts1[0], 0xFFu, 159u);
    cg[2][7] = pack_low(ts0[6] + ts1[1], 0xFFu, 158u);
    cg[2][8] = pack_low(ts0[7] + ts1[0], 0xFFu, 143u);
    cg[2][9] = pack_low(ts0[7] + ts1[1], 0xFFu, 142u);
    cg[2][10] = pack_low(ts0[8] + ts1[0], 0xFFu, 127u);
    cg[2][11] = pack_low(ts0[9] + ts1[0], 0xFFu, 111u);
    cg[2][12] = pack_low(ts0[10] + ts1[0], 0xFFu, 95u);
    cg[2][13] = pack_low(ts0[11] + ts1[0], 0xFFu, 79u);
    cg[2][14] = pack_low(ts0[12] + ts1[0], 0xFFu, 63u);
    cg[2][15] = pack_low(ts0[13] + ts1[0], 0xFFu, 47u);
    cg[3][0] = pack_low(ts0[14] + ts1[0], 0xFFu, 31u);
    cg[3][1] = pack_low(ts0[15] + ts1[0], 0xFFu, 15u);
    cg[3][2] = NEG_INF;
    cg[3][3] = NEG_INF;
    cg[3][4] = NEG_INF;
    cg[3][5] = NEG_INF;
    cg[3][6] = NEG_INF;
    cg[3][7] = NEG_INF;
    cg[3][8] = NEG_INF;
    cg[3][9] = NEG_INF;
    cg[3][10] = NEG_INF;
    cg[3][11] = NEG_INF;
    cg[3][12] = NEG_INF;
    cg[3][13] = NEG_INF;
    cg[3][14] = NEG_INF;
    cg[3][15] = NEG_INF;
    sort16(cg[0]); sort16(cg[1]); sort16(cg[2]); sort16(cg[3]);
    merge16(cg[0], cg[1]); merge16(cg[2], cg[3]); merge16(cg[0], cg[2]);
    WAVE_LDS_SYNC();
    const float m = cg[0][0]; float z = 0.f; float ev[16];
#pragma unroll
    for (int k = 0; k < 16; ++k) { ev[k] = __expf(cg[0][k] - m); z += ev[k]; }
    const float zi = 1.0f / z;
    int eo[8]; float go[8];
#pragma unroll
    for (int k = 0; k < 8; ++k) { float wa = cg[0][k], wb = cg[0][8 + k], ea = ev[k], eb = ev[8 + k]; asm volatile("" : "+v"(wa), "+v"(wb), "+v"(ea), "+v"(eb));
        const float w = h2 ? wb : wa; const int flat = 255 - (int)(__float_as_uint(w) & 0xFFu);
        eo[k] = til[flat >> 4] * 128 + til[16 + (flat & 15)]; go[k] = (h2 ? eb : ea) * zi; }
    GAS int* ex = (GAS int*)(P.ws + WS_EXP) + t * 128 + head * 16 + 8 * h2; GAS float* gw = (GAS float*)(P.ws + WS_GW) + t * 128 + head * 16 + 8 * h2;
    typedef int i32x4 __attribute__((ext_vector_type(4)));
    *(GAS i32x4*)ex = (i32x4){eo[0], eo[1], eo[2], eo[3]}; *(GAS i32x4*)(ex + 4) = (i32x4){eo[4], eo[5], eo[6], eo[7]};
    *(GAS f32x4*)gw = (f32x4){go[0], go[1], go[2], go[3]}; *(GAS f32x4*)(gw + 4) = (f32x4){go[4], go[5], go[6], go[7]};
    WAVE_LDS_SYNC();
}
__device__ __forceinline__ void phase_select(const Params& P, int l, int bid, int nb, LAS unsigned char* lds) {
    int staged = -1;
    for (int u = bid; u < T / 32; u += nb) { const bool stage = (u & 7) != staged; if (stage) __syncthreads(); select_unit(P, l, u, lds, stage); staged = u & 7; }
    __syncthreads();
}
#undef PS_CE
}


typedef float f2v_t __attribute__((ext_vector_type(2)));
__device__ __forceinline__ void fp8x4_to_f32(unsigned w, float& a, float& b, float& c, float& d) { const f2v_t lo = __builtin_amdgcn_cvt_pk_f32_fp8((int)w, false), hi = __builtin_amdgcn_cvt_pk_f32_fp8((int)w, true); a = lo.x; b = lo.y; c = hi.x; d = hi.y; }
constexpr int PA_CH = 4;
__device__ __forceinline__ void phase_peer_apply3(const Params& P, int l, int bid, int nb) {
    const int tid = TID(), lane = tid & 63, wave = __builtin_amdgcn_readfirstlane(tid >> 6);
    const GAS bf16* xf = (const GAS bf16*)(P.ws + WS_ACT0);
    const GAS unsigned char* U = (const GAS unsigned char*)(P.ws + WS_U) + (size_t)l * NEXP * D + lane * 16; const GAS unsigned char* V = (const GAS unsigned char*)(P.ws + WS_V) + (size_t)l * NEXP * D + lane * 16;
    const float* su = (const float*)(P.ws + WS_SU) + (size_t)l * NEXP; const float* sv = (const float*)(P.ws + WS_SV) + (size_t)l * NEXP;
    const int* ex = (const int*)(P.ws + WS_EXP); const float* gw = (const float*)(P.ws + WS_GW); GAS bf16* hn = (GAS bf16*)(P.ws + WS_ACT2);
    for (int t = bid * 8 + wave; t < T; t += nb * 8) {
        float x[32], acc[32];
#pragma unroll
        for (int j = 0; j < 2; ++j)
#pragma unroll
            for (int q = 0; q < 2; ++q) { float f[8]; unpack8(*(const GAS v4u*)(xf + (size_t)t * D + j * 1024 + lane * 16 + q * 8), f);
#pragma unroll
                for (int e = 0; e < 8; ++e) { x[j * 16 + q * 8 + e] = f[e]; acc[j * 16 + q * 8 + e] = 0.f; } }
        const int* exr = ex + (size_t)t * 128; const float* gwr = gw + (size_t)t * 128;
        int en[PA_CH];
#pragma unroll
        for (int i = 0; i < PA_CH; ++i) en[i] = __builtin_amdgcn_readfirstlane(exr[i]);
        v4u Ur[PA_CH][2], Vr[2][2];
#pragma unroll
        for (int i = 0; i < PA_CH; ++i)
#pragma unroll
            for (int j = 0; j < 2; ++j) Ur[i][j] = *(const GAS v4u*)(U + (size_t)en[i] * D + j * 1024);
#if DUP_PHASE == 10
        for (int rep = 0; rep < 2; ++rep) { if (rep == 1) { float zz = 0.f; asm volatile("" : "+v"(zz));
#pragma unroll
            for (int i = 0; i < 32; ++i) acc[i] *= zz; }
#endif
#pragma unroll 1
        for (int kc = 0; kc < 128 / PA_CH; ++kc) {
            int ec[PA_CH]; float d[PA_CH];
#pragma unroll
            for (int i = 0; i < PA_CH; ++i) ec[i] = en[i];
            const int kn = kc < 128 / PA_CH - 1 ? kc + 1 : kc;
#pragma unroll
            for (int i = 0; i < PA_CH; ++i) en[i] = __builtin_amdgcn_readfirstlane(exr[PA_CH * kn + i]);
#pragma unroll
            for (int i = 0; i < PA_CH; ++i) { float s = 0.f;
#pragma unroll
                for (int j = 0; j < 2; ++j) { float a, b, c, dd;
                    fp8x4_to_f32(Ur[i][j].x, a, b, c, dd); s += a * x[j * 16 + 0] + b * x[j * 16 + 1] + c * x[j * 16 + 2] + dd * x[j * 16 + 3];
                    fp8x4_to_f32(Ur[i][j].y, a, b, c, dd); s += a * x[j * 16 + 4] + b * x[j * 16 + 5] + c * x[j * 16 + 6] + dd * x[j * 16 + 7];
                    fp8x4_to_f32(Ur[i][j].z, a, b, c, dd); s += a * x[j * 16 + 8] + b * x[j * 16 + 9] + c * x[j * 16 + 10] + dd * x[j * 16 + 11];
                    fp8x4_to_f32(Ur[i][j].w, a, b, c, dd); s += a * x[j * 16 + 12] + b * x[j * 16 + 13] + c * x[j * 16 + 14] + dd * x[j * 16 + 15]; }
                d[i] = s; }
#define PA_VLOAD(slot, i) do { _Pragma("unroll") for (int j = 0; j < 2; ++j) Vr[slot][j] = *(const GAS v4u*)(V + (size_t)ec[i] * D + j * 1024); } while (0)
#define PA_VACC1(wd, base) do { float a, b, c, dd; fp8x4_to_f32((wd), a, b, c, dd); acc[(base)] += wgt * a; acc[(base) + 1] += wgt * b; acc[(base) + 2] += wgt * c; acc[(base) + 3] += wgt * dd; } while (0)
#define PA_VACC(slot, i) do { const float wgt = d[i]; _Pragma("unroll") for (int j = 0; j < 2; ++j) { PA_VACC1(Vr[slot][j].x, j * 16); PA_VACC1(Vr[slot][j].y, j * 16 + 4); PA_VACC1(Vr[slot][j].z, j * 16 + 8); PA_VACC1(Vr[slot][j].w, j * 16 + 12); } } while (0)
            PA_VLOAD(0, 0); PA_VLOAD(1, 1);
#pragma unroll
            for (int i = 0; i < PA_CH; ++i)
#pragma unroll
                for (int j = 0; j < 2; ++j) Ur[i][j] = *(const GAS v4u*)(U + (size_t)en[i] * D + j * 1024);
#pragma unroll
            for (int i = 0; i < PA_CH; ++i) { const float dt = wave_sum(d[i]) * __builtin_bit_cast(float, __builtin_amdgcn_readfirstlane(__builtin_bit_cast(int, su[ec[i]])));
                const float g = __builtin_bit_cast(float, __builtin_amdgcn_readfirstlane(__builtin_bit_cast(int, gwr[PA_CH * kc + i]))) * __builtin_bit_cast(float, __builtin_amdgcn_readfirstlane(__builtin_bit_cast(int, sv[ec[i]])));
                d[i] = g * 0.5f * dt * (1.0f + erff(dt * 0.70710678118654752f)); }
#pragma unroll
            for (int i = 0; i < PA_CH; ++i) { if (i & 1) { PA_VACC(1, i); if (i + 2 < PA_CH) PA_VLOAD(1, i + 2); } else { PA_VACC(0, i); if (i + 2 < PA_CH) PA_VLOAD(0, i + 2); } }
#undef PA_VLOAD
#undef PA_VACC
#undef PA_VACC1
        }
#if DUP_PHASE == 10
        }
#endif
        GAS float* hrow = (GAS float*)P.out + (size_t)t * D + lane * 16; float ss = 0.f;
#pragma unroll
        for (int j = 0; j < 2; ++j)
#pragma unroll
            for (int q = 0; q < 4; ++q) { f32x4 hv = *(const GAS f32x4*)(hrow + j * 1024 + q * 4);
                hv.x += acc[j * 16 + q * 4 + 0]; hv.y += acc[j * 16 + q * 4 + 1]; hv.z += acc[j * 16 + q * 4 + 2]; hv.w += acc[j * 16 + q * 4 + 3];
                *(GAS f32x4*)(hrow + j * 1024 + q * 4) = hv; acc[j * 16 + q * 4 + 0] = hv.x; acc[j * 16 + q * 4 + 1] = hv.y; acc[j * 16 + q * 4 + 2] = hv.z; acc[j * 16 + q * 4 + 3] = hv.w;
                ss += hv.x * hv.x + hv.y * hv.y + hv.z * hv.z + hv.w * hv.w; }
        ss = wave_sum(ss); const float rr = 1.0f / sqrtf(ss * (1.0f / D) + EPS); const GAS float* gain = (const GAS float*)P.in[I_LNPLE] + (size_t)l * D + lane * 16;
#pragma unroll
        for (int j = 0; j < 2; ++j)
#pragma unroll
            for (int q = 0; q < 2; ++q) { const f32x4 g0 = *(const GAS f32x4*)(gain + j * 1024 + q * 8), g1 = *(const GAS f32x4*)(gain + j * 1024 + q * 8 + 4); const int b0 = j * 16 + q * 8;
                v4u o; o.x = pk2(acc[b0 + 0] * rr * g0.x, acc[b0 + 1] * rr * g0.y); o.y = pk2(acc[b0 + 2] * rr * g0.z, acc[b0 + 3] * rr * g0.w);
                o.z = pk2(acc[b0 + 4] * rr * g1.x, acc[b0 + 5] * rr * g1.y); o.w = pk2(acc[b0 + 6] * rr * g1.z, acc[b0 + 7] * rr * g1.w);
                *(GAS v4u*)(hn + (size_t)t * D + j * 1024 + lane * 16 + q * 8) = o; }
    }
}


__device__ __forceinline__ void norm_row_i8(f32x4 (&v)[8], float ss, const float* gain, GAS unsigned char* orow, GAS float* sc, int lane) {
    const float r = 1.0f / sqrtf(ss * (1.0f / D) + EPS); float am = 0.f;
#pragma unroll
    for (int j = 0; j < 8; ++j) { const f32x4 g = *(const f32x4*)(gain + (j * 64 + lane) * 4); v[j] = v[j] * r * g; am = fmaxf(am, fmaxf(fmaxf(fabsf(v[j].x), fabsf(v[j].y)), fmaxf(fabsf(v[j].z), fabsf(v[j].w)))); }
    am = wave_max(am); const float S = am > 0.f ? 127.0f / am : 0.f;
#pragma unroll
    for (int j = 0; j < 8; ++j) *(GAS unsigned*)(orow + (j * 64 + lane) * 4) = pack_i8x4(v[j].x, v[j].y, v[j].z, v[j].w, S);
    if (lane == 0) *sc = am * (1.0f / 127.0f);
}
template <bool SRC16 = false>
__device__ __forceinline__ void phase_norm_i8(const void* src, const float* gain, unsigned char* dst8, float* scales, int bid, int nb) {
    const int tid = TID(), lane = tid & 63, wave = tid >> 6, nw = 8;
    const int step = nb * nw; int t = bid * nw + wave;
    for (; t + step < T; t += 2 * step) { f32x4 v0[8], v1[8];
#pragma unroll
        for (int j = 0; j < 8; ++j) { v0[j] = ldrow4<SRC16>(src, (size_t)t * D + (j * 64 + lane) * 4); v1[j] = ldrow4<SRC16>(src, (size_t)(t + step) * D + (j * 64 + lane) * 4); }
        float s0 = 0.f, s1 = 0.f;
#pragma unroll
        for (int j = 0; j < 8; ++j) { s0 += v0[j].x * v0[j].x + v0[j].y * v0[j].y + v0[j].z * v0[j].z + v0[j].w * v0[j].w; s1 += v1[j].x * v1[j].x + v1[j].y * v1[j].y + v1[j].z * v1[j].z + v1[j].w * v1[j].w; }
        s0 = wave_sum(s0); s1 = wave_sum(s1);
        norm_row_i8(v0, s0, gain, (GAS unsigned char*)dst8 + (size_t)t * D, (GAS float*)scales + t, lane); norm_row_i8(v1, s1, gain, (GAS unsigned char*)dst8 + (size_t)(t + step) * D, (GAS float*)scales + t + step, lane); }
    for (; t < T; t += step) { f32x4 v[8]; float s_ = 0.f;
#pragma unroll
        for (int j = 0; j < 8; ++j) { v[j] = ldrow4<SRC16>(src, (size_t)t * D + (j * 64 + lane) * 4); s_ += v[j].x * v[j].x + v[j].y * v[j].y + v[j].z * v[j].z + v[j].w * v[j].w; }
        const float ss = wave_sum(s_); norm_row_i8(v, ss, gain, (GAS unsigned char*)dst8 + (size_t)t * D, (GAS float*)scales + t, lane); }
}
__device__ __forceinline__ void quant_rows_i8(const bf16* srcm, unsigned char* dstm, float* scm, int nrows, int bid, int nb) {
    const int tid = TID(), lane = tid & 63, wave = tid >> 6;
    for (int n = bid * 8 + wave; n < nrows; n += nb * 8) {
        const GAS bf16* src = (const GAS bf16*)srcm + (size_t)n * D; float f[4][8]; float am = 0.f;
#pragma unroll
        for (int j = 0; j < 4; ++j) { unpack8(*(const GAS v4u*)(src + (j * 64 + lane) * 8), f[j]);
#pragma unroll
            for (int e = 0; e < 8; ++e) am = fmaxf(am, fabsf(f[j][e])); }
        am = wave_max(am); const float S = am > 0.f ? 127.0f / am : 0.f;
        GAS unsigned char* dst = (GAS unsigned char*)dstm + (size_t)n * D;
#pragma unroll
        for (int j = 0; j < 4; ++j) *(GAS v2u*)(dst + (j * 64 + lane) * 8) = (v2u){pack_i8x4(f[j][0], f[j][1], f[j][2], f[j][3], S), pack_i8x4(f[j][4], f[j][5], f[j][6], f[j][7], S)};
        if (lane == 0) ((GAS float*)scm)[n] = am * (1.0f / 127.0f);
    }
}
constexpr int QR_TM = NTM * 128, QR_VT = QR_TM + NVT * 128, QR_WO = QR_VT + D, QR_WQ = QR_WO + D, QR_ALL = QR_WQ + D;
__device__ __forceinline__ void quant_row_ptrs(unsigned char* ws, int l, int g, const GAS bf16*& src, GAS unsigned char*& dst, GAS float*& sc) {
    size_t so, d8, ss; int r;
    if (g < QR_TM) { r = l * NTM * 128 + g; so = WS_WINTM; d8 = WS_WIN8TM; ss = WS_SWTM; }
    else if (g < QR_VT) { r = l * NVT * 128 + (g - QR_TM); so = WS_WINVT; d8 = WS_WIN8VT; ss = WS_SWVT; }
    else if (g < QR_WO) { r = l * D + (g - QR_VT); so = WS_WOUT; d8 = WS_WO8; ss = WS_SWO; }
    else if (g < QR_WQ) { r = l * D + (g - QR_WO); so = WS_WQ; d8 = WS_WQ8; ss = WS_SWQ; }
    else { r = l * D + (g - QR_WQ); so = WS_WGATE; d8 = WS_WG8; ss = WS_SWG; }
    src = (const GAS bf16*)(ws + so) + (size_t)r * D; dst = (GAS unsigned char*)(ws + d8) + (size_t)r * D; sc = (GAS float*)(ws + ss) + r;
}
__device__ __forceinline__ void quant_all_rows(const Params& P, int l, int bid, int nb) {
    const int tid = TID(), lane = tid & 63, wave = tid >> 6; const int step = nb * 8;
    for (int g0 = bid * 8 + wave; g0 < QR_ALL; g0 += 3 * step) {
        v4u w[3][4]; GAS unsigned char* dst[3]; GAS float* sc[3];
#pragma unroll
        for (int u = 0; u < 3; ++u) { const int g = g0 + u * step; const GAS bf16* src; quant_row_ptrs(P.ws, l, g < QR_ALL ? g : g0, src, dst[u], sc[u]);
#pragma unroll
            for (int j = 0; j < 4; ++j) w[u][j] = *(const GAS v4u*)(src + (j * 64 + lane) * 8); }
#pragma unroll
        for (int u = 0; u < 3; ++u) { if (g0 + u * step >= QR_ALL) break;
            float f[4][8]; float am = 0.f;
#pragma unroll
            for (int j = 0; j < 4; ++j) { unpack8(w[u][j], f[j]);
#pragma unroll
                for (int e = 0; e < 8; ++e) am = fmaxf(am, fabsf(f[j][e])); }
            am = wave_max(am); const float S = am > 0.f ? 127.0f / am : 0.f;
#pragma unroll
            for (int j = 0; j < 4; ++j) *(GAS v2u*)(dst[u] + (j * 64 + lane) * 8) = (v2u){pack_i8x4(f[j][0], f[j][1], f[j][2], f[j][3], S), pack_i8x4(f[j][4], f[j][5], f[j][6], f[j][7], S)};
            if (lane == 0) *sc[u] = am * (1.0f / 127.0f); }
    }
}
__device__ __forceinline__ void quant_wgate(const Params& P, int l, int bid, int nb) {
    const int tid = TID(), lane = tid & 63, wave = tid >> 6;
    for (int n = bid * 8 + wave; n < D; n += nb * 8) {
        const GAS bf16* src = (const GAS bf16*)(P.ws + WS_WGATE) + ((size_t)l * D + n) * D; float f[4][8]; float am = 0.f;
#pragma unroll
        for (int j = 0; j < 4; ++j) { unpack8(*(const GAS v4u*)(src + (j * 64 + lane) * 8), f[j]);
#pragma unroll
            for (int e = 0; e < 8; ++e) am = fmaxf(am, fabsf(f[j][e])); }
        am = wave_max(am); const float S = am > 0.f ? 127.0f / am : 0.f;
        GAS unsigned char* dst = (GAS unsigned char*)(P.ws + WS_WG8) + ((size_t)l * D + n) * D;
#pragma unroll
        for (int j = 0; j < 4; ++j) *(GAS v2u*)(dst + (j * 64 + lane) * 8) = (v2u){pack_i8x4(f[j][0], f[j][1], f[j][2], f[j][3], S), pack_i8x4(f[j][4], f[j][5], f[j][6], f[j][7], S)};
        if (lane == 0) ((GAS float*)(P.ws + WS_SWG))[(size_t)l * D + n] = am * (1.0f / 127.0f);
    }
}
#define XB_TMO      128
#define XB_XCNT(j)  (256  + 64 * (j))
#define XB_XSUB(j)  (1280 + 64 * (j))
#define XB_XGEN(j)  (2304 + 64 * (j))
#define XB_TOP      3328
#define XB_TOPGEN   3392
#define XCD_BAR_WORDS 3456
#define XB_SPIN_CAP (1u << 22)
__device__ __forceinline__ unsigned xb_ld(unsigned* p)              { return __hip_atomic_load(p, __ATOMIC_RELAXED, __HIP_MEMORY_SCOPE_AGENT); }
__device__ __forceinline__ unsigned xb_add(unsigned* p, unsigned v) { return __hip_atomic_fetch_add(p, v, __ATOMIC_RELAXED, __HIP_MEMORY_SCOPE_AGENT); }
__device__ __forceinline__ unsigned xb_xcc_id() { return (unsigned)__builtin_amdgcn_s_getreg((3 << 11) | 20) & 0xFu; }
#define XB_SPIN(cond, bar) do { unsigned _sp = 0; while (cond) { __builtin_amdgcn_s_sleep(1); \
    if ((++_sp & 255u) == 0u) { if (xb_ld(&(bar)[XB_TMO])) break; if (_sp > XB_SPIN_CAP) { atomicAdd(&(bar)[XB_TMO], 1u); break; } } } } while (0)
struct XcdBarrier { unsigned* bar; unsigned x; volatile LAS unsigned* st; };
__device__ __forceinline__ XcdBarrier xcd_barrier_post(unsigned* bar, volatile LAS unsigned* st) {
    XcdBarrier b; b.bar = bar; b.x = xb_xcc_id(); b.st = st;
    if (threadIdx.x == 0) (void)xb_add(&bar[XB_XCNT(b.x)], 1u);
    return b;
}
__device__ __forceinline__ void xcd_barrier_complete(unsigned* bar, unsigned x, unsigned& nloc, unsigned& nx) {
    const unsigned G = gridDim.x * gridDim.y * gridDim.z;
    unsigned sum, cnt, mine, sp = 0u;
    for (;;) {
        sum = 0u; cnt = 0u; mine = 0u;
#pragma unroll
        for (unsigned j = 0; j < 16; ++j) { const unsigned c = xb_ld(&bar[XB_XCNT(j)]); sum += c; cnt += (c > 0u) ? 1u : 0u; mine = (j == x) ? c : mine; }
        if (sum == G) break;
        __builtin_amdgcn_s_sleep(1);
        if ((++sp & 255u) == 0u) { if (xb_ld(&bar[XB_TMO])) break; if (sp > XB_SPIN_CAP) { atomicAdd(&bar[XB_TMO], 1u); break; } }
    }
    nloc = mine > 0u ? mine : 1u; nx = cnt > 0u ? cnt : 1u;
}
__device__ __forceinline__ void xcd_barrier(const XcdBarrier& b) {
    asm volatile("s_waitcnt vmcnt(0)" ::: "memory");
    __syncthreads();
    if (threadIdx.x == 0) {
        unsigned* bar = b.bar;
        __builtin_amdgcn_s_waitcnt(0);
        unsigned nloc = b.st[0], nx = b.st[1];
        if (nloc == 0u) { xcd_barrier_complete(bar, b.x, nloc, nx); b.st[0] = nloc; b.st[1] = nx; }
        const unsigned old = xb_add(&bar[XB_XSUB(b.x)], 1u);
        const unsigned gen = old / nloc;
        if (old + 1u == (gen + 1u) * nloc) {
            __builtin_amdgcn_fence(__ATOMIC_RELEASE, "agent");
            asm volatile("s_waitcnt vmcnt(0)" ::: "memory");
            const unsigned og = xb_add(&bar[XB_TOP], 1u);
            const unsigned tg = og / nx;
            if (og + 1u == (tg + 1u) * nx) xb_add(&bar[XB_TOPGEN], 1u);
            else XB_SPIN(xb_ld(&bar[XB_TOPGEN]) == tg, bar);
            __builtin_amdgcn_fence(__ATOMIC_ACQUIRE, "agent");
            xb_add(&bar[XB_XGEN(b.x)], 1u);
            asm volatile("s_waitcnt vmcnt(0)" ::: "memory");
        } else {
            XB_SPIN(xb_ld(&bar[XB_XGEN(b.x)]) == gen, bar);
            __builtin_amdgcn_fence(__ATOMIC_ACQUIRE, "agent");
            asm volatile("s_waitcnt vmcnt(0)" ::: "memory");
        }
    }
    __syncthreads();
}


namespace pz {
constexpr int NSL = 16, NTG = T / 8, QITEMS = (NSL / 8) * NTG;
__device__ __forceinline__ void load_rows(const GAS unsigned char* tab, unsigned poff, const int (&id)[16], v4u (&rows)[16]) {
#pragma unroll
    for (int i = 0; i < 16; ++i) rows[i] = *(const GAS v4u*)(tab + (((unsigned)id[i] << 7) | poff));
}
__device__ __forceinline__ void load_ids(const int* ex, size_t t, int e8, int (&id)[16]) {
    typedef int i32x4 __attribute__((ext_vector_type(4)));
#pragma unroll
    for (int q = 0; q < 4; ++q) { const i32x4 v = *(const GAS i32x4*)((const GAS int*)ex + t * 128 + 16 * e8 + 4 * q); id[4 * q] = v.x; id[4 * q + 1] = v.y; id[4 * q + 2] = v.z; id[4 * q + 3] = v.w; }
}
typedef float f2p __attribute__((ext_vector_type(2)));
__device__ __forceinline__ unsigned item_A(const Params& P, int l, int xq, int c, int tg, int lane, int (&id)[2][16], v4u (&rows)[2][16], unsigned itn_raw) {
    const int e8 = lane >> 3, part = lane & 7;
    const GAS unsigned char* tab0 = (const GAS unsigned char*)(P.ws + WS_U) + (size_t)l * NSL * NEXP * 128; const unsigned poff = part * 16;
    const GAS unsigned char* tab = tab0 + (size_t)c * NEXP * 128; unsigned itn = 0xffffffffu; size_t tn0 = 0; const GAS unsigned char* tabn = tab;
    const GAS bf16* xf = (const GAS bf16*)(P.ws + WS_ACT0) + 128 * c + 16 * part; const int* ex = (const int*)(P.ws + WS_EXP);
    GAS bf16* pdh = (GAS bf16*)(P.ws + WS_PD) + (size_t)c * T * 128 + 16 * e8;
    const size_t t0 = (size_t)tg * 8;
#pragma unroll
    for (int n = 0; n < 8; ++n) { const size_t t = t0 + n; const int bf = n & 1;
        if (n < 7) load_rows(tab, poff, id[bf ^ 1], rows[bf ^ 1]);
        if (n < 6) load_ids(ex, t + 2, e8, id[bf]);
        if (n == 6) { itn = (unsigned)__builtin_amdgcn_readfirstlane((int)itn_raw);
            if (itn < (unsigned)QITEMS) { tn0 = (size_t)(itn % NTG) * 8; tabn = tab0 + (size_t)(xq + 8 * (int)(itn / NTG)) * NEXP * 128; load_ids(ex, tn0, e8, id[0]); } }
        if (n == 7 && itn < (unsigned)QITEMS) { load_rows(tabn, poff, id[0], rows[0]); load_ids(ex, tn0 + 1, e8, id[1]); }
#if PEER_A_I8
        const v4u xw = *(const GAS v4u*)((const GAS unsigned char*)(P.ws + WS_XF8) + t * D + 128 * c + 16 * part);
        int sacc[16];
#pragma unroll
        for (int i = 0; i < 16; ++i) { const v4u rw = rows[bf][i]; int a; asm("v_dot4_i32_i8 %0, %1, %2, 0" : "=v"(a) : "v"(rw.x), "v"(xw.x)); a = __builtin_amdgcn_sdot4((int)rw.y, (int)xw.y, a, false);
            a = __builtin_amdgcn_sdot4((int)rw.z, (int)xw.z, a, false); sacc[i] = __builtin_amdgcn_sdot4((int)rw.w, (int)xw.w, a, false); }
        { const bool b2 = part & 4, b1 = part & 2, b0 = part & 1; int r8[8], r4[4], r2[2];
#pragma unroll
          for (int i = 0; i < 8; ++i) { const int snd = b2 ? sacc[i] : sacc[8 + i], kp = b2 ? sacc[8 + i] : sacc[i]; r8[i] = kp + swz_xor_i<4>(snd); }
#pragma unroll
          for (int i = 0; i < 4; ++i) { const int snd = b1 ? r8[i] : r8[4 + i], kp = b1 ? r8[4 + i] : r8[i]; r4[i] = kp + swz_xor_i<2>(snd); }
#pragma unroll
          for (int i = 0; i < 2; ++i) { const int snd = b0 ? r4[i] : r4[2 + i], kp = b0 ? r4[2 + i] : r4[i]; r2[i] = kp + swz_xor_i<1>(snd); }
          *(GAS unsigned*)((GAS bf16*)pdh + t * 128 + 2 * part) = pk2((float)r2[0] * (1.0f / 16384.0f), (float)r2[1] * (1.0f / 16384.0f)); }
#else
        f2p x2[8];
        { const v4u w0 = *(const GAS v4u*)(xf + t * D), w1 = *(const GAS v4u*)(xf + t * D + 8);
          x2[0] = (f2p){bf2f(w0.x & 0xffff), bf2f(w0.x >> 16)}; x2[1] = (f2p){bf2f(w0.y & 0xffff), bf2f(w0.y >> 16)}; x2[2] = (f2p){bf2f(w0.z & 0xffff), bf2f(w0.z >> 16)}; x2[3] = (f2p){bf2f(w0.w & 0xffff), bf2f(w0.w >> 16)};
          x2[4] = (f2p){bf2f(w1.x & 0xffff), bf2f(w1.x >> 16)}; x2[5] = (f2p){bf2f(w1.y & 0xffff), bf2f(w1.y >> 16)}; x2[6] = (f2p){bf2f(w1.z & 0xffff), bf2f(w1.z >> 16)}; x2[7] = (f2p){bf2f(w1.w & 0xffff), bf2f(w1.w >> 16)}; }
        float sacc[16];
#pragma unroll
        for (int i = 0; i < 16; ++i) { const v4u rw = rows[bf][i]; f2p s2 = {0.f, 0.f};
            s2 = __builtin_elementwise_fma(__builtin_amdgcn_cvt_pk_f32_fp8((int)rw.x, false), x2[0], s2); s2 = __builtin_elementwise_fma(__builtin_amdgcn_cvt_pk_f32_fp8((int)rw.x, true), x2[1], s2);
            s2 = __builtin_elementwise_fma(__builtin_amdgcn_cvt_pk_f32_fp8((int)rw.y, false), x2[2], s2); s2 = __builtin_elementwise_fma(__builtin_amdgcn_cvt_pk_f32_fp8((int)rw.y, true), x2[3], s2);
            s2 = __builtin_elementwise_fma(__builtin_amdgcn_cvt_pk_f32_fp8((int)rw.z, false), x2[4], s2); s2 = __builtin_elementwise_fma(__builtin_amdgcn_cvt_pk_f32_fp8((int)rw.z, true), x2[5], s2);
            s2 = __builtin_elementwise_fma(__builtin_amdgcn_cvt_pk_f32_fp8((int)rw.w, false), x2[6], s2); s2 = __builtin_elementwise_fma(__builtin_amdgcn_cvt_pk_f32_fp8((int)rw.w, true), x2[7], s2);
            sacc[i] = s2.x + s2.y; }
        { const bool b2 = part & 4, b1 = part & 2, b0 = part & 1; float r8[8], r4[4], r2[2];
#pragma unroll
          for (int i = 0; i < 8; ++i) { const float snd = b2 ? sacc[i] : sacc[8 + i], kp = b2 ? sacc[8 + i] : sacc[i]; r8[i] = kp + swz_xor<4>(snd); }
#pragma unroll
          for (int i = 0; i < 4; ++i) { const float snd = b1 ? r8[i] : r8[4 + i], kp = b1 ? r8[4 + i] : r8[i]; r4[i] = kp + swz_xor<2>(snd); }
#pragma unroll
          for (int i = 0; i < 2; ++i) { const float snd = b0 ? r4[i] : r4[2 + i], kp = b0 ? r4[2 + i] : r4[i]; r2[i] = kp + swz_xor<1>(snd); }
          *(GAS unsigned*)((GAS bf16*)pdh + t * 128 + 2 * part) = pk2(r2[0], r2[1]); }
#endif
    }
    return itn;
}
__device__ __forceinline__ unsigned item_B(const Params& P, int l, int xq, int c, int tg, int lane, int (&id)[2][16], v4u (&rows)[2][16], unsigned itn_raw) {
    const int e8 = lane >> 3, part = lane & 7;
    const GAS unsigned char* tab0 = (const GAS unsigned char*)(P.ws + WS_V) + (size_t)l * NSL * NEXP * 128; const unsigned poff = part * 16;
    const GAS unsigned char* tab = tab0 + (size_t)c * NEXP * 128; unsigned itn = 0xffffffffu; size_t tn0 = 0; const GAS unsigned char* tabn = tab;
    const int* ex = (const int*)(P.ws + WS_EXP); const GAS float* wv = (const GAS float*)(P.ws + WS_WV) + 16 * e8;
    GAS float* hcol = (GAS float*)P.out + 128 * c + 16 * part;
    const size_t t0 = (size_t)tg * 8;
#pragma unroll
    for (int n = 0; n < 8; ++n) { const size_t t = t0 + n; const int bf = n & 1;
        if (n < 7) load_rows(tab, poff, id[bf ^ 1], rows[bf ^ 1]);
        if (n < 6) load_ids(ex, t + 2, e8, id[bf]);
        if (n == 6) { itn = (unsigned)__builtin_amdgcn_readfirstlane((int)itn_raw);
            if (itn < (unsigned)QITEMS) { tn0 = (size_t)(itn % NTG) * 8; tabn = tab0 + (size_t)(xq + 8 * (int)(itn / NTG)) * NEXP * 128; load_ids(ex, tn0, e8, id[0]); } }
        if (n == 7 && itn < (unsigned)QITEMS) { load_rows(tabn, poff, id[0], rows[0]); load_ids(ex, tn0 + 1, e8, id[1]); }
        float w[16];
#pragma unroll
        for (int q = 0; q < 4; ++q) { const f32x4 v = *(const GAS f32x4*)(wv + t * 128 + 4 * q); w[4 * q] = v.x; w[4 * q + 1] = v.y; w[4 * q + 2] = v.z; w[4 * q + 3] = v.w; }
        f2p acc2[8];
#pragma unroll
        for (int q = 0; q < 8; ++q) acc2[q] = (f2p){0.f, 0.f};
#pragma unroll
        for (int i = 0; i < 16; ++i) { const v4u rw = rows[bf][i]; const f2p w2 = {w[i], w[i]};
            acc2[0] = __builtin_elementwise_fma(__builtin_amdgcn_cvt_pk_f32_fp8((int)rw.x, false), w2, acc2[0]); acc2[1] = __builtin_elementwise_fma(__builtin_amdgcn_cvt_pk_f32_fp8((int)rw.x, true), w2, acc2[1]);
            acc2[2] = __builtin_elementwise_fma(__builtin_amdgcn_cvt_pk_f32_fp8((int)rw.y, false), w2, acc2[2]); acc2[3] = __builtin_elementwise_fma(__builtin_amdgcn_cvt_pk_f32_fp8((int)rw.y, true), w2, acc2[3]);
            acc2[4] = __builtin_elementwise_fma(__builtin_amdgcn_cvt_pk_f32_fp8((int)rw.z, false), w2, acc2[4]); acc2[5] = __builtin_elementwise_fma(__builtin_amdgcn_cvt_pk_f32_fp8((int)rw.z, true), w2, acc2[5]);
            acc2[6] = __builtin_elementwise_fma(__builtin_amdgcn_cvt_pk_f32_fp8((int)rw.w, false), w2, acc2[6]); acc2[7] = __builtin_elementwise_fma(__builtin_amdgcn_cvt_pk_f32_fp8((int)rw.w, true), w2, acc2[7]); }
        float acc[16];
#pragma unroll
        for (int q = 0; q < 8; ++q) { acc[2 * q] = acc2[q].x; acc[2 * q + 1] = acc2[q].y; }
        { const bool b3 = e8 & 1; float r8[8], r4[4], r2[2];
#pragma unroll
          for (int i = 0; i < 8; ++i) { const auto pr = __builtin_amdgcn_permlane32_swap(__builtin_bit_cast(unsigned, acc[i]), __builtin_bit_cast(unsigned, acc[8 + i]), false, false);
              r8[i] = __builtin_bit_cast(float, (unsigned)pr[0]) + __builtin_bit_cast(float, (unsigned)pr[1]); }
#pragma unroll
          for (int i = 0; i < 4; ++i) { const auto pr = __builtin_amdgcn_permlane16_swap(__builtin_bit_cast(unsigned, r8[i]), __builtin_bit_cast(unsigned, r8[4 + i]), false, false);
              r4[i] = __builtin_bit_cast(float, (unsigned)pr[0]) + __builtin_bit_cast(float, (unsigned)pr[1]); }
#pragma unroll
          for (int i = 0; i < 2; ++i) { const float snd = b3 ? r4[i] : r4[2 + i], kp = b3 ? r4[2 + i] : r4[i]; r2[i] = kp + swz_xor<8>(snd); }
#if H16
          GAS h2_t* hp = (GAS h2_t*)((GAS _Float16*)(P.ws + WS_H16) + 128 * c + 16 * part + t * D + 2 * e8); const h2_t hv = *hp; *hp = (h2_t){(_Float16)((float)hv.x + r2[0]), (_Float16)((float)hv.y + r2[1])}; }
#else
          GAS f2p* hp = (GAS f2p*)(hcol + t * D + 2 * e8); f2p hv = *hp; hv.x += r2[0]; hv.y += r2[1]; *hp = hv; }
#endif
    }
    return itn;
}
template <int WHICH>
__device__ __forceinline__ void phase_sliced(const Params& P, int l) {
    unsigned* qbase = (unsigned*)(P.ws + WS_CTL) + 16384 + 64 * ((l * 2 + WHICH) * 8);
    const unsigned x0 = xb_xcc_id() & 7u;
    const int lane = TID() & 63, e8 = lane >> 3, part = lane & 7;
    const int* ex = (const int*)(P.ws + WS_EXP);
    const GAS unsigned char* tab0 = (const GAS unsigned char*)(P.ws + (WHICH == 0 ? WS_U : WS_V)) + (size_t)l * NSL * NEXP * 128; const unsigned poff = part * 16;
    for (unsigned s_ = 0; s_ < 8; ++s_) { const unsigned xq = (x0 + s_) & 7u;
        unsigned it = 0u;
        if (lane == 0) it = __hip_atomic_fetch_add(qbase + 64 * xq, 1u, __ATOMIC_RELAXED, __HIP_MEMORY_SCOPE_AGENT);
        it = (unsigned)__builtin_amdgcn_readfirstlane((int)it);
        if (it >= (unsigned)QITEMS) continue;
        int id[2][16]; v4u rows[2][16];
        { const size_t t0 = (size_t)(it % NTG) * 8; const GAS unsigned char* tab = tab0 + (size_t)((int)xq + 8 * (int)(it / NTG)) * NEXP * 128;
          load_ids(ex, t0, e8, id[0]); load_rows(tab, poff, id[0], rows[0]); load_ids(ex, t0 + 1, e8, id[1]); }
        for (;;) {
            unsigned itn_raw = 0xffffffffu;
            if (lane == 0) itn_raw = __hip_atomic_fetch_add(qbase + 64 * xq, 1u, __ATOMIC_RELAXED, __HIP_MEMORY_SCOPE_AGENT);
            const int c = (int)xq + 8 * (int)(it / NTG), tg = (int)(it % NTG);
            const unsigned itn = WHICH == 0 ? item_A(P, l, (int)xq, c, tg, lane, id, rows, itn_raw) : item_B(P, l, (int)xq, c, tg, lane, id, rows, itn_raw);
            if (itn >= (unsigned)QITEMS) break;
            it = itn;
        }
    }
}
__device__ __forceinline__ void phase_weights(const Params& P, int l, int bid, int nb) {
    const int tid = TID();
    const GAS bf16* pd = (const GAS bf16*)(P.ws + WS_PD); const GAS int* ex = (const GAS int*)(P.ws + WS_EXP); const GAS float* gw = (const GAS float*)(P.ws + WS_GW);
    const GAS float* su = (const GAS float*)(P.ws + WS_SU) + (size_t)l * NEXP; const GAS float* sv = (const GAS float*)(P.ws + WS_SV) + (size_t)l * NEXP; GAS float* wv = (GAS float*)(P.ws + WS_WV);
    typedef int i32x4 __attribute__((ext_vector_type(4)));
    for (size_t i8 = (size_t)bid * 512 + tid; i8 < (size_t)T * 128 / 8; i8 += (size_t)nb * 512) {
        const size_t i = i8 * 8; float s8[8];
#pragma unroll
        for (int q = 0; q < 8; ++q) s8[q] = 0.f;
#pragma unroll
        for (int c = 0; c < NSL; ++c) { float f[8]; unpack8(*(const GAS v4u*)(pd + (size_t)c * T * 128 + i), f);
#pragma unroll
            for (int q = 0; q < 8; ++q) s8[q] += f[q]; }
        const i32x4 e0 = *(const GAS i32x4*)(ex + i), e1 = *(const GAS i32x4*)(ex + i + 4); const f32x4 g0 = *(const GAS f32x4*)(gw + i), g1 = *(const GAS f32x4*)(gw + i + 4);
        const int ee[8] = {e0.x, e0.y, e0.z, e0.w, e1.x, e1.y, e1.z, e1.w}; const float gg[8] = {g0.x, g0.y, g0.z, g0.w, g1.x, g1.y, g1.z, g1.w}; float o[8];
        const float xs = PEER_A_I8 ? 16384.0f * ((const GAS float*)(P.ws + WS_SXF))[i >> 7] : 1.0f;
#pragma unroll
        for (int q = 0; q < 8; ++q) { const float dt = s8[q] * xs * su[ee[q]]; o[q] = gg[q] * sv[ee[q]] * 0.5f * dt * (1.0f + erff(dt * 0.70710678118654752f)); }
        *(GAS f32x4*)(wv + i) = (f32x4){o[0], o[1], o[2], o[3]}; *(GAS f32x4*)(wv + i + 4) = (f32x4){o[4], o[5], o[6], o[7]};
    }
}
}

#ifndef FAST_GEMM
#define FAST_GEMM 1
#endif
#ifndef FAST_ATTN
#define FAST_ATTN 1
#endif
#ifndef FAST_SELECT
#define FAST_SELECT 1
#endif
#ifndef FAST_PREP
#define FAST_PREP 1
#endif
constexpr int LDS_BYTES = 147456;
constexpr int LDS_MISC = 131072;
constexpr int NPH_L = 12, NPHASES = 1 + DEPTH * NPH_L + 1;
struct Args { Params P; int ph_lo, ph_hi; };
__global__ void __launch_bounds__(512, 2) mk_fwd(Args a) {
    extern __shared__ __attribute__((aligned(16))) unsigned char lds_raw[];
    LAS unsigned char* lds = (LAS unsigned char*)lds_raw;
    const Params& P0 = a.P;
    const int bid0 = blockIdx.x, nb = gridDim.x;
    volatile LAS unsigned* misc = (volatile LAS unsigned*)(lds + LDS_MISC);
    if (threadIdx.x < 64) misc[threadIdx.x] = 0u;
    __syncthreads();
    XcdBarrier bar = xcd_barrier_post((unsigned*)(P0.ws + WS_CTL) + 1024, misc + 8);
    const int lo = a.ph_lo, hi = a.ph_hi;
#define IN(k) (lo <= (k) && (k) < hi)
#define BAR(k) do { if (IN(k) && IN((k) + 1)) xcd_barrier(bar); } while (0)
#define PH const Params P = fresh(P0); const int bid = launder_s(bid0); unsigned char* ws = P.ws; (void)ws; (void)bid
    if (IN(0)) { PH; phase_prologue(P, bid, nb, lds); }
#if DUP_PHASE == 100
    BAR(0);
    if (IN(0)) { PH; phase_prologue(P, bid, nb, lds); }
#endif
    BAR(0);
    for (int l = 0; l < DEPTH; ++l) {
        const int pb = 1 + l * NPH_L;
        if (IN(pb + 0)) { PH; phase_norm_mix(P, l, bid, nb, lds);
#if GATE_I8 && WQ_I8 && WOUT_I8 && PROJ_I8 && H16
#elif GATE_I8 && WQ_I8 && WOUT_I8 && PROJ_I8
            quant_all_rows(P, l, bid, nb);
#else
#if GATE_I8
            quant_wgate(P, l, bid, nb);
#endif
#if WQ_I8
            quant_rows_i8((const bf16*)(ws + WS_WQ) + (size_t)l * D * D, (unsigned char*)(ws + WS_WQ8) + (size_t)l * D * D, (float*)(ws + WS_SWQ) + (size_t)l * D, D, bid, nb);
#endif
#if WOUT_I8
            quant_rows_i8((const bf16*)(ws + WS_WOUT) + (size_t)l * D * D, (unsigned char*)(ws + WS_WO8) + (size_t)l * D * D, (float*)(ws + WS_SWO) + (size_t)l * D, D, bid, nb);
#endif
#if PROJ_I8
            quant_rows_i8((const bf16*)(ws + WS_WINTM) + (size_t)l * NTM * 128 * D, (unsigned char*)(ws + WS_WIN8TM) + (size_t)l * NTM * 128 * D, (float*)(ws + WS_SWTM) + (size_t)l * NTM * 128, NTM * 128, bid, nb);
            quant_rows_i8((const bf16*)(ws + WS_WINVT) + (size_t)l * NVT * 128 * D, (unsigned char*)(ws + WS_WIN8VT) + (size_t)l * NVT * 128 * D, (float*)(ws + WS_SWVT) + (size_t)l * NVT * 128, NVT * 128, bid, nb);
#endif
#endif
        }
#if DUP_PHASE == 300
        if (IN(pb + 0)) { PH; phase_norm_mix(P, l, bid, nb, lds); }
#endif
        BAR(pb + 0);
        if (IN(pb + 1)) { PH;
            const bf16* act = (const bf16*)(ws + WS_ACT0);
            const bf16* wtm = (const bf16*)(ws + WS_WINTM) + (size_t)l * NTM * 128 * D; const bf16* wvt = (const bf16*)(ws + WS_WINVT) + (size_t)l * NVT * 128 * D;
#if FAST_GEMM
#if PROJ_I8
            pg8::Gemm g{act, (const bf16*)(ws + WS_WIN8TM + (size_t)l * NTM * 128 * D), D / 2, (const bf16*)(ws + WS_WIN8VT + (size_t)l * NVT * 128 * D), act, 64, 17}; pg8::DualOrder so{64, 17, 7, 64, nb, bid};
            pg8::EpiProjI8 e{(bf16*)(ws + WS_TM), (bf16*)(ws + WS_VT), (const float*)(ws + WS_SA), (const float*)(ws + WS_SWTM) + (size_t)l * NTM * 128, (const float*)(ws + WS_SWVT) + (size_t)l * NVT * 128};
            pg8::gemm_phase(lds, g, so, e);
#else
            pg8::Gemm g{act, wtm, D, wvt, act, 64, 17}; pg8::DualOrder so{64, 17, 7, 64, nb, bid}; pg8::EpiProj e{(bf16*)(ws + WS_TM), (bf16*)(ws + WS_VT)};
            pg8::gemm_phase(lds, g, so, e);
#endif
#if DUP_PHASE == 200
            __syncthreads(); pg8::gemm_phase(lds, g, so, e);
#endif
#else
            EpiProjTM e1{(bf16*)(ws + WS_TM)}; phase_gemm_naive(act, wtm, D, T, NTM * 128, e1, bid, nb, lds);
            EpiProjVT e2{(bf16*)(ws + WS_VT)}; phase_gemm_naive(wvt, act, D, NVT * 128, T, e2, bid, nb, lds);
#endif
        }
        BAR(pb + 1);
#if FAST_PREP
        if (IN(pb + 2)) { PH; pf::phase_prep(P, l, bid, nb, lds); }
#if DUP_PHASE == 300
        if (IN(pb + 2)) { PH; pf::phase_prep(P, l, bid, nb, lds); }
#endif
#else
        if (IN(pb + 2)) { PH; phase_prep_naive(P, l, bid, nb); }
#endif
        BAR(pb + 2);
#if FAST_ATTN
        if (IN(pb + 3)) { PH; fa::phase_attn(P, l, lds); }
#if DUP_PHASE == 3
        BAR(pb + 3);
        if (IN(pb + 3)) { PH; if (bid == 0 && TID() == 0) ((unsigned*)(P.ws + WS_CTL))[8192 + 64 * l] = 0u; }
        BAR(pb + 3);
        if (IN(pb + 3)) { PH; fa::phase_attn(P, l, lds); }
#endif
        BAR(pb + 3);
#else
        if (IN(pb + 3)) { PH; phase_attn_naive1(P, bid, nb, lds); }
        BAR(pb + 3);
        if (IN(pb + 4)) { PH; phase_attn_naive2(P, bid, nb, lds); }
#endif
#if !FAST_ATTN
        BAR(pb + 4);
#endif
        if (IN(pb + 5)) { PH; phase_ynorm(P, bid, nb); }
#if DUP_PHASE == 300
        if (IN(pb + 5)) { PH; phase_ynorm(P, bid, nb); }
#endif
        BAR(pb + 5);
        if (IN(pb + 6)) { PH;
#if FAST_GEMM
#if WOUT_I8
            pg8::Gemm g{(const bf16*)(ws + WS_ACT2), (const bf16*)(ws + WS_WO8 + (size_t)l * D * D), D / 2, nullptr, nullptr, 1 << 30, 1 << 30}; pg8::StaticOrder so; so.init(T, D, nb, bid);
#if H16
            pg8::EpiResidI8 e{l == 0 ? P.in[I_X] : nullptr, (float*)(ws + WS_H16), (const float*)(ws + WS_SY), (const float*)(ws + WS_SWO) + (size_t)l * D}; pg8::gemm_phase(lds, g, so, e); }
#else
            pg8::EpiResidI8 e{l == 0 ? P.in[I_X] : P.out, P.out, (const float*)(ws + WS_SY), (const float*)(ws + WS_SWO) + (size_t)l * D}; pg8::gemm_phase(lds, g, so, e); }
#endif
#else
            pg8::Gemm g{(const bf16*)(ws + WS_ACT2), (const bf16*)(ws + WS_WOUT) + (size_t)l * D * D, D, nullptr, nullptr, 1 << 30, 1 << 30}; pg8::StaticOrder so; so.init(T, D, nb, bid);
            pg8::EpiResidT e{l == 0 ? P.in[I_X] : P.out, P.out}; pg8::gemm_phase(lds, g, so, e); }
#endif
#else
            EpiResid e{l == 0 ? P.in[I_X] : P.out, P.out};
            phase_gemm_naive((const bf16*)(ws + WS_ACT2), (const bf16*)(ws + WS_WOUT) + (size_t)l * D * D, D, T, D, e, bid, nb, lds); }
#endif
        BAR(pb + 6);
#if H16
        if (IN(pb + 7)) { PH; phase_norm<true>(ws + WS_H16, P.in[I_LNFFN] + (size_t)l * D, nullptr, bid, nb, (unsigned char*)(ws + WS_XF8), (float*)(ws + WS_SXF)); }
#else
        if (IN(pb + 7)) { PH; phase_norm(P.out, P.in[I_LNFFN] + (size_t)l * D, (bf16*)(ws + WS_ACT0), bid, nb, WQ_I8 ? (unsigned char*)(ws + WS_XF8) : nullptr, (float*)(ws + WS_SXF)); }
#endif
#if DUP_PHASE == 300
        if (IN(pb + 7)) { PH; phase_norm(P.out, P.in[I_LNFFN] + (size_t)l * D, (bf16*)(ws + WS_ACT0), bid, nb); }
#endif
        BAR(pb + 7);
        if (IN(pb + 8)) { PH;
#if FAST_GEMM
#if WQ_I8
            { pg8::Gemm g{(const bf16*)(ws + WS_XF8), (const bf16*)(ws + WS_WQ8 + (size_t)l * D * D), D / 2, nullptr, nullptr, 1 << 30, 1 << 30}; pg8::StaticOrder so; so.init(T, D, nb, bid);
              pg8::EpiStoreI8 e{(bf16*)(ws + WS_ACT1), (const float*)(ws + WS_SXF), (const float*)(ws + WS_SWQ) + (size_t)l * D}; pg8::gemm_phase(lds, g, so, e);
#else
            { pg8::Gemm g{(const bf16*)(ws + WS_ACT0), (const bf16*)(ws + WS_WQ) + (size_t)l * D * D, D, nullptr, nullptr, 1 << 30, 1 << 30}; pg8::StaticOrder so; so.init(T, D, nb, bid);
              pg8::EpiStoreT e{(bf16*)(ws + WS_ACT1)}; pg8::gemm_phase(lds, g, so, e);
#endif
#if DUP_PHASE == 200
              __syncthreads(); pg8::gemm_phase(lds, g, so, e);
#endif
            }
            { pg8::Gemm g{(const bf16*)(ws + WS_P) + (size_t)l * T * PLE, (const bf16*)(ws + WS_WPROJ) + (size_t)l * D * PLE, PLE, nullptr, nullptr, 1 << 30, 1 << 30}; pg8::StaticOrder so; so.init(T, D, nb, bid);
              pg8::EpiStoreT e{(bf16*)(ws + WS_ACT3)}; pg8::gemm_phase(lds, g, so, e); }
#else
            EpiStoreBf16 e{(bf16*)(ws + WS_ACT1)}; phase_gemm_naive((const bf16*)(ws + WS_ACT0), (const bf16*)(ws + WS_WQ) + (size_t)l * D * D, D, T, D, e, bid, nb, lds);
            EpiStoreBf16 e2{(bf16*)(ws + WS_ACT3)}; phase_gemm_naive((const bf16*)(ws + WS_P) + (size_t)l * T * PLE, (const bf16*)(ws + WS_WPROJ) + (size_t)l * D * PLE, PLE, T, D, e2, bid, nb, lds);
#endif
        }
        BAR(pb + 8);
#if FAST_SELECT
        if (IN(pb + 9)) { PH; ps::phase_select(P, l, bid, nb, lds); }
#if DUP_PHASE == 300
        if (IN(pb + 9)) { PH; ps::phase_select(P, l, bid, nb, lds); }
#endif
#else
        if (IN(pb + 9)) { PH; phase_peer_select_naive(P, l, bid, nb, lds); }
#endif
#if DUP_PHASE == 9
        BAR(pb + 9);
        if (IN(pb + 9)) { PH; phase_peer_select_naive(P, l, bid, nb, lds); }
#endif
        BAR(pb + 9);
#if PEER_SLICED
        if (IN(pb + 10)) { PH; pz::phase_sliced<0>(P, l); }
        BAR(pb + 10);
        if (IN(pb + 10)) { PH; pz::phase_weights(P, l, bid, nb); }
        BAR(pb + 10);
        if (IN(pb + 10)) { PH; pz::phase_sliced<1>(P, l); }
        BAR(pb + 10);
#if GATE_I8
        if (IN(pb + 10)) { PH; phase_norm_i8<H16 != 0>(H16 ? (const void*)(ws + WS_H16) : (const void*)P.out, P.in[I_LNPLE] + (size_t)l * D, (unsigned char*)(ws + WS_ACT2), (float*)(ws + WS_SHN), bid, nb); }
#else
        if (IN(pb + 10)) { PH; phase_norm(P.out, P.in[I_LNPLE] + (size_t)l * D, (bf16*)(ws + WS_ACT2), bid, nb); }
#endif
        BAR(pb + 10);
#else
        if (IN(pb + 10)) { PH; phase_peer_apply3(P, l, bid, nb); }
        BAR(pb + 10);
#endif
        if (IN(pb + 11)) { PH;
#if FAST_GEMM
#if GATE_I8
            pg8::Gemm g{(const bf16*)(ws + WS_ACT2), (const bf16*)(ws + WS_WG8 + (size_t)l * D * D), D / 2, nullptr, nullptr, 1 << 30, 1 << 30}; pg8::StaticOrder so; so.init(T, D, nb, bid);
            pg8::EpiPleGateI8 e{H16 ? (float*)(ws + WS_H16) : P.out, (const bf16*)(ws + WS_ACT3), (const float*)(ws + WS_SHN), (const float*)(ws + WS_SWG) + (size_t)l * D}; pg8::gemm_phase(lds, g, so, e); }
#else
            pg8::Gemm g{(const bf16*)(ws + WS_ACT2), (const bf16*)(ws + WS_WGATE) + (size_t)l * D * D, D, nullptr, nullptr, 1 << 30, 1 << 30}; pg8::StaticOrder so; so.init(T, D, nb, bid);
            pg8::EpiPleGateT e{P.out, (const bf16*)(ws + WS_ACT3)}; pg8::gemm_phase(lds, g, so, e); }
#endif
#else
            EpiPleGate e{P.out, (const bf16*)(ws + WS_ACT3)};
            phase_gemm_naive((const bf16*)(ws + WS_ACT2), (const bf16*)(ws + WS_WGATE) + (size_t)l * D * D, D, T, D, e, bid, nb, lds); }
#endif
        BAR(pb + 11);
    }
#if DUP_PHASE == 400
    for (int zz = 0; zz < 20; ++zz) xcd_barrier(bar);
#endif
    if (IN(NPHASES - 1)) { PH; phase_final(P, bid, nb); }
#undef IN
#undef BAR
#undef PH
}

#ifndef MK_LAUNCHES
#define MK_LAUNCHES 1
#endif
extern "C" void kernel_launch(void* const* d_in, const int* in_sizes, int n_in, void* d_out, int out_size, void* d_ws, size_t ws_size, hipStream_t stream) {
    static int grid = 0;
    if (grid == 0) {
        if (n_in != 19 || out_size != T * D || ws_size < WS_END) { fprintf(stderr, "kernel_launch: unexpected shapes (n_in %d out %d ws %zu need %zu)\n", n_in, out_size, ws_size, (size_t)WS_END); grid = -1; return; }
        int dev = 0, cus = 0, per_cu = 0;
        if (hipGetDevice(&dev) != hipSuccess || hipDeviceGetAttribute(&cus, hipDeviceAttributeMultiprocessorCount, dev) != hipSuccess) { grid = -1; return; }
        if (hipFuncSetAttribute((const void*)mk_fwd, hipFuncAttributeMaxDynamicSharedMemorySize, LDS_BYTES) != hipSuccess) { fprintf(stderr, "kernel_launch: hipFuncSetAttribute failed\n"); grid = -1; return; }
        if (hipOccupancyMaxActiveBlocksPerMultiprocessor(&per_cu, (const void*)mk_fwd, 512, LDS_BYTES) != hipSuccess || per_cu < 1) { fprintf(stderr, "kernel_launch: occupancy query reports %d blocks per CU\n", per_cu); }
        (void)hipGetLastError();
        grid = cus;
    }
    if (grid < 0) return;
    (void)hipMemsetAsync((char*)d_ws + WS_CTL, 0, CTL_USED_BYTES, stream);
    Args a{};
    for (int i = 0; i < 19; ++i) a.P.in[i] = (const float*)d_in[i];
    a.P.out = (float*)d_out; a.P.ws = (unsigned char*)d_ws;
#if MK_LAUNCHES == 1
    a.ph_lo = 0; a.ph_hi = NPHASES;
    hipLaunchKernelGGL(mk_fwd, dim3(grid), dim3(512), LDS_BYTES, stream, a);
#else
    for (int p = 0; p < NPHASES; ++p) { a.ph_lo = p; a.ph_hi = p + 1; hipLaunchKernelGGL(mk_fwd, dim3(grid), dim3(512), LDS_BYTES, stream, a); }
#endif
}
```

```cpp
#include <hip/hip_runtime.h>
#ifndef WQ_I8
#define WQ_I8 1
#endif
#ifndef WOUT_I8
#define WOUT_I8 1
#endif
#ifndef PROJ_I8
#define PROJ_I8 1
#endif
#ifndef GATE_I8
#define GATE_I8 1
#endif
#ifndef FA_STAGGER
#define FA_STAGGER 0
#endif
#ifndef PEER_SLICED
#define PEER_SLICED 1
#ifndef PEER_B_I8
#define PEER_B_I8 1
#endif
#ifndef H16
#define H16 1
#endif
#ifndef PEER_A_I8
#define PEER_A_I8 1
#endif
#endif
#ifndef DUP_PHASE
#define DUP_PHASE 0
#endif
#include <cstdio>
#include <cstdint>

#define GAS __attribute__((address_space(1)))
#define LAS __attribute__((address_space(3)))
typedef unsigned short bf16;
typedef unsigned v4u __attribute__((ext_vector_type(4)));
typedef unsigned v2u __attribute__((ext_vector_type(2)));
typedef float f32x4 __attribute__((ext_vector_type(4)));

constexpr int NB = 8, S = 2048, T = NB * S, D = 2048, DEPTH = 2, HD = 128, PROJ = 6162;
constexpr int NTM = 34, NVT = 14;
constexpr int TM_A_Q = 0, TM_A_K = 6, TM_B_Q = 12, TM_B_KC = 18, TM_B_VC = 20, TM_B_KS = 22, TM_B_KW = 24, TM_C_Q = 26, TM_C_K = 30;
constexpr int VT_A_V = 0, VT_B_VS = 6, VT_B_VW = 8, VT_C_V = 10;
constexpr int GATE_COL0 = 4608;
constexpr int PLE = 256, NEXP = 16384;
constexpr float EPS = 1e-6f;
constexpr float QK_SCALE = 0.08838834764831845f;
#define NEG_INF (-__builtin_inff())

__host__ __device__ constexpr int tm_col0(int s) {
    return s < 6 ? 128 * s : s < 12 ? 768 + 128 * (s - 6) : s < 18 ? 2304 + 128 * (s - 12) : s < 20 ? 3072 + 128 * (s - 18) : s < 22 ? 3328 + 128 * (s - 20)
         : s < 24 ? 3584 + 128 * (s - 22) : s < 26 ? 4096 + 128 * (s - 24) : s < 30 ? 4626 + 128 * (s - 26) : 5138 + 128 * (s - 30);
}
__host__ __device__ constexpr int vt_col0(int v) {
    return v < 6 ? 1536 + 128 * v : v < 8 ? 3840 + 128 * (v - 6) : v < 10 ? 4352 + 128 * (v - 8) : 5650 + 128 * (v - 10);
}

constexpr size_t MiB = 1u << 20;
constexpr size_t align_up(size_t x) { return (x + 255) & ~(size_t)255; }
constexpr size_t WS_CTL = 0, CTL_BYTES = 1 * MiB, CTL_USED_BYTES = 128 * 1024;
constexpr size_t SZ_WINTM = (size_t)NTM * 128 * D * 2, SZ_WINVT = (size_t)NVT * 128 * D * 2, SZ_WSQ = (size_t)D * D * 2, SZ_WPROJ = (size_t)D * PLE * 2;
constexpr size_t WS_WINTM = WS_CTL + CTL_BYTES;
constexpr size_t WS_WINVT = WS_WINTM + DEPTH * SZ_WINTM;
constexpr size_t WS_WOUT = WS_WINVT + DEPTH * SZ_WINVT;
constexpr size_t WS_WQ = WS_WOUT + DEPTH * SZ_WSQ;
constexpr size_t WS_WGATE = WS_WQ + DEPTH * SZ_WSQ;
constexpr size_t WS_WPROJ = WS_WGATE + DEPTH * SZ_WSQ;
constexpr size_t WS_WG = WS_WPROJ + DEPTH * SZ_WPROJ;
constexpr size_t WS_KEYS = align_up(WS_WG + (size_t)DEPTH * 18 * D * 4);
constexpr size_t WS_CWT = WS_KEYS + (size_t)DEPTH * 16 * 128 * 128 * 2;
constexpr size_t WS_U = WS_CWT + (size_t)DEPTH * 2 * 128 * 4096 * 2;
constexpr size_t WS_V = WS_U + (size_t)DEPTH * NEXP * D;
constexpr size_t WS_SU = WS_V + (size_t)DEPTH * NEXP * D;
constexpr size_t WS_SV = WS_SU + (size_t)DEPTH * NEXP * 4;
constexpr size_t WS_P = WS_SV + (size_t)DEPTH * NEXP * 4;
constexpr size_t WS_TM = WS_P + (size_t)DEPTH * T * PLE * 2;
constexpr size_t WS_VT = WS_TM + (size_t)NB * NTM * S * 128 * 2;
constexpr size_t WS_KCMP = WS_VT + (size_t)NB * NVT * S * 128 * 2;
constexpr size_t WS_VCMPT = WS_KCMP + (size_t)NB * 2 * 128 * 128 * 2;
constexpr size_t WS_KMEAN = WS_VCMPT + (size_t)NB * 2 * 128 * 128 * 2;
constexpr size_t WS_GATES = WS_KMEAN + (size_t)NB * 8 * 4 * 128 * 4;
constexpr size_t WS_SS = align_up(WS_GATES + (size_t)T * 18 * 4);
constexpr size_t WS_OCMP = WS_SS + (size_t)T * 16 * 4;
constexpr size_t WS_SEL = WS_OCMP + (size_t)T * 768 * 4;
constexpr size_t WS_EXP = WS_SEL + (size_t)T * 16 * 4;
constexpr size_t WS_GW = WS_EXP + (size_t)T * 128 * 4;
constexpr size_t SZ_ACT = (size_t)T * D * 2;
constexpr size_t WS_ACT0 = WS_GW + (size_t)T * 128 * 4;
constexpr size_t WS_ACT1 = WS_ACT0 + SZ_ACT;
constexpr size_t WS_ACT2 = WS_ACT1 + SZ_ACT;
constexpr size_t WS_ACT3 = WS_ACT2 + SZ_ACT;
constexpr size_t WS_TBL = WS_ACT3 + SZ_ACT;
constexpr size_t WS_PD = WS_TBL + (size_t)16 * 3 * 2304 * 4;
constexpr size_t WS_H16 = WS_PD + (size_t)16 * T * 128 * 2;
constexpr size_t WS_WV = WS_PD + (size_t)16 * T * 128 * 4;
constexpr size_t WS_WG8 = WS_WV + (size_t)T * 128 * 4;
constexpr size_t WS_SWG = WS_WG8 + (size_t)DEPTH * D * D;
constexpr size_t WS_SHN = WS_SWG + (size_t)DEPTH * D * 4;
constexpr size_t WS_WIN8TM = WS_SHN + (size_t)T * 4;
constexpr size_t WS_WIN8VT = WS_WIN8TM + (size_t)DEPTH * NTM * 128 * D;
constexpr size_t WS_SWTM = WS_WIN8VT + (size_t)DEPTH * NVT * 128 * D;
constexpr size_t WS_SWVT = WS_SWTM + (size_t)DEPTH * NTM * 128 * 4;
constexpr size_t WS_SA = WS_SWVT + (size_t)DEPTH * NVT * 128 * 4;
constexpr size_t WS_XF8 = WS_SA + (size_t)T * 4;
constexpr size_t WS_SXF = WS_XF8 + (size_t)T * D;
constexpr size_t WS_WQ8 = WS_SXF + (size_t)T * 4;
constexpr size_t WS_SWQ = WS_WQ8 + (size_t)DEPTH * D * D;
constexpr size_t WS_WO8 = WS_SWQ + (size_t)DEPTH * D * 4;
constexpr size_t WS_SWO = WS_WO8 + (size_t)DEPTH * D * D;
constexpr size_t WS_SY = WS_SWO + (size_t)DEPTH * D * 4;
constexpr size_t WS_POSW = WS_SY + (size_t)T * 4;
constexpr size_t WS_END = WS_POSW + (size_t)DEPTH * 2 * 32 * 128 * 4;
static_assert(!H16 || (WQ_I8 && WOUT_I8 && PROJ_I8 && GATE_I8 && PEER_A_I8 && PEER_SLICED), "the fp16 residual stream is wired into the int8 paths only");
static_assert(WS_END <= (size_t)1024 * MiB, "workspace map exceeds 1 GiB");

__device__ __forceinline__ float bf2f(unsigned v) { return __uint_as_float(v << 16); }
__device__ __forceinline__ unsigned f2bf(float f) { unsigned u = __float_as_uint(f); return (u + 0x7fffu + ((u >> 16) & 1u)) >> 16; }
typedef __bf16 pkbf2_t __attribute__((ext_vector_type(2)));
typedef float pkf2_t __attribute__((ext_vector_type(2)));
__device__ __forceinline__ unsigned pk2(float lo, float hi) { const pkf2_t v = {lo, hi}; return __builtin_bit_cast(unsigned, __builtin_convertvector(v, pkbf2_t)); }
__device__ __forceinline__ unsigned pack_i8x4(float a, float b, float c, float d, float S) {
    const float M = 12582912.0f;
    const unsigned ya = __float_as_uint(__builtin_fmaf(a, S, M)), yb = __float_as_uint(__builtin_fmaf(b, S, M)), yc = __float_as_uint(__builtin_fmaf(c, S, M)), yd = __float_as_uint(__builtin_fmaf(d, S, M));
    return __builtin_amdgcn_perm(yb, ya, 0x0c0c0400u) | __builtin_amdgcn_perm(yd, yc, 0x04000c0cu);
}
typedef _Float16 h4_t __attribute__((ext_vector_type(4)));
typedef _Float16 h2_t __attribute__((ext_vector_type(2)));
__device__ __forceinline__ f32x4 ldh4(const GAS _Float16* p) { const h4_t v = *(const GAS h4_t*)p; return (f32x4){(float)v.x, (float)v.y, (float)v.z, (float)v.w}; }
__device__ __forceinline__ void sth4(GAS _Float16* p, f32x4 v) { *(GAS h4_t*)p = (h4_t){(_Float16)v.x, (_Float16)v.y, (_Float16)v.z, (_Float16)v.w}; }
template <bool SRC16> __device__ __forceinline__ f32x4 ldrow4(const void* base, size_t idx) { if (SRC16) return ldh4((const GAS _Float16*)base + idx); return *(const GAS f32x4*)((const GAS float*)base + idx); }
template <int M> __device__ __forceinline__ int swz_xor_i(int v) { return __builtin_amdgcn_ds_swizzle(v, (M << 10) | 0x1F); }
template <int M> __device__ __forceinline__ float swz_xor(float v) { return __builtin_bit_cast(float, swz_xor_i<M>(__builtin_bit_cast(int, v))); }
__device__ __forceinline__ void halves_i(int v, int& lo, int& hi) { const auto pr = __builtin_amdgcn_permlane32_swap((unsigned)v, (unsigned)v, false, false); lo = (int)pr[0]; hi = (int)pr[1]; }
__device__ __forceinline__ void halves(float v, float& lo, float& hi) { int a, b; halves_i(__builtin_bit_cast(int, v), a, b); lo = __builtin_bit_cast(float, a); hi = __builtin_bit_cast(float, b); }
__device__ __forceinline__ float wave_sum(float v) {
    v += swz_xor<1>(v); v += swz_xor<2>(v); v += swz_xor<4>(v); v += swz_xor<8>(v); v += swz_xor<16>(v);
    float lo, hi; halves(v, lo, hi); return lo + hi;
}
__device__ __forceinline__ float wave_max(float v) {
    v = fmaxf(v, swz_xor<1>(v)); v = fmaxf(v, swz_xor<2>(v)); v = fmaxf(v, swz_xor<4>(v)); v = fmaxf(v, swz_xor<8>(v)); v = fmaxf(v, swz_xor<16>(v));
    float lo, hi; halves(v, lo, hi); return fmaxf(lo, hi);
}
__device__ __forceinline__ int wave_min_i(int v) {
    int t;
    t = swz_xor_i<1>(v); v = t < v ? t : v; t = swz_xor_i<2>(v); v = t < v ? t : v; t = swz_xor_i<4>(v); v = t < v ? t : v; t = swz_xor_i<8>(v); v = t < v ? t : v; t = swz_xor_i<16>(v); v = t < v ? t : v;
    int lo, hi; halves_i(v, lo, hi); return lo < hi ? lo : hi;
}
__device__ __forceinline__ unsigned wave_or(unsigned v) {
    int x = (int)v; x |= swz_xor_i<1>(x); x |= swz_xor_i<2>(x); x |= swz_xor_i<4>(x); x |= swz_xor_i<8>(x); x |= swz_xor_i<16>(x);
    int lo, hi; halves_i(x, lo, hi); return (unsigned)(lo | hi);
}
__device__ __forceinline__ float lane_get(float v, int src) { return __builtin_bit_cast(float, __builtin_amdgcn_ds_bpermute(src << 2, __builtin_bit_cast(int, v))); }
__device__ __forceinline__ int lane_get_i(int v, int src) { return __builtin_amdgcn_ds_bpermute(src << 2, v); }
__device__ __forceinline__ int rel_bucket(int d) {
    if (d < 16) return d < 0 ? 0 : d;
    return 16 + (d >= 21) + (d >= 27) + (d >= 35) + (d >= 46) + (d >= 59) + (d >= 77) + (d >= 99) + (d >= 128) + (d >= 166) + (d >= 216) + (d >= 280) + (d >= 363) + (d >= 470) + (d >= 609) + (d >= 790);
}
#define WAVE_LDS_SYNC() do { asm volatile("s_waitcnt lgkmcnt(0)" ::: "memory"); __builtin_amdgcn_wave_barrier(); } while (0)

struct Params {
    const float* in[19];
    float* out;
    unsigned char* ws;
};
__device__ __forceinline__ int launder_i(int v) { asm volatile("" : "+v"(v)); return v; }
__device__ __forceinline__ int launder_s(int v) { asm volatile("" : "+s"(v)); return v; }
template <class Tp> __device__ __forceinline__ Tp* launder_p(Tp* p) { asm volatile("" : "+s"(p)); return p; }
__device__ __forceinline__ Params fresh(const Params& P) { Params Q;
#pragma unroll
    for (int i = 0; i < 19; ++i) Q.in[i] = launder_p(P.in[i]);
    Q.out = launder_p(P.out); Q.ws = launder_p(P.ws); return Q; }
#define TID() launder_i((int)threadIdx.x)
enum { I_X = 0, I_P, I_LNMIX, I_WIN, I_CMPWK, I_CMPWV, I_CMPPOS, I_OUTNORM, I_WOUT, I_RELBIAS, I_LNFFN, I_PEERWQ, I_PEERKEYS, I_PEERU, I_PEERV, I_LNPLE, I_PLEGATE, I_PLEPROJ, I_LNFINAL };

__device__ __forceinline__ void transpose_tile(const float* src, int ldsrc, int scol0, int k0, bf16* dst, int dstride, int drow0, const float* scale, LAS float* scr, int lane) {
    const bool al16 = ((scol0 & 3) == 0) && ((ldsrc & 3) == 0);
    if (al16) {
#pragma unroll
        for (int i = 0; i < 8; ++i) { const int kk = 8 * i + (lane >> 3), c4 = (lane & 7) * 4; f32x4 v = *(const GAS f32x4*)((const GAS float*)src + (size_t)(k0 + kk) * ldsrc + scol0 + c4);
            if (scale) { const float sc_ = scale[k0 + kk]; v = v * sc_; }
            scr[kk * 33 + c4] = v.x; scr[kk * 33 + c4 + 1] = v.y; scr[kk * 33 + c4 + 2] = v.z; scr[kk * 33 + c4 + 3] = v.w; }
    } else if (((scol0 | ldsrc) & 1) == 0) {
        typedef float f32x2 __attribute__((ext_vector_type(2)));
#pragma unroll
        for (int i = 0; i < 16; ++i) { const int kk = 4 * i + (lane >> 4), c2 = (lane & 15) * 2; f32x2 v = *(const GAS f32x2*)((const GAS float*)src + (size_t)(k0 + kk) * ldsrc + scol0 + c2);
            if (scale) { const float sc_ = scale[k0 + kk]; v = v * sc_; }
            scr[kk * 33 + c2] = v.x; scr[kk * 33 + c2 + 1] = v.y; }
    } else {
#pragma unroll 8
        for (int i = 0; i < 32; ++i) { const int kk = 2 * i + (lane >> 5); float v = src[(size_t)(k0 + kk) * ldsrc + scol0 + (lane & 31)]; if (scale) v *= scale[k0 + kk]; scr[kk * 33 + (lane & 31)] = v; }
    }
    WAVE_LDS_SYNC();
    const int c = lane & 7;
#pragma unroll
    for (int j = 0; j < 4; ++j) { const int n = (lane >> 3) + 8 * j; const LAS float* s = scr + (8 * c) * 33 + n;
        v4u o; o.x = pk2(s[0 * 33], s[1 * 33]); o.y = pk2(s[2 * 33], s[3 * 33]); o.z = pk2(s[4 * 33], s[5 * 33]); o.w = pk2(s[6 * 33], s[7 * 33]);
        *(v4u*)(dst + (size_t)(drow0 + n) * dstride + k0 + 8 * c) = o; }
    WAVE_LDS_SYNC();
}
constexpr int TL_TM = 32 * NTM * 4, TL_VT = 32 * NVT * 4, TL_SQ = 32 * 64, TL_PROJ = 4 * 64, TL_CW = 64 * 4;
constexpr int TL_LAYER = TL_TM + TL_VT + 3 * TL_SQ + TL_PROJ + 2 * TL_CW;
__device__ __forceinline__ void prologue_tile(const Params& P, int item, LAS float* scr, int lane) {
    const int l = item / TL_LAYER; int r = item % TL_LAYER;
    unsigned char* ws = P.ws;
    if (r < TL_TM) { const int nb = r / 32, kb = r % 32, slot = nb / 4, sub = nb % 4;
        transpose_tile(P.in[I_WIN] + (size_t)l * D * PROJ, PROJ, tm_col0(slot) + 32 * sub, 64 * kb, (bf16*)(ws + WS_WINTM) + (size_t)l * NTM * 128 * D, D, slot * 128 + 32 * sub, nullptr, scr, lane); return; }
    r -= TL_TM;
    if (r < TL_VT) { const int nb = r / 32, kb = r % 32, slot = nb / 4, sub = nb % 4;
        transpose_tile(P.in[I_WIN] + (size_t)l * D * PROJ, PROJ, vt_col0(slot) + 32 * sub, 64 * kb, (bf16*)(ws + WS_WINVT) + (size_t)l * NVT * 128 * D, D, slot * 128 + 32 * sub, nullptr, scr, lane); return; }
    r -= TL_VT;
    if (r < TL_SQ) { const int nb = r / 32, kb = r % 32;
        transpose_tile(P.in[I_WOUT] + (size_t)l * D * D, D, 32 * nb, 64 * kb, (bf16*)(ws + WS_WOUT) + (size_t)l * D * D, D, 32 * nb, P.in[I_OUTNORM] + (size_t)l * D, scr, lane); return; }
    r -= TL_SQ;
    if (r < TL_SQ) { const int nb = r / 32, kb = r % 32;
        transpose_tile(P.in[I_PEERWQ] + (size_t)l * D * D, D, 32 * nb, 64 * kb, (bf16*)(ws + WS_WQ) + (size_t)l * D * D, D, 32 * nb, nullptr, scr, lane); return; }
    r -= TL_SQ;
    if (r < TL_SQ) { const int nb = r / 32, kb = r % 32;
        transpose_tile(P.in[I_PLEGATE] + (size_t)l * D * D, D, 32 * nb, 64 * kb, (bf16*)(ws + WS_WGATE) + (size_t)l * D * D, D, 32 * nb, nullptr, scr, lane); return; }
    r -= TL_SQ;
    if (r < TL_PROJ) { const int nb = r / 4, kb = r % 4;
        transpose_tile(P.in[I_PLEPROJ] + (size_t)l * PLE * D, D, 32 * nb, 64 * kb, (bf16*)(ws + WS_WPROJ) + (size_t)l * D * PLE, PLE, 32 * nb, nullptr, scr, lane); return; }
    r -= TL_PROJ;
    { const int which = r / TL_CW; r %= TL_CW; const int nb = r / 64, kb = r % 64;
      transpose_tile((which ? P.in[I_CMPWV] : P.in[I_CMPWK]) + (size_t)l * 4096 * 128, 128, 32 * nb, 64 * kb, (bf16*)(ws + WS_CWT) + ((size_t)l * 2 + which) * 128 * 4096, 4096, 32 * nb, nullptr, scr, lane); }
}
__device__ __forceinline__ void cvt_f32_bf16(const float* src, bf16* dst, size_t n, size_t i0, size_t stride) {
    for (size_t i = i0 * 8; i < n; i += stride * 8) {
        const f32x4 a = *(const f32x4*)(src + i), b = *(const f32x4*)(src + i + 4);
        v4u o; o.x = pk2(a.x, a.y); o.y = pk2(a.z, a.w); o.z = pk2(b.x, b.y); o.w = pk2(b.z, b.w);
        *(v4u*)(dst + i) = o;
    }
}
__device__ __forceinline__ void phase_prologue(const Params& P, int bid, int nb, LAS unsigned char* lds) {
    const int tid = TID(), lane = tid & 63, wave = tid >> 6, nw = 8;
    LAS float* scr = (LAS float*)lds + wave * (64 * 33);
    for (int it = bid * nw + wave; it < DEPTH * TL_LAYER; it += nb * nw) prologue_tile(P, it, scr, lane);
    const size_t gi = (size_t)bid * 512 + tid, gs = (size_t)nb * 512;
    for (int row0 = (bid * nw + wave) * 2; row0 < 2 * DEPTH * NEXP; row0 += nb * nw * 2) {
        f32x4 v[2][2][4]; float am[2] = {0.f, 0.f};
#pragma unroll
        for (int u = 0; u < 2; ++u) { const int row = row0 + u; const int isv = row >= DEPTH * NEXP, rr = isv ? row - DEPTH * NEXP : row;
            const GAS float* src = (const GAS float*)(isv ? P.in[I_PEERV] : P.in[I_PEERU]) + (size_t)rr * D + lane * 16;
#pragma unroll
            for (int j = 0; j < 2; ++j)
#pragma unroll
                for (int q = 0; q < 4; ++q) v[u][j][q] = *(const GAS f32x4*)(src + j * 1024 + q * 4); }
#pragma unroll
        for (int u = 0; u < 2; ++u) { const int row = row0 + u; const int isv = row >= DEPTH * NEXP, rr = isv ? row - DEPTH * NEXP : row;
#pragma unroll
            for (int j = 0; j < 2; ++j)
#pragma unroll
                for (int q = 0; q < 4; ++q) am[u] = fmaxf(am[u], fmaxf(fmaxf(fabsf(v[u][j][q].x), fabsf(v[u][j][q].y)), fmaxf(fabsf(v[u][j][q].z), fabsf(v[u][j][q].w))));
            am[u] = wave_max(am[u]); const bool i8row = (PEER_A_I8 && !isv) || (PEER_B_I8 && isv); const float sc = am[u] > 0.f ? am[u] * (i8row ? 1.0f / 127.0f : 1.0f / 240.0f) : 1.0f, inv = 1.0f / sc;
            const int lyr = rr >= NEXP, ee = rr & (NEXP - 1);
            GAS unsigned char* dstb = (GAS unsigned char*)(P.ws + (isv ? WS_V : WS_U)) + (size_t)lyr * NEXP * D + (size_t)ee * 128;
#pragma unroll
            for (int j = 0; j < 2; ++j) { v4u o; int w;
                if (i8row) { o.x = pack_i8x4(v[u][j][0].x, v[u][j][0].y, v[u][j][0].z, v[u][j][0].w, inv); o.y = pack_i8x4(v[u][j][1].x, v[u][j][1].y, v[u][j][1].z, v[u][j][1].w, inv);
                             o.z = pack_i8x4(v[u][j][2].x, v[u][j][2].y, v[u][j][2].z, v[u][j][2].w, inv); o.w = pack_i8x4(v[u][j][3].x, v[u][j][3].y, v[u][j][3].z, v[u][j][3].w, inv); } else {
                w = __builtin_amdgcn_cvt_pk_fp8_f32(v[u][j][0].x * inv, v[u][j][0].y * inv, 0, false); w = __builtin_amdgcn_cvt_pk_fp8_f32(v[u][j][0].z * inv, v[u][j][0].w * inv, w, true); o.x = (unsigned)w;
                w = __builtin_amdgcn_cvt_pk_fp8_f32(v[u][j][1].x * inv, v[u][j][1].y * inv, 0, false); w = __builtin_amdgcn_cvt_pk_fp8_f32(v[u][j][1].z * inv, v[u][j][1].w * inv, w, true); o.y = (unsigned)w;
                w = __builtin_amdgcn_cvt_pk_fp8_f32(v[u][j][2].x * inv, v[u][j][2].y * inv, 0, false); w = __builtin_amdgcn_cvt_pk_fp8_f32(v[u][j][2].z * inv, v[u][j][2].w * inv, w, true); o.z = (unsigned)w;
                w = __builtin_amdgcn_cvt_pk_fp8_f32(v[u][j][3].x * inv, v[u][j][3].y * inv, 0, false); w = __builtin_amdgcn_cvt_pk_fp8_f32(v[u][j][3].z * inv, v[u][j][3].w * inv, w, true); o.w = (unsigned)w; }
#if PEER_SLICED
                { const int qc = lane + 64 * j; *(GAS v4u*)(dstb + (size_t)(qc >> 3) * NEXP * 128 + (qc & 7) * 16) = o; }
#else
                *(GAS v4u*)((GAS unsigned char*)(P.ws + (isv ? WS_V : WS_U)) + (size_t)rr * D + lane * 16 + j * 1024) = o;
#endif
            }
            if (lane == 0) ((GAS float*)(P.ws + (isv ? WS_SV : WS_SU)))[rr] = sc; }
    }
    cvt_f32_bf16(P.in[I_P], (bf16*)(P.ws + WS_P), (size_t)DEPTH * T * PLE, gi, gs);
    cvt_f32_bf16(P.in[I_PEERKEYS], (bf16*)(P.ws + WS_KEYS), (size_t)DEPTH * 16 * 128 * 128, gi, gs);
    bf16* wg = (bf16*)(P.ws + WS_WG);
    for (size_t i = gi; i < (size_t)DEPTH * 18 * D; i += gs) { const int l = (int)(i / (18 * D)), j = (int)((i / D) % 18), k = (int)(i % D); wg[i] = (bf16)f2bf(P.in[I_WIN][(size_t)l * D * PROJ + (size_t)k * PROJ + GATE_COL0 + j]); }
    float* tbl = (float*)(P.ws + WS_TBL);
    for (size_t i = gi; i < (size_t)16 * 3 * 2304; i += gs) { const int idx = (int)(i % 2304), kind = (int)((i / 2304) % 3), gh = (int)(i / (3 * 2304)); const int d = idx - 256; float v = -2e30f;
        if (d >= 0) { const float bias = P.in[I_RELBIAS][rel_bucket(d) * 16 + gh] * 1.4426950408889634f;
            if (kind == 0) v = bias;
            else if (kind == 1) { if (d <= 511) v = bias; }
            else { const int mult = (d <= 128 ? 1 : 0) + ((d & 3) == 0 && d <= 512 ? 1 : 0) + ((d & 15) == 0 ? 1 : 0); if (mult > 0) v = bias + (mult == 1 ? 0.f : mult == 2 ? 1.0f : 1.5849625007211562f); } }
        tbl[i] = v; }
    __syncthreads();
    { LAS float* red = (LAS float*)lds;
      for (int item = bid; item < DEPTH * 2 * 32; item += nb) { const int l = item >> 6, which = (item >> 5) & 1, kc = item & 31, e = tid & 127, kq = tid >> 7;
          const GAS float* w = (const GAS float*)(which ? P.in[I_CMPWV] : P.in[I_CMPWK]) + ((size_t)l * 4096 + kc * 128 + kq * 32) * 128 + e; const GAS float* pos = (const GAS float*)P.in[I_CMPPOS] + (size_t)l * 4096 + kc * 128 + kq * 32;
          float a = 0.f;
#pragma unroll 8
          for (int j = 0; j < 32; ++j) a = __builtin_fmaf(pos[j], w[(size_t)j * 128], a);
          red[tid] = a; __syncthreads();
          if (tid < 128) ((GAS float*)(P.ws + WS_POSW))[(size_t)item * 128 + tid] = (red[tid] + red[128 + tid]) + (red[256 + tid] + red[384 + tid]);
          __syncthreads(); } }
}

__device__ __forceinline__ float row_load_ss(const float* row, int lane, f32x4 (&v)[8]) {
    float s = 0.f;
#pragma unroll
    for (int j = 0; j < 8; ++j) { v[j] = *(const f32x4*)(row + (j * 64 + lane) * 4); s += v[j].x * v[j].x + v[j].y * v[j].y + v[j].z * v[j].z + v[j].w * v[j].w; }
    return wave_sum(s);
}
__device__ __forceinline__ void row_norm_store_bf16(f32x4 (&v)[8], float ss, const float* gain, bf16* orow, int lane, unsigned char* o8 = nullptr, float* sc8 = nullptr) {
    const float r = 1.0f / sqrtf(ss * (1.0f / D) + EPS); float am = 0.f;
#pragma unroll
    for (int j = 0; j < 8; ++j) { const f32x4 g = *(const f32x4*)(gain + (j * 64 + lane) * 4); v[j] = v[j] * r * g; am = fmaxf(am, fmaxf(fmaxf(fabsf(v[j].x), fabsf(v[j].y)), fmaxf(fabsf(v[j].z), fabsf(v[j].w))));
        if (orow) { v2u o; o.x = pk2(v[j].x, v[j].y); o.y = pk2(v[j].z, v[j].w); *(v2u*)(orow + (j * 64 + lane) * 4) = o; } }
    if (o8) { am = wave_max(am); const float S8 = am > 0.f ? 127.0f / am : 0.f;
#pragma unroll
        for (int j = 0; j < 8; ++j) *(GAS unsigned*)((GAS unsigned char*)o8 + (j * 64 + lane) * 4) = pack_i8x4(v[j].x, v[j].y, v[j].z, v[j].w, S8);
        if (lane == 0) *sc8 = am * (1.0f / 127.0f); }
}
typedef __bf16 bf2g_t __attribute__((ext_vector_type(2)));
__device__ __forceinline__ float dot2g(unsigned a, unsigned b, float c) { return __builtin_amdgcn_fdot2_f32_bf16(__builtin_bit_cast(bf2g_t, a), __builtin_bit_cast(bf2g_t, b), c, false); }
__device__ __forceinline__ void quant_all_rows(const Params& P, int l, int bid, int nb);
#if H16
__device__ __forceinline__ void phase_norm_mix(const Params& P, int l, int bid, int nb, LAS unsigned char* lds) {
    const int tid = TID(), lane = tid & 63, wave = tid >> 6, nw = 8;
    const GAS float* xsrc = (const GAS float*)P.in[I_X]; const GAS _Float16* hsrc = (const GAS _Float16*)(P.ws + WS_H16);
    GAS unsigned char* a8 = (GAS unsigned char*)(P.ws + WS_ACT0); GAS float* gates = (GAS float*)(P.ws + WS_GATES); GAS float* sa = (GAS float*)(P.ws + WS_SA);
    const GAS float* gain = (const GAS float*)P.in[I_LNMIX] + (size_t)l * D;
    { const GAS v4u* wsrc = (const GAS v4u*)((const GAS bf16*)(P.ws + WS_WG) + (size_t)l * 18 * D); LAS v4u* wl = (LAS v4u*)lds;
      v4u stg[9];
#pragma unroll
      for (int i = 0; i < 9; ++i) stg[i] = wsrc[tid + 512 * i];
      quant_all_rows(P, l, bid, nb);
#pragma unroll
      for (int i = 0; i < 9; ++i) wl[tid + 512 * i] = stg[i]; }
    __syncthreads();
    const LAS v2u* wl2 = (const LAS v2u*)lds;
    const int step = nb * nw;
    for (int t0 = bid * nw + wave; t0 < T; t0 += 4 * step) {
        v2u ab[4][8];
#pragma unroll
        for (int pr = 0; pr < 2; ++pr) {
            f32x4 v[2][8]; float ss[2] = {0.f, 0.f};
#pragma unroll
            for (int u = 0; u < 2; ++u) { const int t = t0 + (2 * pr + u) * step; const size_t tt = t < T ? t : t0;
                if (l == 0) {
#pragma unroll
                    for (int j = 0; j < 8; ++j) v[u][j] = *(const GAS f32x4*)(xsrc + tt * D + (j * 64 + lane) * 4);
                } else {
#pragma unroll
                    for (int j = 0; j < 8; ++j) v[u][j] = ldh4(hsrc + tt * D + (j * 64 + lane) * 4);
                } }
#pragma unroll
            for (int u = 0; u < 2; ++u) {
#pragma unroll
                for (int j = 0; j < 8; ++j) ss[u] += v[u][j].x * v[u][j].x + v[u][j].y * v[u][j].y + v[u][j].z * v[u][j].z + v[u][j].w * v[u][j].w;
                ss[u] = wave_sum(ss[u]); }
#pragma unroll
            for (int u = 0; u < 2; ++u) { const int t = t0 + (2 * pr + u) * step; const float r = 1.0f / sqrtf(ss[u] * (1.0f / D) + EPS); float am = 0.f;
#pragma unroll
                for (int j = 0; j < 8; ++j) { const f32x4 g = *(const GAS f32x4*)(gain + (j * 64 + lane) * 4); v[u][j] = v[u][j] * r * g;
                    ab[2 * pr + u][j].x = pk2(v[u][j].x, v[u][j].y); ab[2 * pr + u][j].y = pk2(v[u][j].z, v[u][j].w);
                    am = fmaxf(am, fmaxf(fmaxf(fabsf(v[u][j].x), fabsf(v[u][j].y)), fmaxf(fabsf(v[u][j].z), fabsf(v[u][j].w)))); }
                am = wave_max(am); const float S8 = am > 0.f ? 127.0f / am : 0.f;
                if (t < T) {
#pragma unroll
                    for (int j = 0; j < 8; ++j) *(GAS unsigned*)(a8 + (size_t)t * D + (j * 64 + lane) * 4) = pack_i8x4(v[u][j].x, v[u][j].y, v[u][j].z, v[u][j].w, S8);
                    if (lane == 0) sa[t] = am * (1.0f / 127.0f); } }
        }
        const int trow = t0 + (lane >> 4) * step;
#pragma unroll 2
        for (int c = 0; c < 18; ++c) { float s0 = 0.f, s1 = 0.f, s2 = 0.f, s3 = 0.f;
#pragma unroll
            for (int j = 0; j < 8; ++j) { const v2u w = wl2[c * (D / 4) + j * 64 + lane];
                s0 = dot2g(ab[0][j].x, w.x, s0); s0 = dot2g(ab[0][j].y, w.y, s0); s1 = dot2g(ab[1][j].x, w.x, s1); s1 = dot2g(ab[1][j].y, w.y, s1);
                s2 = dot2g(ab[2][j].x, w.x, s2); s2 = dot2g(ab[2][j].y, w.y, s2); s3 = dot2g(ab[3][j].x, w.x, s3); s3 = dot2g(ab[3][j].y, w.y, s3); }
            const auto p02 = __builtin_amdgcn_permlane32_swap(__builtin_bit_cast(unsigned, s0), __builtin_bit_cast(unsigned, s2), false, false);
            const auto p13 = __builtin_amdgcn_permlane32_swap(__builtin_bit_cast(unsigned, s1), __builtin_bit_cast(unsigned, s3), false, false);
            const float x0 = __builtin_bit_cast(float, (unsigned)p02[0]) + __builtin_bit_cast(float, (unsigned)p02[1]), x1 = __builtin_bit_cast(float, (unsigned)p13[0]) + __builtin_bit_cast(float, (unsigned)p13[1]);
            const auto q = __builtin_amdgcn_permlane16_swap(__builtin_bit_cast(unsigned, x0), __builtin_bit_cast(unsigned, x1), false, false);
            float y = __builtin_bit_cast(float, (unsigned)q[0]) + __builtin_bit_cast(float, (unsigned)q[1]);
            y += swz_xor<8>(y); y += swz_xor<4>(y); y += swz_xor<2>(y); y += swz_xor<1>(y);
            if ((lane & 15) == 0 && trow < T) gates[(size_t)trow * 18 + c] = 1.0f / (1.0f + __expf(-y)); }
    }
    __syncthreads();
}
#else
__device__ __forceinline__ void phase_norm_mix(const Params& P, int l, int bid, int nb, LAS unsigned char* lds) {
    const int tid = TID(), lane = tid & 63, wave = tid >> 6, nw = 8;
    const float* hsrc = l == 0 ? P.in[I_X] : P.out;
    bf16* a = (bf16*)(P.ws + WS_ACT0); float* gates = (float*)(P.ws + WS_GATES);
    { const GAS v4u* wsrc = (const GAS v4u*)((const GAS bf16*)(P.ws + WS_WG) + (size_t)l * 18 * D); LAS v4u* wl = (LAS v4u*)lds;
      for (int i = tid; i < 18 * D / 8; i += 512) wl[i] = wsrc[i]; }
    __syncthreads();
    const LAS v2u* wl2 = (const LAS v2u*)lds;
    for (int t = bid * nw + wave; t < T; t += nb * nw) {
        f32x4 v[8]; float ss;
#if H16
        if (l == 0) ss = row_load_ss(hsrc + (size_t)t * D, lane, v);
        else { float s_ = 0.f;
#pragma unroll
            for (int j = 0; j < 8; ++j) { v[j] = ldh4((const GAS _Float16*)(P.ws + WS_H16) + (size_t)t * D + (j * 64 + lane) * 4); s_ += v[j].x * v[j].x + v[j].y * v[j].y + v[j].z * v[j].z + v[j].w * v[j].w; }
            ss = wave_sum(s_); }
#else
        ss = row_load_ss(hsrc + (size_t)t * D, lane, v);
#endif
        const float r = 1.0f / sqrtf(ss * (1.0f / D) + EPS); v2u ab[8];
#pragma unroll
        for (int j = 0; j < 8; ++j) { const f32x4 g = *(const f32x4*)(P.in[I_LNMIX] + (size_t)l * D + (j * 64 + lane) * 4); v[j] = v[j] * r * g;
            ab[j].x = pk2(v[j].x, v[j].y); ab[j].y = pk2(v[j].z, v[j].w);
#if !PROJ_I8
            *(v2u*)(a + (size_t)t * D + (j * 64 + lane) * 4) = ab[j];
#endif
        }
#if PROJ_I8
        { float am = 0.f;
#pragma unroll
          for (int j = 0; j < 8; ++j) am = fmaxf(am, fmaxf(fmaxf(fabsf(v[j].x), fabsf(v[j].y)), fmaxf(fabsf(v[j].z), fabsf(v[j].w))));
          am = wave_max(am); const float S8 = am > 0.f ? 127.0f / am : 0.f;
#pragma unroll
          for (int j = 0; j < 8; ++j) *(GAS unsigned*)((GAS unsigned char*)a + (size_t)t * D + (j * 64 + lane) * 4) = pack_i8x4(v[j].x, v[j].y, v[j].z, v[j].w, S8);
          if (lane == 0) ((GAS float*)(P.ws + WS_SA))[t] = am * (1.0f / 127.0f); }
#endif
#pragma unroll 2
        for (int c = 0; c < 18; ++c) { float sacc = 0.f;
#pragma unroll
            for (int j = 0; j < 8; ++j) { const v2u w = wl2[c * (D / 4) + j * 64 + lane]; sacc = dot2g(ab[j].x, w.x, sacc); sacc = dot2g(ab[j].y, w.y, sacc); }
            const float sv_ = wave_sum(sacc); if (lane == 0) gates[(size_t)t * 18 + c] = 1.0f / (1.0f + __expf(-sv_)); }
    }
    __syncthreads();
}
#endif
template <bool SRC16 = false>
__device__ __forceinline__ void phase_norm(const void* src, const float* gain, bf16* dst, int bid, int nb, unsigned char* d8 = nullptr, float* s8 = nullptr) {
    const int tid = TID(), lane = tid & 63, wave = tid >> 6, nw = 8;
    const int step = nb * nw;
    int t = bid * nw + wave;
    if constexpr (SRC16) {
        for (; t + 7 * step < T; t += 8 * step) { h4_t raw[8][8];
#pragma unroll
            for (int i = 0; i < 8; ++i)
#pragma unroll
                for (int j = 0; j < 8; ++j) raw[i][j] = *(const GAS h4_t*)((const GAS _Float16*)src + (size_t)(t + i * step) * D + (j * 64 + lane) * 4);
#pragma unroll
            for (int i = 0; i < 8; ++i) { f32x4 v[8]; float s_ = 0.f; const size_t tt = (size_t)(t + i * step);
#pragma unroll
                for (int j = 0; j < 8; ++j) { v[j] = (f32x4){(float)raw[i][j].x, (float)raw[i][j].y, (float)raw[i][j].z, (float)raw[i][j].w}; s_ += v[j].x * v[j].x + v[j].y * v[j].y + v[j].z * v[j].z + v[j].w * v[j].w; }
                row_norm_store_bf16(v, wave_sum(s_), gain, dst ? dst + tt * D : nullptr, lane, d8 ? d8 + tt * D : nullptr, s8 + tt); } }
    }
    for (; t + step < T; t += 2 * step) { f32x4 v0[8], v1[8];
#pragma unroll
        for (int j = 0; j < 8; ++j) { v0[j] = ldrow4<SRC16>(src, (size_t)t * D + (j * 64 + lane) * 4); v1[j] = ldrow4<SRC16>(src, (size_t)(t + step) * D + (j * 64 + lane) * 4); }
        float s0 = 0.f, s1 = 0.f;
#pragma unroll
        for (int j = 0; j < 8; ++j) { s0 += v0[j].x * v0[j].x + v0[j].y * v0[j].y + v0[j].z * v0[j].z + v0[j].w * v0[j].w; s1 += v1[j].x * v1[j].x + v1[j].y * v1[j].y + v1[j].z * v1[j].z + v1[j].w * v1[j].w; }
        s0 = wave_sum(s0); s1 = wave_sum(s1);
        row_norm_store_bf16(v0, s0, gain, dst ? dst + (size_t)t * D : nullptr, lane, d8 ? d8 + (size_t)t * D : nullptr, s8 + t); row_norm_store_bf16(v1, s1, gain, dst ? dst + (size_t)(t + step) * D : nullptr, lane, d8 ? d8 + (size_t)(t + step) * D : nullptr, s8 + t + step); }
    for (; t < T; t += step) { f32x4 v[8]; float s_ = 0.f;
#pragma unroll
        for (int j = 0; j < 8; ++j) { v[j] = ldrow4<SRC16>(src, (size_t)t * D + (j * 64 + lane) * 4); s_ += v[j].x * v[j].x + v[j].y * v[j].y + v[j].z * v[j].z + v[j].w * v[j].w; }
        row_norm_store_bf16(v, wave_sum(s_), gain, dst ? dst + (size_t)t * D : nullptr, lane, d8 ? d8 + (size_t)t * D : nullptr, s8 + t); }
}
__device__ __forceinline__ void phase_final(const Params& P, int bid, int nb) {
    const int tid = TID(), lane = tid & 63, wave = tid >> 6, nw = 8;
    const int step = nb * nw; int t = bid * nw + wave;
    for (; t + step < T; t += 2 * step) { f32x4 v0[8], v1[8]; GAS float* r0p = (GAS float*)P.out + (size_t)t * D; GAS float* r1p = (GAS float*)P.out + (size_t)(t + step) * D;
#pragma unroll
        for (int j = 0; j < 8; ++j) {
#if H16
            v0[j] = ldh4((const GAS _Float16*)(P.ws + WS_H16) + (size_t)t * D + (j * 64 + lane) * 4); v1[j] = ldh4((const GAS _Float16*)(P.ws + WS_H16) + (size_t)(t + step) * D + (j * 64 + lane) * 4);
#else
            v0[j] = *(const GAS f32x4*)(r0p + (j * 64 + lane) * 4); v1[j] = *(const GAS f32x4*)(r1p + (j * 64 + lane) * 4);
#endif
        }
        float s0 = 0.f, s1 = 0.f;
#pragma unroll
        for (int j = 0; j < 8; ++j) { s0 += v0[j].x * v0[j].x + v0[j].y * v0[j].y + v0[j].z * v0[j].z + v0[j].w * v0[j].w; s1 += v1[j].x * v1[j].x + v1[j].y * v1[j].y + v1[j].z * v1[j].z + v1[j].w * v1[j].w; }
        s0 = wave_sum(s0); s1 = wave_sum(s1);
        const float q0 = 1.0f / sqrtf(s0 * (1.0f / D) + EPS), q1 = 1.0f / sqrtf(s1 * (1.0f / D) + EPS);
#pragma unroll
        for (int j = 0; j < 8; ++j) { const f32x4 g = *(const f32x4*)(P.in[I_LNFINAL] + (j * 64 + lane) * 4); *(GAS f32x4*)(r0p + (j * 64 + lane) * 4) = v0[j] * q0 * g; *(GAS f32x4*)(r1p + (j * 64 + lane) * 4) = v1[j] * q1 * g; } }
    for (; t < T; t += step) { f32x4 v[8]; float* row = P.out + (size_t)t * D;
#if H16
        float s_ = 0.f;
#pragma unroll
        for (int j = 0; j < 8; ++j) { v[j] = ldh4((const GAS _Float16*)(P.ws + WS_H16) + (size_t)t * D + (j * 64 + lane) * 4); s_ += v[j].x * v[j].x + v[j].y * v[j].y + v[j].z * v[j].z + v[j].w * v[j].w; }
        const float ss = wave_sum(s_);
#else
        const float ss = row_load_ss(row, lane, v);
#endif
        const float r = 1.0f / sqrtf(ss * (1.0f / D) + EPS);
#pragma unroll
        for (int j = 0; j < 8; ++j) { const f32x4 g = *(const f32x4*)(P.in[I_LNFINAL] + (j * 64 + lane) * 4); *(f32x4*)(row + (j * 64 + lane) * 4) = v[j] * r * g; } }
}
__device__ __forceinline__ void phase_ynorm(const Params& P, int bid, int nb) {
    const int tid = TID(), lane = tid & 63, wave = tid >> 6, nw = 8;
    const GAS bf16* o = (const GAS bf16*)(P.ws + WS_ACT1); GAS bf16* y = (GAS bf16*)(P.ws + WS_ACT2); const GAS float* ss = (const GAS float*)(P.ws + WS_SS);
    const int step = nb * nw;
    for (int t0 = bid * nw + wave; t0 < T; t0 += 2 * step) {
        v4u w[2][4]; float sv[2];
#pragma unroll
        for (int u = 0; u < 2; ++u) { const int t = t0 + u * step; const bool ok = t < T; const size_t tt = ok ? t : t0;
            sv[u] = lane < 16 ? ss[tt * 16 + lane] : 0.f;
#pragma unroll
            for (int j = 0; j < 4; ++j) w[u][j] = *(const GAS v4u*)(o + tt * D + (j * 64 + lane) * 8); }
#pragma unroll
        for (int u = 0; u < 2; ++u) { const int t = t0 + u * step; if (t >= T) break;
            float sa = lane < 6 ? sv[u] : 0.f, sb = (lane >= 6 && lane < 12) ? sv[u] : 0.f, sc = (lane >= 12 && lane < 16) ? sv[u] : 0.f;
            sa = wave_sum(sa); sb = wave_sum(sb); sc = wave_sum(sc);
            const float ra = 1.0f / sqrtf(sa * (1.0f / 768.f) + EPS), rb = 1.0f / sqrtf(sb * (1.0f / 768.f) + EPS), rc = 1.0f / sqrtf(sc * (1.0f / 512.f) + EPS);
#if WOUT_I8
            float yv[4][8]; float am = 0.f;
#pragma unroll
            for (int j = 0; j < 4; ++j) { const int c0 = (j * 64 + lane) * 8; const float r = c0 < 768 ? ra : c0 < 1536 ? rb : rc; const v4u ww = w[u][j];
                yv[j][0] = bf2f(ww.x & 0xffff) * r; yv[j][1] = bf2f(ww.x >> 16) * r; yv[j][2] = bf2f(ww.y & 0xffff) * r; yv[j][3] = bf2f(ww.y >> 16) * r;
                yv[j][4] = bf2f(ww.z & 0xffff) * r; yv[j][5] = bf2f(ww.z >> 16) * r; yv[j][6] = bf2f(ww.w & 0xffff) * r; yv[j][7] = bf2f(ww.w >> 16) * r;
#pragma unroll
                for (int e = 0; e < 8; ++e) am = fmaxf(am, fabsf(yv[j][e])); }
            am = wave_max(am); const float S8 = am > 0.f ? 127.0f / am : 0.f;
#pragma unroll
            for (int j = 0; j < 4; ++j) *(GAS v2u*)((GAS unsigned char*)y + (size_t)t * D + (j * 64 + lane) * 8) = (v2u){pack_i8x4(yv[j][0], yv[j][1], yv[j][2], yv[j][3], S8), pack_i8x4(yv[j][4], yv[j][5], yv[j][6], yv[j][7], S8)};
            if (lane == 0) ((GAS float*)(P.ws + WS_SY))[t] = am * (1.0f / 127.0f); }
#else
#pragma unroll
            for (int j = 0; j < 4; ++j) { const int c0 = (j * 64 + lane) * 8; const float r = c0 < 768 ? ra : c0 < 1536 ? rb : rc; const v4u ww = w[u][j]; v4u q;
                q.x = pk2(bf2f(ww.x & 0xffff) * r, bf2f(ww.x >> 16) * r); q.y = pk2(bf2f(ww.y & 0xffff) * r, bf2f(ww.y >> 16) * r);
                q.z = pk2(bf2f(ww.z & 0xffff) * r, bf2f(ww.z >> 16) * r); q.w = pk2(bf2f(ww.w & 0xffff) * r, bf2f(ww.w >> 16) * r);
                *(GAS v4u*)(y + (size_t)t * D + c0) = q; } }
#endif
    }
}

struct EpiProjTM {
    bf16* tm;
    __device__ __forceinline__ void elem(int R, int C, float v) const { const int b = R >> 11, s = R & 2047, slot = C >> 7, d = C & 127; tm[(((size_t)b * NTM + slot) * S + s) * 128 + d] = (bf16)f2bf(v); }
};
struct EpiProjVT {
    bf16* vt;
    __device__ __forceinline__ void elem(int R, int C, float v) const { const int b = C >> 11, s = C & 2047, slot = R >> 7, d = R & 127; vt[(((size_t)b * NVT + slot) * 128 + d) * S + s] = (bf16)f2bf(v); }
};
struct EpiResid {
    const float* base; float* out;
    __device__ __forceinline__ void elem(int R, int C, float v) const { out[(size_t)R * D + C] = base[(size_t)R * D + C] + v; }
};
struct EpiStoreBf16 {
    bf16* o;
    __device__ __forceinline__ void elem(int R, int C, float v) const { o[(size_t)R * D + C] = (bf16)f2bf(v); }
};
struct EpiPleGate {
    float* out; const bf16* pp;
    __device__ __forceinline__ void elem(int R, int C, float v) const { const size_t i = (size_t)R * D + C; out[i] = out[i] + (1.0f / (1.0f + __expf(-v))) * bf2f(pp[i]); }
};

template <class Epi>
__device__ __forceinline__ void gemm_naive_tile(const bf16* Aside, const bf16* Bside, int K, int r0, int c0, const Epi& E, int tid, LAS float* sm) {
    typedef LAS float (*T68)[68];
    T68 As = (T68)sm, Bs = (T68)(sm + 32 * 68);
    const int tx = tid & 15, ty = tid >> 4;
    float acc[4][4];
#pragma unroll
    for (int i = 0; i < 4; ++i)
#pragma unroll
        for (int j = 0; j < 4; ++j) acc[i][j] = 0.f;
    const int lr = tid >> 2, lk = (tid & 3) * 8;
    for (int k0 = 0; k0 < K; k0 += 32) {
        const v4u av = *(const v4u*)(Aside + (size_t)(r0 + lr) * K + k0 + lk), bv = *(const v4u*)(Bside + (size_t)(c0 + lr) * K + k0 + lk);
        __syncthreads();
        As[lk + 0][lr] = bf2f(av.x & 0xffff); As[lk + 1][lr] = bf2f(av.x >> 16); As[lk + 2][lr] = bf2f(av.y & 0xffff); As[lk + 3][lr] = bf2f(av.y >> 16);
        As[lk + 4][lr] = bf2f(av.z & 0xffff); As[lk + 5][lr] = bf2f(av.z >> 16); As[lk + 6][lr] = bf2f(av.w & 0xffff); As[lk + 7][lr] = bf2f(av.w >> 16);
        Bs[lk + 0][lr] = bf2f(bv.x & 0xffff); Bs[lk + 1][lr] = bf2f(bv.x >> 16); Bs[lk + 2][lr] = bf2f(bv.y & 0xffff); Bs[lk + 3][lr] = bf2f(bv.y >> 16);
        Bs[lk + 4][lr] = bf2f(bv.z & 0xffff); Bs[lk + 5][lr] = bf2f(bv.z >> 16); Bs[lk + 6][lr] = bf2f(bv.w & 0xffff); Bs[lk + 7][lr] = bf2f(bv.w >> 16);
        __syncthreads();
#pragma unroll
        for (int kk = 0; kk < 32; ++kk) {
            const f32x4 a = *(const LAS f32x4*)&As[kk][ty * 4], b = *(const LAS f32x4*)&Bs[kk][tx * 4];
            const float aa[4] = {a.x, a.y, a.z, a.w}, bb[4] = {b.x, b.y, b.z, b.w};
#pragma unroll
            for (int i = 0; i < 4; ++i)
#pragma unroll
                for (int j = 0; j < 4; ++j) acc[i][j] += aa[i] * bb[j];
        }
    }
#pragma unroll
    for (int i = 0; i < 4; ++i)
#pragma unroll
        for (int j = 0; j < 4; ++j) E.elem(r0 + ty * 4 + i, c0 + tx * 4 + j, acc[i][j]);
}
template <class Epi>
__device__ __forceinline__ void phase_gemm_naive(const bf16* Aside, const bf16* Bside, int K, int nR, int nC, const Epi& E, int bid, int nb, LAS unsigned char* lds) {
    const int tid_ = TID(); const int half = tid_ >> 8, vtid = tid_ & 255; LAS float* sm = (LAS float*)lds + half * (2 * 32 * 68);
    const int tc = nC / 64, nt = (nR / 64) * tc;
    for (int base = bid * 2; base < nt; base += nb * 2) { const int tile = base + half; gemm_naive_tile(Aside, Bside, K, (tile / tc) * 64, (tile % tc) * 64, E, vtid, sm); }
    __syncthreads();
}


namespace pg8 {
#define PG8_LAS __attribute__((address_space(3)))
typedef unsigned short bf16_t;
typedef short bf16x8 __attribute__((ext_vector_type(8)));
typedef float f32x4 __attribute__((ext_vector_type(4)));
typedef unsigned u32x4 __attribute__((ext_vector_type(4)));
constexpr int BM = 256, BK = 64, HALF = 128, HTB = HALF * BK * 2, STAGE_BYTES = 8 * HTB, NXCD = 8, WGM = 8;
__host__ __device__ __forceinline__ int lds_byte(int r, int c) { const int st = (r >> 4) * 2 + (c >> 5), rr = r & 15, cc = c & 31, ob = rr * 64 + cc * 2; return st * 1024 + (ob ^ (((ob >> 9) & 1) << 5)); }
__host__ __device__ __forceinline__ void stage_rc(int b, int& R, int& C) { const int st = b / 1024, sb = b % 1024, swz = sb ^ (((sb >> 9) & 1) << 5); R = (st >> 1) * 16 + swz / 64; C = (st & 1) * 32 + (swz % 64) / 2; }
__host__ __device__ __forceinline__ int perm32(int rho) { const int n = rho >> 4, i = rho & 15; return 8 * (i >> 2) + 4 * n + (i & 3); }
struct Unit { int pm, pn; };
struct Gemm { const bf16_t* A; const bf16_t* Bt; int K; const bf16_t* A2; const bf16_t* Bt2; int splitM, splitN;
    __device__ __forceinline__ const char* a_ptr(int pm, size_t tstep) const { return pm < splitM ? (const char*)A + (size_t)pm * tstep : (const char*)A2 + (size_t)(pm - splitM) * tstep; }
    __device__ __forceinline__ const char* b_ptr(int pn, size_t tstep) const { return pn < splitN ? (const char*)Bt + (size_t)pn * tstep : (const char*)Bt2 + (size_t)(pn - splitN) * tstep; } };
__device__ __forceinline__ void order_map(int wgid, int nM, int nN, Unit& u) {
    const int nwg = nM * nN; { const int q = nwg / NXCD, r = nwg % NXCD, xcd = wgid % NXCD, off = wgid / NXCD; wgid = (xcd < r ? xcd * (q + 1) : r * (q + 1) + (xcd - r) * q) + off; }
    const int nig = WGM * nN, gid = wgid / nig, fm = gid * WGM, gsz = (nM - fm) < WGM ? (nM - fm) : WGM;
    u.pm = fm + ((wgid % nig) % gsz); u.pn = (wgid % nig) / gsz;
}
struct StaticOrder {
    int nM, nN, nwg, G, c;
    __device__ void init(int M, int N, int G_, int c_) { nM = M / BM; nN = N / BM; nwg = nM * nN; G = G_; c = c_; }
    __device__ bool next(int i, Unit& u) const { const long L = (long)i * G + c; if (L >= nwg) return false; order_map((int)L, nM, nN, u); return true; }
    __device__ __forceinline__ void a_ready(const Unit&) const {}
    __device__ __forceinline__ void done(const Unit&) const {}
};
struct DualOrder {
    int nM1, nN1, nM2, nN2, G, c;
    __device__ bool next(int i, Unit& u) const { long L = (long)i * G + c; const int n1 = nM1 * nN1;
        if (L < n1) { order_map((int)L, nM1, nN1, u); return true; }
        L -= n1; if (L >= nM2 * nN2) return false; order_map((int)L, nM2, nN2, u); u.pm += nM1; u.pn += nN1; return true; }
    __device__ __forceinline__ void a_ready(const Unit&) const {}
    __device__ __forceinline__ void done(const Unit&) const {}
};
__device__ __forceinline__ unsigned cvt_pk_bf16(float lo, float hi) { unsigned r; asm volatile("v_cvt_pk_bf16_f32 %0, %1, %2" : "=v"(r) : "v"(lo), "v"(hi)); return r; }
struct EpiProj {
    static constexpr bool PERM = true, AFTER_DRAIN = false, I8 = false;
    bf16_t* tm; bf16_t* vt;
    __device__ __forceinline__ void operator()(const f32x4 (&acc)[2][2][4][2], const Unit& u, int wr, int wc, int fr, int fq) const {
        if (u.pm < 64) {
#pragma unroll
            for (int ai = 0; ai < 2; ++ai)
#pragma unroll
                for (int m = 0; m < 4; ++m) { const int r = u.pm * BM + ai * HALF + wr * 64 + m * 16 + fr, b = r >> 11, s = r & 2047;
#pragma unroll
                    for (int bj = 0; bj < 2; ++bj) { const int slot = 2 * u.pn + bj, d0 = wc * 32 + 8 * fq;
                        const f32x4 v0 = acc[ai][bj][m][0], v1 = acc[ai][bj][m][1];
                        u32x4 w; w.x = cvt_pk_bf16(v0[0], v0[1]); w.y = cvt_pk_bf16(v0[2], v0[3]); w.z = cvt_pk_bf16(v1[0], v1[1]); w.w = cvt_pk_bf16(v1[2], v1[3]);
                        *(GAS u32x4*)((GAS bf16_t*)tm + (((size_t)b * NTM + slot) * S + s) * 128 + d0) = w; } }
        } else {
            const int pmv = u.pm - 64, pnv = u.pn - 17;
#pragma unroll
            for (int ai = 0; ai < 2; ++ai)
#pragma unroll
                for (int m = 0; m < 4; ++m) { const int vslot = 2 * pmv + ai, d = wr * 64 + m * 16 + fr;
#pragma unroll
                    for (int bj = 0; bj < 2; ++bj) { const int c0 = pnv * BM + bj * HALF + wc * 32 + 8 * fq, b = c0 >> 11, s = c0 & 2047;
                        const f32x4 v0 = acc[ai][bj][m][0], v1 = acc[ai][bj][m][1];
                        u32x4 w; w.x = cvt_pk_bf16(v0[0], v0[1]); w.y = cvt_pk_bf16(v0[2], v0[3]); w.z = cvt_pk_bf16(v1[0], v1[1]); w.w = cvt_pk_bf16(v1[2], v1[3]);
                        *(GAS u32x4*)((GAS bf16_t*)vt + (((size_t)b * NVT + vslot) * 128 + d) * S + s) = w; } }
        }
    }
};
struct EpiResidT {
    static constexpr bool PERM = false, AFTER_DRAIN = false, I8 = false;
    const float* base; float* out;
    __device__ __forceinline__ void operator()(const f32x4 (&acc)[2][2][4][2], const Unit& u, int wr, int wc, int fr, int fq) const {
        const int row0 = u.pm * BM + wr * 64 + fr, col0 = u.pn * BM + wc * 32 + 4 * fq;
        const GAS float* bp = (const GAS float*)base; GAS float* op = (GAS float*)out;
#pragma unroll
        for (int ai = 0; ai < 2; ++ai)
#pragma unroll
            for (int mp = 0; mp < 2; ++mp) { f32x4 t[2][2][2];
#pragma unroll
                for (int mm = 0; mm < 2; ++mm) { const size_t off = (size_t)(row0 + ai * HALF + (2 * mp + mm) * 16) * D + col0;
#pragma unroll
                    for (int bj = 0; bj < 2; ++bj)
#pragma unroll
                        for (int n = 0; n < 2; ++n) t[mm][bj][n] = *(const GAS f32x4*)(bp + off + bj * HALF + n * 16); }
#pragma unroll
                for (int mm = 0; mm < 2; ++mm) { const size_t off = (size_t)(row0 + ai * HALF + (2 * mp + mm) * 16) * D + col0;
#pragma unroll
                    for (int bj = 0; bj < 2; ++bj)
#pragma unroll
                        for (int n = 0; n < 2; ++n) *(GAS f32x4*)(op + off + bj * HALF + n * 16) = t[mm][bj][n] + acc[ai][bj][2 * mp + mm][n]; } }
    }
};
struct EpiStoreT {
    static constexpr bool PERM = true, AFTER_DRAIN = false, I8 = false;
    bf16_t* o;
    __device__ __forceinline__ void operator()(const f32x4 (&acc)[2][2][4][2], const Unit& u, int wr, int wc, int fr, int fq) const {
        const int row0 = u.pm * BM + wr * 64 + fr, col0 = u.pn * BM + wc * 32 + 8 * fq;
#pragma unroll
        for (int ai = 0; ai < 2; ++ai)
#pragma unroll
            for (int m = 0; m < 4; ++m) { bf16_t* rowp = o + (size_t)(row0 + ai * HALF + m * 16) * D + col0;
#pragma unroll
                for (int bj = 0; bj < 2; ++bj) { const f32x4 v0 = acc[ai][bj][m][0], v1 = acc[ai][bj][m][1];
                    u32x4 w; w.x = cvt_pk_bf16(v0[0], v0[1]); w.y = cvt_pk_bf16(v0[2], v0[3]); w.z = cvt_pk_bf16(v1[0], v1[1]); w.w = cvt_pk_bf16(v1[2], v1[3]);
                    *(GAS u32x4*)((GAS bf16_t*)rowp + bj * HALF) = w; } }
    }
};
struct EpiPleGateT {
    static constexpr bool PERM = false, AFTER_DRAIN = false, I8 = false;
    float* out; const bf16_t* pp;
    __device__ __forceinline__ void operator()(const f32x4 (&acc)[2][2][4][2], const Unit& u, int wr, int wc, int fr, int fq) const {
        const int row0 = u.pm * BM + wr * 64 + fr, col0 = u.pn * BM + wc * 32 + 4 * fq;
        GAS float* op = (GAS float*)out; const GAS bf16_t* ppp = (const GAS bf16_t*)pp;
#pragma unroll
        for (int ai = 0; ai < 2; ++ai)
#pragma unroll
            for (int mp = 0; mp < 2; ++mp) { f32x4 t[2][2][2]; v2u pw[2][2][2];
#pragma unroll
                for (int mm = 0; mm < 2; ++mm) { const size_t off = (size_t)(row0 + ai * HALF + (2 * mp + mm) * 16) * D + col0;
#pragma unroll
                    for (int bj = 0; bj < 2; ++bj)
#pragma unroll
                        for (int n = 0; n < 2; ++n) { t[mm][bj][n] = *(const GAS f32x4*)(op + off + bj * HALF + n * 16); pw[mm][bj][n] = *(const GAS v2u*)(ppp + off + bj * HALF + n * 16); } }
#pragma unroll
                for (int mm = 0; mm < 2; ++mm) { const size_t off = (size_t)(row0 + ai * HALF + (2 * mp + mm) * 16) * D + col0;
#pragma unroll
                    for (int bj = 0; bj < 2; ++bj)
#pragma unroll
                        for (int n = 0; n < 2; ++n) { const f32x4 hv = t[mm][bj][n], a = acc[ai][bj][2 * mp + mm][n]; const v2u p2 = pw[mm][bj][n];
                            f32x4 r; r[0] = hv[0] + bf2f(p2.x & 0xffff) / (1.0f + __expf(-a[0])); r[1] = hv[1] + bf2f(p2.x >> 16) / (1.0f + __expf(-a[1]));
                            r[2] = hv[2] + bf2f(p2.y & 0xffff) / (1.0f + __expf(-a[2])); r[3] = hv[3] + bf2f(p2.y >> 16) / (1.0f + __expf(-a[3]));
                            *(GAS f32x4*)(op + off + bj * HALF + n * 16) = r; } } }
    }
};

typedef int i32x4 __attribute__((ext_vector_type(4)));
template <bool I8> struct AccSel { typedef f32x4 type; };
template <> struct AccSel<true> { typedef i32x4 type; };
__device__ __forceinline__ void mma16(f32x4& acc, const bf16x8 b, const bf16x8 a) { acc = __builtin_amdgcn_mfma_f32_16x16x32_bf16(b, a, acc, 0, 0, 0); }
__device__ __forceinline__ void mma16(i32x4& acc, const bf16x8 b, const bf16x8 a) { acc = __builtin_amdgcn_mfma_i32_16x16x64_i8(__builtin_bit_cast(i32x4, b), __builtin_bit_cast(i32x4, a), acc, 0, 0, 0); }
#if !H16
struct EpiPleGateI8 {
    static constexpr bool PERM = false, AFTER_DRAIN = false, I8 = true;
    float* out; const bf16_t* pp; const float* sa; const float* sw;
    __device__ __forceinline__ void operator()(const i32x4 (&acc)[2][2][4][2], const Unit& u, int wr, int wc, int fr, int fq) const {
        const int row0 = u.pm * BM + wr * 64 + fr, col0 = u.pn * BM + wc * 32 + 4 * fq;
        GAS float* op = (GAS float*)out; const GAS bf16_t* ppp = (const GAS bf16_t*)pp;
        f32x4 swv[2][2];
#pragma unroll
        for (int bj = 0; bj < 2; ++bj)
#pragma unroll
            for (int n = 0; n < 2; ++n) swv[bj][n] = *(const GAS f32x4*)((const GAS float*)sw + col0 + bj * HALF + n * 16);
#pragma unroll
        for (int ai = 0; ai < 2; ++ai)
#pragma unroll
            for (int mp = 0; mp < 2; ++mp) { f32x4 t[2][2][2]; v2u pw[2][2][2]; float rs[2];
#pragma unroll
                for (int mm = 0; mm < 2; ++mm) { const int row = row0 + ai * HALF + (2 * mp + mm) * 16; const size_t off = (size_t)row * D + col0; rs[mm] = ((const GAS float*)sa)[row];
#pragma unroll
                    for (int bj = 0; bj < 2; ++bj)
#pragma unroll
                        for (int n = 0; n < 2; ++n) {
#if H16
                            t[mm][bj][n] = ldh4((const GAS _Float16*)out + off + bj * HALF + n * 16);
#else
                            t[mm][bj][n] = *(const GAS f32x4*)(op + off + bj * HALF + n * 16);
#endif
                            pw[mm][bj][n] = *(const GAS v2u*)(ppp + off + bj * HALF + n * 16); } }
#pragma unroll
                for (int mm = 0; mm < 2; ++mm) { const size_t off = (size_t)(row0 + ai * HALF + (2 * mp + mm) * 16) * D + col0;
#pragma unroll
                    for (int bj = 0; bj < 2; ++bj)
#pragma unroll
                        for (int n = 0; n < 2; ++n) { const f32x4 hv = t[mm][bj][n]; const i32x4 ai4 = acc[ai][bj][2 * mp + mm][n]; const v2u p2 = pw[mm][bj][n]; const f32x4 sc = swv[bj][n] * rs[mm];
                            const float a0 = (float)ai4[0] * sc[0], a1 = (float)ai4[1] * sc[1], a2 = (float)ai4[2] * sc[2], a3 = (float)ai4[3] * sc[3];
                            f32x4 r; r[0] = hv[0] + bf2f(p2.x & 0xffff) / (1.0f + __expf(-a0)); r[1] = hv[1] + bf2f(p2.x >> 16) / (1.0f + __expf(-a1));
                            r[2] = hv[2] + bf2f(p2.y & 0xffff) / (1.0f + __expf(-a2)); r[3] = hv[3] + bf2f(p2.y >> 16) / (1.0f + __expf(-a3));
#if H16
                            sth4((GAS _Float16*)out + off + bj * HALF + n * 16, r);
#else
                            *(GAS f32x4*)(op + off + bj * HALF + n * 16) = r;
#endif
                        } } }
    }
};
#endif
struct EpiStoreI8 {
    static constexpr bool PERM = true, AFTER_DRAIN = false, I8 = true;
    bf16_t* o; const float* sa; const float* sw;
    __device__ __forceinline__ void operator()(const i32x4 (&acc)[2][2][4][2], const Unit& u, int wr, int wc, int fr, int fq) const {
        const int row0 = u.pm * BM + wr * 64 + fr, col0 = u.pn * BM + wc * 32 + 8 * fq;
        f32x4 cs[2][2];
#pragma unroll
        for (int bj = 0; bj < 2; ++bj) { const GAS float* p = (const GAS float*)sw + col0 + bj * HALF; cs[bj][0] = *(const GAS f32x4*)p; cs[bj][1] = *(const GAS f32x4*)(p + 4); }
        float rsv[2][4];
#pragma unroll
        for (int ai = 0; ai < 2; ++ai)
#pragma unroll
            for (int m = 0; m < 4; ++m) rsv[ai][m] = ((const GAS float*)sa)[row0 + ai * HALF + m * 16];
#pragma unroll
        for (int ai = 0; ai < 2; ++ai)
#pragma unroll
            for (int m = 0; m < 4; ++m) { const int row = row0 + ai * HALF + m * 16; bf16_t* rowp = o + (size_t)row * D + col0; const float rs = rsv[ai][m];
#pragma unroll
                for (int bj = 0; bj < 2; ++bj) { const i32x4 a0 = acc[ai][bj][m][0], a1 = acc[ai][bj][m][1]; const f32x4 s0 = cs[bj][0] * rs, s1 = cs[bj][1] * rs;
                    u32x4 w; w.x = cvt_pk_bf16((float)a0[0] * s0[0], (float)a0[1] * s0[1]); w.y = cvt_pk_bf16((float)a0[2] * s0[2], (float)a0[3] * s0[3]);
                    w.z = cvt_pk_bf16((float)a1[0] * s1[0], (float)a1[1] * s1[1]); w.w = cvt_pk_bf16((float)a1[2] * s1[2], (float)a1[3] * s1[3]);
                    *(GAS u32x4*)((GAS bf16_t*)rowp + bj * HALF) = w; } }
    }
};
#if H16
typedef _Float16 h8_t __attribute__((ext_vector_type(8)));
struct EpiResidI8 {
    static constexpr bool PERM = true, AFTER_DRAIN = false, I8 = true;
    const float* base; float* out; const float* sa; const float* sw;
    __device__ __forceinline__ void operator()(const i32x4 (&acc)[2][2][4][2], const Unit& u, int wr, int wc, int fr, int fq) const {
        const int row0 = u.pm * BM + wr * 64 + fr, col0 = u.pn * BM + wc * 32 + 8 * fq;
        const GAS float* bp = (const GAS float*)base; GAS _Float16* oh = (GAS _Float16*)out;
        f32x4 cs[2][2];
#pragma unroll
        for (int bj = 0; bj < 2; ++bj) { const GAS float* p = (const GAS float*)sw + col0 + bj * HALF; cs[bj][0] = *(const GAS f32x4*)p; cs[bj][1] = *(const GAS f32x4*)(p + 4); }
        auto emit = [&](const int ai, const int mp, const int mm, const int bj, const f32x4 t0, const f32x4 t1, const float rsv) __attribute__((always_inline)) {
            const size_t off = (size_t)(row0 + ai * HALF + (2 * mp + mm) * 16) * D + col0;
            const i32x4 a0 = acc[ai][bj][2 * mp + mm][0], a1 = acc[ai][bj][2 * mp + mm][1]; const f32x4 s0 = cs[bj][0] * rsv, s1 = cs[bj][1] * rsv;
            const f32x4 r0 = t0 + (f32x4){(float)a0[0] * s0[0], (float)a0[1] * s0[1], (float)a0[2] * s0[2], (float)a0[3] * s0[3]};
            const f32x4 r1 = t1 + (f32x4){(float)a1[0] * s1[0], (float)a1[1] * s1[1], (float)a1[2] * s1[2], (float)a1[3] * s1[3]};
            *(GAS h8_t*)(oh + off + bj * HALF) = (h8_t){(_Float16)r0[0], (_Float16)r0[1], (_Float16)r0[2], (_Float16)r0[3], (_Float16)r1[0], (_Float16)r1[1], (_Float16)r1[2], (_Float16)r1[3]}; };
        if (bp) {
#pragma unroll
            for (int ai = 0; ai < 2; ++ai)
#pragma unroll
                for (int mp = 0; mp < 2; ++mp) { f32x4 t[2][2][2]; float rs[2];
#pragma unroll
                    for (int mm = 0; mm < 2; ++mm) { const int row = row0 + ai * HALF + (2 * mp + mm) * 16; const size_t off = (size_t)row * D + col0; rs[mm] = ((const GAS float*)sa)[row];
#pragma unroll
                        for (int bj = 0; bj < 2; ++bj) { t[mm][bj][0] = *(const GAS f32x4*)(bp + off + bj * HALF); t[mm][bj][1] = *(const GAS f32x4*)(bp + off + bj * HALF + 4); } }
#pragma unroll
                    for (int mm = 0; mm < 2; ++mm)
#pragma unroll
                        for (int bj = 0; bj < 2; ++bj) emit(ai, mp, mm, bj, t[mm][bj][0], t[mm][bj][1], rs[mm]); }
        } else {
            auto load = [&](const int ai, const int mp, h8_t (&hv)[2][2], float (&rs)[2]) __attribute__((always_inline)) {
#pragma unroll
                for (int mm = 0; mm < 2; ++mm) { const int row = row0 + ai * HALF + (2 * mp + mm) * 16; const size_t off = (size_t)row * D + col0; rs[mm] = ((const GAS float*)sa)[row];
#pragma unroll
                    for (int bj = 0; bj < 2; ++bj) hv[mm][bj] = *(const GAS h8_t*)(oh + off + bj * HALF); } };
            auto finish = [&](const int ai, const int mp, const h8_t (&hv)[2][2], const float (&rs)[2]) __attribute__((always_inline)) {
#pragma unroll
                for (int mm = 0; mm < 2; ++mm)
#pragma unroll
                    for (int bj = 0; bj < 2; ++bj) { const h8_t h8 = hv[mm][bj];
                        emit(ai, mp, mm, bj, (f32x4){(float)h8[0], (float)h8[1], (float)h8[2], (float)h8[3]}, (f32x4){(float)h8[4], (float)h8[5], (float)h8[6], (float)h8[7]}, rs[mm]); } };
            h8_t hA[2][2], hB[2][2]; float rA[2], rB[2];
            load(0, 0, hA, rA); load(0, 1, hB, rB);
            finish(0, 0, hA, rA); load(1, 0, hA, rA);
            finish(0, 1, hB, rB); load(1, 1, hB, rB);
            finish(1, 0, hA, rA); finish(1, 1, hB, rB);
        }
    }
};
struct EpiPleGateI8 {
    static constexpr bool PERM = true, AFTER_DRAIN = false, I8 = true;
    float* out; const bf16_t* pp; const float* sa; const float* sw;
    __device__ __forceinline__ void operator()(const i32x4 (&acc)[2][2][4][2], const Unit& u, int wr, int wc, int fr, int fq) const {
        const int row0 = u.pm * BM + wr * 64 + fr, col0 = u.pn * BM + wc * 32 + 8 * fq;
        GAS _Float16* oh = (GAS _Float16*)out; const GAS bf16_t* ppp = (const GAS bf16_t*)pp;
        f32x4 cs[2][2];
#pragma unroll
        for (int bj = 0; bj < 2; ++bj) { const GAS float* p = (const GAS float*)sw + col0 + bj * HALF; cs[bj][0] = *(const GAS f32x4*)p; cs[bj][1] = *(const GAS f32x4*)(p + 4); }
        auto load = [&](const int k, h8_t (&hv)[2], u32x4 (&pw)[2], float (&rs)[2]) __attribute__((always_inline)) { const int ai = k >> 2, mp = (k >> 1) & 1, bj = k & 1;
#pragma unroll
            for (int mm = 0; mm < 2; ++mm) { const int row = row0 + ai * HALF + (2 * mp + mm) * 16; const size_t off = (size_t)row * D + col0 + bj * HALF; rs[mm] = ((const GAS float*)sa)[row];
                hv[mm] = *(const GAS h8_t*)(oh + off); pw[mm] = *(const GAS u32x4*)(ppp + off); } };
        auto finish = [&](const int k, const h8_t (&hv)[2], const u32x4 (&pw)[2], const float (&rs)[2]) __attribute__((always_inline)) { const int ai = k >> 2, mp = (k >> 1) & 1, bj = k & 1;
#pragma unroll
            for (int mm = 0; mm < 2; ++mm) { const size_t off = (size_t)(row0 + ai * HALF + (2 * mp + mm) * 16) * D + col0 + bj * HALF;
                const i32x4 a0 = acc[ai][bj][2 * mp + mm][0], a1 = acc[ai][bj][2 * mp + mm][1]; const f32x4 s0 = cs[bj][0] * rs[mm], s1 = cs[bj][1] * rs[mm]; const u32x4 p4 = pw[mm]; const h8_t h8 = hv[mm];
                float r[8];
                r[0] = (float)h8[0] + bf2f(p4.x & 0xffff) / (1.0f + __expf(-(float)a0[0] * s0[0])); r[1] = (float)h8[1] + bf2f(p4.x >> 16) / (1.0f + __expf(-(float)a0[1] * s0[1]));
                r[2] = (float)h8[2] + bf2f(p4.y & 0xffff) / (1.0f + __expf(-(float)a0[2] * s0[2])); r[3] = (float)h8[3] + bf2f(p4.y >> 16) / (1.0f + __expf(-(float)a0[3] * s0[3]));
                r[4] = (float)h8[4] + bf2f(p4.z & 0xffff) / (1.0f + __expf(-(float)a1[0] * s1[0])); r[5] = (float)h8[5] + bf2f(p4.z >> 16) / (1.0f + __expf(-(float)a1[1] * s1[1]));
                r[6] = (float)h8[6] + bf2f(p4.w & 0xffff) / (1.0f + __expf(-(float)a1[2] * s1[2])); r[7] = (float)h8[7] + bf2f(p4.w >> 16) / (1.0f + __expf(-(float)a1[3] * s1[3]));
                *(GAS h8_t*)(oh + off) = (h8_t){(_Float16)r[0], (_Float16)r[1], (_Float16)r[2], (_Float16)r[3], (_Float16)r[4], (_Float16)r[5], (_Float16)r[6], (_Float16)r[7]}; } };
        h8_t hA[2], hB[2], hC[2]; u32x4 pA[2], pB[2], pC[2]; float rA[2], rB[2], rC[2];
        load(0, hA, pA, rA); load(1, hB, pB, rB); load(2, hC, pC, rC);
        finish(0, hA, pA, rA); load(3, hA, pA, rA);
        finish(1, hB, pB, rB); load(4, hB, pB, rB);
        finish(2, hC, pC, rC); load(5, hC, pC, rC);
        finish(3, hA, pA, rA); load(6, hA, pA, rA);
        finish(4, hB, pB, rB); load(7, hB, pB, rB);
        finish(5, hC, pC, rC); finish(6, hA, pA, rA); finish(7, hB, pB, rB);
    }
};
#else
struct EpiResidI8 {
    static constexpr bool PERM = false, AFTER_DRAIN = false, I8 = true;
    const float* base; float* out; const float* sa; const float* sw;
    __device__ __forceinline__ void operator()(const i32x4 (&acc)[2][2][4][2], const Unit& u, int wr, int wc, int fr, int fq) const {
        const int row0 = u.pm * BM + wr * 64 + fr, col0 = u.pn * BM + wc * 32 + 4 * fq;
        const GAS float* bp = (const GAS float*)base; GAS float* op = (GAS float*)out;
#if H16
        GAS _Float16* oh = (GAS _Float16*)out;
#endif
        f32x4 cs[2][2];
#pragma unroll
        for (int bj = 0; bj < 2; ++bj)
#pragma unroll
            for (int n = 0; n < 2; ++n) cs[bj][n] = *(const GAS f32x4*)((const GAS float*)sw + col0 + bj * HALF + n * 16);
#pragma unroll
        for (int ai = 0; ai < 2; ++ai)
#pragma unroll
            for (int mp = 0; mp < 2; ++mp) { f32x4 t[2][2][2]; float rs[2];
#pragma unroll
                for (int mm = 0; mm < 2; ++mm) { const int row = row0 + ai * HALF + (2 * mp + mm) * 16; const size_t off = (size_t)row * D + col0; rs[mm] = ((const GAS float*)sa)[row];
#pragma unroll
                    for (int bj = 0; bj < 2; ++bj)
#pragma unroll
                        for (int n = 0; n < 2; ++n) {
#if H16
                            if (bp) t[mm][bj][n] = *(const GAS f32x4*)(bp + off + bj * HALF + n * 16); else t[mm][bj][n] = ldh4(oh + off + bj * HALF + n * 16);
#else
                            t[mm][bj][n] = *(const GAS f32x4*)(bp + off + bj * HALF + n * 16);
#endif
                        } }
#pragma unroll
                for (int mm = 0; mm < 2; ++mm) { const size_t off = (size_t)(row0 + ai * HALF + (2 * mp + mm) * 16) * D + col0;
#pragma unroll
                    for (int bj = 0; bj < 2; ++bj)
#pragma unroll
                        for (int n = 0; n < 2; ++n) { const i32x4 a = acc[ai][bj][2 * mp + mm][n]; const f32x4 sc = cs[bj][n] * rs[mm];
                            const f32x4 rv = t[mm][bj][n] + (f32x4){(float)a[0] * sc[0], (float)a[1] * sc[1], (float)a[2] * sc[2], (float)a[3] * sc[3]};
#if H16
                            sth4(oh + off + bj * HALF + n * 16, rv);
#else
                            *(GAS f32x4*)(op + off + bj * HALF + n * 16) = rv;
#endif
                        } } }
    }
};
#endif
struct EpiProjI8 {
    static constexpr bool PERM = true, AFTER_DRAIN = false, I8 = true;
    bf16_t* tm; bf16_t* vt; const float* sa; const float* swtm; const float* swvt;
    __device__ __forceinline__ void operator()(const i32x4 (&acc)[2][2][4][2], const Unit& u, int wr, int wc, int fr, int fq) const {
        if (u.pm < 64) {
            f32x4 cs[2][2];
#pragma unroll
            for (int bj = 0; bj < 2; ++bj) { const GAS float* p = (const GAS float*)swtm + (2 * u.pn + bj) * 128 + wc * 32 + 8 * fq; cs[bj][0] = *(const GAS f32x4*)p; cs[bj][1] = *(const GAS f32x4*)(p + 4); }
            float rsv[2][4];
#pragma unroll
            for (int ai = 0; ai < 2; ++ai)
#pragma unroll
                for (int m = 0; m < 4; ++m) rsv[ai][m] = ((const GAS float*)sa)[u.pm * BM + ai * HALF + wr * 64 + m * 16 + fr];
#pragma unroll
            for (int ai = 0; ai < 2; ++ai)
#pragma unroll
                for (int m = 0; m < 4; ++m) { const int r = u.pm * BM + ai * HALF + wr * 64 + m * 16 + fr, b = r >> 11, s = r & 2047; const float rs = rsv[ai][m];
#pragma unroll
                    for (int bj = 0; bj < 2; ++bj) { const int slot = 2 * u.pn + bj, d0 = wc * 32 + 8 * fq;
                        const i32x4 a0 = acc[ai][bj][m][0], a1 = acc[ai][bj][m][1]; const f32x4 s0 = cs[bj][0] * rs, s1 = cs[bj][1] * rs;
                        u32x4 w; w.x = cvt_pk_bf16((float)a0[0] * s0[0], (float)a0[1] * s0[1]); w.y = cvt_pk_bf16((float)a0[2] * s0[2], (float)a0[3] * s0[3]);
                        w.z = cvt_pk_bf16((float)a1[0] * s1[0], (float)a1[1] * s1[1]); w.w = cvt_pk_bf16((float)a1[2] * s1[2], (float)a1[3] * s1[3]);
                        *(GAS u32x4*)((GAS bf16_t*)tm + (((size_t)b * NTM + slot) * S + s) * 128 + d0) = w; } }
        } else {
            const int pmv = u.pm - 64, pnv = u.pn - 17;
            f32x4 cs[2][2];
#pragma unroll
            for (int bj = 0; bj < 2; ++bj) { const GAS float* p = (const GAS float*)sa + pnv * BM + bj * HALF + wc * 32 + 8 * fq; cs[bj][0] = *(const GAS f32x4*)p; cs[bj][1] = *(const GAS f32x4*)(p + 4); }
            float rsv[2][4];
#pragma unroll
            for (int ai = 0; ai < 2; ++ai)
#pragma unroll
                for (int m = 0; m < 4; ++m) rsv[ai][m] = ((const GAS float*)swvt)[(2 * pmv + ai) * 128 + wr * 64 + m * 16 + fr];
#pragma unroll
            for (int ai = 0; ai < 2; ++ai)
#pragma unroll
                for (int m = 0; m < 4; ++m) { const int vslot = 2 * pmv + ai, d = wr * 64 + m * 16 + fr; const float rs = rsv[ai][m];
#pragma unroll
                    for (int bj = 0; bj < 2; ++bj) { const int c0 = pnv * BM + bj * HALF + wc * 32 + 8 * fq, b = c0 >> 11, s = c0 & 2047;
                        const i32x4 a0 = acc[ai][bj][m][0], a1 = acc[ai][bj][m][1]; const f32x4 s0 = cs[bj][0] * rs, s1 = cs[bj][1] * rs;
                        u32x4 w; w.x = cvt_pk_bf16((float)a0[0] * s0[0], (float)a0[1] * s0[1]); w.y = cvt_pk_bf16((float)a0[2] * s0[2], (float)a0[3] * s0[3]);
                        w.z = cvt_pk_bf16((float)a1[0] * s1[0], (float)a1[1] * s1[1]); w.w = cvt_pk_bf16((float)a1[2] * s1[2], (float)a1[3] * s1[3]);
                        *(GAS u32x4*)((GAS bf16_t*)vt + (((size_t)b * NVT + vslot) * 128 + d) * S + s) = w; } }
        }
    }
};
template <class Epi, class Sched>
__device__ __forceinline__ void gemm_phase(PG8_LAS unsigned char* lds, const Gemm g, const Sched& S, const Epi& E) {
    const int tid = TID(), wid = __builtin_amdgcn_readfirstlane(tid >> 6), lane = tid & 63, wr = wid >> 2, wc = wid & 3, fr = lane & 15, fq = lane >> 4;
    const int K = g.K, nt = K / BK;
    unsigned voffA[2], voffB[2];
#pragma unroll
    for (int i = 0; i < 2; ++i) { int R, C; stage_rc(tid * 16 + i * 8192, R, C); const int Rb = Epi::PERM ? ((R & ~31) + perm32(R & 31)) : R;
        voffA[i] = (unsigned)(R * K + C) * 2u; voffB[i] = (unsigned)(Rb * K + C) * 2u; }
    const size_t kstep = (size_t)(BK * 2);
    const size_t hstep = (size_t)HALF * K * 2;
    const size_t tstep = 2 * hstep;
    const unsigned ldsw = (unsigned)wid * 1024u;
    const int aoff = lds_byte(wr * 64 + fr, fq * 8), boff = lds_byte(wc * 32 + fr, fq * 8);
#define PG8_SA(b, h) (((b) * 2 + (h)) * HTB)
#define PG8_SB(b, h) ((4 + (b) * 2 + (h)) * HTB)
#define PG8_STAGE(bufoff, gbase, voff) do { _Pragma("unroll") for (int _i = 0; _i < 2; ++_i) \
        __builtin_amdgcn_global_load_lds((const unsigned*)((const char*)(gbase) + (voff)[_i]), (PG8_LAS unsigned*)(lds + (bufoff) + ldsw + _i * 8192), 16, 0, 0); } while (0)
#define PG8_LDA(dst, b, h) do { _Pragma("unroll") for (int m = 0; m < 4; ++m) _Pragma("unroll") for (int k = 0; k < 2; ++k) dst[m][k] = *(const PG8_LAS bf16x8*)(lds + PG8_SA(b, h) + aoff + m * 2048 + k * 1024); } while (0)
#define PG8_LDB(dst, b, h) do { _Pragma("unroll") for (int n = 0; n < 2; ++n) _Pragma("unroll") for (int k = 0; k < 2; ++k) dst[n][k] = *(const PG8_LAS bf16x8*)(lds + PG8_SB(b, h) + boff + n * 2048 + k * 1024); } while (0)
#define PG8_MMA(ai, bj, At, Bt) do { __builtin_amdgcn_s_setprio(1); _Pragma("unroll") for (int m = 0; m < 4; ++m) _Pragma("unroll") for (int n = 0; n < 2; ++n) _Pragma("unroll") for (int k = 0; k < 2; ++k) \
        mma16(acc[ai][bj][m][n], Bt[n][k], At[m][k]); __builtin_amdgcn_s_setprio(0); } while (0)
#define PG8_WAIT_V(n) asm volatile("s_waitcnt vmcnt(" #n ")" ::: "memory")
#define PG8_WAIT_L(n) asm volatile("s_waitcnt lgkmcnt(" #n ")" ::: "memory")
#define PG8_BAR __builtin_amdgcn_s_barrier()
#define PG8_SCHED __builtin_amdgcn_sched_barrier(0)
    Unit cur, nxt; int ui = 0;
    if (!S.next(0, cur)) return;
    typedef typename AccSel<Epi::I8>::type acc_t;
    acc_t acc[2][2][4][2];
#pragma unroll
    for (int a = 0; a < 2; ++a)
#pragma unroll
        for (int b = 0; b < 2; ++b)
#pragma unroll
            for (int m = 0; m < 4; ++m)
#pragma unroll
                for (int n = 0; n < 2; ++n) acc[a][b][m][n] = acc_t{};
    bf16x8 At[4][2], B0[2][2], B1[2][2];
    const char* cA = g.a_ptr(cur.pm, tstep); const char* cB = g.b_ptr(cur.pn, tstep);
    S.a_ready(cur);
    PG8_STAGE(PG8_SB(0, 0), cB, voffB); PG8_STAGE(PG8_SA(0, 0), cA, voffA); PG8_STAGE(PG8_SB(0, 1), cB + hstep, voffB); PG8_STAGE(PG8_SA(0, 1), cA + hstep, voffA);
    if (wr == 1) PG8_BAR;
    PG8_WAIT_V(4); PG8_BAR;
    PG8_STAGE(PG8_SB(1, 0), cB + kstep, voffB); PG8_STAGE(PG8_SA(1, 0), cA + kstep, voffA); PG8_STAGE(PG8_SB(1, 1), cB + hstep + kstep, voffB);
    PG8_WAIT_V(6); PG8_BAR;
    for (;;) {
        const bool has_next = S.next(ui + 1, nxt);
        const char* nA = has_next ? g.a_ptr(nxt.pm, tstep) : cA; const char* nB = has_next ? g.b_ptr(nxt.pn, tstep) : cB;
        for (int t = 0; t < nt; t += 2) {
            const bool last = (t == nt - 2);
            const char* a1 = cA + (size_t)(t + 1) * kstep;
            const char* a2 = last ? nA : cA + (size_t)(t + 2) * kstep; const char* b2 = last ? nB : cB + (size_t)(t + 2) * kstep;
            const char* a3 = a2 + kstep; const char* b3 = b2 + kstep;
            if (last && has_next) S.a_ready(nxt);
            PG8_LDB(B0, 0, 0); PG8_SCHED; PG8_LDA(At, 0, 0); PG8_STAGE(PG8_SA(1, 1), a1 + hstep, voffA);
            PG8_WAIT_L(8); PG8_BAR; PG8_WAIT_L(0); PG8_MMA(0, 0, At, B0); PG8_BAR; PG8_SCHED;
            PG8_LDB(B1, 0, 1); PG8_STAGE(PG8_SB(0, 0), b2, voffB);
            PG8_BAR; PG8_WAIT_L(0); PG8_MMA(0, 1, At, B1); PG8_BAR;
            PG8_LDA(At, 0, 1); PG8_STAGE(PG8_SA(0, 0), a2, voffA);
            PG8_BAR; PG8_WAIT_L(0); PG8_MMA(1, 0, At, B0); PG8_BAR; PG8_SCHED;
            PG8_STAGE(PG8_SB(0, 1), b2 + hstep, voffB);
            PG8_WAIT_V(6); PG8_BAR; PG8_MMA(1, 1, At, B1); PG8_BAR;
            PG8_LDB(B0, 1, 0); PG8_SCHED; PG8_LDA(At, 1, 0); PG8_STAGE(PG8_SA(0, 1), a2 + hstep, voffA);
            PG8_WAIT_L(8); PG8_BAR; PG8_WAIT_L(0); PG8_MMA(0, 0, At, B0); PG8_BAR; PG8_SCHED;
            PG8_LDB(B1, 1, 1); PG8_STAGE(PG8_SB(1, 0), b3, voffB);
            PG8_BAR; PG8_WAIT_L(0); PG8_MMA(0, 1, At, B1); PG8_BAR;
            PG8_LDA(At, 1, 1); PG8_STAGE(PG8_SA(1, 0), a3, voffA);
            PG8_BAR; PG8_WAIT_L(0); PG8_MMA(1, 0, At, B0); PG8_BAR; PG8_SCHED;
            PG8_STAGE(PG8_SB(1, 1), b3 + hstep, voffB);
            PG8_WAIT_V(6); PG8_BAR; PG8_MMA(1, 1, At, B1); PG8_BAR;
        }
        if constexpr (!Epi::AFTER_DRAIN) { E(acc, cur, wr, wc, fr, fq); S.done(cur); }
        if (!has_next) break;
#pragma unroll
        for (int a = 0; a < 2; ++a)
#pragma unroll
            for (int b = 0; b < 2; ++b)
#pragma unroll
                for (int m = 0; m < 4; ++m)
#pragma unroll
                    for (int n = 0; n < 2; ++n) acc[a][b][m][n] = acc_t{};
        cur = nxt; cA = nA; cB = nB; ++ui;
    }
    PG8_WAIT_V(0);
    if (wr == 0) PG8_BAR;
    PG8_BAR;
    if constexpr (Epi::AFTER_DRAIN) { E.fused(acc, cur, wr, wc, fr, fq, lds, wid, lane); S.done(cur); }
#undef PG8_SA
#undef PG8_SB
#undef PG8_STAGE
#undef PG8_LDA
#undef PG8_LDB
#undef PG8_MMA
#undef PG8_WAIT_V
#undef PG8_WAIT_L
#undef PG8_BAR
#undef PG8_SCHED
}
}

__device__ __forceinline__ void phase_prep_naive(const Params& P, int l, int bid, int nb) {
    const int tid_ = TID(); const int half = tid_ >> 8, tid = tid_ & 255;
    for (int vb = bid * 2 + half; vb < NB * 2 * 128; vb += nb * 2) {
        const int n = vb & 127, g = (vb >> 7) & 1, b = vb >> 8;
        const int which = tid >> 7, e = tid & 127;
        const bf16* tm = (const bf16*)(P.ws + WS_TM);
        const bf16* src = tm + (((size_t)b * NTM + (which ? TM_B_VC : TM_B_KC) + g) * S) * 128;
        const float* w = (which ? P.in[I_CMPWV] : P.in[I_CMPWK]) + (size_t)l * 32 * 128 * 128; const float* pos = P.in[I_CMPPOS] + (size_t)l * 32 * 128;
        float acc = 0.f;
        if (n < 127) for (int ll = 0; ll < 32; ++ll) for (int d = 0; d < 128; ++d) acc += (bf2f(src[(size_t)(16 * n + ll) * 128 + d]) + pos[ll * 128 + d]) * w[((size_t)ll * 128 + d) * 128 + e];
        if (which == 0) ((bf16*)(P.ws + WS_KCMP))[(((size_t)b * 2 + g) * 128 + n) * 128 + e] = (bf16)f2bf(acc);
        else ((bf16*)(P.ws + WS_VCMPT))[(((size_t)b * 2 + g) * 128 + e) * 128 + n] = (bf16)f2bf(acc);
    }
    for (int w = bid * 512 + tid_; w < NB * 8 * 4 * 128; w += nb * 512) {
        const int d = w & 127, id = w >> 7, h = id & 3, blk = (id >> 2) & 7, b = id >> 5;
        const bf16* k = (const bf16*)(P.ws + WS_TM) + (((size_t)b * NTM + TM_C_K + h) * S + blk * 256) * 128;
        float s = 0.f; for (int j = 0; j < 256; ++j) s += bf2f(k[(size_t)j * 128 + d]);
        ((float*)(P.ws + WS_KMEAN))[(((size_t)b * 8 + blk) * 4 + h) * 128 + d] = s * (1.0f / 256.f);
    }
}

struct KeyRef { const bf16* krow; int vkey; int dist; bool valid; };
template <class F>
__device__ __forceinline__ void naive_attend(const LAS float* qs, LAS float* sc, int n, F f, const float* biascol, const bf16* Vt, int vstride, int lane, float& o0, float& o1, float& lse, float& zinv) {
    float mx = NEG_INF;
    for (int idx = lane; idx < n; idx += 64) {
        const KeyRef kr = f(idx); float s = NEG_INF;
        if (kr.valid) { float dot = 0.f;
#pragma unroll 4
            for (int c = 0; c < 16; ++c) { const v4u w = *(const v4u*)(kr.krow + c * 8); const f32x4 qa = *(const LAS f32x4*)(qs + c * 8), qb = *(const LAS f32x4*)(qs + c * 8 + 4);
                dot += bf2f(w.x & 0xffff) * qa.x + bf2f(w.x >> 16) * qa.y + bf2f(w.y & 0xffff) * qa.z + bf2f(w.y >> 16) * qa.w + bf2f(w.z & 0xffff) * qb.x + bf2f(w.z >> 16) * qb.y + bf2f(w.w & 0xffff) * qb.z + bf2f(w.w >> 16) * qb.w; }
            s = dot * QK_SCALE + biascol[rel_bucket(kr.dist) * 16]; }
        sc[idx] = s; mx = fmaxf(mx, s);
    }
    mx = wave_max(mx); const float m = (mx > NEG_INF) ? mx : 0.f;
    WAVE_LDS_SYNC();
    float z = 0.f;
    for (int idx = lane; idx < n; idx += 64) { const float e = __expf(sc[idx] - m); sc[idx] = e; z += e; }
    z = wave_sum(z); const float zs = z > 0.f ? z : 1.f;
    WAVE_LDS_SYNC();
    float a0 = 0.f, a1 = 0.f;
    for (int idx = 0; idx < n; ++idx) { const float p = sc[idx]; if (p != 0.f) { const KeyRef kr = f(idx); a0 += p * bf2f(Vt[(size_t)(2 * lane) * vstride + kr.vkey]); a1 += p * bf2f(Vt[(size_t)(2 * lane + 1) * vstride + kr.vkey]); } }
    zinv = 1.0f / zs; o0 = a0 * zinv; o1 = a1 * zinv; lse = z > 0.f ? m + __logf(zs) : NEG_INF;
}
__device__ __forceinline__ void load_q_lds(const bf16* qrow, LAS float* qs, int lane) { qs[2 * lane] = bf2f(qrow[2 * lane]); qs[2 * lane + 1] = bf2f(qrow[2 * lane + 1]); WAVE_LDS_SYNC(); }

__device__ __forceinline__ void attnA_item(const Params& P, int id, int lane, LAS float* qs, LAS float* sc) {
    const int i = id & 2047, h = (id >> 11) % 6, b = id / (6 * S);
    const bf16* tm = (const bf16*)(P.ws + WS_TM); const bf16* vt = (const bf16*)(P.ws + WS_VT);
    const bf16* Q = tm + (((size_t)b * NTM + TM_A_Q + h) * S) * 128; const bf16* K = tm + (((size_t)b * NTM + TM_A_K + h) * S) * 128; const bf16* V = vt + (((size_t)b * NVT + VT_A_V + h) * 128) * S;
    load_q_lds(Q + (size_t)i * 128, qs, lane);
    const float* biascol = P.in[I_RELBIAS] + h;
    float o0[3], o1[3], lse[3], zi;
#pragma unroll
    for (int p = 0; p < 3; ++p) { const int dil = p == 0 ? 1 : p == 1 ? 4 : 16; const int nk = min(128, i / dil) + 1;
        naive_attend(qs, sc, nk, [&](int idx) { KeyRef r; const int j = i - idx * dil; r.krow = K + (size_t)j * 128; r.vkey = j; r.dist = idx * dil; r.valid = true; return r; }, biascol, V, S, lane, o0[p], o1[p], lse[p], zi);
        WAVE_LDS_SYNC(); }
    const float m = fmaxf(lse[0], fmaxf(lse[1], lse[2])); const float w0 = __expf(lse[0] - m), w1 = __expf(lse[1] - m), w2 = __expf(lse[2] - m), wi = 1.0f / (w0 + w1 + w2);
    const float r0 = (w0 * o0[0] + w1 * o0[1] + w2 * o0[2]) * wi, r1 = (w0 * o1[0] + w1 * o1[1] + w2 * o1[2]) * wi;
    const size_t t = (size_t)b * S + i; bf16* o = (bf16*)(P.ws + WS_ACT1);
    *(unsigned*)(o + t * D + h * 128 + 2 * lane) = pk2(r0, r1);
    const float ssq = wave_sum(r0 * r0 + r1 * r1); if (lane == 0) ((float*)(P.ws + WS_SS))[t * 16 + h] = ssq;
}
__device__ __forceinline__ void attnB1_item(const Params& P, int id, int lane, LAS float* qs, LAS float* sc, LAS float* imp) {
    const int i = id & 2047, g = (id >> 11) & 1, b = id >> 12;
    const bf16* tm = (const bf16*)(P.ws + WS_TM);
    const bf16* Kc = (const bf16*)(P.ws + WS_KCMP) + ((size_t)b * 2 + g) * 128 * 128; const bf16* Vc = (const bf16*)(P.ws + WS_VCMPT) + ((size_t)b * 2 + g) * 128 * 128;
    const size_t t = (size_t)b * S + i; const float* gates = (const float*)(P.ws + WS_GATES) + t * 18; float* ocmp = (float*)(P.ws + WS_OCMP) + t * 768;
    const int ncv = i >= 31 ? (i - 31) / 16 + 1 : 0;
    if (lane < 32) imp[lane] = 0.f;
    WAVE_LDS_SYNC();
    for (int r = 0; r < 3; ++r) { const int h = g * 3 + r;
        load_q_lds(tm + (((size_t)b * NTM + TM_B_Q + h) * S + i) * 128, qs, lane);
        float o0, o1, lse, zi;
        naive_attend(qs, sc, ncv, [&](int n) { KeyRef kr; kr.krow = Kc + (size_t)n * 128; kr.vkey = n; kr.dist = i - (16 * n + 31); kr.valid = true; return kr; }, P.in[I_RELBIAS] + 6 + h, Vc, 128, lane, o0, o1, lse, zi);
        const float g0 = gates[h * 3 + 0];
        ocmp[h * 128 + 2 * lane] = g0 * o0; ocmp[h * 128 + 2 * lane + 1] = g0 * o1;
        WAVE_LDS_SYNC();
        if (lane < 32) { float a = 0.f; for (int n = 4 * lane - 1; n <= 4 * lane + 3; ++n) if (n >= 0 && n < ncv) a += sc[n] * zi; imp[lane] += a; }
        WAVE_LDS_SYNC(); }
    const int qblk = i >> 6; float val = NEG_INF;
    if (lane < 32) { val = imp[lane]; if (lane == 0 || lane == qblk || lane == qblk - 1) val = 1e4f; else if (lane > qblk) val = -1e4f; }
    int* sel = (int*)(P.ws + WS_SEL) + (t * 2 + g) * 8;
    for (int k = 0; k < 8; ++k) { const float m = wave_max(val); const int mi = wave_min_i(val == m ? lane : 1 << 30); if (lane == mi) val = NEG_INF; if (lane == 0) sel[k] = mi; }
    WAVE_LDS_SYNC();
}
__device__ __forceinline__ void attnB2_item(const Params& P, int id, int lane, LAS float* qs, LAS float* sc) {
    const int i = id & 2047, h = (id >> 11) % 6, b = id / (6 * S), g = h / 3;
    const bf16* tm = (const bf16*)(P.ws + WS_TM); const bf16* vt = (const bf16*)(P.ws + WS_VT);
    const bf16* Ks = tm + (((size_t)b * NTM + TM_B_KS + g) * S) * 128; const bf16* Kw = tm + (((size_t)b * NTM + TM_B_KW + g) * S) * 128;
    const bf16* Vs = vt + (((size_t)b * NVT + VT_B_VS + g) * 128) * S; const bf16* Vw = vt + (((size_t)b * NVT + VT_B_VW + g) * 128) * S;
    const size_t t = (size_t)b * S + i; const float* gates = (const float*)(P.ws + WS_GATES) + t * 18; const float* ocmp = (const float*)(P.ws + WS_OCMP) + t * 768;
    const int* sel = (const int*)(P.ws + WS_SEL) + (t * 2 + g) * 8;
    load_q_lds(tm + (((size_t)b * NTM + TM_B_Q + h) * S + i) * 128, qs, lane);
    const float* biascol = P.in[I_RELBIAS] + 6 + h;
    float s0, s1, w0, w1, lse, zi;
    naive_attend(qs, sc, 512, [&](int idx) { KeyRef kr; const int key = sel[idx >> 6] * 64 + (idx & 63); kr.krow = Ks + (size_t)key * 128; kr.vkey = key; kr.dist = i - key; kr.valid = key <= i; return kr; }, biascol, Vs, S, lane, s0, s1, lse, zi);
    WAVE_LDS_SYNC();
    naive_attend(qs, sc, min(511, i) + 1, [&](int idx) { KeyRef kr; const int j = i - idx; kr.krow = Kw + (size_t)j * 128; kr.vkey = j; kr.dist = idx; kr.valid = true; return kr; }, biascol, Vw, S, lane, w0, w1, lse, zi);
    WAVE_LDS_SYNC();
    const float g1 = gates[h * 3 + 1], g2 = gates[h * 3 + 2];
    const float r0 = ocmp[h * 128 + 2 * lane] + g1 * s0 + g2 * w0, r1 = ocmp[h * 128 + 2 * lane + 1] + g1 * s1 + g2 * w1;
    bf16* o = (bf16*)(P.ws + WS_ACT1);
    *(unsigned*)(o + t * D + (6 + h) * 128 + 2 * lane) = pk2(r0, r1);
    const float ssq = wave_sum(r0 * r0 + r1 * r1); if (lane == 0) ((float*)(P.ws + WS_SS))[t * 16 + 6 + h] = ssq;
}
__device__ __forceinline__ void attnC_item(const Params& P, int id, int lane, LAS float* qs, LAS float* sc) {
    const int i = id & 2047, h = (id >> 11) & 3, b = id >> 13;
    const bf16* tm = (const bf16*)(P.ws + WS_TM); const bf16* vt = (const bf16*)(P.ws + WS_VT);
    const bf16* K = tm + (((size_t)b * NTM + TM_C_K + h) * S) * 128; const bf16* V = vt + (((size_t)b * NVT + VT_C_V + h) * 128) * S;
    load_q_lds(tm + (((size_t)b * NTM + TM_C_Q + h) * S + i) * 128, qs, lane);
    const float* biascol = P.in[I_RELBIAS] + 12 + h;
    const int qblk = i >> 8, blk0 = qblk << 8;
    float a0, a1, lseo, zi;
    naive_attend(qs, sc, i - blk0 + 1, [&](int idx) { KeyRef kr; const int j = blk0 + idx; kr.krow = K + (size_t)j * 128; kr.vkey = j; kr.dist = i - j; kr.valid = true; return kr; }, biascol, V, S, lane, a0, a1, lseo, zi);
    WAVE_LDS_SYNC();
    const float* km = (const float*)(P.ws + WS_KMEAN) + (size_t)b * 8 * 4 * 128;
    float gv = NEG_INF;
    { float part[8];
#pragma unroll
      for (int n = 0; n < 8; ++n) part[n] = wave_sum(qs[2 * lane] * km[((size_t)n * 4 + h) * 128 + 2 * lane] + qs[2 * lane + 1] * km[((size_t)n * 4 + h) * 128 + 2 * lane + 1]);
#pragma unroll
      for (int n = 0; n < 8; ++n) if (lane == n && n < qblk) gv = part[n]; }
    int sb0, sb1, sb2;
    { float m = wave_max(gv); sb0 = wave_min_i((gv == m && lane < 8) ? lane : 1 << 30); if (lane == sb0) gv = __builtin_nanf("");
      m = wave_max(gv); sb1 = wave_min_i((gv == m && lane < 8) ? lane : 1 << 30); if (lane == sb1) gv = __builtin_nanf("");
      m = wave_max(gv); sb2 = wave_min_i((gv == m && lane < 8) ? lane : 1 << 30); }
    float b0, b1, lseg;
    naive_attend(qs, sc, 768, [&](int idx) { KeyRef kr; const int sb = idx < 256 ? sb0 : idx < 512 ? sb1 : sb2; const int key = sb * 256 + (idx & 255); kr.krow = K + (size_t)key * 128; kr.vkey = key; kr.dist = i - key; kr.valid = sb < qblk; return kr; }, biascol, V, S, lane, b0, b1, lseg, zi);
    WAVE_LDS_SYNC();
    float r0, r1;
    if (lseg == NEG_INF) { r0 = a0; r1 = a1; }
    else { const float m = fmaxf(lseo, lseg), wo = __expf(lseo - m), wg = __expf(lseg - m), wi = 1.0f / (wo + wg); r0 = (wo * a0 + wg * b0) * wi; r1 = (wo * a1 + wg * b1) * wi; }
    const size_t t = (size_t)b * S + i; bf16* o = (bf16*)(P.ws + WS_ACT1);
    *(unsigned*)(o + t * D + (12 + h) * 128 + 2 * lane) = pk2(r0, r1);
    const float ssq = wave_sum(r0 * r0 + r1 * r1); if (lane == 0) ((float*)(P.ws + WS_SS))[t * 16 + 12 + h] = ssq;
}
constexpr int NA_WAVE_F = 128 + 2048 + 32;
__device__ __forceinline__ void phase_attn_naive1(const Params& P, int bid, int nb, LAS unsigned char* lds) {
    const int tid_ = TID(); const int lane = tid_ & 63, wave = tid_ >> 6, gw = bid * 8 + wave, ngw = nb * 8;
    LAS float* qs = (LAS float*)lds + wave * NA_WAVE_F; LAS float* sc = qs + 128; LAS float* imp = sc + 2048;
    for (int id = gw; id < NB * 6 * S; id += ngw) attnA_item(P, id, lane, qs, sc);
    for (int id = gw; id < NB * 2 * S; id += ngw) attnB1_item(P, id, lane, qs, sc, imp);
    for (int id = gw; id < NB * 4 * S; id += ngw) attnC_item(P, id, lane, qs, sc);
}
__device__ __forceinline__ void phase_attn_naive2(const Params& P, int bid, int nb, LAS unsigned char* lds) {
    const int tid_ = TID(); const int lane = tid_ & 63, wave = tid_ >> 6, gw = bid * 8 + wave, ngw = nb * 8;
    LAS float* qs = (LAS float*)lds + wave * NA_WAVE_F; LAS float* sc = qs + 128;
    for (int id = gw; id < NB * 6 * S; id += ngw) attnB2_item(P, id, lane, qs, sc);
}

template <int NV>
__device__ __forceinline__ void wave_top16(float (&v)[NV], int idx0, int istep, int lane, float& outv, int& outi) {
    outv = 0.f; outi = 0;
    for (int k = 0; k < 16; ++k) {
        float bv = v[0]; int bi = idx0;
#pragma unroll
        for (int e = 1; e < NV; ++e) if (v[e] > bv) { bv = v[e]; bi = idx0 + e * istep; }
        const float m = wave_max(bv); const int mi = wave_min_i(bv == m ? bi : 1 << 30);
#pragma unroll
        for (int e = 0; e < NV; ++e) if (idx0 + e * istep == mi) v[e] = NEG_INF;
        if (lane == k) { outv = m; outi = mi; }
    }
}
__device__ __forceinline__ void peer_select_item(const Params& P, int l, int id, int lane, LAS float* qs) {
    const int h = id & 7; const size_t t = id >> 3;
    const bf16* q = (const bf16*)(P.ws + WS_ACT1) + t * D + h * 256;
#pragma unroll
    for (int j = 0; j < 4; ++j) qs[lane * 4 + j] = bf2f(q[lane * 4 + j]);
    WAVE_LDS_SYNC();
    float tv[2]; int ti[2];
#pragma unroll
    for (int c = 0; c < 2; ++c) {
        const float* keys = P.in[I_PEERKEYS] + ((((size_t)l * 8 + h) * 2 + c) * 128) * 128;
        float sc[2] = {0.f, 0.f};
        const float* k0p = keys + (size_t)lane * 128; const float* k1p = k0p + 64 * 128;
#pragma unroll 4
        for (int d = 0; d < 128; d += 4) { const f32x4 qq = *(const LAS f32x4*)(qs + c * 128 + d); const f32x4 k0 = *(const f32x4*)(k0p + d), k1 = *(const f32x4*)(k1p + d);
            sc[0] += qq.x * k0.x + qq.y * k0.y + qq.z * k0.z + qq.w * k0.w; sc[1] += qq.x * k1.x + qq.y * k1.y + qq.z * k1.z + qq.w * k1.w; }
        wave_top16<2>(sc, lane, 64, lane, tv[c], ti[c]);
    }
    float cv[4];
    const float s0 = lane_get(tv[0], lane >> 2);
#pragma unroll
    for (int e = 0; e < 4; ++e) cv[e] = s0 + lane_get(tv[1], (lane & 3) * 4 + e);
    float bs; int bj; wave_top16<4>(cv, lane * 4, 1, lane, bs, bj);
    const int ei = lane_get_i(ti[0], bj >> 4) * 128 + lane_get_i(ti[1], bj & 15);
    const float m = lane_get(bs, 0); float e = lane < 16 ? __expf(bs - m) : 0.f; const float z = wave_sum(e);
    if (lane < 16) { ((int*)(P.ws + WS_EXP))[t * 128 + h * 16 + lane] = ei; ((float*)(P.ws + WS_GW))[t * 128 + h * 16 + lane] = e / z; }
    WAVE_LDS_SYNC();
}
__device__ __forceinline__ void phase_peer_select_naive(const Params& P, int l, int bid, int nb, LAS unsigned char* lds) {
    const int tid_ = TID(); const int lane = tid_ & 63, wave = tid_ >> 6, gw = bid * 8 + wave, ngw = nb * 8;
    LAS float* qs = (LAS float*)lds + wave * 256;
    for (int id = gw; id < T * 8; id += ngw) peer_select_item(P, l, id, lane, qs);
}
__device__ __forceinline__ void unpack8(const v4u w, float (&f)[8]) { f[0] = bf2f(w.x & 0xffff); f[1] = bf2f(w.x >> 16); f[2] = bf2f(w.y & 0xffff); f[3] = bf2f(w.y >> 16); f[4] = bf2f(w.z & 0xffff); f[5] = bf2f(w.z >> 16); f[6] = bf2f(w.w & 0xffff); f[7] = bf2f(w.w >> 16); }

namespace fa {
typedef short bf16x8 __attribute__((ext_vector_type(8)));
typedef float f32x16 __attribute__((ext_vector_type(16)));
typedef __bf16 bf2_t __attribute__((ext_vector_type(2)));
typedef float f2_t __attribute__((ext_vector_type(2)));
#define FA_MFMA(a, b, c) __builtin_amdgcn_mfma_f32_32x32x16_bf16((a), (b), (c), 0, 0, 0)
constexpr float C1 = 0.08838834764831845f * 1.4426950408889634f;
constexpr float LOG2E = 1.4426950408889634f;
constexpr float DEAD = -2e30f, MINIT = -1e30f;
constexpr int KP = 272, VP = 136;
constexpr int STG = 64 * KP + 128 * VP;
constexpr int L_STG0 = 0, L_STG1 = STG, L_T1 = 2 * STG, TBL = 2304 * 4, L_T2 = L_T1 + TBL, L_X = L_T2 + TBL;
constexpr int L_KC = 0, KCP = 272, L_VC = 128 * KCP, VCP = 264;
static_assert(L_VC + 128 * VCP <= L_T1 && L_X + 3 * TBL <= 131072 - 256, "attention LDS map");
constexpr int L_CTL = 131072 - 256;
__device__ __forceinline__ unsigned cvt2(float lo, float hi) { f2_t v = {lo, hi}; return __builtin_bit_cast(unsigned, __builtin_convertvector(v, bf2_t)); }
__device__ __forceinline__ float xhalf(float v, int h) { float lo, hi; halves(v, lo, hi); return h ? lo : hi; }
__device__ __forceinline__ int xhalf_i(int v, int h) { int lo, hi; halves_i(v, lo, hi); return h ? lo : hi; }

__device__ __forceinline__ void copy_table(LAS float* T, const Params& P, int kind, int gh, int tid) {
    const GAS f32x4* src = (const GAS f32x4*)((const GAS float*)(P.ws + WS_TBL) + (size_t)(gh * 3 + kind) * 2304);
    for (int i = tid; i < 576; i += 512) *(LAS f32x4*)(T + 4 * i) = src[i];
}
struct Stream { const bf16* K; const bf16* Vt; const LAS float* T; int jlo, jhi; unsigned ormask; int shift; unsigned rowmask; int maxd; };
struct State { f32x16 o[4]; float m, l; };
__device__ __forceinline__ void state_init(State& s) {
#pragma unroll
    for (int mt = 0; mt < 4; ++mt)
#pragma unroll
        for (int i = 0; i < 16; ++i) s.o[mt][i] = 0.f;
    s.m = MINIT; s.l = 0.f;
}
__device__ __forceinline__ int next_active(int j, int jhi, unsigned ormask, int shift) { while (j <= jhi && !((ormask >> (j >> shift)) & 1u)) ++j; return j <= jhi ? j : -1; }
__device__ __forceinline__ void run_stream(const Stream& st, const bf16x8 (&bq)[8], State& S, int qpos, LAS unsigned char* lds, int tid) {
    const int lane = tid & 63, r = lane & 31, h = lane >> 5;
    int j = next_active(st.jlo, st.jhi, st.ormask, st.shift);
    if (j < 0) return;
    const GAS unsigned char* Kg = (const GAS unsigned char*)st.K; const GAS unsigned char* Vg = (const GAS unsigned char*)st.Vt;
    const int kc0 = tid, kc1 = tid + 512;
    const unsigned k_lds0 = (kc0 >> 4) * KP + (kc0 & 15) * 16, k_lds1 = (kc1 >> 4) * KP + (kc1 & 15) * 16;
    const unsigned v_lds0 = 64 * KP + (kc0 >> 3) * VP + (kc0 & 7) * 16, v_lds1 = 64 * KP + (kc1 >> 3) * VP + (kc1 & 7) * 16;
    const size_t v_g0 = (size_t)(kc0 >> 3) * (::S * 2) + (kc0 & 7) * 16, v_g1 = (size_t)(kc1 >> 3) * (::S * 2) + (kc1 & 7) * 16;
    v4u ka0, ka1, va0, va1, kb0, kb1, vb0, vb1;
#define FA_PREFETCH(kr0, kr1, vr0, vr1, jj) do { const size_t kb_ = (size_t)(jj) * (64 * 256); kr0 = *(const GAS v4u*)(Kg + kb_ + (size_t)kc0 * 16); kr1 = *(const GAS v4u*)(Kg + kb_ + (size_t)kc1 * 16); \
        const size_t vb_ = (size_t)(jj) * 128; vr0 = *(const GAS v4u*)(Vg + vb_ + v_g0); vr1 = *(const GAS v4u*)(Vg + vb_ + v_g1); } while (0)
#define FA_WRITE(kr0, kr1, vr0, vr1, stg) do { LAS unsigned char* sw = lds + (stg); *(LAS v4u*)(sw + k_lds0) = kr0; *(LAS v4u*)(sw + k_lds1) = kr1; \
        *(LAS v2u*)(sw + v_lds0) = (v2u){vr0.x, vr0.y}; *(LAS v2u*)(sw + v_lds0 + 8) = (v2u){vr0.z, vr0.w}; *(LAS v2u*)(sw + v_lds1) = (v2u){vr1.x, vr1.y}; *(LAS v2u*)(sw + v_lds1 + 8) = (v2u){vr1.z, vr1.w}; } while (0)
    auto compute = [&](const int j, const LAS unsigned char* sb, const bool force_dead) __attribute__((always_inline)) {
#if FA_STAGGER
        if (tid >= 256) __builtin_amdgcn_s_sleep(FA_STAGGER);
#endif
        const bool bit = ((st.rowmask >> (j >> st.shift)) & 1u) && !force_dead;
        const int bidx = bit ? (qpos - 64 * j + 256 - 4 * h - 59) : (4 - 4 * h);
        const LAS float* tp = st.T + bidx;
        const int wq_hi = qpos - r + 31, wq_lo = qpos - r;
#pragma unroll
        for (int kt = 0; kt < 2; ++kt) {
            if (64 * j + 32 * kt > wq_hi || 64 * j + 32 * kt + 31 < wq_lo - st.maxd) continue;
            f32x16 sc;
#pragma unroll
            for (int i = 0; i < 16; ++i) sc[i] = 0.f;
            { bf16x8 af[8];
#pragma unroll
              for (int ks = 0; ks < 8; ++ks) af[ks] = *(const LAS bf16x8*)(sb + (32 * kt + r) * KP + (16 * ks + 8 * h) * 2);
              __builtin_amdgcn_s_setprio(1);
#pragma unroll
              for (int ks = 0; ks < 8; ++ks) sc = FA_MFMA(af[ks], bq[ks], sc);
              __builtin_amdgcn_s_setprio(0); }
            float mloc = S.m;
#pragma unroll
            for (int i = 0; i < 16; ++i) { const float s = __builtin_fmaf(sc[i], C1, tp[59 - 32 * kt - 8 * (i >> 2) - (i & 3)]); sc[i] = s; mloc = fmaxf(mloc, s); }
            float mlo_, mhi_; halves(mloc, mlo_, mhi_); const float mnew = fmaxf(mlo_, mhi_);
            const float alpha = __builtin_amdgcn_exp2f(S.m - mnew);
            float lsum = 0.f;
#pragma unroll
            for (int i = 0; i < 16; ++i) { const float p = __builtin_amdgcn_exp2f(sc[i] - mnew); sc[i] = p; lsum += p; }
            S.l = S.l * alpha + lsum; S.m = mnew;
            if (__builtin_amdgcn_ballot_w64(alpha != 1.0f) != 0ull) {
#pragma unroll
                for (int mt = 0; mt < 4; ++mt)
#pragma unroll
                    for (int i = 0; i < 16; ++i) S.o[mt][i] *= alpha;
            }
#pragma unroll
            for (int s2 = 0; s2 < 2; ++s2) { const int sp = 2 * kt + s2, s8 = s2 * 8;
                v4u pw; pw.x = cvt2(sc[s8 + 0], sc[s8 + 1]); pw.y = cvt2(sc[s8 + 2], sc[s8 + 3]); pw.z = cvt2(sc[s8 + 4], sc[s8 + 5]); pw.w = cvt2(sc[s8 + 6], sc[s8 + 7]);
                const bf16x8 pb = __builtin_bit_cast(bf16x8, pw);
                bf16x8 vf[4];
#pragma unroll
                for (int mt = 0; mt < 4; ++mt) { const LAS unsigned char* vp = sb + 64 * KP + (32 * mt + r) * VP + (16 * sp + 4 * h) * 2;
                    const v2u lo = *(const LAS v2u*)vp, hi = *(const LAS v2u*)(vp + 16);
                    vf[mt] = __builtin_bit_cast(bf16x8, (v4u){lo.x, lo.y, hi.x, hi.y}); }
                __builtin_amdgcn_s_setprio(1);
#pragma unroll
                for (int mt = 0; mt < 4; ++mt) S.o[mt] = FA_MFMA(vf[mt], pb, S.o[mt]);
                __builtin_amdgcn_s_setprio(0); }
        }
    };
    int jc = j, jn = next_active(jc + 1, st.jhi, st.ormask, st.shift);
    FA_PREFETCH(ka0, ka1, va0, va1, jc); FA_WRITE(ka0, ka1, va0, va1, L_STG0);
    FA_PREFETCH(ka0, ka1, va0, va1, jn >= 0 ? jn : jc);
    __syncthreads();
    for (;;) {
        const int j2 = jn >= 0 ? next_active(jn + 1, st.jhi, st.ormask, st.shift) : -1;
        FA_PREFETCH(kb0, kb1, vb0, vb1, j2 >= 0 ? j2 : jc);
        compute(jc, lds + L_STG0, false);
        asm volatile("s_waitcnt vmcnt(4)" ::: "memory");
        FA_WRITE(ka0, ka1, va0, va1, L_STG1);
        asm volatile("s_waitcnt lgkmcnt(0)\n\ts_barrier" ::: "memory");
        if (jn < 0) break;
        const int j3 = j2 >= 0 ? next_active(j2 + 1, st.jhi, st.ormask, st.shift) : -1;
        FA_PREFETCH(ka0, ka1, va0, va1, j3 >= 0 ? j3 : jn);
        compute(jn, lds + L_STG1, false);
        asm volatile("s_waitcnt vmcnt(4)" ::: "memory");
        FA_WRITE(kb0, kb1, vb0, vb1, L_STG0);
        asm volatile("s_waitcnt lgkmcnt(0)\n\ts_barrier" ::: "memory");
        if (j2 < 0) break;
        jc = j2; jn = j3;
    }
    asm volatile("s_waitcnt vmcnt(0)" ::: "memory");
    __syncthreads();
#undef FA_PREFETCH
#undef FA_WRITE
}
__device__ __forceinline__ void load_q(const bf16* Qrow, bf16x8 (&bq)[8], int h) {
#pragma unroll
    for (int ks = 0; ks < 8; ++ks) bq[ks] = __builtin_bit_cast(bf16x8, *(const GAS v4u*)((const GAS bf16*)Qrow + 16 * ks + 8 * h));
}
__device__ __forceinline__ float finish(State& S, float wgt) { float llo_, lhi_; halves(S.l, llo_, lhi_); const float lt = llo_ + lhi_; const float inv = wgt / lt;
#pragma unroll
    for (int mt = 0; mt < 4; ++mt)
#pragma unroll
        for (int i = 0; i < 16; ++i) S.o[mt][i] *= inv;
    return inv; }
__device__ __forceinline__ void store_out(const State& S, bf16* o, float* ss, size_t t, int gh, int h) {
    float q = 0.f; GAS bf16* op = (GAS bf16*)o + t * D + gh * 128 + 4 * h;
#pragma unroll
    for (int mt = 0; mt < 4; ++mt)
#pragma unroll
        for (int g = 0; g < 4; ++g) { const float a = S.o[mt][4 * g], b = S.o[mt][4 * g + 1], c = S.o[mt][4 * g + 2], d = S.o[mt][4 * g + 3];
            q += a * a + b * b + c * c + d * d; *(GAS v2u*)(op + 32 * mt + 8 * g) = (v2u){cvt2(a, b), cvt2(c, d)}; }
    { float qlo_, qhi_; halves(q, qlo_, qhi_); q = qlo_ + qhi_; } if (h == 0) ss[t * 16 + gh] = q;
}
__device__ __forceinline__ void decode_unit(int u, int& b, int& gh, int& qt) {
    int isb, w;
    if (u < 240) { isb = 1; qt = 7 - u / 48; w = u % 48; }
    else if (u < 320) { isb = 0; qt = 7; w = u - 240; }
    else if (u < 368) { isb = 1; qt = 2; w = u - 320; }
    else if (u < 528) { isb = 0; qt = 6 - (u - 368) / 80; w = (u - 368) % 80; }
    else if (u < 576) { isb = 1; qt = 1; w = u - 528; }
    else if (u < 736) { isb = 0; qt = 4 - (u - 576) / 80; w = (u - 576) % 80; }
    else if (u < 784) { isb = 1; qt = 0; w = u - 736; }
    else { isb = 0; qt = 2 - (u - 784) / 80; w = (u - 784) % 80; }
    b = w & 7; const int hh = w >> 3;
    if (isb) gh = 6 + hh; else gh = hh < 6 ? hh : 12 + (hh - 6);
}

__device__ __forceinline__ void attn_unit(const Params& P, int u, LAS unsigned char* lds) {
    const int tid = TID();
    const int lane = tid & 63, wave = tid >> 6, r = lane & 31, h = lane >> 5;
    int b, gh, qt; decode_unit(u, b, gh, qt);
    const int q0 = qt * 256, qpos = q0 + 32 * wave + r; const size_t t = (size_t)b * S + qpos;
    const bf16* tm = (const bf16*)(P.ws + WS_TM); const bf16* vt = (const bf16*)(P.ws + WS_VT);
    bf16* o = (bf16*)(P.ws + WS_ACT1); float* ss = (float*)(P.ws + WS_SS);
    volatile LAS unsigned* ctl = (volatile LAS unsigned*)(lds + L_CTL);
    LAS float* T1 = (LAS float*)(lds + L_T1); LAS float* T2 = (LAS float*)(lds + L_T2);
    bf16x8 bq[8]; State St;
    if (gh < 6) {
        copy_table(T1, P, 2, gh, tid);
        load_q(tm + (((size_t)b * NTM + TM_A_Q + gh) * S + qpos) * 128, bq, h);
        __syncthreads();
        state_init(St);
        Stream s{tm + ((size_t)b * NTM + TM_A_K + gh) * S * 128, vt + ((size_t)b * NVT + VT_A_V + gh) * 128 * S, T1, 0, 4 * qt + 3, 0xffffffffu, 0, 0xffffffffu, 4096};
        run_stream(s, bq, St, qpos, lds, tid);
        finish(St, 1.0f); store_out(St, o, ss, t, gh, h);
    } else if (gh >= 12) {
        const int hc = gh - 12;
        copy_table(T1, P, 0, gh, tid);
        LAS float* km = (LAS float*)(lds + L_X);
        { const float* kmg = (const float*)(P.ws + WS_KMEAN) + (size_t)b * 8 * 4 * 128;
          for (int i = tid; i < qt * 128; i += 512) km[i] = kmg[((size_t)(i >> 7) * 4 + hc) * 128 + (i & 127)]; }
        load_q(tm + (((size_t)b * NTM + TM_C_Q + hc) * S + qpos) * 128, bq, h);
        if (tid == 0) ctl[1] = 0u;
        __syncthreads();
        float gate[8];
#pragma unroll
        for (int n = 0; n < 8; ++n) gate[n] = 0.f;
#pragma unroll
        for (int ks = 0; ks < 8; ++ks) { const v4u w = __builtin_bit_cast(v4u, bq[ks]); float f[8]; unpack8(w, f);
#pragma unroll
            for (int n = 0; n < 8; ++n) if (n < qt) { const f32x4 k0 = *(const LAS f32x4*)(km + n * 128 + 16 * ks + 8 * h), k1 = *(const LAS f32x4*)(km + n * 128 + 16 * ks + 8 * h + 4);
                gate[n] += f[0] * k0.x + f[1] * k0.y + f[2] * k0.z + f[3] * k0.w + f[4] * k1.x + f[5] * k1.y + f[6] * k1.z + f[7] * k1.w; } }
        unsigned rowmask = 1u << qt;
#pragma unroll
        for (int n = 0; n < 8; ++n) { float glo_, ghi_; halves(gate[n], glo_, ghi_); gate[n] = glo_ + ghi_; if (n >= qt) gate[n] = NEG_INF; }
#pragma unroll
        for (int k = 0; k < 3; ++k) { float bv = NEG_INF; int bi = -1;
#pragma unroll
            for (int n = 0; n < 8; ++n) if (gate[n] > bv) { bv = gate[n]; bi = n; }
#pragma unroll
            for (int n = 0; n < 8; ++n) if (n == bi) { gate[n] = NEG_INF; rowmask |= 1u << n; } }
        { const unsigned om = wave_or(rowmask); if (lane == 0) atomicOr((unsigned*)(ctl + 1), om); }
        __syncthreads();
        const unsigned ormask = ctl[1];
        state_init(St);
        Stream s{tm + ((size_t)b * NTM + TM_C_K + hc) * S * 128, vt + ((size_t)b * NVT + VT_C_V + hc) * 128 * S, T1, 0, 4 * qt + 3, ormask, 2, rowmask, 4096};
        run_stream(s, bq, St, qpos, lds, tid);
        finish(St, 1.0f); store_out(St, o, ss, t, gh, h);
    } else {
        const int hb = gh - 6, g = hb / 3;
        const float* gates = (const float*)(P.ws + WS_GATES) + t * 18 + hb * 3; const float g0 = gates[0], g1 = gates[1], g2 = gates[2];
        GAS float* oacc = (GAS float*)(P.ws + WS_OCMP) + t * 768 + hb * 128 + 4 * h;
        { const GAS unsigned char* kcg = (const GAS unsigned char*)((const bf16*)(P.ws + WS_KCMP) + ((size_t)b * 2 + g) * 128 * 128); const GAS unsigned char* vcg = (const GAS unsigned char*)((const bf16*)(P.ws + WS_VCMPT) + ((size_t)b * 2 + g) * 128 * 128);
#pragma unroll
          for (int c = tid; c < 2048; c += 512) { const v4u kv = *(const GAS v4u*)(kcg + (size_t)c * 16); *(LAS v4u*)(lds + L_KC + (c >> 4) * KCP + (c & 15) * 16) = kv;
              const v4u vv = *(const GAS v4u*)(vcg + (size_t)c * 16); LAS unsigned char* vd = lds + L_VC + (c >> 4) * VCP + (c & 15) * 16; *(LAS v2u*)vd = (v2u){vv.x, vv.y}; *(LAS v2u*)(vd + 8) = (v2u){vv.z, vv.w}; } }
#pragma unroll
        for (int rr = 0; rr < 3; ++rr) copy_table((LAS float*)(lds + L_X + rr * TBL), P, 0, 6 + g * 3 + rr, tid);
        copy_table(T1, P, 0, gh, tid); copy_table(T2, P, 1, gh, tid);
        if (tid == 0) ctl[1] = 0u;
        __syncthreads();
        float imp[16];
#pragma unroll
        for (int a = 0; a < 16; ++a) imp[a] = 0.f;
        f32x16 sc[4];
#pragma unroll 1
        for (int rq = 0; rq < 3; ++rq) { int rr = hb - g * 3 + 1 + rq; rr = rr >= 3 ? rr - 3 : rr; const int hh = g * 3 + rr;
            asm volatile("" ::: "memory");
            load_q(tm + (((size_t)b * NTM + TM_B_Q + hh) * S + qpos) * 128, bq, h);
            const LAS float* Tc = (const LAS float*)(lds + L_X + rr * TBL);
#pragma unroll
            for (int kt = 0; kt < 4; ++kt) {
#pragma unroll
                for (int i = 0; i < 16; ++i) sc[kt][i] = 0.f;
#pragma unroll
                for (int ks = 0; ks < 8; ++ks) { const bf16x8 a = *(const LAS bf16x8*)(lds + L_KC + (32 * kt + r) * KCP + (16 * ks + 8 * h) * 2); sc[kt] = FA_MFMA(a, bq[ks], sc[kt]); } }
            float mloc = MINIT;
#pragma unroll
            for (int kt = 0; kt < 4; ++kt)
#pragma unroll
                for (int i = 0; i < 16; ++i) { const int n = 32 * kt + 8 * (i >> 2) + 4 * h + (i & 3); int idx = qpos - 16 * n - 31 + 256; idx = idx < 0 ? 0 : idx;
                    const float s = __builtin_fmaf(sc[kt][i], C1, Tc[idx]); sc[kt][i] = s; mloc = fmaxf(mloc, s); }
            float mlo_, mhi_; halves(mloc, mlo_, mhi_); const float mrow = fmaxf(mlo_, mhi_); float lsum = 0.f;
#pragma unroll
            for (int kt = 0; kt < 4; ++kt)
#pragma unroll
                for (int i = 0; i < 16; ++i) { const float p = __builtin_amdgcn_exp2f(sc[kt][i] - mrow); sc[kt][i] = p; lsum += p; }
            { float slo_, shi_; halves(lsum, slo_, shi_); lsum = slo_ + shi_; } const float inv = lsum > 0.f ? 1.0f / lsum : 0.f;
#pragma unroll
            for (int a = 0; a < 16; ++a) { const int kt = a >> 2, i0 = (a & 3) * 4;
                const float p0 = sc[kt][i0] * inv, p1 = sc[kt][i0 + 1] * inv, p2 = sc[kt][i0 + 2] * inv, p3 = sc[kt][i0 + 3] * inv;
                sc[kt][i0] = p0; sc[kt][i0 + 1] = p1; sc[kt][i0 + 2] = p2; sc[kt][i0 + 3] = p3;
                imp[a] += (p0 + p1) + (p2 + p3); }
            { float prev = 0.f;
#pragma unroll
              for (int a = 0; a < 16; ++a) { const float lv = xhalf(sc[a >> 2][(a & 3) * 4 + 3], h); imp[a] += h ? lv : prev; prev = lv; } }
        }
        state_init(St);
#pragma unroll
        for (int sp = 0; sp < 8; ++sp) { const int kt = sp >> 1, s8 = (sp & 1) * 8;
            v4u pw; pw.x = cvt2(sc[kt][s8 + 0], sc[kt][s8 + 1]); pw.y = cvt2(sc[kt][s8 + 2], sc[kt][s8 + 3]); pw.z = cvt2(sc[kt][s8 + 4], sc[kt][s8 + 5]); pw.w = cvt2(sc[kt][s8 + 6], sc[kt][s8 + 7]);
            const bf16x8 pb = __builtin_bit_cast(bf16x8, pw);
#pragma unroll
            for (int mt = 0; mt < 4; ++mt) { const LAS unsigned char* vp = lds + L_VC + (32 * mt + r) * VCP + (16 * sp + 4 * h) * 2;
                const v2u lo = *(const LAS v2u*)vp, hi = *(const LAS v2u*)(vp + 16);
                St.o[mt] = FA_MFMA(__builtin_bit_cast(bf16x8, (v4u){lo.x, lo.y, hi.x, hi.y}), pb, St.o[mt]); } }
#pragma unroll
        for (int mt = 0; mt < 4; ++mt)
#pragma unroll
            for (int gq = 0; gq < 4; ++gq) *(GAS f32x4*)(oacc + 32 * mt + 8 * gq) = (f32x4){St.o[mt][4 * gq] * g0, St.o[mt][4 * gq + 1] * g0, St.o[mt][4 * gq + 2] * g0, St.o[mt][4 * gq + 3] * g0};
        const int qblk = qpos >> 6;
        unsigned selmask;
        if (qblk <= 7) selmask = (2u << qblk) - 1u;
        else { selmask = 1u | (3u << (qblk - 1));
#pragma unroll
            for (int a = 0; a < 16; ++a) { const int jb = 2 * a + h; if (jb == 0 || jb >= qblk - 1) imp[a] = NEG_INF; }
#pragma unroll 1
            for (int k = 0; k < 5; ++k) { float bv = NEG_INF; int bj = 1 << 20;
#pragma unroll
                for (int a = 0; a < 16; ++a) if (imp[a] > bv) { bv = imp[a]; bj = 2 * a + h; }
                const float ov = xhalf(bv, h); const int oj = xhalf_i(bj, h);
                const bool mine = (bv > ov) || (bv == ov && bj < oj);
                const int wj = mine ? bj : oj;
                if (wj < 32) { selmask |= 1u << wj;
#pragma unroll
                    for (int a = 0; a < 16; ++a) if (2 * a + h == wj) imp[a] = NEG_INF; } } }
        { const unsigned om = wave_or(selmask); if (lane == 0) atomicOr((unsigned*)(ctl + 1), om); }
        load_q(tm + (((size_t)b * NTM + TM_B_Q + hb) * S + qpos) * 128, bq, h);
        __syncthreads();
        const unsigned ormask = ctl[1];
        state_init(St);
        { Stream s{tm + ((size_t)b * NTM + TM_B_KS + g) * S * 128, vt + ((size_t)b * NVT + VT_B_VS + g) * 128 * S, T1, 0, 4 * qt + 3, ormask, 0, selmask, 4096};
          run_stream(s, bq, St, qpos, lds, tid); }
        { f32x4 pvv[4][4];
#pragma unroll
          for (int mt = 0; mt < 4; ++mt)
#pragma unroll
              for (int gq = 0; gq < 4; ++gq) pvv[mt][gq] = *(const GAS f32x4*)(oacc + 32 * mt + 8 * gq);
          finish(St, g1);
#pragma unroll
          for (int mt = 0; mt < 4; ++mt)
#pragma unroll
              for (int gq = 0; gq < 4; ++gq) { const f32x4 pv = pvv[mt][gq];
                  *(GAS f32x4*)(oacc + 32 * mt + 8 * gq) = (f32x4){pv.x + St.o[mt][4 * gq], pv.y + St.o[mt][4 * gq + 1], pv.z + St.o[mt][4 * gq + 2], pv.w + St.o[mt][4 * gq + 3]}; } }
        state_init(St);
        { const int jlo = q0 >= 512 ? (q0 - 512) / 64 : 0;
          Stream s{tm + ((size_t)b * NTM + TM_B_KW + g) * S * 128, vt + ((size_t)b * NVT + VT_B_VW + g) * 128 * S, T2, jlo, 4 * qt + 3, 0xffffffffu, 0, 0xffffffffu, 511};
          run_stream(s, bq, St, qpos, lds, tid); }
        finish(St, g2);
#pragma unroll
        for (int mt = 0; mt < 4; ++mt)
#pragma unroll
            for (int gq = 0; gq < 4; ++gq) { const f32x4 pv = *(const GAS f32x4*)(oacc + 32 * mt + 8 * gq);
                St.o[mt][4 * gq] += pv.x; St.o[mt][4 * gq + 1] += pv.y; St.o[mt][4 * gq + 2] += pv.z; St.o[mt][4 * gq + 3] += pv.w; }
        store_out(St, o, ss, t, gh, h);
    }
}
__device__ __forceinline__ void phase_attn(const Params& P, int l, LAS unsigned char* lds) {
    const int tid = TID();
    volatile LAS unsigned* ctl = (volatile LAS unsigned*)(lds + L_CTL);
    unsigned* qctr = (unsigned*)(P.ws + WS_CTL) + 8192 + 64 * l;
    const unsigned nbk_ = gridDim.x, bk_ = blockIdx.x; const bool stat_ = nbk_ >= 256u; bool first_ = stat_ && bk_ < 256u;
    for (;;) {
        unsigned u;
        if (first_) { u = bk_; first_ = false; }
        else { __syncthreads();
               if (tid == 0) ctl[0] = (stat_ ? 256u : 0u) + __hip_atomic_fetch_add(qctr, 1u, __ATOMIC_RELAXED, __HIP_MEMORY_SCOPE_AGENT);
               __syncthreads();
               u = ctl[0]; }
        if (u >= 1024u) break;
        attn_unit(P, (int)u, lds);
    }
}
#undef FA_MFMA
}

namespace pf {
typedef short bf16x8 __attribute__((ext_vector_type(8)));
typedef float f32x16 __attribute__((ext_vector_type(16)));
__device__ __forceinline__ void cmp_unit(const Params& P, int l, int u, LAS unsigned char* lds) {
    const int tid = TID(), lane = tid & 63, wave = tid >> 6, r = lane & 31, h = lane >> 5;
    const int which = u >> 7, bg = (u >> 3) & 15, b = bg >> 1, g = bg & 1, n0 = ((u >> 1) & 3) * 32, e0 = (u & 1) * 64;
    const GAS bf16* A = (const GAS bf16*)(P.ws + WS_TM) + (((size_t)b * NTM + (which ? TM_B_VC : TM_B_KC) + g) * S + 16 * (n0 + r)) * 128 + 512 * wave + 8 * h;
    const GAS bf16* Bt = (const GAS bf16*)(P.ws + WS_CWT) + (((size_t)l * 2 + which) * 128 + e0 + r) * 4096 + 512 * wave + 8 * h;
    float pw = 0.f;
    if (tid < 64) { const GAS float* pp = (const GAS float*)(P.ws + WS_POSW) + ((size_t)l * 2 + which) * 32 * 128 + e0 + tid;
#pragma unroll
        for (int kc = 0; kc < 32; ++kc) pw += pp[kc * 128]; }
    f32x16 acc[2];
#pragma unroll
    for (int ct = 0; ct < 2; ++ct)
#pragma unroll
        for (int i = 0; i < 16; ++i) acc[ct][i] = 0.f;
#pragma unroll 8
    for (int ks = 0; ks < 32; ++ks) {
        const bf16x8 a = __builtin_bit_cast(bf16x8, *(const GAS v4u*)(A + 16 * ks));
#pragma unroll
        for (int ct = 0; ct < 2; ++ct) { const bf16x8 bb = __builtin_bit_cast(bf16x8, *(const GAS v4u*)(Bt + (size_t)ct * 32 * 4096 + 16 * ks)); acc[ct] = __builtin_amdgcn_mfma_f32_32x32x16_bf16(a, bb, acc[ct], 0, 0, 0); }
    }
    LAS float* red = (LAS float*)lds; LAS float* pwl = red + 8 * 2048;
#pragma unroll
    for (int ct = 0; ct < 2; ++ct)
#pragma unroll
        for (int i = 0; i < 16; ++i) red[((wave * 2 + ct) * 16 + i) * 64 + lane] = acc[ct][i];
    if (tid < 64) pwl[tid] = pw;
    __syncthreads();
#pragma unroll
    for (int j = 0; j < 4; ++j) { const int o = tid + 512 * j; float v = 0.f;
#pragma unroll
        for (int w = 0; w < 8; ++w) v += red[w * 2048 + o];
        const int ln = o & 63, i = (o >> 6) & 15, ct = o >> 10; const int n = n0 + (i & 3) + 8 * (i >> 2) + 4 * (ln >> 5), e = e0 + 32 * ct + (ln & 31);
        v += pwl[32 * ct + (ln & 31)];
        if (n == 127) v = 0.f;
        if (which == 0) ((GAS bf16*)(P.ws + WS_KCMP))[(((size_t)b * 2 + g) * 128 + n) * 128 + e] = (bf16)f2bf(v);
        else ((GAS bf16*)(P.ws + WS_VCMPT))[(((size_t)b * 2 + g) * 128 + e) * 128 + n] = (bf16)f2bf(v); }
    __syncthreads();
}
__device__ __forceinline__ void kmean_load(const Params& P, int u, unsigned (&w)[32]) {
    const int tid = TID(), dp = tid & 63, part = tid >> 6; const int hc = u & 3, blk = (u >> 2) & 7, b = u >> 5;
    const GAS bf16* k = (const GAS bf16*)(P.ws + WS_TM) + (((size_t)b * NTM + TM_C_K + hc) * S + blk * 256 + part * 32) * 128 + 2 * dp;
#pragma unroll
    for (int j = 0; j < 32; ++j) w[j] = *(const GAS unsigned*)(k + (size_t)j * 128);
}
__device__ __forceinline__ void kmean_finish(const Params& P, int u, const unsigned (&w)[32], LAS unsigned char* lds) {
    const int tid = TID(), dp = tid & 63, part = tid >> 6; const int hc = u & 3, blk = (u >> 2) & 7, b = u >> 5;
    float s0 = 0.f, s1 = 0.f;
#pragma unroll
    for (int j = 0; j < 32; ++j) { s0 += bf2f(w[j] & 0xffff); s1 += bf2f(w[j] >> 16); }
    LAS float* red = (LAS float*)lds; red[part * 128 + 2 * dp] = s0; red[part * 128 + 2 * dp + 1] = s1;
    __syncthreads();
    if (tid < 128) { float v = 0.f;
#pragma unroll
        for (int p = 0; p < 8; ++p) v += red[p * 128 + tid];
        ((GAS float*)(P.ws + WS_KMEAN))[(((size_t)b * 8 + blk) * 4 + hc) * 128 + tid] = v * (1.0f / 256.f); }
    __syncthreads();
}
__device__ __forceinline__ void phase_prep(const Params& P, int l, int bid, int nb, LAS unsigned char* lds) {
    for (int u = bid; u < 256; u += nb) { unsigned w[32]; kmean_load(P, u, w); cmp_unit(P, l, u, lds); kmean_finish(P, u, w, lds); }
}
}

typedef __bf16 bf2_t __attribute__((ext_vector_type(2)));
__device__ __forceinline__ float dot2bf(unsigned a, unsigned b, float c) { return __builtin_amdgcn_fdot2_f32_bf16(__builtin_bit_cast(bf2_t, a), __builtin_bit_cast(bf2_t, b), c, false); }

namespace ps {
typedef short bf16x8 __attribute__((ext_vector_type(8)));
typedef float f32x16 __attribute__((ext_vector_type(16)));
#define PS_CE(a, b) do { const float hi_ = fmaxf((a), (b)), lo_ = fminf((a), (b)); (a) = hi_; (b) = lo_; } while (0)
__device__ __forceinline__ void sort16(float (&v)[16]) {
#pragma unroll
    for (int k = 2; k <= 16; k <<= 1)
#pragma unroll
        for (int j = k >> 1; j > 0; j >>= 1)
#pragma unroll
            for (int i = 0; i < 16; ++i) { const int p = i ^ j; if (p > i) { if ((i & k) == 0) PS_CE(v[i], v[p]); else PS_CE(v[p], v[i]); } }
}
__device__ __forceinline__ void merge16(float (&a)[16], const float (&b)[16]) {
#pragma unroll
    for (int i = 0; i < 16; ++i) a[i] = fmaxf(a[i], b[15 - i]);
#pragma unroll
    for (int j = 8; j > 0; j >>= 1)
#pragma unroll
        for (int i = 0; i < 16; ++i) { const int p = i ^ j; if (p > i) PS_CE(a[i], a[p]); }
}
__device__ __forceinline__ float pack_low(float v, unsigned mask, unsigned tag) { return __uint_as_float((__float_as_uint(v) & ~mask) | tag); }
constexpr int SKP = 272;
__device__ __forceinline__ void load_q8(const GAS bf16* qrow, int h2, bf16x8 (&bq)[8]) {
#pragma unroll
    for (int ks = 0; ks < 8; ++ks) bq[ks] = __builtin_bit_cast(bf16x8, *(const GAS v4u*)(qrow + 16 * ks + 8 * h2));
}
__device__ __forceinline__ void top16_half(const LAS unsigned char* keys, const bf16x8 (&bq)[8], int r, int h2, float (&top)[16]) {
    float grp[4][16];
#pragma unroll
    for (int kt = 0; kt < 4; ++kt) { f32x16 sc;
#pragma unroll
        for (int i = 0; i < 16; ++i) sc[i] = 0.f;
#pragma unroll
        for (int ks = 0; ks < 8; ++ks) { const bf16x8 a = *(const LAS bf16x8*)(keys + (32 * kt + r) * SKP + (16 * ks + 8 * h2) * 2); sc = __builtin_amdgcn_mfma_f32_32x32x16_bf16(a, bq[ks], sc, 0, 0, 0); }
#pragma unroll
        for (int i = 0; i < 16; ++i) { const int key = 32 * kt + (i & 3) + 8 * (i >> 2); grp[kt][i] = pack_low(sc[i], 0x7Fu, (unsigned)(127 - key) - 4u * (unsigned)h2); } }
    sort16(grp[0]); sort16(grp[1]); sort16(grp[2]); sort16(grp[3]);
    merge16(grp[0], grp[1]); merge16(grp[2], grp[3]); merge16(grp[0], grp[2]);
    float oth[16];
#pragma unroll
    for (int i = 0; i < 16; ++i) oth[i] = fa::xhalf(grp[0][i], h2);
    merge16(grp[0], oth);
#pragma unroll
    for (int i = 0; i < 16; ++i) top[i] = grp[0][i];
}
__device__ __forceinline__ void select_unit(const Params& P, int l, int u, LAS unsigned char* lds, bool stage) {
    const int tid = TID(), lane = tid & 63, wave = tid >> 6, r = lane & 31, h2 = lane >> 5;
    const int head = u & 7; const size_t t = (size_t)(u >> 3) * 256 + wave * 32 + r;
    const GAS bf16* q = (const GAS bf16*)(P.ws + WS_ACT1) + t * D + head * 256;
    bf16x8 bq0[8], bq1[8]; load_q8(q, h2, bq0); load_q8(q + 128, h2, bq1);
    if (stage) { const GAS v4u* kg = (const GAS v4u*)((const GAS bf16*)(P.ws + WS_KEYS) + (((size_t)l * 8 + head) * 2) * 128 * 128);
      v4u kv[8];
#pragma unroll
      for (int i = 0; i < 8; ++i) kv[i] = kg[tid + 512 * i];
#pragma unroll
      for (int i = 0; i < 8; ++i) { const int pc = tid + 512 * i; *(LAS v4u*)(lds + (pc >> 4) * SKP + (pc & 15) * 16) = kv[i]; } }
    __syncthreads();
    float ts0[16], ts1[16];
    top16_half(lds, bq0, r, h2, ts0);
    top16_half(lds + 128 * SKP, bq1, r, h2, ts1);
    LAS int* til = (LAS int*)(lds + 256 * SKP) + (wave * 32 + r) * 32;
#pragma unroll
    for (int k = 0; k < 16; ++k) { float va = ts0[k], vb = ts1[k]; asm volatile("" : "+v"(va), "+v"(vb)); const float v = h2 ? vb : va; til[h2 * 16 + k] = 127 - (int)(__float_as_uint(v) & 0x7Fu); }
    float cg[4][16];
    cg[0][0] = pack_low(ts0[0] + ts1[0], 0xFFu, 255u);
    cg[0][1] = pack_low(ts0[0] + ts1[1], 0xFFu, 254u);
    cg[0][2] = pack_low(ts0[0] + ts1[2], 0xFFu, 253u);
    cg[0][3] = pack_low(ts0[0] + ts1[3], 0xFFu, 252u);
    cg[0][4] = pack_low(ts0[0] + ts1[4], 0xFFu, 251u);
    cg[0][5] = pack_low(ts0[0] + ts1[5], 0xFFu, 250u);
    cg[0][6] = pack_low(ts0[0] + ts1[6], 0xFFu, 249u);
    cg[0][7] = pack_low(ts0[0] + ts1[7], 0xFFu, 248u);
    cg[0][8] = pack_low(ts0[0] + ts1[8], 0xFFu, 247u);
    cg[0][9] = pack_low(ts0[0] + ts1[9], 0xFFu, 246u);
    cg[0][10] = pack_low(ts0[0] + ts1[10], 0xFFu, 245u);
    cg[0][11] = pack_low(ts0[0] + ts1[11], 0xFFu, 244u);
    cg[0][12] = pack_low(ts0[0] + ts1[12], 0xFFu, 243u);
    cg[0][13] = pack_low(ts0[0] + ts1[13], 0xFFu, 242u);
    cg[0][14] = pack_low(ts0[0] + ts1[14], 0xFFu, 241u);
    cg[0][15] = pack_low(ts0[0] + ts1[15], 0xFFu, 240u);
    cg[1][0] = pack_low(ts0[1] + ts1[0], 0xFFu, 239u);
    cg[1][1] = pack_low(ts0[1] + ts1[1], 0xFFu, 238u);
    cg[1][2] = pack_low(ts0[1] + ts1[2], 0xFFu, 237u);
    cg[1][3] = pack_low(ts0[1] + ts1[3], 0xFFu, 236u);
    cg[1][4] = pack_low(ts0[1] + ts1[4], 0xFFu, 235u);
    cg[1][5] = pack_low(ts0[1] + ts1[5], 0xFFu, 234u);
    cg[1][6] = pack_low(ts0[1] + ts1[6], 0xFFu, 233u);
    cg[1][7] = pack_low(ts0[1] + ts1[7], 0xFFu, 232u);
    cg[1][8] = pack_low(ts0[2] + ts1[0], 0xFFu, 223u);
    cg[1][9] = pack_low(ts0[2] + ts1[1], 0xFFu, 222u);
    cg[1][10] = pack_low(ts0[2] + ts1[2], 0xFFu, 221u);
    cg[1][11] = pack_low(ts0[2] + ts1[3], 0xFFu, 220u);
    cg[1][12] = pack_low(ts0[2] + ts1[4], 0xFFu, 219u);
    cg[1][13] = pack_low(ts0[3] + ts1[0], 0xFFu, 207u);
    cg[1][14] = pack_low(ts0[3] + ts1[1], 0xFFu, 206u);
    cg[1][15] = pack_low(ts0[3] + ts1[2], 0xFFu, 205u);
    cg[2][0] = pack_low(ts0[3] + ts1[3], 0xFFu, 204u);
    cg[2][1] = pack_low(ts0[4] + ts1[0], 0xFFu, 191u);
    cg[2][2] = pack_low(ts0[4] + ts1[1], 0xFFu, 190u);
    cg[2][3] = pack_low(ts0[4] + ts1[2], 0xFFu, 189u);
    cg[2][4] = pack_low(ts0[5] + ts1[0], 0xFFu, 175u);
    cg[2][5] = pack_low(ts0[5] + ts1[1], 0xFFu, 174u);
    cg[2][6] = pack_low(ts0[6] + ts1[0], 0xFFu, 159u);
    cg[2][7] = pack_low(ts0[6] + ts1[1], 0xFFu, 158u);
    cg[2][8] = pack_low(ts0[7] + ts1[0], 0xFFu, 143u);
    cg[2][9] = pack_low(ts0[7] + ts1[1], 0xFFu, 142u);
    cg[2][10] = pack_low(ts0[8] + ts1[0], 0xFFu, 127u);
    cg[2][11] = pack_low(ts0[9] + ts1[0], 0xFFu, 111u);
    cg[2][12] = pack_low(ts0[10] + ts1[0], 0xFFu, 95u);
    cg[2][13] = pack_low(ts0[11] + ts1[0], 0xFFu, 79u);
    cg[2][14] = pack_low(ts0[12] + ts1[0], 0xFFu, 63u);
    cg[2][15] = pack_low(ts0[13] + ts1[0], 0xFFu, 47u);
    cg[3][0] = pack_low(ts0[14] + ts1[0], 0xFFu, 31u);
    cg[3][1] = pack_low(ts0[15] + ts1[0], 0xFFu, 15u);
    cg[3][2] = NEG_INF;
    cg[3][3] = NEG_INF;
    cg[3][4] = NEG_INF;
    cg[3][5] = NEG_INF;
    cg[3][6] = NEG_INF;
    cg[3][7] = NEG_INF;
    cg[3][8] = NEG_INF;
    cg[3][9] = NEG_INF;
    cg[3][10] = NEG_INF;
    cg[3][11] = NEG_INF;
    cg[3][12] = NEG_INF;
    cg[3][13] = NEG_INF;
    cg[3][14] = NEG_INF;
    cg[3][15] = NEG_INF;
    sort16(cg[0]); sort16(cg[1]); sort16(cg[2]); sort16(cg[3]);
    merge16(cg[0], cg[1]); merge16(cg[2], cg[3]); merge16(cg[0], cg[2]);
    WAVE_LDS_SYNC();
    const float m = cg[0][0]; float z = 0.f; float ev[16];
#pragma unroll
    for (int k = 0; k < 16; ++k) { ev[k] = __expf(cg[0][k] - m); z += ev[k]; }
    const float zi = 1.0f / z;
    int eo[8]; float go[8];
#pragma unroll
    for (int k = 0; k < 8; ++k) { float wa = cg[0][k], wb = cg[0][8 + k], ea = ev[k], eb = ev[8 + k]; asm volatile("" : "+v"(wa), "+v"(wb), "+v"(ea), "+v"(eb));
        const float w = h2 ? wb : wa; const int flat = 255 - (int)(__float_as_uint(w) & 0xFFu);
        eo[k] = til[flat >> 4] * 128 + til[16 + (flat & 15)]; go[k] = (h2 ? eb : ea) * zi; }
    GAS int* ex = (GAS int*)(P.ws + WS_EXP) + t * 128 + head * 16 + 8 * h2; GAS float* gw = (GAS float*)(P.ws + WS_GW) + t * 128 + head * 16 + 8 * h2;
    typedef int i32x4 __attribute__((ext_vector_type(4)));
    *(GAS i32x4*)ex = (i32x4){eo[0], eo[1], eo[2], eo[3]}; *(GAS i32x4*)(ex + 4) = (i32x4){eo[4], eo[5], eo[6], eo[7]};
    *(GAS f32x4*)gw = (f32x4){go[0], go[1], go[2], go[3]}; *(GAS f32x4*)(gw + 4) = (f32x4){go[4], go[5], go[6], go[7]};
    WAVE_LDS_SYNC();
}
__device__ __forceinline__ void phase_select(const Params& P, int l, int bid, int nb, LAS unsigned char* lds) {
    int staged = -1;
    for (int u = bid; u < T / 32; u += nb) { const bool stage = (u & 7) != staged; if (stage) __syncthreads(); select_unit(P, l, u, lds, stage); staged = u & 7; }
    __syncthreads();
}
#undef PS_CE
}


typedef float f2v_t __attribute__((ext_vector_type(2)));
__device__ __forceinline__ void fp8x4_to_f32(unsigned w, float& a, float& b, float& c, float& d) { const f2v_t lo = __builtin_amdgcn_cvt_pk_f32_fp8((int)w, false), hi = __builtin_amdgcn_cvt_pk_f32_fp8((int)w, true); a = lo.x; b = lo.y; c = hi.x; d = hi.y; }
constexpr int PA_CH = 4;
__device__ __forceinline__ void phase_peer_apply3(const Params& P, int l, int bid, int nb) {
    const int tid = TID(), lane = tid & 63, wave = __builtin_amdgcn_readfirstlane(tid >> 6);
    const GAS bf16* xf = (const GAS bf16*)(P.ws + WS_ACT0);
    const GAS unsigned char* U = (const GAS unsigned char*)(P.ws + WS_U) + (size_t)l * NEXP * D + lane * 16; const GAS unsigned char* V = (const GAS unsigned char*)(P.ws + WS_V) + (size_t)l * NEXP * D + lane * 16;
    const float* su = (const float*)(P.ws + WS_SU) + (size_t)l * NEXP; const float* sv = (const float*)(P.ws + WS_SV) + (size_t)l * NEXP;
    const int* ex = (const int*)(P.ws + WS_EXP); const float* gw = (const float*)(P.ws + WS_GW); GAS bf16* hn = (GAS bf16*)(P.ws + WS_ACT2);
    for (int t = bid * 8 + wave; t < T; t += nb * 8) {
        float x[32], acc[32];
#pragma unroll
        for (int j = 0; j < 2; ++j)
#pragma unroll
            for (int q = 0; q < 2; ++q) { float f[8]; unpack8(*(const GAS v4u*)(xf + (size_t)t * D + j * 1024 + lane * 16 + q * 8), f);
#pragma unroll
                for (int e = 0; e < 8; ++e) { x[j * 16 + q * 8 + e] = f[e]; acc[j * 16 + q * 8 + e] = 0.f; } }
        const int* exr = ex + (size_t)t * 128; const float* gwr = gw + (size_t)t * 128;
        int en[PA_CH];
#pragma unroll
        for (int i = 0; i < PA_CH; ++i) en[i] = __builtin_amdgcn_readfirstlane(exr[i]);
        v4u Ur[PA_CH][2], Vr[2][2];
#pragma unroll
        for (int i = 0; i < PA_CH; ++i)
#pragma unroll
            for (int j = 0; j < 2; ++j) Ur[i][j] = *(const GAS v4u*)(U + (size_t)en[i] * D + j * 1024);
#if DUP_PHASE == 10
        for (int rep = 0; rep < 2; ++rep) { if (rep == 1) { float zz = 0.f; asm volatile("" : "+v"(zz));
#pragma unroll
            for (int i = 0; i < 32; ++i) acc[i] *= zz; }
#endif
#pragma unroll 1
        for (int kc = 0; kc < 128 / PA_CH; ++kc) {
            int ec[PA_CH]; float d[PA_CH];
#pragma unroll
            for (int i = 0; i < PA_CH; ++i) ec[i] = en[i];
            const int kn = kc < 128 / PA_CH - 1 ? kc + 1 : kc;
#pragma unroll
            for (int i = 0; i < PA_CH; ++i) en[i] = __builtin_amdgcn_readfirstlane(exr[PA_CH * kn + i]);
#pragma unroll
            for (int i = 0; i < PA_CH; ++i) { float s = 0.f;
#pragma unroll
                for (int j = 0; j < 2; ++j) { float a, b, c, dd;
                    fp8x4_to_f32(Ur[i][j].x, a, b, c, dd); s += a * x[j * 16 + 0] + b * x[j * 16 + 1] + c * x[j * 16 + 2] + dd * x[j * 16 + 3];
                    fp8x4_to_f32(Ur[i][j].y, a, b, c, dd); s += a * x[j * 16 + 4] + b * x[j * 16 + 5] + c * x[j * 16 + 6] + dd * x[j * 16 + 7];
                    fp8x4_to_f32(Ur[i][j].z, a, b, c, dd); s += a * x[j * 16 + 8] + b * x[j * 16 + 9] + c * x[j * 16 + 10] + dd * x[j * 16 + 11];
                    fp8x4_to_f32(Ur[i][j].w, a, b, c, dd); s += a * x[j * 16 + 12] + b * x[j * 16 + 13] + c * x[j * 16 + 14] + dd * x[j * 16 + 15]; }
                d[i] = s; }
#define PA_VLOAD(slot, i) do { _Pragma("unroll") for (int j = 0; j < 2; ++j) Vr[slot][j] = *(const GAS v4u*)(V + (size_t)ec[i] * D + j * 1024); } while (0)
#define PA_VACC1(wd, base) do { float a, b, c, dd; fp8x4_to_f32((wd), a, b, c, dd); acc[(base)] += wgt * a; acc[(base) + 1] += wgt * b; acc[(base) + 2] += wgt * c; acc[(base) + 3] += wgt * dd; } while (0)
#define PA_VACC(slot, i) do { const float wgt = d[i]; _Pragma("unroll") for (int j = 0; j < 2; ++j) { PA_VACC1(Vr[slot][j].x, j * 16); PA_VACC1(Vr[slot][j].y, j * 16 + 4); PA_VACC1(Vr[slot][j].z, j * 16 + 8); PA_VACC1(Vr[slot][j].w, j * 16 + 12); } } while (0)
            PA_VLOAD(0, 0); PA_VLOAD(1, 1);
#pragma unroll
            for (int i = 0; i < PA_CH; ++i)
#pragma unroll
                for (int j = 0; j < 2; ++j) Ur[i][j] = *(const GAS v4u*)(U + (size_t)en[i] * D + j * 1024);
#pragma unroll
            for (int i = 0; i < PA_CH; ++i) { const float dt = wave_sum(d[i]) * __builtin_bit_cast(float, __builtin_amdgcn_readfirstlane(__builtin_bit_cast(int, su[ec[i]])));
                const float g = __builtin_bit_cast(float, __builtin_amdgcn_readfirstlane(__builtin_bit_cast(int, gwr[PA_CH * kc + i]))) * __builtin_bit_cast(float, __builtin_amdgcn_readfirstlane(__builtin_bit_cast(int, sv[ec[i]])));
                d[i] = g * 0.5f * dt * (1.0f + erff(dt * 0.70710678118654752f)); }
#pragma unroll
            for (int i = 0; i < PA_CH; ++i) { if (i & 1) { PA_VACC(1, i); if (i + 2 < PA_CH) PA_VLOAD(1, i + 2); } else { PA_VACC(0, i); if (i + 2 < PA_CH) PA_VLOAD(0, i + 2); } }
#undef PA_VLOAD
#undef PA_VACC
#undef PA_VACC1
        }
#if DUP_PHASE == 10
        }
#endif
        GAS float* hrow = (GAS float*)P.out + (size_t)t * D + lane * 16; float ss = 0.f;
#pragma unroll
        for (int j = 0; j < 2; ++j)
#pragma unroll
            for (int q = 0; q < 4; ++q) { f32x4 hv = *(const GAS f32x4*)(hrow + j * 1024 + q * 4);
                hv.x += acc[j * 16 + q * 4 + 0]; hv.y += acc[j * 16 + q * 4 + 1]; hv.z += acc[j * 16 + q * 4 + 2]; hv.w += acc[j * 16 + q * 4 + 3];
                *(GAS f32x4*)(hrow + j * 1024 + q * 4) = hv; acc[j * 16 + q * 4 + 0] = hv.x; acc[j * 16 + q * 4 + 1] = hv.y; acc[j * 16 + q * 4 + 2] = hv.z; acc[j * 16 + q * 4 + 3] = hv.w;
                ss += hv.x * hv.x + hv.y * hv.y + hv.z * hv.z + hv.w * hv.w; }
        ss = wave_sum(ss); const float rr = 1.0f / sqrtf(ss * (1.0f / D) + EPS); const GAS float* gain = (const GAS float*)P.in[I_LNPLE] + (size_t)l * D + lane * 16;
#pragma unroll
        for (int j = 0; j < 2; ++j)
#pragma unroll
            for (int q = 0; q < 2; ++q) { const f32x4 g0 = *(const GAS f32x4*)(gain + j * 1024 + q * 8), g1 = *(const GAS f32x4*)(gain + j * 1024 + q * 8 + 4); const int b0 = j * 16 + q * 8;
                v4u o; o.x = pk2(acc[b0 + 0] * rr * g0.x, acc[b0 + 1] * rr * g0.y); o.y = pk2(acc[b0 + 2] * rr * g0.z, acc[b0 + 3] * rr * g0.w);
                o.z = pk2(acc[b0 + 4] * rr * g1.x, acc[b0 + 5] * rr * g1.y); o.w = pk2(acc[b0 + 6] * rr * g1.z, acc[b0 + 7] * rr * g1.w);
                *(GAS v4u*)(hn + (size_t)t * D + j * 1024 + lane * 16 + q * 8) = o; }
    }
}


__device__ __forceinline__ void norm_row_i8(f32x4 (&v)[8], float ss, const float* gain, GAS unsigned char* orow, GAS float* sc, int lane) {
    const float r = 1.0f / sqrtf(ss * (1.0f / D) + EPS); float am = 0.f;
#pragma unroll
    for (int j = 0; j < 8; ++j) { const f32x4 g = *(const f32x4*)(gain + (j * 64 + lane) * 4); v[j] = v[j] * r * g; am = fmaxf(am, fmaxf(fmaxf(fabsf(v[j].x), fabsf(v[j].y)), fmaxf(fabsf(v[j].z), fabsf(v[j].w)))); }
    am = wave_max(am); const float S = am > 0.f ? 127.0f / am : 0.f;
#pragma unroll
    for (int j = 0; j < 8; ++j) *(GAS unsigned*)(orow + (j * 64 + lane) * 4) = pack_i8x4(v[j].x, v[j].y, v[j].z, v[j].w, S);
    if (lane == 0) *sc = am * (1.0f / 127.0f);
}
template <bool SRC16 = false>
__device__ __forceinline__ void phase_norm_i8(const void* src, const float* gain, unsigned char* dst8, float* scales, int bid, int nb) {
    const int tid = TID(), lane = tid & 63, wave = tid >> 6, nw = 8;
    const int step = nb * nw; int t = bid * nw + wave;
    if constexpr (SRC16) {
        for (; t + 7 * step < T; t += 8 * step) { h4_t raw[8][8];
#pragma unroll
            for (int i = 0; i < 8; ++i)
#pragma unroll
                for (int j = 0; j < 8; ++j) raw[i][j] = *(const GAS h4_t*)((const GAS _Float16*)src + (size_t)(t + i * step) * D + (j * 64 + lane) * 4);
#pragma unroll
            for (int i = 0; i < 8; ++i) { f32x4 v[8]; float s_ = 0.f; const size_t tt = (size_t)(t + i * step);
#pragma unroll
                for (int j = 0; j < 8; ++j) { v[j] = (f32x4){(float)raw[i][j].x, (float)raw[i][j].y, (float)raw[i][j].z, (float)raw[i][j].w}; s_ += v[j].x * v[j].x + v[j].y * v[j].y + v[j].z * v[j].z + v[j].w * v[j].w; }
                norm_row_i8(v, wave_sum(s_), gain, (GAS unsigned char*)dst8 + tt * D, (GAS float*)scales + tt, lane); } }
    }
    for (; t + step < T; t += 2 * step) { f32x4 v0[8], v1[8];
#pragma unroll
        for (int j = 0; j < 8; ++j) { v0[j] = ldrow4<SRC16>(src, (size_t)t * D + (j * 64 + lane) * 4); v1[j] = ldrow4<SRC16>(src, (size_t)(t + step) * D + (j * 64 + lane) * 4); }
        float s0 = 0.f, s1 = 0.f;
#pragma unroll
        for (int j = 0; j < 8; ++j) { s0 += v0[j].x * v0[j].x + v0[j].y * v0[j].y + v0[j].z * v0[j].z + v0[j].w * v0[j].w; s1 += v1[j].x * v1[j].x + v1[j].y * v1[j].y + v1[j].z * v1[j].z + v1[j].w * v1[j].w; }
        s0 = wave_sum(s0); s1 = wave_sum(s1);
        norm_row_i8(v0, s0, gain, (GAS unsigned char*)dst8 + (size_t)t * D, (GAS float*)scales + t, lane); norm_row_i8(v1, s1, gain, (GAS unsigned char*)dst8 + (size_t)(t + step) * D, (GAS float*)scales + t + step, lane); }
    for (; t < T; t += step) { f32x4 v[8]; float s_ = 0.f;
#pragma unroll
        for (int j = 0; j < 8; ++j) { v[j] = ldrow4<SRC16>(src, (size_t)t * D + (j * 64 + lane) * 4); s_ += v[j].x * v[j].x + v[j].y * v[j].y + v[j].z * v[j].z + v[j].w * v[j].w; }
        const float ss = wave_sum(s_); norm_row_i8(v, ss, gain, (GAS unsigned char*)dst8 + (size_t)t * D, (GAS float*)scales + t, lane); }
}
__device__ __forceinline__ void quant_rows_i8(const bf16* srcm, unsigned char* dstm, float* scm, int nrows, int bid, int nb) {
    const int tid = TID(), lane = tid & 63, wave = tid >> 6;
    for (int n = bid * 8 + wave; n < nrows; n += nb * 8) {
        const GAS bf16* src = (const GAS bf16*)srcm + (size_t)n * D; float f[4][8]; float am = 0.f;
#pragma unroll
        for (int j = 0; j < 4; ++j) { unpack8(*(const GAS v4u*)(src + (j * 64 + lane) * 8), f[j]);
#pragma unroll
            for (int e = 0; e < 8; ++e) am = fmaxf(am, fabsf(f[j][e])); }
        am = wave_max(am); const float S = am > 0.f ? 127.0f / am : 0.f;
        GAS unsigned char* dst = (GAS unsigned char*)dstm + (size_t)n * D;
#pragma unroll
        for (int j = 0; j < 4; ++j) *(GAS v2u*)(dst + (j * 64 + lane) * 8) = (v2u){pack_i8x4(f[j][0], f[j][1], f[j][2], f[j][3], S), pack_i8x4(f[j][4], f[j][5], f[j][6], f[j][7], S)};
        if (lane == 0) ((GAS float*)scm)[n] = am * (1.0f / 127.0f);
    }
}
constexpr int QR_TM = NTM * 128, QR_VT = QR_TM + NVT * 128, QR_WO = QR_VT + D, QR_WQ = QR_WO + D, QR_ALL = QR_WQ + D;
__device__ __forceinline__ void quant_row_ptrs(unsigned char* ws, int l, int g, const GAS bf16*& src, GAS unsigned char*& dst, GAS float*& sc) {
    size_t so, d8, ss; int r;
    if (g < QR_TM) { r = l * NTM * 128 + g; so = WS_WINTM; d8 = WS_WIN8TM; ss = WS_SWTM; }
    else if (g < QR_VT) { r = l * NVT * 128 + (g - QR_TM); so = WS_WINVT; d8 = WS_WIN8VT; ss = WS_SWVT; }
    else if (g < QR_WO) { r = l * D + (g - QR_VT); so = WS_WOUT; d8 = WS_WO8; ss = WS_SWO; }
    else if (g < QR_WQ) { r = l * D + (g - QR_WO); so = WS_WQ; d8 = WS_WQ8; ss = WS_SWQ; }
    else { r = l * D + (g - QR_WQ); so = WS_WGATE; d8 = WS_WG8; ss = WS_SWG; }
    src = (const GAS bf16*)(ws + so) + (size_t)r * D; dst = (GAS unsigned char*)(ws + d8) + (size_t)r * D; sc = (GAS float*)(ws + ss) + r;
}
__device__ __forceinline__ void quant_all_rows(const Params& P, int l, int bid, int nb) {
    const int tid = TID(), lane = tid & 63, wave = tid >> 6; const int step = nb * 8;
    for (int g0 = bid * 8 + wave; g0 < QR_ALL; g0 += 3 * step) {
        v4u w[3][4]; GAS unsigned char* dst[3]; GAS float* sc[3];
#pragma unroll
        for (int u = 0; u < 3; ++u) { const int g = g0 + u * step; const GAS bf16* src; quant_row_ptrs(P.ws, l, g < QR_ALL ? g : g0, src, dst[u], sc[u]);
#pragma unroll
            for (int j = 0; j < 4; ++j) w[u][j] = *(const GAS v4u*)(src + (j * 64 + lane) * 8); }
#pragma unroll
        for (int u = 0; u < 3; ++u) { if (g0 + u * step >= QR_ALL) break;
            float f[4][8]; float am = 0.f;
#pragma unroll
            for (int j = 0; j < 4; ++j) { unpack8(w[u][j], f[j]);
#pragma unroll
                for (int e = 0; e < 8; ++e) am = fmaxf(am, fabsf(f[j][e])); }
            am = wave_max(am); const float S = am > 0.f ? 127.0f / am : 0.f;
#pragma unroll
            for (int j = 0; j < 4; ++j) *(GAS v2u*)(dst[u] + (j * 64 + lane) * 8) = (v2u){pack_i8x4(f[j][0], f[j][1], f[j][2], f[j][3], S), pack_i8x4(f[j][4], f[j][5], f[j][6], f[j][7], S)};
            if (lane == 0) *sc[u] = am * (1.0f / 127.0f); }
    }
}
__device__ __forceinline__ void quant_wgate(const Params& P, int l, int bid, int nb) {
    const int tid = TID(), lane = tid & 63, wave = tid >> 6;
    for (int n = bid * 8 + wave; n < D; n += nb * 8) {
        const GAS bf16* src = (const GAS bf16*)(P.ws + WS_WGATE) + ((size_t)l * D + n) * D; float f[4][8]; float am = 0.f;
#pragma unroll
        for (int j = 0; j < 4; ++j) { unpack8(*(const GAS v4u*)(src + (j * 64 + lane) * 8), f[j]);
#pragma unroll
            for (int e = 0; e < 8; ++e) am = fmaxf(am, fabsf(f[j][e])); }
        am = wave_max(am); const float S = am > 0.f ? 127.0f / am : 0.f;
        GAS unsigned char* dst = (GAS unsigned char*)(P.ws + WS_WG8) + ((size_t)l * D + n) * D;
#pragma unroll
        for (int j = 0; j < 4; ++j) *(GAS v2u*)(dst + (j * 64 + lane) * 8) = (v2u){pack_i8x4(f[j][0], f[j][1], f[j][2], f[j][3], S), pack_i8x4(f[j][4], f[j][5], f[j][6], f[j][7], S)};
        if (lane == 0) ((GAS float*)(P.ws + WS_SWG))[(size_t)l * D + n] = am * (1.0f / 127.0f);
    }
}
#define XB_TMO      128
#define XB_XCNT(j)  (256  + 64 * (j))
#define XB_XSUB(j)  (1280 + 64 * (j))
#define XB_XGEN(j)  (2304 + 64 * (j))
#define XB_TOP      3328
#define XB_TOPGEN   3392
#define XCD_BAR_WORDS 3456
#define XB_SPIN_CAP (1u << 22)
__device__ __forceinline__ unsigned xb_ld(unsigned* p)              { return __hip_atomic_load(p, __ATOMIC_RELAXED, __HIP_MEMORY_SCOPE_AGENT); }
__device__ __forceinline__ unsigned xb_add(unsigned* p, unsigned v) { return __hip_atomic_fetch_add(p, v, __ATOMIC_RELAXED, __HIP_MEMORY_SCOPE_AGENT); }
__device__ __forceinline__ unsigned xb_xcc_id() { return (unsigned)__builtin_amdgcn_s_getreg((3 << 11) | 20) & 0xFu; }
#define XB_SPIN(cond, bar) do { unsigned _sp = 0; while (cond) { __builtin_amdgcn_s_sleep(1); \
    if ((++_sp & 255u) == 0u) { if (xb_ld(&(bar)[XB_TMO])) break; if (_sp > XB_SPIN_CAP) { atomicAdd(&(bar)[XB_TMO], 1u); break; } } } } while (0)
struct XcdBarrier { unsigned* bar; unsigned x; volatile LAS unsigned* st; };
__device__ __forceinline__ XcdBarrier xcd_barrier_post(unsigned* bar, volatile LAS unsigned* st) {
    XcdBarrier b; b.bar = bar; b.x = xb_xcc_id(); b.st = st;
    if (threadIdx.x == 0) st[8] = xb_add(&bar[XB_XCNT(b.x)], 1u);
    return b;
}
__device__ __forceinline__ void xcd_barrier_complete(unsigned* bar, unsigned x, unsigned& nloc, unsigned& nx) {
    const unsigned G = gridDim.x * gridDim.y * gridDim.z;
    unsigned sum, cnt, mine, sp = 0u;
    for (;;) {
        sum = 0u; cnt = 0u; mine = 0u;
#pragma unroll
        for (unsigned j = 0; j < 16; ++j) { const unsigned c = xb_ld(&bar[XB_XCNT(j)]); sum += c; cnt += (c > 0u) ? 1u : 0u; mine = (j == x) ? c : mine; }
        if (sum == G) break;
        __builtin_amdgcn_s_sleep(1);
        if ((++sp & 255u) == 0u) { if (xb_ld(&bar[XB_TMO])) break; if (sp > XB_SPIN_CAP) { atomicAdd(&bar[XB_TMO], 1u); break; } }
    }
    nloc = mine > 0u ? mine : 1u; nx = cnt > 0u ? cnt : 1u;
}
__device__ __forceinline__ void xcd_barrier(const XcdBarrier& b) {
    asm volatile("s_waitcnt vmcnt(0)" ::: "memory");
    __syncthreads();
    if (threadIdx.x == 0) {
        unsigned* bar = b.bar;
        __builtin_amdgcn_s_waitcnt(0);
        unsigned nloc = b.st[0], nx = b.st[1];
        if (nloc == 0u) { xcd_barrier_complete(bar, b.x, nloc, nx); b.st[0] = nloc; b.st[1] = nx; }
        const unsigned old = xb_add(&bar[XB_XSUB(b.x)], 1u);
        const unsigned gen = old / nloc;
        if (old + 1u == (gen + 1u) * nloc) {
            __builtin_amdgcn_fence(__ATOMIC_RELEASE, "agent");
            asm volatile("s_waitcnt vmcnt(0)" ::: "memory");
            const unsigned og = xb_add(&bar[XB_TOP], 1u);
            const unsigned tg = og / nx;
            if (og + 1u == (tg + 1u) * nx) xb_add(&bar[XB_TOPGEN], 1u);
            else XB_SPIN(xb_ld(&bar[XB_TOPGEN]) == tg, bar);
            __builtin_amdgcn_fence(__ATOMIC_ACQUIRE, "agent");
            xb_add(&bar[XB_XGEN(b.x)], 1u);
            asm volatile("s_waitcnt vmcnt(0)" ::: "memory");
        } else {
            XB_SPIN(xb_ld(&bar[XB_XGEN(b.x)]) == gen, bar);
            __builtin_amdgcn_fence(__ATOMIC_ACQUIRE, "agent");
            asm volatile("s_waitcnt vmcnt(0)" ::: "memory");
        }
    }
    __syncthreads();
}


namespace pz {
constexpr int NSL = 16, NTOK = 16, NTG = T / NTOK, QITEMS = (NSL / 8) * NTG;
__device__ __forceinline__ void load_rows(const GAS unsigned char* tab, unsigned poff, const int (&id)[16], v4u (&rows)[16]) {
#pragma unroll
    for (int i = 0; i < 16; ++i) rows[i] = *(const GAS v4u*)(tab + (((unsigned)id[i] << 7) | poff));
}
__device__ __forceinline__ void load_ids(const int* ex, size_t t, int e8, int (&id)[16]) {
    typedef int i32x4 __attribute__((ext_vector_type(4)));
#pragma unroll
    for (int q = 0; q < 4; ++q) { const i32x4 v = *(const GAS i32x4*)((const GAS int*)ex + t * 128 + 16 * e8 + 4 * q); id[4 * q] = v.x; id[4 * q + 1] = v.y; id[4 * q + 2] = v.z; id[4 * q + 3] = v.w; }
}
typedef float f2p __attribute__((ext_vector_type(2)));
__device__ __forceinline__ unsigned item_A(const Params& P, int l, int xq, int c, int tg, int lane, int (&id)[2][16], v4u (&rows)[2][16], unsigned itn_raw, v4u& xw0) {
    const int e8 = lane >> 3, part = lane & 7;
    const GAS unsigned char* tab0 = (const GAS unsigned char*)(P.ws + WS_U) + (size_t)l * NSL * NEXP * 128; const unsigned poff = part * 16;
    const GAS unsigned char* tab = tab0 + (size_t)c * NEXP * 128; unsigned itn = 0xffffffffu; size_t tn0 = 0; const GAS unsigned char* tabn = tab;
    const GAS bf16* xf = (const GAS bf16*)(P.ws + WS_ACT0) + 128 * c + 16 * part; const int* ex = (const int*)(P.ws + WS_EXP);
    GAS bf16* pdh = (GAS bf16*)(P.ws + WS_PD) + (size_t)c * T * 128 + 16 * e8;
    const size_t t0 = (size_t)tg * NTOK;
    const GAS unsigned char* x8 = (const GAS unsigned char*)(P.ws + WS_XF8) + 16 * part;
    v4u xwn = xw0;
#pragma unroll
    for (int n = 0; n < NTOK; ++n) { const size_t t = t0 + n; const int bf = n & 1;
        const v4u xw = xwn;
        if (n < NTOK - 1) xwn = *(const GAS v4u*)(x8 + (t + 1) * D + 128 * c);
        if (n < NTOK - 2) load_ids(ex, t + 2, e8, id[bf]);
        if (n == NTOK - 2) { itn = (unsigned)__builtin_amdgcn_readfirstlane((int)itn_raw);
            if (itn < (unsigned)QITEMS) { tn0 = (size_t)(itn % NTG) * NTOK; tabn = tab0 + (size_t)(xq + 8 * (int)(itn / NTG)) * NEXP * 128; load_ids(ex, tn0, e8, id[0]); } }
        if (n < NTOK - 1) load_rows(tab, poff, id[bf ^ 1], rows[bf ^ 1]);
        if (n == NTOK - 1 && itn < (unsigned)QITEMS) { xw0 = *(const GAS v4u*)(x8 + tn0 * D + 128 * (xq + 8 * (int)(itn / NTG))); load_ids(ex, tn0 + 1, e8, id[1]); load_rows(tabn, poff, id[0], rows[0]); }
#if PEER_A_I8
        int sacc[16];
#pragma unroll
        for (int i = 0; i < 16; ++i) { const v4u rw = rows[bf][i]; int a; asm("v_dot4_i32_i8 %0, %1, %2, 0" : "=v"(a) : "v"(rw.x), "v"(xw.x)); a = __builtin_amdgcn_sdot4((int)rw.y, (int)xw.y, a, false);
            a = __builtin_amdgcn_sdot4((int)rw.z, (int)xw.z, a, false); sacc[i] = __builtin_amdgcn_sdot4((int)rw.w, (int)xw.w, a, false); }
        { const bool b2 = part & 4, b1 = part & 2, b0 = part & 1; int r8[8], r4[4], r2[2];
#pragma unroll
          for (int i = 0; i < 8; ++i) { const int snd = b2 ? sacc[i] : sacc[8 + i], kp = b2 ? sacc[8 + i] : sacc[i]; r8[i] = kp + swz_xor_i<4>(snd); }
#pragma unroll
          for (int i = 0; i < 4; ++i) { const int snd = b1 ? r8[i] : r8[4 + i], kp = b1 ? r8[4 + i] : r8[i]; r4[i] = kp + swz_xor_i<2>(snd); }
#pragma unroll
          for (int i = 0; i < 2; ++i) { const int snd = b0 ? r4[i] : r4[2 + i], kp = b0 ? r4[2 + i] : r4[i]; r2[i] = kp + swz_xor_i<1>(snd); }
          *(GAS unsigned*)((GAS bf16*)pdh + t * 128 + 2 * part) = pk2((float)r2[0] * (1.0f / 16384.0f), (float)r2[1] * (1.0f / 16384.0f)); }
#else
        f2p x2[8];
        { const v4u w0 = *(const GAS v4u*)(xf + t * D), w1 = *(const GAS v4u*)(xf + t * D + 8);
          x2[0] = (f2p){bf2f(w0.x & 0xffff), bf2f(w0.x >> 16)}; x2[1] = (f2p){bf2f(w0.y & 0xffff), bf2f(w0.y >> 16)}; x2[2] = (f2p){bf2f(w0.z & 0xffff), bf2f(w0.z >> 16)}; x2[3] = (f2p){bf2f(w0.w & 0xffff), bf2f(w0.w >> 16)};
          x2[4] = (f2p){bf2f(w1.x & 0xffff), bf2f(w1.x >> 16)}; x2[5] = (f2p){bf2f(w1.y & 0xffff), bf2f(w1.y >> 16)}; x2[6] = (f2p){bf2f(w1.z & 0xffff), bf2f(w1.z >> 16)}; x2[7] = (f2p){bf2f(w1.w & 0xffff), bf2f(w1.w >> 16)}; }
        float sacc[16];
#pragma unroll
        for (int i = 0; i < 16; ++i) { const v4u rw = rows[bf][i]; f2p s2 = {0.f, 0.f};
            s2 = __builtin_elementwise_fma(__builtin_amdgcn_cvt_pk_f32_fp8((int)rw.x, false), x2[0], s2); s2 = __builtin_elementwise_fma(__builtin_amdgcn_cvt_pk_f32_fp8((int)rw.x, true), x2[1], s2);
            s2 = __builtin_elementwise_fma(__builtin_amdgcn_cvt_pk_f32_fp8((int)rw.y, false), x2[2], s2); s2 = __builtin_elementwise_fma(__builtin_amdgcn_cvt_pk_f32_fp8((int)rw.y, true), x2[3], s2);
            s2 = __builtin_elementwise_fma(__builtin_amdgcn_cvt_pk_f32_fp8((int)rw.z, false), x2[4], s2); s2 = __builtin_elementwise_fma(__builtin_amdgcn_cvt_pk_f32_fp8((int)rw.z, true), x2[5], s2);
            s2 = __builtin_elementwise_fma(__builtin_amdgcn_cvt_pk_f32_fp8((int)rw.w, false), x2[6], s2); s2 = __builtin_elementwise_fma(__builtin_amdgcn_cvt_pk_f32_fp8((int)rw.w, true), x2[7], s2);
            sacc[i] = s2.x + s2.y; }
        { const bool b2 = part & 4, b1 = part & 2, b0 = part & 1; float r8[8], r4[4], r2[2];
#pragma unroll
          for (int i = 0; i < 8; ++i) { const float snd = b2 ? sacc[i] : sacc[8 + i], kp = b2 ? sacc[8 + i] : sacc[i]; r8[i] = kp + swz_xor<4>(snd); }
#pragma unroll
          for (int i = 0; i < 4; ++i) { const float snd = b1 ? r8[i] : r8[4 + i], kp = b1 ? r8[4 + i] : r8[i]; r4[i] = kp + swz_xor<2>(snd); }
#pragma unroll
          for (int i = 0; i < 2; ++i) { const float snd = b0 ? r4[i] : r4[2 + i], kp = b0 ? r4[2 + i] : r4[i]; r2[i] = kp + swz_xor<1>(snd); }
          *(GAS unsigned*)((GAS bf16*)pdh + t * 128 + 2 * part) = pk2(r2[0], r2[1]); }
#endif
    }
    return itn;
}
#if PEER_B_I8
__device__ __forceinline__ unsigned item_B(const Params& P, int l, int xq, int c, int tg, int lane, int (&id)[2][16], v4u (&rows)[2][16], unsigned itn_raw, v4u (&w0)[2], h2_t& h0) {
    const int e8 = lane >> 3, part = lane & 7;
    const GAS unsigned char* tab0 = (const GAS unsigned char*)(P.ws + WS_V) + (size_t)l * NSL * NEXP * 128; const unsigned poff = part * 16;
    const GAS unsigned char* tab = tab0 + (size_t)c * NEXP * 128; unsigned itn = 0xffffffffu; size_t tn0 = 0; const GAS unsigned char* tabn = tab;
    const int* ex = (const int*)(P.ws + WS_EXP); const GAS unsigned char* wv8 = (const GAS unsigned char*)(P.ws + WS_WV) + 16 * e8; const GAS float* wsc = (const GAS float*)(P.ws + WS_WV + (size_t)T * 128) + e8;
    const size_t t0 = (size_t)tg * NTOK;
    GAS _Float16* hbase = (GAS _Float16*)(P.ws + WS_H16) + 16 * part + 2 * e8;
    v4u wn = w0[0]; float wsn = __uint_as_float(w0[1].x); h2_t hn = h0;
#pragma unroll
    for (int n = 0; n < NTOK; ++n) { const size_t t = t0 + n; const int bf = n & 1;
        const v4u wq = wn; const float wsc_cur = wsn; const h2_t hcur = hn;
        if (n < NTOK - 1) { wn = *(const GAS v4u*)(wv8 + (t + 1) * 128); wsn = wsc[(t + 1) * 8]; hn = *(const GAS h2_t*)(hbase + (t + 1) * D + 128 * c); }
        if (n < NTOK - 2) load_ids(ex, t + 2, e8, id[bf]);
        if (n == NTOK - 2) { itn = (unsigned)__builtin_amdgcn_readfirstlane((int)itn_raw);
            if (itn < (unsigned)QITEMS) { tn0 = (size_t)(itn % NTG) * NTOK; tabn = tab0 + (size_t)(xq + 8 * (int)(itn / NTG)) * NEXP * 128; load_ids(ex, tn0, e8, id[0]); } }
        if (n < NTOK - 1) load_rows(tab, poff, id[bf ^ 1], rows[bf ^ 1]);
        if (n == NTOK - 1 && itn < (unsigned)QITEMS) {
            w0[0] = *(const GAS v4u*)(wv8 + tn0 * 128); w0[1].x = __float_as_uint(wsc[tn0 * 8]);
            h0 = *(const GAS h2_t*)(hbase + tn0 * D + 128 * (xq + 8 * (int)(itn / NTG)));
            load_ids(ex, tn0 + 1, e8, id[1]); load_rows(tabn, poff, id[0], rows[0]); }
        int ia[16];
#pragma unroll
        for (int q = 0; q < 16; ++q) ia[q] = 0;
        const unsigned wqa[4] = {wq.x, wq.y, wq.z, wq.w};
#pragma unroll
        for (int g4 = 0; g4 < 4; ++g4) { const v4u ra = rows[bf][4 * g4], rb = rows[bf][4 * g4 + 1], rc = rows[bf][4 * g4 + 2], rd = rows[bf][4 * g4 + 3]; const int wd = (int)wqa[g4];
            const unsigned A[4] = {ra.x, ra.y, ra.z, ra.w}, B[4] = {rb.x, rb.y, rb.z, rb.w}, C[4] = {rc.x, rc.y, rc.z, rc.w}, Dd[4] = {rd.x, rd.y, rd.z, rd.w};
#pragma unroll
            for (int d = 0; d < 4; ++d) {
                const unsigned lo01 = __builtin_amdgcn_perm(B[d], A[d], 0x05010400u), hi01 = __builtin_amdgcn_perm(B[d], A[d], 0x07030602u);
                const unsigned lo23 = __builtin_amdgcn_perm(Dd[d], C[d], 0x05010400u), hi23 = __builtin_amdgcn_perm(Dd[d], C[d], 0x07030602u);
                const unsigned c0 = __builtin_amdgcn_perm(lo23, lo01, 0x05040100u), c1 = __builtin_amdgcn_perm(lo23, lo01, 0x07060302u);
                const unsigned c2 = __builtin_amdgcn_perm(hi23, hi01, 0x05040100u), c3 = __builtin_amdgcn_perm(hi23, hi01, 0x07060302u);
                ia[4 * d] = __builtin_amdgcn_sdot4((int)c0, wd, ia[4 * d], false); ia[4 * d + 1] = __builtin_amdgcn_sdot4((int)c1, wd, ia[4 * d + 1], false);
                ia[4 * d + 2] = __builtin_amdgcn_sdot4((int)c2, wd, ia[4 * d + 2], false); ia[4 * d + 3] = __builtin_amdgcn_sdot4((int)c3, wd, ia[4 * d + 3], false); } }
        float acc[16];
#pragma unroll
        for (int q = 0; q < 16; ++q) acc[q] = (float)ia[q] * wsc_cur;
        { const bool b3 = e8 & 1; float r8[8], r4[4], r2[2];
#pragma unroll
          for (int i = 0; i < 8; ++i) { const auto pr = __builtin_amdgcn_permlane32_swap(__builtin_bit_cast(unsigned, acc[i]), __builtin_bit_cast(unsigned, acc[8 + i]), false, false);
              r8[i] = __builtin_bit_cast(float, (unsigned)pr[0]) + __builtin_bit_cast(float, (unsigned)pr[1]); }
#pragma unroll
          for (int i = 0; i < 4; ++i) { const auto pr = __builtin_amdgcn_permlane16_swap(__builtin_bit_cast(unsigned, r8[i]), __builtin_bit_cast(unsigned, r8[4 + i]), false, false);
              r4[i] = __builtin_bit_cast(float, (unsigned)pr[0]) + __builtin_bit_cast(float, (unsigned)pr[1]); }
#pragma unroll
          for (int i = 0; i < 2; ++i) { const float snd = b3 ? r4[i] : r4[2 + i], kp = b3 ? r4[2 + i] : r4[i]; r2[i] = kp + swz_xor<8>(snd); }
          GAS h2_t* hp = (GAS h2_t*)(hbase + t * D + 128 * c); const h2_t hv = hcur; *hp = (h2_t){(_Float16)((float)hv.x + r2[0]), (_Float16)((float)hv.y + r2[1])}; }
    }
    return itn;
}
#else
__device__ __forceinline__ unsigned item_B(const Params& P, int l, int xq, int c, int tg, int lane, int (&id)[2][16], v4u (&rows)[2][16], unsigned itn_raw, v4u (&w0)[2], h2_t& h0) {
    const int e8 = lane >> 3, part = lane & 7;
    const GAS unsigned char* tab0 = (const GAS unsigned char*)(P.ws + WS_V) + (size_t)l * NSL * NEXP * 128; const unsigned poff = part * 16;
    const GAS unsigned char* tab = tab0 + (size_t)c * NEXP * 128; unsigned itn = 0xffffffffu; size_t tn0 = 0; const GAS unsigned char* tabn = tab;
    const int* ex = (const int*)(P.ws + WS_EXP); const GAS bf16* wv = (const GAS bf16*)(P.ws + WS_WV) + 16 * e8;
    GAS float* hcol = (GAS float*)P.out + 128 * c + 16 * part;
    const size_t t0 = (size_t)tg * NTOK;
    GAS _Float16* hbase = (GAS _Float16*)(P.ws + WS_H16) + 16 * part + 2 * e8;
    v4u wn[2]; h2_t hn;
    wn[0] = w0[0]; wn[1] = w0[1]; hn = h0;
#pragma unroll
    for (int n = 0; n < NTOK; ++n) { const size_t t = t0 + n; const int bf = n & 1;
        float w[16];
#pragma unroll
        for (int q = 0; q < 2; ++q) { w[8 * q] = bf2f(wn[q].x & 0xffff); w[8 * q + 1] = bf2f(wn[q].x >> 16); w[8 * q + 2] = bf2f(wn[q].y & 0xffff); w[8 * q + 3] = bf2f(wn[q].y >> 16);
            w[8 * q + 4] = bf2f(wn[q].z & 0xffff); w[8 * q + 5] = bf2f(wn[q].z >> 16); w[8 * q + 6] = bf2f(wn[q].w & 0xffff); w[8 * q + 7] = bf2f(wn[q].w >> 16); }
        const h2_t hcur = hn;
        if (n < NTOK - 1) { wn[0] = *(const GAS v4u*)(wv + (t + 1) * 128); wn[1] = *(const GAS v4u*)(wv + (t + 1) * 128 + 8);
            hn = *(const GAS h2_t*)(hbase + (t + 1) * D + 128 * c); }
        if (n < NTOK - 2) load_ids(ex, t + 2, e8, id[bf]);
        if (n == NTOK - 2) { itn = (unsigned)__builtin_amdgcn_readfirstlane((int)itn_raw);
            if (itn < (unsigned)QITEMS) { tn0 = (size_t)(itn % NTG) * NTOK; tabn = tab0 + (size_t)(xq + 8 * (int)(itn / NTG)) * NEXP * 128; load_ids(ex, tn0, e8, id[0]); } }
        if (n < NTOK - 1) load_rows(tab, poff, id[bf ^ 1], rows[bf ^ 1]);
        if (n == NTOK - 1 && itn < (unsigned)QITEMS) {
            w0[0] = *(const GAS v4u*)(wv + tn0 * 128); w0[1] = *(const GAS v4u*)(wv + tn0 * 128 + 8);
            h0 = *(const GAS h2_t*)(hbase + tn0 * D + 128 * (xq + 8 * (int)(itn / NTG)));
            load_ids(ex, tn0 + 1, e8, id[1]); load_rows(tabn, poff, id[0], rows[0]); }
        f2p acc2[8];
#pragma unroll
        for (int q = 0; q < 8; ++q) acc2[q] = (f2p){0.f, 0.f};
#pragma unroll
        for (int i = 0; i < 16; ++i) { const v4u rw = rows[bf][i]; const f2p w2 = {w[i], w[i]};
            acc2[0] = __builtin_elementwise_fma(__builtin_amdgcn_cvt_pk_f32_fp8((int)rw.x, false), w2, acc2[0]); acc2[1] = __builtin_elementwise_fma(__builtin_amdgcn_cvt_pk_f32_fp8((int)rw.x, true), w2, acc2[1]);
            acc2[2] = __builtin_elementwise_fma(__builtin_amdgcn_cvt_pk_f32_fp8((int)rw.y, false), w2, acc2[2]); acc2[3] = __builtin_elementwise_fma(__builtin_amdgcn_cvt_pk_f32_fp8((int)rw.y, true), w2, acc2[3]);
            acc2[4] = __builtin_elementwise_fma(__builtin_amdgcn_cvt_pk_f32_fp8((int)rw.z, false), w2, acc2[4]); acc2[5] = __builtin_elementwise_fma(__builtin_amdgcn_cvt_pk_f32_fp8((int)rw.z, true), w2, acc2[5]);
            acc2[6] = __builtin_elementwise_fma(__builtin_amdgcn_cvt_pk_f32_fp8((int)rw.w, false), w2, acc2[6]); acc2[7] = __builtin_elementwise_fma(__builtin_amdgcn_cvt_pk_f32_fp8((int)rw.w, true), w2, acc2[7]); }
        float acc[16];
#pragma unroll
        for (int q = 0; q < 8; ++q) { acc[2 * q] = acc2[q].x; acc[2 * q + 1] = acc2[q].y; }
        { const bool b3 = e8 & 1; float r8[8], r4[4], r2[2];
#pragma unroll
          for (int i = 0; i < 8; ++i) { const auto pr = __builtin_amdgcn_permlane32_swap(__builtin_bit_cast(unsigned, acc[i]), __builtin_bit_cast(unsigned, acc[8 + i]), false, false);
              r8[i] = __builtin_bit_cast(float, (unsigned)pr[0]) + __builtin_bit_cast(float, (unsigned)pr[1]); }
#pragma unroll
          for (int i = 0; i < 4; ++i) { const auto pr = __builtin_amdgcn_permlane16_swap(__builtin_bit_cast(unsigned, r8[i]), __builtin_bit_cast(unsigned, r8[4 + i]), false, false);
              r4[i] = __builtin_bit_cast(float, (unsigned)pr[0]) + __builtin_bit_cast(float, (unsigned)pr[1]); }
#pragma unroll
          for (int i = 0; i < 2; ++i) { const float snd = b3 ? r4[i] : r4[2 + i], kp = b3 ? r4[2 + i] : r4[i]; r2[i] = kp + swz_xor<8>(snd); }
#if H16
          GAS h2_t* hp = (GAS h2_t*)(hbase + t * D + 128 * c); const h2_t hv = hcur; *hp = (h2_t){(_Float16)((float)hv.x + r2[0]), (_Float16)((float)hv.y + r2[1])}; }
#else
          GAS f2p* hp = (GAS f2p*)(hcol + t * D + 2 * e8); f2p hv = *hp; hv.x += r2[0]; hv.y += r2[1]; *hp = hv; }
#endif
    }
    return itn;
}
#endif
template <int WHICH>
__device__ __forceinline__ void phase_sliced(const Params& P, int l, LAS unsigned char* lds) {
    unsigned* qbase = (unsigned*)(P.ws + WS_CTL) + 16384 + 64 * ((l * 2 + WHICH) * 8);
    const unsigned x0 = xb_xcc_id() & 7u;
    volatile LAS unsigned* misc_ = (volatile LAS unsigned*)(lds + 131072);
    const unsigned nloc_ = misc_[8] ? misc_[8] : 1u, nx_ = misc_[9], rank_ = misc_[16];
    const unsigned W_ = (unsigned)__builtin_amdgcn_readfirstlane((int)(nloc_ * 8u)), wx_ = (unsigned)__builtin_amdgcn_readfirstlane((int)(rank_ * 8u + (unsigned)(TID() >> 6)));
    const unsigned QS = (unsigned)__builtin_amdgcn_readfirstlane((int)(nx_ == 8u ? (unsigned)(QITEMS / 8) * 7u : 0u));
    const int lane = TID() & 63, e8 = lane >> 3, part = lane & 7;
    const int* ex = (const int*)(P.ws + WS_EXP);
    const GAS unsigned char* tab0 = (const GAS unsigned char*)(P.ws + (WHICH == 0 ? WS_U : WS_V)) + (size_t)l * NSL * NEXP * 128; const unsigned poff = part * 16;
    for (unsigned s_ = 0; s_ < 8; ++s_) { const unsigned xq = (x0 + s_) & 7u;
        unsigned it = 0u; const bool own = (s_ == 0u);
        if (own && wx_ < QS) it = wx_;
        else { if (lane == 0) it = QS + __hip_atomic_fetch_add(qbase + 64 * xq, 1u, __ATOMIC_RELAXED, __HIP_MEMORY_SCOPE_AGENT);
               it = (unsigned)__builtin_amdgcn_readfirstlane((int)it); }
        if (it >= (unsigned)QITEMS) continue;
        int id[2][16]; v4u rows[2][16]; v4u xw0 = {0u, 0u, 0u, 0u}; v4u w0[2] = {{0u, 0u, 0u, 0u}, {0u, 0u, 0u, 0u}}; h2_t h0 = {(_Float16)0.f, (_Float16)0.f};
        { const size_t t0 = (size_t)(it % NTG) * NTOK; const GAS unsigned char* tab = tab0 + (size_t)((int)xq + 8 * (int)(it / NTG)) * NEXP * 128;
          const int c0_ = (int)xq + 8 * (int)(it / NTG);
          if (WHICH == 0) xw0 = *(const GAS v4u*)((const GAS unsigned char*)(P.ws + WS_XF8) + 16 * part + t0 * D + 128 * c0_);
          else {
#if PEER_B_I8
              { w0[0] = *(const GAS v4u*)((const GAS unsigned char*)(P.ws + WS_WV) + 16 * e8 + t0 * 128); w0[1].x = __float_as_uint(((const GAS float*)(P.ws + WS_WV + (size_t)T * 128))[t0 * 8 + e8]); }
#else
              { const GAS bf16* wv0_ = (const GAS bf16*)(P.ws + WS_WV) + 16 * e8 + t0 * 128; w0[0] = *(const GAS v4u*)wv0_; w0[1] = *(const GAS v4u*)(wv0_ + 8); }
#endif
              h0 = *(const GAS h2_t*)((GAS _Float16*)(P.ws + WS_H16) + 16 * part + 2 * e8 + t0 * D + 128 * c0_); }
          load_ids(ex, t0, e8, id[0]); load_rows(tab, poff, id[0], rows[0]); load_ids(ex, t0 + 1, e8, id[1]); }
        for (;;) {
            unsigned itn_raw = 0xffffffffu;
            if (own && it + W_ < QS) itn_raw = it + W_;
            else if (lane == 0) itn_raw = QS + __hip_atomic_fetch_add(qbase + 64 * xq, 1u, __ATOMIC_RELAXED, __HIP_MEMORY_SCOPE_AGENT);
            const int c = (int)xq + 8 * (int)(it / NTG), tg = (int)(it % NTG);
            const unsigned itn = WHICH == 0 ? item_A(P, l, (int)xq, c, tg, lane, id, rows, itn_raw, xw0) : item_B(P, l, (int)xq, c, tg, lane, id, rows, itn_raw, w0, h0);
            if (itn >= (unsigned)QITEMS) break;
            it = itn;
        }
    }
}
__device__ __forceinline__ void phase_weights(const Params& P, int l, int bid, int nb) {
    const int tid = TID();
    const GAS bf16* pd = (const GAS bf16*)(P.ws + WS_PD); const GAS int* ex = (const GAS int*)(P.ws + WS_EXP); const GAS float* gw = (const GAS float*)(P.ws + WS_GW);
    const GAS float* su = (const GAS float*)(P.ws + WS_SU) + (size_t)l * NEXP; const GAS float* sv = (const GAS float*)(P.ws + WS_SV) + (size_t)l * NEXP; GAS float* wv = (GAS float*)(P.ws + WS_WV);
    typedef int i32x4 __attribute__((ext_vector_type(4)));
    for (size_t i8 = (size_t)bid * 512 + tid; i8 < (size_t)T * 128 / 8; i8 += (size_t)nb * 512) {
        const size_t i = i8 * 8; float s8[8];
#pragma unroll
        for (int q = 0; q < 8; ++q) s8[q] = 0.f;
#pragma unroll
        for (int c = 0; c < NSL; ++c) { float f[8]; unpack8(*(const GAS v4u*)(pd + (size_t)c * T * 128 + i), f);
#pragma unroll
            for (int q = 0; q < 8; ++q) s8[q] += f[q]; }
        const i32x4 e0 = *(const GAS i32x4*)(ex + i), e1 = *(const GAS i32x4*)(ex + i + 4); const f32x4 g0 = *(const GAS f32x4*)(gw + i), g1 = *(const GAS f32x4*)(gw + i + 4);
        const int ee[8] = {e0.x, e0.y, e0.z, e0.w, e1.x, e1.y, e1.z, e1.w}; const float gg[8] = {g0.x, g0.y, g0.z, g0.w, g1.x, g1.y, g1.z, g1.w}; float o[8];
        const float xs = PEER_A_I8 ? 16384.0f * ((const GAS float*)(P.ws + WS_SXF))[i >> 7] : 1.0f;
#pragma unroll
        for (int q = 0; q < 8; ++q) { const float dt = s8[q] * xs * su[ee[q]]; o[q] = gg[q] * sv[ee[q]] * 0.5f * dt * (1.0f + erff(dt * 0.70710678118654752f)); }
#if PEER_B_I8
        { float am = 0.f;
#pragma unroll
          for (int q = 0; q < 8; ++q) am = fmaxf(am, fabsf(o[q]));
          am = fmaxf(am, swz_xor<1>(am)); const float S8 = am > 0.f ? 127.0f / am : 0.f;
          *(GAS v2u*)((GAS unsigned char*)wv + i) = (v2u){pack_i8x4(o[0], o[1], o[2], o[3], S8), pack_i8x4(o[4], o[5], o[6], o[7], S8)};
          if (((i >> 3) & 1) == 0) ((GAS float*)((GAS unsigned char*)wv + (size_t)T * 128))[i >> 4] = am * (1.0f / 127.0f); }
#else
        *(GAS v4u*)((GAS bf16*)wv + i) = (v4u){pk2(o[0], o[1]), pk2(o[2], o[3]), pk2(o[4], o[5]), pk2(o[6], o[7])};
#endif
    }
}
}

#ifndef FAST_GEMM
#define FAST_GEMM 1
#endif
#ifndef FAST_ATTN
#define FAST_ATTN 1
#endif
#ifndef FAST_SELECT
#define FAST_SELECT 1
#endif
#ifndef FAST_PREP
#define FAST_PREP 1
#endif
constexpr int LDS_BYTES = 147456;
constexpr int LDS_MISC = 131072;
constexpr int NPH_L = 12, NPHASES = 1 + DEPTH * NPH_L + 1;
struct Args { Params P; int ph_lo, ph_hi; };
__global__ void __launch_bounds__(512, 2) mk_fwd(Args a) {
    extern __shared__ __attribute__((aligned(16))) unsigned char lds_raw[];
    LAS unsigned char* lds = (LAS unsigned char*)lds_raw;
    const Params& P0 = a.P;
    const int bid0 = blockIdx.x, nb = gridDim.x;
    volatile LAS unsigned* misc = (volatile LAS unsigned*)(lds + LDS_MISC);
    if (threadIdx.x < 64) misc[threadIdx.x] = 0u;
    __syncthreads();
    XcdBarrier bar = xcd_barrier_post((unsigned*)(P0.ws + WS_CTL) + 1024, misc + 8);
    const int lo = a.ph_lo, hi = a.ph_hi;
#define IN(k) (lo <= (k) && (k) < hi)
#define BAR(k) do { if (IN(k) && IN((k) + 1)) xcd_barrier(bar); } while (0)
#define PH const Params P = fresh(P0); const int bid = launder_s(bid0); unsigned char* ws = P.ws; (void)ws; (void)bid
    if (IN(0)) { PH; phase_prologue(P, bid, nb, lds); }
#if DUP_PHASE == 100
    BAR(0);
    if (IN(0)) { PH; phase_prologue(P, bid, nb, lds); }
#endif
    BAR(0);
    for (int l = 0; l < DEPTH; ++l) {
        const int pb = 1 + l * NPH_L;
        if (IN(pb + 0)) { PH; phase_norm_mix(P, l, bid, nb, lds);
#if GATE_I8 && WQ_I8 && WOUT_I8 && PROJ_I8 && H16
#elif GATE_I8 && WQ_I8 && WOUT_I8 && PROJ_I8
            quant_all_rows(P, l, bid, nb);
#else
#if GATE_I8
            quant_wgate(P, l, bid, nb);
#endif
#if WQ_I8
            quant_rows_i8((const bf16*)(ws + WS_WQ) + (size_t)l * D * D, (unsigned char*)(ws + WS_WQ8) + (size_t)l * D * D, (float*)(ws + WS_SWQ) + (size_t)l * D, D, bid, nb);
#endif
#if WOUT_I8
            quant_rows_i8((const bf16*)(ws + WS_WOUT) + (size_t)l * D * D, (unsigned char*)(ws + WS_WO8) + (size_t)l * D * D, (float*)(ws + WS_SWO) + (size_t)l * D, D, bid, nb);
#endif
#if PROJ_I8
            quant_rows_i8((const bf16*)(ws + WS_WINTM) + (size_t)l * NTM * 128 * D, (unsigned char*)(ws + WS_WIN8TM) + (size_t)l * NTM * 128 * D, (float*)(ws + WS_SWTM) + (size_t)l * NTM * 128, NTM * 128, bid, nb);
            quant_rows_i8((const bf16*)(ws + WS_WINVT) + (size_t)l * NVT * 128 * D, (unsigned char*)(ws + WS_WIN8VT) + (size_t)l * NVT * 128 * D, (float*)(ws + WS_SWVT) + (size_t)l * NVT * 128, NVT * 128, bid, nb);
#endif
#endif
        }
#if DUP_PHASE == 300
        if (IN(pb + 0)) { PH; phase_norm_mix(P, l, bid, nb, lds); }
#endif
        BAR(pb + 0);
        if (IN(pb + 1)) { PH;
            const bf16* act = (const bf16*)(ws + WS_ACT0);
            const bf16* wtm = (const bf16*)(ws + WS_WINTM) + (size_t)l * NTM * 128 * D; const bf16* wvt = (const bf16*)(ws + WS_WINVT) + (size_t)l * NVT * 128 * D;
#if FAST_GEMM
#if PROJ_I8
            pg8::Gemm g{act, (const bf16*)(ws + WS_WIN8TM + (size_t)l * NTM * 128 * D), D / 2, (const bf16*)(ws + WS_WIN8VT + (size_t)l * NVT * 128 * D), act, 64, 17}; pg8::DualOrder so{64, 17, 7, 64, nb, bid};
            pg8::EpiProjI8 e{(bf16*)(ws + WS_TM), (bf16*)(ws + WS_VT), (const float*)(ws + WS_SA), (const float*)(ws + WS_SWTM) + (size_t)l * NTM * 128, (const float*)(ws + WS_SWVT) + (size_t)l * NVT * 128};
            pg8::gemm_phase(lds, g, so, e);
#else
            pg8::Gemm g{act, wtm, D, wvt, act, 64, 17}; pg8::DualOrder so{64, 17, 7, 64, nb, bid}; pg8::EpiProj e{(bf16*)(ws + WS_TM), (bf16*)(ws + WS_VT)};
            pg8::gemm_phase(lds, g, so, e);
#endif
#if DUP_PHASE == 200
            __syncthreads(); pg8::gemm_phase(lds, g, so, e);
#endif
#else
            EpiProjTM e1{(bf16*)(ws + WS_TM)}; phase_gemm_naive(act, wtm, D, T, NTM * 128, e1, bid, nb, lds);
            EpiProjVT e2{(bf16*)(ws + WS_VT)}; phase_gemm_naive(wvt, act, D, NVT * 128, T, e2, bid, nb, lds);
#endif
        }
        BAR(pb + 1);
#if FAST_PREP
        if (IN(pb + 2)) { PH; pf::phase_prep(P, l, bid, nb, lds); }
#if DUP_PHASE == 300
        if (IN(pb + 2)) { PH; pf::phase_prep(P, l, bid, nb, lds); }
#endif
#else
        if (IN(pb + 2)) { PH; phase_prep_naive(P, l, bid, nb); }
#endif
        BAR(pb + 2);
#if FAST_ATTN
        if (IN(pb + 3)) { PH; fa::phase_attn(P, l, lds); }
#if DUP_PHASE == 3
        BAR(pb + 3);
        if (IN(pb + 3)) { PH; if (bid == 0 && TID() == 0) ((unsigned*)(P.ws + WS_CTL))[8192 + 64 * l] = 0u; }
        BAR(pb + 3);
        if (IN(pb + 3)) { PH; fa::phase_attn(P, l, lds); }
#endif
        BAR(pb + 3);
#else
        if (IN(pb + 3)) { PH; phase_attn_naive1(P, bid, nb, lds); }
        BAR(pb + 3);
        if (IN(pb + 4)) { PH; phase_attn_naive2(P, bid, nb, lds); }
#endif
#if !FAST_ATTN
        BAR(pb + 4);
#endif
        if (IN(pb + 5)) { PH; phase_ynorm(P, bid, nb); }
#if DUP_PHASE == 300
        if (IN(pb + 5)) { PH; phase_ynorm(P, bid, nb); }
#endif
        BAR(pb + 5);
        if (IN(pb + 6)) { PH;
#if FAST_GEMM
#if WOUT_I8
            pg8::Gemm g{(const bf16*)(ws + WS_ACT2), (const bf16*)(ws + WS_WO8 + (size_t)l * D * D), D / 2, nullptr, nullptr, 1 << 30, 1 << 30}; pg8::StaticOrder so; so.init(T, D, nb, bid);
#if H16
            pg8::EpiResidI8 e{l == 0 ? P.in[I_X] : nullptr, (float*)(ws + WS_H16), (const float*)(ws + WS_SY), (const float*)(ws + WS_SWO) + (size_t)l * D}; pg8::gemm_phase(lds, g, so, e); }
#else
            pg8::EpiResidI8 e{l == 0 ? P.in[I_X] : P.out, P.out, (const float*)(ws + WS_SY), (const float*)(ws + WS_SWO) + (size_t)l * D}; pg8::gemm_phase(lds, g, so, e); }
#endif
#else
            pg8::Gemm g{(const bf16*)(ws + WS_ACT2), (const bf16*)(ws + WS_WOUT) + (size_t)l * D * D, D, nullptr, nullptr, 1 << 30, 1 << 30}; pg8::StaticOrder so; so.init(T, D, nb, bid);
            pg8::EpiResidT e{l == 0 ? P.in[I_X] : P.out, P.out}; pg8::gemm_phase(lds, g, so, e); }
#endif
#else
            EpiResid e{l == 0 ? P.in[I_X] : P.out, P.out};
            phase_gemm_naive((const bf16*)(ws + WS_ACT2), (const bf16*)(ws + WS_WOUT) + (size_t)l * D * D, D, T, D, e, bid, nb, lds); }
#endif
        BAR(pb + 6);
#if H16
        if (IN(pb + 7)) { PH; phase_norm<true>(ws + WS_H16, P.in[I_LNFFN] + (size_t)l * D, nullptr, bid, nb, (unsigned char*)(ws + WS_XF8), (float*)(ws + WS_SXF)); }
#else
        if (IN(pb + 7)) { PH; phase_norm(P.out, P.in[I_LNFFN] + (size_t)l * D, (bf16*)(ws + WS_ACT0), bid, nb, WQ_I8 ? (unsigned char*)(ws + WS_XF8) : nullptr, (float*)(ws + WS_SXF)); }
#endif
#if DUP_PHASE == 300
        if (IN(pb + 7)) { PH; phase_norm(P.out, P.in[I_LNFFN] + (size_t)l * D, (bf16*)(ws + WS_ACT0), bid, nb); }
#endif
        BAR(pb + 7);
        if (IN(pb + 8)) { PH;
#if FAST_GEMM
#if WQ_I8
            { pg8::Gemm g{(const bf16*)(ws + WS_XF8), (const bf16*)(ws + WS_WQ8 + (size_t)l * D * D), D / 2, nullptr, nullptr, 1 << 30, 1 << 30}; pg8::StaticOrder so; so.init(T, D, nb, bid);
              pg8::EpiStoreI8 e{(bf16*)(ws + WS_ACT1), (const float*)(ws + WS_SXF), (const float*)(ws + WS_SWQ) + (size_t)l * D}; pg8::gemm_phase(lds, g, so, e);
#else
            { pg8::Gemm g{(const bf16*)(ws + WS_ACT0), (const bf16*)(ws + WS_WQ) + (size_t)l * D * D, D, nullptr, nullptr, 1 << 30, 1 << 30}; pg8::StaticOrder so; so.init(T, D, nb, bid);
              pg8::EpiStoreT e{(bf16*)(ws + WS_ACT1)}; pg8::gemm_phase(lds, g, so, e);
#endif
#if DUP_PHASE == 200
              __syncthreads(); pg8::gemm_phase(lds, g, so, e);
#endif
            }
            { pg8::Gemm g{(const bf16*)(ws + WS_P) + (size_t)l * T * PLE, (const bf16*)(ws + WS_WPROJ) + (size_t)l * D * PLE, PLE, nullptr, nullptr, 1 << 30, 1 << 30}; pg8::StaticOrder so; so.init(T, D, nb, bid);
              pg8::EpiStoreT e{(bf16*)(ws + WS_ACT3)}; pg8::gemm_phase(lds, g, so, e); }
#else
            EpiStoreBf16 e{(bf16*)(ws + WS_ACT1)}; phase_gemm_naive((const bf16*)(ws + WS_ACT0), (const bf16*)(ws + WS_WQ) + (size_t)l * D * D, D, T, D, e, bid, nb, lds);
            EpiStoreBf16 e2{(bf16*)(ws + WS_ACT3)}; phase_gemm_naive((const bf16*)(ws + WS_P) + (size_t)l * T * PLE, (const bf16*)(ws + WS_WPROJ) + (size_t)l * D * PLE, PLE, T, D, e2, bid, nb, lds);
#endif
        }
        BAR(pb + 8);
#if FAST_SELECT
        if (IN(pb + 9)) { PH; ps::phase_select(P, l, bid, nb, lds); }
#if DUP_PHASE == 300
        if (IN(pb + 9)) { PH; ps::phase_select(P, l, bid, nb, lds); }
#endif
#else
        if (IN(pb + 9)) { PH; phase_peer_select_naive(P, l, bid, nb, lds); }
#endif
#if DUP_PHASE == 9
        BAR(pb + 9);
        if (IN(pb + 9)) { PH; phase_peer_select_naive(P, l, bid, nb, lds); }
#endif
        BAR(pb + 9);
#if PEER_SLICED
        if (IN(pb + 10)) { PH; pz::phase_sliced<0>(P, l, lds); }
        BAR(pb + 10);
        if (IN(pb + 10)) { PH; pz::phase_weights(P, l, bid, nb); }
        BAR(pb + 10);
        if (IN(pb + 10)) { PH; pz::phase_sliced<1>(P, l, lds); }
        BAR(pb + 10);
#if GATE_I8
        if (IN(pb + 10)) { PH; phase_norm_i8<H16 != 0>(H16 ? (const void*)(ws + WS_H16) : (const void*)P.out, P.in[I_LNPLE] + (size_t)l * D, (unsigned char*)(ws + WS_ACT2), (float*)(ws + WS_SHN), bid, nb); }
#else
        if (IN(pb + 10)) { PH; phase_norm(P.out, P.in[I_LNPLE] + (size_t)l * D, (bf16*)(ws + WS_ACT2), bid, nb); }
#endif
        BAR(pb + 10);
#else
        if (IN(pb + 10)) { PH; phase_peer_apply3(P, l, bid, nb); }
        BAR(pb + 10);
#endif
        if (IN(pb + 11)) { PH;
#if FAST_GEMM
#if GATE_I8
            pg8::Gemm g{(const bf16*)(ws + WS_ACT2), (const bf16*)(ws + WS_WG8 + (size_t)l * D * D), D / 2, nullptr, nullptr, 1 << 30, 1 << 30}; pg8::StaticOrder so; so.init(T, D, nb, bid);
            pg8::EpiPleGateI8 e{H16 ? (float*)(ws + WS_H16) : P.out, (const bf16*)(ws + WS_ACT3), (const float*)(ws + WS_SHN), (const float*)(ws + WS_SWG) + (size_t)l * D}; pg8::gemm_phase(lds, g, so, e); }
#else
            pg8::Gemm g{(const bf16*)(ws + WS_ACT2), (const bf16*)(ws + WS_WGATE) + (size_t)l * D * D, D, nullptr, nullptr, 1 << 30, 1 << 30}; pg8::StaticOrder so; so.init(T, D, nb, bid);
            pg8::EpiPleGateT e{P.out, (const bf16*)(ws + WS_ACT3)}; pg8::gemm_phase(lds, g, so, e); }
#endif
#else
            EpiPleGate e{P.out, (const bf16*)(ws + WS_ACT3)};
            phase_gemm_naive((const bf16*)(ws + WS_ACT2), (const bf16*)(ws + WS_WGATE) + (size_t)l * D * D, D, T, D, e, bid, nb, lds); }
#endif
        BAR(pb + 11);
    }
#if DUP_PHASE == 400
    for (int zz = 0; zz < 20; ++zz) xcd_barrier(bar);
#endif
    if (IN(NPHASES - 1)) { PH; phase_final(P, bid, nb); }
#undef IN
#undef BAR
#undef PH
}

#ifndef MK_LAUNCHES
#define MK_LAUNCHES 1
#endif
extern "C" void kernel_launch(void* const* d_in, const int* in_sizes, int n_in, void* d_out, int out_size, void* d_ws, size_t ws_size, hipStream_t stream) {
    static int grid = 0;
    if (grid == 0) {
        if (n_in != 19 || out_size != T * D || ws_size < WS_END) { fprintf(stderr, "kernel_launch: unexpected shapes (n_in %d out %d ws %zu need %zu)\n", n_in, out_size, ws_size, (size_t)WS_END); grid = -1; return; }
        int dev = 0, cus = 0, per_cu = 0;
        if (hipGetDevice(&dev) != hipSuccess || hipDeviceGetAttribute(&cus, hipDeviceAttributeMultiprocessorCount, dev) != hipSuccess) { grid = -1; return; }
        if (hipFuncSetAttribute((const void*)mk_fwd, hipFuncAttributeMaxDynamicSharedMemorySize, LDS_BYTES) != hipSuccess) { fprintf(stderr, "kernel_launch: hipFuncSetAttribute failed\n"); grid = -1; return; }
        if (hipOccupancyMaxActiveBlocksPerMultiprocessor(&per_cu, (const void*)mk_fwd, 512, LDS_BYTES) != hipSuccess || per_cu < 1) { fprintf(stderr, "kernel_launch: occupancy query reports %d blocks per CU\n", per_cu); }
        (void)hipGetLastError();
        grid = cus;
    }
    if (grid < 0) return;
    (void)hipMemsetAsync((char*)d_ws + WS_CTL, 0, CTL_USED_BYTES, stream);
    Args a{};
    for (int i = 0; i < 19; ++i) a.P.in[i] = (const float*)d_in[i];
    a.P.out = (float*)d_out; a.P.ws = (unsigned char*)d_ws;
#if MK_LAUNCHES == 1
    a.ph_lo = 0; a.ph_hi = NPHASES;
    hipLaunchKernelGGL(mk_fwd, dim3(grid), dim3(512), LDS_BYTES, stream, a);
#else
    for (int p = 0; p < NPHASES; ++p) { a.ph_lo = p; a.ph_hi = p + 1; hipLaunchKernelGGL(mk_fwd, dim3(grid), dim3(512), LDS_BYTES, stream, a); }
#endif
}
```
